# Optimizing an MI355X kernel written in HIP

```python
import jax, jax.numpy as jnp
from jax import lax
import numpy as np

D_MODEL = 2048
BATCH = 2
SEQ = 4096
DEPTH = 2
DEC_BATCH = 2
DEC_SEQ = 16384
PAST_LEN = 128

N_MEM = 256
MLA_HEADS = 8
MLA_NOPE = 128
MLA_ROPE = 64
MLA_V = 128
Q_LORA = 512
KV_LORA = 256
HG_HEADS = 8
HG_DK = 128
HG_DV = 128
CHUNK = 64
MIX_WIDTH = MLA_HEADS * MLA_V + HG_HEADS * HG_DV
OFF_CQ = 0
OFF_CKV = OFF_CQ + Q_LORA
OFF_KR = OFF_CKV + KV_LORA
OFF_HQ = OFF_KR + MLA_ROPE
OFF_HFF = OFF_HQ + HG_HEADS * HG_DK
OFF_HFB = OFF_HFF + HG_HEADS * HG_DK
OFF_HI = OFF_HFB + HG_HEADS * HG_DK
OFF_HG = OFF_HI + HG_HEADS * HG_DV
IN_COLS = OFF_HG + HG_HEADS * HG_DV
XATTN_HEADS = 4
XATTN_DH = D_MODEL // XATTN_HEADS
D_FF = 4 * D_MODEL
Q_BLOCK = 128
ROPE_THETA = 10000.0
EPS = 1e-6

kernel_name = "hybrid_mla_hgrn2_bidir_encoder"


def rms_norm(x, g):
    xf = x.astype(jnp.float32)
    y = xf * lax.rsqrt(jnp.mean(xf * xf, axis=-1, keepdims=True) + EPS)
    return (y * g.astype(jnp.float32)).astype(x.dtype)


def apply_rope(x, seq_len):
    half = x.shape[-1] // 2
    pos = jnp.arange(seq_len, dtype=jnp.float32)
    inv_freq = ROPE_THETA ** (-jnp.arange(half, dtype=jnp.float32) / half)
    ang = pos[:, None] * inv_freq[None, :]
    cos = jnp.cos(ang)[None, :, None, :]
    sin = jnp.sin(ang)[None, :, None, :]
    xf = x.astype(jnp.float32)
    x1, x2 = xf[..., :half], xf[..., half:]
    out = jnp.concatenate([x1 * cos - x2 * sin, x2 * cos + x1 * sin], axis=-1)
    return out.astype(x.dtype)


def block_attention(q, k, v, scale):
    b, s, h, dq = q.shape
    nb = s // Q_BLOCK
    qb = q.reshape(b, nb, Q_BLOCK, h, dq).transpose(1, 0, 2, 3, 4)

    def one_block(qblk):
        sc = jnp.einsum('bqhd,bkhd->bhqk', qblk, k).astype(jnp.float32) * scale
        p = jax.nn.softmax(sc, axis=-1).astype(v.dtype)
        return jnp.einsum('bhqk,bkhd->bqhd', p, v)

    o = lax.map(one_block, qb)
    return o.transpose(1, 0, 2, 3, 4).reshape(b, s, h, v.shape[-1])


def mla_group(proj, q_norm, w_uq, kv_norm, w_ukv):
    b, s, _ = proj.shape
    c_q = proj[..., OFF_CQ:OFF_CQ + Q_LORA]
    c_kv = proj[..., OFF_CKV:OFF_CKV + KV_LORA]
    k_r = proj[..., OFF_KR:OFF_KR + MLA_ROPE]
    q = (rms_norm(c_q, q_norm) @ w_uq).reshape(b, s, MLA_HEADS, MLA_NOPE + MLA_ROPE)
    kv = (rms_norm(c_kv, kv_norm) @ w_ukv).reshape(b, s, MLA_HEADS, MLA_NOPE + MLA_V)
    q_nope, q_rope = q[..., :MLA_NOPE], q[..., MLA_NOPE:]
    k_nope, v = kv[..., :MLA_NOPE], kv[..., MLA_NOPE:]
    q_rope = apply_rope(q_rope, s)
    k_rope = apply_rope(k_r[:, :, None, :], s)
    q = jnp.concatenate([q_nope, q_rope], axis=-1)
    k = jnp.concatenate([k_nope, jnp.broadcast_to(k_rope, (b, s, MLA_HEADS, MLA_ROPE))], axis=-1)
    o = block_attention(q, k, v, (MLA_NOPE + MLA_ROPE) ** -0.5)
    return o.reshape(b, s, MLA_HEADS * MLA_V)


def hgrn_direction(q, k, v, logf):
    b, s, h, dk = q.shape
    dv = v.shape[-1]
    n = s // CHUNK

    def chunks(t):
        return t.reshape(b, n, CHUNK, h, t.shape[-1]).transpose(1, 0, 3, 2, 4)

    lower = jnp.tril(jnp.ones((CHUNK, CHUNK), dtype=bool))[None, None, :, :, None]

    def step(state, inp):
        qc, kc, vc, lc = inp
        bcum = jnp.cumsum(lc, axis=2)
        inter = jnp.einsum('bhtk,bhkv->bhtv', qc * jnp.exp(bcum), state)
        rel = bcum[:, :, :, None, :] - bcum[:, :, None, :, :]
        decay = jnp.exp(jnp.where(lower, rel, -jnp.inf))
        scores = jnp.einsum('bhtk,bhsk,bhtsk->bhts', qc, kc, decay)
        intra = jnp.einsum('bhts,bhsv->bhtv', scores, vc)
        btot = bcum[:, :, -1:, :]
        new_state = jnp.exp(btot[:, :, 0, :])[..., None] * state + jnp.einsum(
            'bhsk,bhsv->bhkv', kc * jnp.exp(btot - bcum), vc)
        return new_state, inter + intra

    init = jnp.zeros((b, h, dk, dv), jnp.float32)
    _, o = lax.scan(step, init, (chunks(q), chunks(k), chunks(v), chunks(logf)))
    return o.transpose(1, 0, 3, 2, 4).reshape(b, s, h, dv)


def hgrn2_group(proj, lb, out_norm):
    b, s, _ = proj.shape
    f32 = jnp.float32
    q = jax.nn.silu(proj[..., OFF_HQ:OFF_HFF].astype(f32)) * (HG_DK ** -0.5)
    q = q.reshape(b, s, HG_HEADS, HG_DK)
    v = proj[..., OFF_HI:OFF_HG].astype(f32).reshape(b, s, HG_HEADS, HG_DV)
    g = proj[..., OFF_HG:IN_COLS].astype(f32).reshape(b, s, HG_HEADS, HG_DV)

    def gates(z, lbd):
        z = z.astype(f32).reshape(b, s, HG_HEADS, HG_DK)
        lbd = lbd.astype(f32).reshape(HG_HEADS, HG_DK)
        logf = jnp.logaddexp(jnp.log(lbd), jnp.log1p(-lbd) + jax.nn.log_sigmoid(z))
        k = (1.0 - lbd) * jax.nn.sigmoid(-z)
        return k, logf

    k_f, lf_f = gates(proj[..., OFF_HFF:OFF_HFB], lb[0])
    k_b, lf_b = gates(proj[..., OFF_HFB:OFF_HI], lb[1])
    o_f = hgrn_direction(q, k_f, v, lf_f)
    o_b = jnp.flip(hgrn_direction(jnp.flip(q, 1), jnp.flip(k_b, 1), jnp.flip(v, 1), jnp.flip(lf_b, 1)), 1)
    o = o_f + o_b
    o = o * lax.rsqrt(jnp.mean(o * o, axis=-1, keepdims=True) + EPS) * out_norm.astype(f32)
    o = o * jax.nn.silu(g)
    return o.reshape(b, s, HG_HEADS * HG_DV).astype(proj.dtype)


def memory_cross_attention(h, m, w_xq, w_xk, w_xv, w_xo):
    b, s, _ = h.shape
    nm = m.shape[1]
    q = (h @ w_xq).reshape(b, s, XATTN_HEADS, XATTN_DH)
    k = (m @ w_xk).reshape(b, nm, XATTN_HEADS, XATTN_DH)
    v = (m @ w_xv).reshape(b, nm, XATTN_HEADS, XATTN_DH)
    sc = jnp.einsum('bqhd,bkhd->bhqk', q, k).astype(jnp.float32) * (XATTN_DH ** -0.5)
    p = jax.nn.softmax(sc, axis=-1).astype(v.dtype)
    o = jnp.einsum('bhqk,bkhd->bqhd', p, v).reshape(b, s, D_MODEL)
    return o @ w_xo


def trunk(x, mem, mix_norm, w_in, q_norm, w_uq, kv_norm, w_ukv, hgrn_lb_logits, hgrn_out_norm,
          w_out, xattn_norm, mem_norm, w_xq, w_xk, w_xv, w_xo, ffn_norm, w_ffn1, w_ffn2, final_norm):
    lb_all = jnp.cumsum(jax.nn.softmax(hgrn_lb_logits.astype(jnp.float32), axis=0), axis=0)
    lb_all = lb_all - lb_all[0:1]
    for l in range(DEPTH):
        h = rms_norm(x, mix_norm[l])
        proj = h @ w_in[l]
        a_out = mla_group(proj, q_norm[l], w_uq[l], kv_norm[l], w_ukv[l])
        b_out = hgrn2_group(proj, lb_all[l], hgrn_out_norm[l])
        x = x + jnp.concatenate([a_out, b_out], axis=-1) @ w_out[l]
        h = rms_norm(x, xattn_norm[l])
        m = rms_norm(mem, mem_norm[l])
        x = x + memory_cross_attention(h, m, w_xq[l], w_xk[l], w_xv[l], w_xo[l])
        h = rms_norm(x, ffn_norm[l])
        u = jax.nn.relu(h @ w_ffn1[l])
        x = x + (u * u) @ w_ffn2[l]
    return rms_norm(x, final_norm)


def setup_inputs(seed: int = 0) -> dict:
    key = jax.random.key(seed)
    ks = jax.random.split(key, 24)
    f32 = jnp.float32

    def w(k, shape, fan_in):
        return jax.random.normal(k, shape, f32) * (fan_in ** -0.5)

    def gain(k, shape):
        return 1.0 + 0.01 * jax.random.normal(k, shape, f32)

    return {
        'x_prompt': jax.random.normal(ks[0], (BATCH, SEQ, D_MODEL), f32),
        'x_sample': jax.random.normal(ks[1], (DEC_BATCH, DEC_SEQ, D_MODEL), f32),
        'mem_prompt': jax.random.normal(ks[2], (BATCH, N_MEM, D_MODEL), f32),
        'mem_sample': jax.random.normal(ks[3], (DEC_BATCH, N_MEM, D_MODEL), f32),
        'mix_norm': gain(ks[4], (DEPTH, D_MODEL)),
        'w_in': w(ks[5], (DEPTH, D_MODEL, IN_COLS), D_MODEL),
        'q_norm': gain(ks[6], (DEPTH, Q_LORA)),
        'w_uq': w(ks[7], (DEPTH, Q_LORA, MLA_HEADS * (MLA_NOPE + MLA_ROPE)), Q_LORA),
        'kv_norm': gain(ks[8], (DEPTH, KV_LORA)),
        'w_ukv': w(ks[9], (DEPTH, KV_LORA, MLA_HEADS * (MLA_NOPE + MLA_V)), KV_LORA),
        'hgrn_lb_logits': 0.5 * jax.random.normal(ks[10], (DEPTH, 2, HG_HEADS * HG_DK), f32),
        'hgrn_out_norm': gain(ks[11], (DEPTH, HG_DV)),
        'w_out': w(ks[12], (DEPTH, MIX_WIDTH, D_MODEL), MIX_WIDTH),
        'xattn_norm': gain(ks[13], (DEPTH, D_MODEL)),
        'mem_norm': gain(ks[14], (DEPTH, D_MODEL)),
        'w_xq': w(ks[15], (DEPTH, D_MODEL, D_MODEL), D_MODEL),
        'w_xk': w(ks[16], (DEPTH, D_MODEL, D_MODEL), D_MODEL),
        'w_xv': w(ks[17], (DEPTH, D_MODEL, D_MODEL), D_MODEL),
        'w_xo': w(ks[18], (DEPTH, D_MODEL, D_MODEL), D_MODEL),
        'ffn_norm': gain(ks[19], (DEPTH, D_MODEL)),
        'w_ffn1': w(ks[20], (DEPTH, D_MODEL, D_FF), D_MODEL),
        'w_ffn2': w(ks[21], (DEPTH, D_FF, D_MODEL), D_FF),
        'final_norm': gain(ks[22], (D_MODEL,)),
    }


def reference(x_prompt, x_sample, mem_prompt, mem_sample, mix_norm, w_in, q_norm, w_uq, kv_norm,
              w_ukv, hgrn_lb_logits, hgrn_out_norm, w_out, xattn_norm, mem_norm, w_xq, w_xk, w_xv,
              w_xo, ffn_norm, w_ffn1, w_ffn2, final_norm):
    y_prompt = trunk(x_prompt, mem_prompt, mix_norm, w_in, q_norm, w_uq, kv_norm, w_ukv,
                     hgrn_lb_logits, hgrn_out_norm, w_out, xattn_norm, mem_norm, w_xq, w_xk, w_xv,
                     w_xo, ffn_norm, w_ffn1, w_ffn2, final_norm)
    y_sample = trunk(x_sample, mem_sample, mix_norm, w_in, q_norm, w_uq, kv_norm, w_ukv,
                     hgrn_lb_logits, hgrn_out_norm, w_out, xattn_norm, mem_norm, w_xq, w_xk, w_xv,
                     w_xo, ffn_norm, w_ffn1, w_ffn2, final_norm)
    return (y_prompt, y_sample)
```

```cpp
#include <hip/hip_runtime.h>
#include <hip/hip_cooperative_groups.h>
#include <cstdio>
namespace cg = cooperative_groups;

#define LAS __attribute__((address_space(3)))
typedef unsigned short bf16_t;
typedef short bf16x8 __attribute__((ext_vector_type(8)));
typedef short s16x4 __attribute__((ext_vector_type(4)));
typedef float f32x4 __attribute__((ext_vector_type(4)));
typedef float f32x8 __attribute__((ext_vector_type(8)));
typedef float f32x16 __attribute__((ext_vector_type(16)));
typedef unsigned u32x4 __attribute__((ext_vector_type(4)));
typedef unsigned u32x2 __attribute__((ext_vector_type(2)));

#ifndef MK_ONE_LAUNCH
#define MK_ONE_LAUNCH 1
#endif

constexpr int DM = 2048, NMEM = 256, DEPTH = 2;
constexpr int INP = 6144;
constexpr int HGW = 5120;
constexpr int TMAX = 32768;
constexpr float EPS = 1e-6f;
constexpr int LDS_BYTES = 144 * 1024;
constexpr int LDS_BCAST = 140 * 1024;
constexpr int LDS_EPI = 128 * 1024;

constexpr size_t al256(size_t x) { return (x + 255) / 256 * 256; }
constexpr size_t E_W_IN = (size_t)INP * 2048, E_W_UQ = 1536 * 512, E_W_UKV = 2048 * 256, E_W_SQ = 2048 * 2048, E_W_F = (size_t)8192 * 2048;
constexpr size_t OFF_W_IN = 0;
constexpr size_t OFF_W_UQ = OFF_W_IN + E_W_IN * 2;
constexpr size_t OFF_W_UKV = OFF_W_UQ + E_W_UQ * 2;
constexpr size_t OFF_W_OUT = OFF_W_UKV + E_W_UKV * 2;
constexpr size_t OFF_W_XQ = OFF_W_OUT + E_W_SQ * 2;
constexpr size_t OFF_W_XK = OFF_W_XQ + E_W_SQ * 2;
constexpr size_t OFF_W_XV = OFF_W_XK + E_W_SQ * 2;
constexpr size_t OFF_W_XO = OFF_W_XV + E_W_SQ * 2;
constexpr size_t OFF_W_F1 = OFF_W_XO + E_W_SQ * 2;
constexpr size_t OFF_W_F2 = OFF_W_F1 + E_W_F * 2;
constexpr size_t OFF_XB = OFF_W_F2 + E_W_F * 2;
constexpr size_t OFF_CQ = OFF_XB + (size_t)TMAX * 2048 * 2;
constexpr size_t OFF_KR = OFF_CQ + (size_t)TMAX * 768 * 2;
constexpr size_t OFF_KROPE = OFF_KR + (size_t)TMAX * 64 * 2;
constexpr size_t OFF_MIX = OFF_KROPE + (size_t)TMAX * 64 * 2;
constexpr size_t OFF_HG = OFF_MIX + (size_t)TMAX * 2048 * 2;
constexpr size_t OFF_Q = OFF_HG + (size_t)TMAX * HGW * 2;
constexpr size_t OFF_KV = OFF_Q + (size_t)TMAX * 1536 * 2;
constexpr size_t OFF_MEMN = OFF_KV + (size_t)TMAX * 2048 * 2;
constexpr size_t OFF_KMEM = OFF_MEMN + (size_t)512 * 2048 * 2;
constexpr size_t OFF_VT = OFF_KMEM + (size_t)512 * 2048 * 2;
constexpr size_t OFF_ROPE = OFF_VT + (size_t)512 * 2048 * 2;
constexpr size_t OFF_SSQ = OFF_ROPE + (size_t)16384 * 32 * 4 * 2;
constexpr size_t OFF_CTR = OFF_SSQ + (size_t)11 * TMAX * 8;
constexpr size_t WS_END = OFF_CTR + 256;
constexpr size_t OFF_XQ = OFF_Q;
constexpr size_t OFF_PBUF = OFF_MIX;
constexpr size_t OFF_OBUF = OFF_HG;
constexpr size_t OFF_U = OFF_HG;
static_assert((size_t)TMAX * 8192 * 2 <= OFF_MEMN - OFF_HG, "u must fit");

struct Params {
    const float* x_in[2]; const float* mem_in[2];
    const float *mix_norm, *w_in, *q_norm, *w_uq, *kv_norm, *w_ukv, *lb_logits, *out_norm, *w_out, *xattn_norm, *mem_norm, *w_xq, *w_xk, *w_xv, *w_xo,
        *ffn_norm, *w_ffn1, *w_ffn2, *final_norm;
    float* out; char* ws;
};

__device__ __forceinline__ int ltid() { int t = threadIdx.x; asm volatile("" : "+v"(t)); return t; }
__device__ __forceinline__ int lbid() { int t = blockIdx.x; asm volatile("" : "+s"(t)); return t; }
__device__ __forceinline__ float bf2f(bf16_t b) { return __uint_as_float(((unsigned)b) << 16); }
__device__ __forceinline__ bf16_t f2bf(float f) { unsigned u = __float_as_uint(f); u += 0x7FFFu + ((u >> 16) & 1u); return (bf16_t)(u >> 16); }
__device__ __forceinline__ unsigned cvtpk(float lo, float hi) { unsigned r; asm volatile("v_cvt_pk_bf16_f32 %0, %1, %2" : "=v"(r) : "v"(lo), "v"(hi)); return r; }
__device__ __forceinline__ void wg_barrier() { asm volatile("s_waitcnt vmcnt(0) lgkmcnt(0)" ::: "memory"); __builtin_amdgcn_s_barrier(); asm volatile("" ::: "memory"); }
typedef unsigned long long ssq_t;
__device__ __forceinline__ ssq_t ssq_fix(float v) { return (ssq_t)(v * 16777216.f + 0.5f); }
__device__ __forceinline__ float ssq_val(ssq_t v) { return (float)v * (1.f / 16777216.f); }
__device__ __forceinline__ void atomic_addf(ssq_t* p, float v) { __hip_atomic_fetch_add(p, ssq_fix(v), __ATOMIC_RELAXED, __HIP_MEMORY_SCOPE_AGENT); }

namespace pg8 {
constexpr int BM = 256, BK = 64, HALF = 128, HTB = HALF * BK * 2, NXCD = 8, WGM = 8;
__host__ __device__ __forceinline__ int lds_byte(int r, int c) { const int st = (r >> 4) * 2 + (c >> 5), rr = r & 15, cc = c & 31, ob = rr * 64 + cc * 2; return st * 1024 + (ob ^ (((ob >> 9) & 1) << 5)); }
__host__ __device__ __forceinline__ void stage_rc(int b, int& R, int& C) { const int st = b / 1024, sb = b % 1024, swz = sb ^ (((sb >> 9) & 1) << 5); R = (st >> 1) * 16 + swz / 64; C = (st & 1) * 32 + (swz % 64) / 2; }
__host__ __device__ __forceinline__ int perm32(int rho) { const int n = rho >> 4, i = rho & 15; return 8 * (i >> 2) + 4 * n + (i & 3); }
}
enum { E_BF16 = 0, E_INPROJ = 1, E_RESID = 2, E_SOFTMAX = 3 };
struct GemmDesc {
    const char* A; const char* B; int lda, ldb, K, nM, nN, nZ;
    int azs, bzs, bbs, tpb;
    int epi, perm;
    bf16_t* out; long ozs; int ldo;
    const ssq_t* ssq_in; float inv_dim; int relu2;
    ssq_t* ssq_out; ssq_t* ssq_out2;
    const float* resid; float* xout; bf16_t* xb;
    bf16_t* out2; bf16_t* out3;
};
struct Unit { int pm, pn, z; const char* a; const char* b; };

__device__ __forceinline__ bool make_gemm(const Params& p, int tr, int l, int k, int i, GemmDesc& g);
__device__ __forceinline__ const Params* launder_p(const Params* q) { asm volatile("" : "+s"(q)); return q; }
__device__ __forceinline__ int launder_i(int v) { asm volatile("" : "+s"(v)); return v; }
__device__ __forceinline__ bool next_unit(const Params* kp, int tr, int l, int k, int gi, int i, int G, int c, Unit& u) {
    GemmDesc g; make_gemm(*launder_p(kp), launder_i(tr), launder_i(l), launder_i(k), launder_i(gi), g);
    const int L = i * G + c; const int per = g.nM * g.nN;
    if (L >= per * g.nZ) return false;
    const int z = L / per; int wgid = L - z * per;
    { const int q = per / pg8::NXCD, r = per % pg8::NXCD, xcd = wgid % pg8::NXCD, off = wgid / pg8::NXCD; wgid = (xcd < r ? xcd * (q + 1) : r * (q + 1) + (xcd - r) * q) + off; }
    const int nig = pg8::WGM * g.nN, gid = wgid / nig, fm = gid * pg8::WGM, gsz = (g.nM - fm) < pg8::WGM ? (g.nM - fm) : pg8::WGM;
    u.pm = fm + ((wgid % nig) % gsz); u.pn = (wgid % nig) / gsz; u.z = z;
    const unsigned ao = (unsigned)z * (unsigned)g.azs + (unsigned)u.pm * (unsigned)(512 * g.lda);
    const unsigned bo = (unsigned)z * (unsigned)g.bzs + (unsigned)u.pn * (unsigned)(512 * g.ldb) + (g.tpb ? (unsigned)(u.pm / g.tpb) * (unsigned)g.bbs : 0u);
    u.a = g.A + (size_t)ao; u.b = g.B + (size_t)bo;
    return true;
}

template <int EPI> __device__ __forceinline__ void gemm_epilogue(const Params* kp, int tr, int l, int k, int gi, f32x4 (&acc)[2][2][4][2], const Unit& u, LAS unsigned char* lds) {
    const int tid_e = ltid(), wid_e = tid_e >> 6, lane_e = tid_e & 63, wr = wid_e >> 2, wc = wid_e & 3, fr = lane_e & 15, fq = lane_e >> 4;
    GemmDesc g; make_gemm(*launder_p(kp), launder_i(tr), launder_i(l), launder_i(k), launder_i(gi), g);
    const int row0 = u.pm * 256 + wr * 64 + fr;
    if constexpr (EPI == E_BF16) {
        const int col0 = u.pn * 256 + wc * 32 + 8 * fq;
#pragma unroll
        for (int ai = 0; ai < 2; ++ai)
#pragma unroll
            for (int m = 0; m < 4; ++m) {
                __builtin_amdgcn_sched_barrier(0);
                const int row = row0 + ai * 128 + m * 16;
                const float rs = g.ssq_in ? __builtin_amdgcn_rsqf(ssq_val(g.ssq_in[row]) * g.inv_dim + EPS) : 1.0f;
                bf16_t* rowp = g.out + (long)u.z * g.ozs + (long)row * g.ldo + col0;
#pragma unroll
                for (int bj = 0; bj < 2; ++bj) {
                    f32x4 v0 = acc[ai][bj][m][0] * rs, v1 = acc[ai][bj][m][1] * rs;
                    if (g.relu2) {
#pragma unroll
                        for (int j = 0; j < 4; ++j) { float a = fmaxf(v0[j], 0.f), b = fmaxf(v1[j], 0.f); v0[j] = a * a; v1[j] = b * b; }
                    }
                    u32x4 w; w.x = cvtpk(v0[0], v0[1]); w.y = cvtpk(v0[2], v0[3]); w.z = cvtpk(v1[0], v1[1]); w.w = cvtpk(v1[2], v1[3]);
                    *(u32x4*)(rowp + bj * 128) = w;
                }
            }
    } else if constexpr (EPI == E_INPROJ) {
        const int lc0 = wc * 32 + 8 * fq;
        const int pn = u.pn;
#pragma unroll
        for (int ai = 0; ai < 2; ++ai)
#pragma unroll
            for (int m = 0; m < 4; ++m) {
                __builtin_amdgcn_sched_barrier(0);
                const int row = row0 + ai * 128 + m * 16;
                const float rs = __builtin_amdgcn_rsqf(ssq_val(g.ssq_in[row]) * g.inv_dim + EPS);
                float ss = 0.f;
#pragma unroll
                for (int bj = 0; bj < 2; ++bj) {
                    const f32x4 v0 = acc[ai][bj][m][0] * rs, v1 = acc[ai][bj][m][1] * rs;
                    u32x4 w; w.x = cvtpk(v0[0], v0[1]); w.y = cvtpk(v0[2], v0[3]); w.z = cvtpk(v1[0], v1[1]); w.w = cvtpk(v1[2], v1[3]);
                    const int lc = lc0 + bj * 128;
                    if (pn < 3) {
                        *(u32x4*)(g.out + (long)row * 768 + pn * 256 + lc) = w;
                        ss += (v0[0] * v0[0] + v0[1] * v0[1]) + (v0[2] * v0[2] + v0[3] * v0[3]) + (v1[0] * v1[0] + v1[1] * v1[1]) + (v1[2] * v1[2] + v1[3] * v1[3]);
                    } else if (pn == 3) {
                        if (lc < 64) *(u32x4*)(g.out2 + (long)row * 64 + lc) = w;
                    } else {
                        *(u32x4*)(g.out3 + (long)row * HGW + (pn - 4) * 256 + lc) = w;
                    }
                }
                if (pn < 3) {
                    ss += __shfl_xor(ss, 16); ss += __shfl_xor(ss, 32);
                    if (fq == 0) atomic_addf((pn < 2 ? g.ssq_out : g.ssq_out2) + row, ss);
                }
            }
    } else if constexpr (EPI == E_RESID) {
        const int col0 = u.pn * 256 + wc * 32 + 4 * fq;
#pragma unroll
        for (int ai = 0; ai < 2; ++ai)
#pragma unroll
            for (int m = 0; m < 4; ++m) {
                __builtin_amdgcn_sched_barrier(0);
                const int row = row0 + ai * 128 + m * 16;
                float ss = 0.f;
#pragma unroll
                for (int bj = 0; bj < 2; ++bj)
#pragma unroll
                    for (int n = 0; n < 2; ++n) {
                        const long o = (long)row * DM + col0 + bj * 128 + n * 16;
                        const f32x4 v = *(const f32x4*)(g.resid + o) + acc[ai][bj][m][n];
                        *(f32x4*)(g.xout + o) = v;
                        u32x2 w; w.x = cvtpk(v[0], v[1]); w.y = cvtpk(v[2], v[3]);
                        *(u32x2*)(g.xb + o) = w;
                        ss += (v[0] * v[0] + v[1] * v[1]) + (v[2] * v[2] + v[3] * v[3]);
                    }
                ss += __shfl_xor(ss, 16); ss += __shfl_xor(ss, 32);
                if (fq == 0) atomic_addf(g.ssq_out + row, ss);
            }
    } else {
        LAS float* smax = (LAS float*)(lds + LDS_EPI);
        LAS float* ssum = (LAS float*)(lds + LDS_EPI + 4096);
        const float C = 0.044194173824159216f * 1.4426950408889634f;
#pragma unroll
        for (int ai = 0; ai < 2; ++ai)
#pragma unroll
            for (int m = 0; m < 4; ++m) {
                __builtin_amdgcn_sched_barrier(0);
                float t = -3.0e38f;
#pragma unroll
                for (int bj = 0; bj < 2; ++bj)
#pragma unroll
                    for (int n = 0; n < 2; ++n)
#pragma unroll
                        for (int j = 0; j < 4; ++j) t = fmaxf(t, acc[ai][bj][m][n][j]);
                t = fmaxf(t, __shfl_xor(t, 16)); t = fmaxf(t, __shfl_xor(t, 32));
                if (fq == 0) smax[(ai * 128 + wr * 64 + m * 16 + fr) * 4 + wc] = t;
            }
        asm volatile("s_waitcnt lgkmcnt(0)" ::: "memory"); __builtin_amdgcn_s_barrier(); asm volatile("" ::: "memory");
#pragma unroll
        for (int ai = 0; ai < 2; ++ai)
#pragma unroll
            for (int m = 0; m < 4; ++m) {
                __builtin_amdgcn_sched_barrier(0);
                const int rl = ai * 128 + wr * 64 + m * 16 + fr;
                const f32x4 q = *(LAS f32x4*)(smax + rl * 4);
                const float mm = fmaxf(fmaxf(q[0], q[1]), fmaxf(q[2], q[3])) * C;
                float s = 0.f;
#pragma unroll
                for (int bj = 0; bj < 2; ++bj)
#pragma unroll
                    for (int n = 0; n < 2; ++n)
#pragma unroll
                        for (int j = 0; j < 4; ++j) { const float e = __builtin_amdgcn_exp2f(acc[ai][bj][m][n][j] * C - mm); acc[ai][bj][m][n][j] = e; s += e; }
                s += __shfl_xor(s, 16); s += __shfl_xor(s, 32);
                if (fq == 0) ssum[rl * 4 + wc] = s;
            }
        asm volatile("s_waitcnt lgkmcnt(0)" ::: "memory"); __builtin_amdgcn_s_barrier(); asm volatile("" ::: "memory");
        const int col0 = wc * 32 + 8 * fq;
#pragma unroll
        for (int ai = 0; ai < 2; ++ai)
#pragma unroll
            for (int m = 0; m < 4; ++m) {
                __builtin_amdgcn_sched_barrier(0);
                const int rl = ai * 128 + wr * 64 + m * 16 + fr;
                const f32x4 q = *(LAS f32x4*)(ssum + rl * 4);
                const float inv = 1.0f / ((q[0] + q[1]) + (q[2] + q[3]));
                bf16_t* rowp = g.out + (long)(u.pm * 256 + rl) * g.ldo + u.z * 256 + col0;
#pragma unroll
                for (int bj = 0; bj < 2; ++bj) {
                    const f32x4 v0 = acc[ai][bj][m][0] * inv, v1 = acc[ai][bj][m][1] * inv;
                    u32x4 w; w.x = cvtpk(v0[0], v0[1]); w.y = cvtpk(v0[2], v0[3]); w.z = cvtpk(v1[0], v1[1]); w.w = cvtpk(v1[2], v1[3]);
                    *(u32x4*)(rowp + bj * 128) = w;
                }
            }
    }
}

template <int EPI> __device__ __forceinline__ void gemm_phase(LAS unsigned char* lds, const Params* kp, int tr, int l, int k, int gi) {
    using namespace pg8;
    int Kdim, lda_, ldb_, perm_;
    { GemmDesc g0; if (!make_gemm(*kp, tr, l, k, gi, g0)) return; Kdim = g0.K; lda_ = g0.lda; ldb_ = g0.ldb; perm_ = g0.perm; }
    const int tid = ltid(), wid = __builtin_amdgcn_readfirstlane(tid >> 6), lane = tid & 63, wr = wid >> 2, wc = wid & 3, fr = lane & 15, fq = lane >> 4;
    const int K = Kdim, nt = K / BK; const int G = gridDim.x, cblk = lbid();
    unsigned voffA[2], voffB[2];
#pragma unroll
    for (int i = 0; i < 2; ++i) { int R, C; stage_rc(tid * 16 + i * 8192, R, C); const int Rb = perm_ ? ((R & ~31) + perm32(R & 31)) : R;
        voffA[i] = (unsigned)(R * lda_ + C) * 2u; voffB[i] = (unsigned)(Rb * ldb_ + C) * 2u; }
    const size_t kstep = (size_t)(BK * 2);
    const size_t hstepA = (size_t)HALF * lda_ * 2, hstepB = (size_t)HALF * ldb_ * 2;
    const unsigned ldsw = (unsigned)wid * 1024u;
    const int aoff = lds_byte(wr * 64 + fr, fq * 8), boff = lds_byte(wc * 32 + fr, fq * 8);
#define PG8_SA(b, h) (((b) * 2 + (h)) * HTB)
#define PG8_SB(b, h) ((4 + (b) * 2 + (h)) * HTB)
#define PG8_STAGE(bufoff, gbase, voff) do { _Pragma("unroll") for (int _i = 0; _i < 2; ++_i) \
        __builtin_amdgcn_global_load_lds((const unsigned*)((const char*)(gbase) + (voff)[_i]), (LAS unsigned*)(lds + (bufoff) + ldsw + _i * 8192), 16, 0, 0); } while (0)
#define PG8_LDA(dst, b, h) do { _Pragma("unroll") for (int m = 0; m < 4; ++m) _Pragma("unroll") for (int k = 0; k < 2; ++k) dst[m][k] = *(const LAS bf16x8*)(lds + PG8_SA(b, h) + aoff + m * 2048 + k * 1024); } while (0)
#define PG8_LDB(dst, b, h) do { _Pragma("unroll") for (int n = 0; n < 2; ++n) _Pragma("unroll") for (int k = 0; k < 2; ++k) dst[n][k] = *(const LAS bf16x8*)(lds + PG8_SB(b, h) + boff + n * 2048 + k * 1024); } while (0)
#define PG8_MMA(ai, bj, At, Bt) do { __builtin_amdgcn_s_setprio(1); _Pragma("unroll") for (int m = 0; m < 4; ++m) _Pragma("unroll") for (int n = 0; n < 2; ++n) _Pragma("unroll") for (int k = 0; k < 2; ++k) \
        acc[ai][bj][m][n] = __builtin_amdgcn_mfma_f32_16x16x32_bf16(Bt[n][k], At[m][k], acc[ai][bj][m][n], 0, 0, 0); __builtin_amdgcn_s_setprio(0); } while (0)
#define PG8_WAIT_V(n) asm volatile("s_waitcnt vmcnt(" #n ")" ::: "memory")
#define PG8_WAIT_L(n) asm volatile("s_waitcnt lgkmcnt(" #n ")" ::: "memory")
#define PG8_BAR __builtin_amdgcn_s_barrier()
#define PG8_SCHED __builtin_amdgcn_sched_barrier(0)
    Unit cur, nxt; int ui = 0;
    if (!next_unit(kp, tr, l, k, gi, 0, G, cblk, cur)) return;
    f32x4 acc[2][2][4][2];
#pragma unroll
    for (int a = 0; a < 2; ++a)
#pragma unroll
        for (int b = 0; b < 2; ++b)
#pragma unroll
            for (int m = 0; m < 4; ++m)
#pragma unroll
                for (int n = 0; n < 2; ++n) acc[a][b][m][n] = (f32x4){0.f, 0.f, 0.f, 0.f};
    bf16x8 At[4][2], B0[2][2], B1[2][2];
    const char* cA = cur.a; const char* cB = cur.b;
    PG8_STAGE(PG8_SB(0, 0), cB, voffB); PG8_STAGE(PG8_SA(0, 0), cA, voffA); PG8_STAGE(PG8_SB(0, 1), cB + hstepB, voffB); PG8_STAGE(PG8_SA(0, 1), cA + hstepA, voffA);
    if (wr == 1) PG8_BAR;
    PG8_WAIT_V(4); PG8_BAR;
    PG8_STAGE(PG8_SB(1, 0), cB + kstep, voffB); PG8_STAGE(PG8_SA(1, 0), cA + kstep, voffA); PG8_STAGE(PG8_SB(1, 1), cB + hstepB + kstep, voffB);
    PG8_WAIT_V(6); PG8_BAR;
    for (;;) {
        const bool has_next = next_unit(kp, tr, l, k, gi, ui + 1, G, cblk, nxt);
        const char* nA = has_next ? nxt.a : cA; const char* nB = has_next ? nxt.b : cB;
        for (int t = 0; t < nt; t += 2) {
            const bool last = (t == nt - 2);
            const char* a1 = cA + (size_t)(t + 1) * kstep;
            const char* a2 = last ? nA : cA + (size_t)(t + 2) * kstep; const char* b2 = last ? nB : cB + (size_t)(t + 2) * kstep;
            const char* a3 = a2 + kstep; const char* b3 = b2 + kstep;
            PG8_LDB(B0, 0, 0); PG8_SCHED; PG8_LDA(At, 0, 0); PG8_STAGE(PG8_SA(1, 1), a1 + hstepA, voffA);
            PG8_WAIT_L(8); PG8_BAR; PG8_WAIT_L(0); PG8_MMA(0, 0, At, B0); PG8_BAR; PG8_SCHED;
            PG8_LDB(B1, 0, 1); PG8_STAGE(PG8_SB(0, 0), b2, voffB);
            PG8_BAR; PG8_WAIT_L(0); PG8_MMA(0, 1, At, B1); PG8_BAR;
            PG8_LDA(At, 0, 1); PG8_STAGE(PG8_SA(0, 0), a2, voffA);
            PG8_BAR; PG8_WAIT_L(0); PG8_MMA(1, 0, At, B0); PG8_BAR; PG8_SCHED;
            PG8_STAGE(PG8_SB(0, 1), b2 + hstepB, voffB);
            PG8_WAIT_V(6); PG8_BAR; PG8_MMA(1, 1, At, B1); PG8_BAR;
            PG8_LDB(B0, 1, 0); PG8_SCHED; PG8_LDA(At, 1, 0); PG8_STAGE(PG8_SA(0, 1), a2 + hstepA, voffA);
            PG8_WAIT_L(8); PG8_BAR; PG8_WAIT_L(0); PG8_MMA(0, 0, At, B0); PG8_BAR; PG8_SCHED;
            PG8_LDB(B1, 1, 1); PG8_STAGE(PG8_SB(1, 0), b3, voffB);
            PG8_BAR; PG8_WAIT_L(0); PG8_MMA(0, 1, At, B1); PG8_BAR;
            PG8_LDA(At, 1, 1); PG8_STAGE(PG8_SA(1, 0), a3, voffA);
            PG8_BAR; PG8_WAIT_L(0); PG8_MMA(1, 0, At, B0); PG8_BAR; PG8_SCHED;
            PG8_STAGE(PG8_SB(1, 1), b3 + hstepB, voffB);
            PG8_WAIT_V(6); PG8_BAR; PG8_MMA(1, 1, At, B1); PG8_BAR;
        }
        gemm_epilogue<EPI>(kp, tr, l, k, gi, acc, cur, lds);
        if (!has_next) break;
#pragma unroll
        for (int a = 0; a < 2; ++a)
#pragma unroll
            for (int b = 0; b < 2; ++b)
#pragma unroll
                for (int m = 0; m < 4; ++m)
#pragma unroll
                    for (int n = 0; n < 2; ++n) acc[a][b][m][n] = (f32x4){0.f, 0.f, 0.f, 0.f};
        cur = nxt; cA = nA; cB = nB; ++ui;
    }
    PG8_WAIT_V(0);
    if (wr == 0) PG8_BAR;
    PG8_BAR;
#undef PG8_SA
#undef PG8_SB
#undef PG8_STAGE
#undef PG8_LDA
#undef PG8_LDB
#undef PG8_MMA
#undef PG8_WAIT_V
#undef PG8_WAIT_L
#undef PG8_BAR
#undef PG8_SCHED
}

namespace att {
constexpr int NW = 8, QBLK = 32, KVBLK = 64;
constexpr float SCALE = 0.07216878364870322f;
constexpr float THR = 8.f;
constexpr int LDQ = 1536, LDK = 2048, LDKR = 64, LDO = 2048;
constexpr int SHM_V = KVBLK * 128 * 2, SHM_K = KVBLK * 128 * 2, SHM_KR = KVBLK * 64 * 2;
#define KSWZ(row, colB) ((row) * 256 + ((colB) ^ (((row) & 7) << 4)))
#define KRSWZ(row, colB) ((row) * 128 + ((colB) ^ (((row) & 7) << 4)))
#define SBAR() __builtin_amdgcn_sched_barrier(0)
__device__ __forceinline__ int crow(int r, int hi) { return (r & 3) + 8 * (r >> 2) + 4 * hi; }
__device__ __forceinline__ void partialSM(f32x16& p0, f32x16& p1, float& m_reg, float& mn, float& alpha) {
    constexpr float C = SCALE * 1.4426950408889634f;
    float pmax = p0[0];
#pragma unroll
    for (int r = 1; r < 16; ++r) pmax = fmaxf(pmax, p0[r]);
#pragma unroll
    for (int r = 0; r < 16; ++r) pmax = fmaxf(pmax, p1[r]);
    { auto rr = __builtin_amdgcn_permlane32_swap(__float_as_uint(pmax), __float_as_uint(pmax), false, false);
      pmax = fmaxf(__uint_as_float(rr[0]), __uint_as_float(rr[1])); }
    if (__builtin_expect(__all(pmax - m_reg <= THR / SCALE), 1)) { mn = m_reg; alpha = 1.f; }
    else { mn = fmaxf(m_reg, pmax); alpha = __builtin_amdgcn_exp2f((m_reg - mn) * C); m_reg = mn; }
    float mnC = -mn * C;
#pragma unroll
    for (int r = 0; r < 16; ++r) p0[r] = fmaf(p0[r], C, mnC);
#pragma unroll
    for (int r = 0; r < 16; ++r) p1[r] = fmaf(p1[r], C, mnC);
#pragma unroll
    for (int r = 0; r < 16; ++r) p0[r] = __builtin_amdgcn_exp2f(p0[r]);
}
__device__ __forceinline__ void finishSM(f32x16& p0, f32x16& p1, float alpha, float& l_reg, bf16x8& pa0, bf16x8& pa1, bf16x8& pa2, bf16x8& pa3) {
#pragma unroll
    for (int r = 0; r < 16; ++r) p1[r] = __builtin_amdgcn_exp2f(p1[r]);
    float ps = 0;
#pragma unroll
    for (int r = 0; r < 16; ++r) ps += p0[r];
#pragma unroll
    for (int r = 0; r < 16; ++r) ps += p1[r];
    { auto rr = __builtin_amdgcn_permlane32_swap(__float_as_uint(ps), __float_as_uint(ps), false, false);
      ps = __uint_as_float(rr[0]) + __uint_as_float(rr[1]); }
    l_reg = l_reg * alpha + ps;
#define PK4(P, BASE, OUT) do { unsigned a0 = cvtpk(P[BASE + 0], P[BASE + 1]), a1 = cvtpk(P[BASE + 2], P[BASE + 3]);   \
    unsigned b0 = cvtpk(P[BASE + 4], P[BASE + 5]), b1 = cvtpk(P[BASE + 6], P[BASE + 7]);                              \
    auto r0 = __builtin_amdgcn_permlane32_swap(a0, b0, false, false); auto r1 = __builtin_amdgcn_permlane32_swap(a1, b1, false, false); \
    u32x4 w = {r0[0], r1[0], r0[1], r1[1]}; OUT = *reinterpret_cast<bf16x8*>(&w); } while (0)
    PK4(p0, 0, pa0); PK4(p0, 8, pa1); PK4(p1, 0, pa2); PK4(p1, 8, pa3);
#undef PK4
}
__device__ __forceinline__ void qkt(f32x16& p0, f32x16& p1, const char* Ks, const char* Krs, const bf16x8* qr, const char* qrl, int r32, int hi) {
    p0 = f32x16{}; p1 = f32x16{};
#pragma unroll
    for (int d0 = 0; d0 < 8; ++d0) { int cb = (d0 * 16 + hi * 8) * 2;
        bf16x8 b0 = *reinterpret_cast<const bf16x8*>(Ks + KSWZ(r32, cb));
        bf16x8 b1 = *reinterpret_cast<const bf16x8*>(Ks + KSWZ(32 + r32, cb));
        p0 = __builtin_amdgcn_mfma_f32_32x32x16_bf16(b0, qr[d0], p0, 0, 0, 0);
        p1 = __builtin_amdgcn_mfma_f32_32x32x16_bf16(b1, qr[d0], p1, 0, 0, 0); }
#pragma unroll
    for (int d0 = 0; d0 < 4; ++d0) { int cb = (d0 * 16 + hi * 8) * 2;
        bf16x8 b0 = *reinterpret_cast<const bf16x8*>(Krs + KRSWZ(r32, cb));
        bf16x8 b1 = *reinterpret_cast<const bf16x8*>(Krs + KRSWZ(32 + r32, cb));
        const bf16x8 qv = *reinterpret_cast<const bf16x8*>(qrl + d0 * 8192);
        p0 = __builtin_amdgcn_mfma_f32_32x32x16_bf16(b0, qv, p0, 0, 0, 0);
        p1 = __builtin_amdgcn_mfma_f32_32x32x16_bf16(b1, qv, p1, 0, 0, 0); }
}
__device__ __forceinline__ int v_st(int k, int c) { const int kk = (k & ~0xC) | ((k & 4) << 1) | ((k & 8) >> 1); return ((kk >> 3) * 4 + (c >> 5)) * 512 + ((kk & 7) * 32 + (c & 31)) * 2; }
__device__ __forceinline__ int v_rd_base(int lane) { return ((lane & 3) << 3) | (((lane >> 2) & 3) << 6) | (((lane >> 4) & 1) << 5) | (((lane >> 5) & 1) << 8); }
constexpr int v_rd_off(int d0, int ks, int half) { return d0 * 512 + ks * 4096 + half * 2048; }
template <int OFF> __device__ __forceinline__ s16x4 tr_read(int vb) {
    s16x4 r; asm volatile("ds_read_b64_tr_b16 %0, %1 offset:%2" : "=&v"(r) : "v"(vb), "i"(OFF) : "memory"); return r;
}
template <int D0> __device__ __forceinline__ void pv_one(f32x16& od, int vb, bf16x8 pa0, bf16x8 pa1, bf16x8 pa2, bf16x8 pa3) {
    const s16x4 l0 = tr_read<v_rd_off(D0, 0, 0)>(vb), h0 = tr_read<v_rd_off(D0, 0, 1)>(vb), l1 = tr_read<v_rd_off(D0, 1, 0)>(vb), h1 = tr_read<v_rd_off(D0, 1, 1)>(vb);
    const s16x4 l2 = tr_read<v_rd_off(D0, 2, 0)>(vb), h2 = tr_read<v_rd_off(D0, 2, 1)>(vb), l3 = tr_read<v_rd_off(D0, 3, 0)>(vb), h3 = tr_read<v_rd_off(D0, 3, 1)>(vb);
    asm volatile("s_waitcnt lgkmcnt(0)" ::: "memory"); SBAR();
#define PK(L, H) (bf16x8){L[0], L[1], L[2], L[3], H[0], H[1], H[2], H[3]}
    od = __builtin_amdgcn_mfma_f32_32x32x16_bf16(pa0, PK(l0, h0), od, 0, 0, 0);
    od = __builtin_amdgcn_mfma_f32_32x32x16_bf16(pa1, PK(l1, h1), od, 0, 0, 0);
    od = __builtin_amdgcn_mfma_f32_32x32x16_bf16(pa2, PK(l2, h2), od, 0, 0, 0);
    od = __builtin_amdgcn_mfma_f32_32x32x16_bf16(pa3, PK(l3, h3), od, 0, 0, 0);
#undef PK
}
__device__ __forceinline__ void pv_d0(f32x16* o, int vb, bf16x8 pa0, bf16x8 pa1, bf16x8 pa2, bf16x8 pa3) {
    pv_one<0>(o[0], vb, pa0, pa1, pa2, pa3); pv_one<1>(o[1], vb, pa0, pa1, pa2, pa3); pv_one<2>(o[2], vb, pa0, pa1, pa2, pa3); pv_one<3>(o[3], vb, pa0, pa1, pa2, pa3);
}

__device__ __forceinline__ void attn_body(const bf16_t* __restrict__ Qb, const bf16_t* __restrict__ Kh, const bf16_t* __restrict__ Vh, const bf16_t* __restrict__ Kr,
                                          bf16_t* __restrict__ Ob, int seq, char* lds) {
    const int tid = ltid(), wid = tid >> 6, lane = tid & 63, r32 = lane & 31, hi = lane >> 5;
    char* V_lds = lds; char* K_lds = lds + 2 * SHM_V; char* KR_lds = lds + 2 * SHM_V + 2 * SHM_K;
    float* ws = (float*)(lds + 2 * SHM_V + 2 * SHM_K + 2 * SHM_KR) + wid * 64; float* li_l = ws; float* al_l = ws + 32;
    float m_reg = -1e30f, l_reg = 0; f32x16 o[4] = {}; bf16x8 qr[8];
    const bf16_t* Qw = Qb + (long)(wid * QBLK + r32) * LDQ + hi * 8;
#pragma unroll
    for (int d0 = 0; d0 < 8; ++d0) qr[d0] = *reinterpret_cast<const bf16x8*>(Qw + d0 * 16);
    char* qrl = lds + 84 * 1024 + tid * 16;
#pragma unroll
    for (int d0 = 0; d0 < 4; ++d0) *reinterpret_cast<bf16x8*>(qrl + d0 * 8192) = *reinterpret_cast<const bf16x8*>(Qw + (8 + d0) * 16);
    const int sr = tid >> 4, sc = (tid & 15) * 8, vst0 = v_st(sr, sc), vst1 = v_st(32 + sr, sc);
    const int krr = tid >> 3, krc = (tid & 7) * 8;
    const int vb0 = (int)(uintptr_t)V_lds + v_rd_base(lane);
    bf16x8 s_vs0, s_vs1, s_ks0, s_ks1, s_kr;
#define SLOAD(k0) do { s_vs0 = *reinterpret_cast<const bf16x8*>(&Vh[(long)((k0) + sr) * LDK + sc]); s_vs1 = *reinterpret_cast<const bf16x8*>(&Vh[(long)((k0) + 32 + sr) * LDK + sc]); \
    s_ks0 = *reinterpret_cast<const bf16x8*>(&Kh[(long)((k0) + sr) * LDK + sc]); s_ks1 = *reinterpret_cast<const bf16x8*>(&Kh[(long)((k0) + 32 + sr) * LDK + sc]); \
    s_kr = *reinterpret_cast<const bf16x8*>(&Kr[(long)((k0) + krr) * LDKR + krc]); } while (0)
#define SWRITE(b) do { *(bf16x8*)(V_lds + (b) * SHM_V + vst0) = s_vs0; *(bf16x8*)(V_lds + (b) * SHM_V + vst1) = s_vs1; int kc = sc * 2;   \
    *(bf16x8*)(K_lds + (b) * SHM_K + KSWZ(sr, kc)) = s_ks0; *(bf16x8*)(K_lds + (b) * SHM_K + KSWZ(32 + sr, kc)) = s_ks1;                  \
    *(bf16x8*)(KR_lds + (b) * SHM_KR + KRSWZ(krr, krc * 2)) = s_kr; } while (0)
#define SWAIT() asm volatile("s_waitcnt vmcnt(0)" ::: "memory")
#define RESC(a) do { if (__any((a) < 1.f)) { if (hi == 0) al_l[r32] = (a); asm volatile("s_waitcnt lgkmcnt(0)" ::: "memory"); \
    _Pragma("unroll") for (int d = 0; d < 4; ++d) _Pragma("unroll") for (int r = 0; r < 16; ++r) o[d][r] *= al_l[crow(r, hi)]; } } while (0)
    f32x16 pA0, pA1, pB0, pB1; float mnA, mnB, alA, alB; bf16x8 pa0, pa1, pa2, pa3; const int NT = seq / KVBLK;
    SLOAD(0); SWAIT(); SWRITE(0); __syncthreads();
    qkt(pA0, pA1, K_lds, KR_lds, qr, qrl, r32, hi); partialSM(pA0, pA1, m_reg, mnA, alA);
    SLOAD(KVBLK);
    SWAIT(); SWRITE(1); __syncthreads();
    for (int j = 1; j + 1 < NT; j += 2) {
        SBAR(); qkt(pB0, pB1, K_lds + SHM_K, KR_lds + SHM_KR, qr, qrl, r32, hi);
        finishSM(pA0, pA1, alA, l_reg, pa0, pa1, pa2, pa3); SBAR();
        SLOAD((j + 1) * KVBLK); SBAR();
        pv_d0(o, vb0, pa0, pa1, pa2, pa3); partialSM(pB0, pB1, m_reg, mnB, alB);
        __syncthreads(); SWAIT(); SWRITE(0);
        RESC(alB); __syncthreads();
        SBAR(); qkt(pA0, pA1, K_lds, KR_lds, qr, qrl, r32, hi);
        finishSM(pB0, pB1, alB, l_reg, pa0, pa1, pa2, pa3); SBAR();
        SLOAD((j + 2) * KVBLK); SBAR();
        pv_d0(o, vb0 + (int)SHM_V, pa0, pa1, pa2, pa3); partialSM(pA0, pA1, m_reg, mnA, alA);
        __syncthreads(); SWAIT(); SWRITE(1);
        RESC(alA); __syncthreads();
    }
    SBAR(); qkt(pB0, pB1, K_lds + SHM_K, KR_lds + SHM_KR, qr, qrl, r32, hi);
    finishSM(pA0, pA1, alA, l_reg, pa0, pa1, pa2, pa3); SBAR();
    pv_d0(o, vb0, pa0, pa1, pa2, pa3); partialSM(pB0, pB1, m_reg, mnB, alB);
    __syncthreads(); RESC(alB);
    finishSM(pB0, pB1, alB, l_reg, pa0, pa1, pa2, pa3); SBAR();
    pv_d0(o, vb0 + (int)SHM_V, pa0, pa1, pa2, pa3);
    if (hi == 0) li_l[r32] = l_reg; asm volatile("s_waitcnt lgkmcnt(0)" ::: "memory");
    float rli[16];
#pragma unroll
    for (int r = 0; r < 16; ++r) rli[r] = __builtin_amdgcn_rcpf(li_l[crow(r, hi)]);
    bf16_t* Ow = Ob + (long)(wid * QBLK) * LDO;
#pragma unroll
    for (int r = 0; r < 16; ++r) { int orow = crow(r, hi);
#pragma unroll
        for (int d0 = 0; d0 < 4; ++d0) Ow[(long)orow * LDO + d0 * 32 + r32] = f2bf(o[d0][r] * rli[r]); }
    __syncthreads();
#undef SLOAD
#undef SWRITE
#undef SWAIT
#undef RESC
}
}

namespace hg {
constexpr int LD = 136, LDT = 72;
constexpr int O_RZ = 0, O_RQ = O_RZ + 64 * LD * 2, O_RV = O_RQ + 64 * LD * 2, O_QD = O_RV + 64 * LD * 2, O_KD = O_QD + 64 * LD * 2,
              O_KDT = O_KD + 64 * LD * 2, O_VT = O_KDT + 128 * LDT * 2, O_P = O_VT + 128 * LDT * 2, O_SEG = O_P + 64 * LDT * 2, O_EV = O_SEG + 4 * 128 * 4, O_END = O_EV + 3 * 128 * 4;
static_assert(O_END <= LDS_BCAST, "hgrn LDS");
__device__ __forceinline__ float clampf(float x, float lo, float hi) { return fminf(fmaxf(x, lo), hi); }

__device__ __forceinline__ void hgrn_unit(LAS unsigned char* lds, bf16_t* hgb  , const float* lb_logits, int layer, int S, int unit) {
    const int tid = ltid(), wid = tid >> 6, lane = tid & 63, l15 = lane & 15, quad = lane >> 4;
    const int dir = unit & 1, h = (unit >> 1) & 7, b = unit >> 4;
    const int qcol = h * 128, zcol = (dir ? 2048 : 1024) + h * 128, vcol = 3072 + h * 128;
    const int ch = tid & 127, seg = tid >> 7;
    float lb = 0.f;
    if (layer > 0) {
        float mx = -3e38f; for (int l = 0; l < DEPTH; ++l) mx = fmaxf(mx, lb_logits[l * 2048 + dir * 1024 + h * 128 + ch]);
        float den = 0.f, num = 0.f; for (int l = 0; l < DEPTH; ++l) { const float e = __expf(lb_logits[l * 2048 + dir * 1024 + h * 128 + ch] - mx); den += e; if (l >= 1 && l <= layer) num += e; }
        lb = num / den;
    }
    const float oml = 1.f - lb;
    LAS bf16_t* RZ = (LAS bf16_t*)(lds + O_RZ); LAS bf16_t* RQ = (LAS bf16_t*)(lds + O_RQ); LAS bf16_t* RV = (LAS bf16_t*)(lds + O_RV);
    LAS bf16_t* QD = (LAS bf16_t*)(lds + O_QD); LAS bf16_t* KD = (LAS bf16_t*)(lds + O_KD); LAS bf16_t* KDT = (LAS bf16_t*)(lds + O_KDT);
    LAS bf16_t* VT = (LAS bf16_t*)(lds + O_VT); LAS bf16_t* PP = (LAS bf16_t*)(lds + O_P);
    LAS float* SEG = (LAS float*)(lds + O_SEG); LAS float* EV = (LAS float*)(lds + O_EV);
    const int n = S / 64;
    const int r0 = tid >> 4, c8 = (tid & 15) * 8;
    bf16x8 pz0, pz1, pq0, pq1, pv0, pv1;
#define HG_ROW(c, tau) ((long)b * S + (dir ? (S - 1 - ((c) * 64 + (tau))) : ((c) * 64 + (tau))))
#define HG_LOAD(c) do { const bf16_t* ra = hgb + HG_ROW(c, r0) * HGW; const bf16_t* rb = hgb + HG_ROW(c, r0 + 32) * HGW; \
    pz0 = *(const bf16x8*)(ra + zcol + c8); pz1 = *(const bf16x8*)(rb + zcol + c8); pq0 = *(const bf16x8*)(ra + qcol + c8); pq1 = *(const bf16x8*)(rb + qcol + c8); \
    pv0 = *(const bf16x8*)(ra + vcol + c8); pv1 = *(const bf16x8*)(rb + vcol + c8); } while (0)
    f32x4 Sst[8];
#pragma unroll
    for (int i = 0; i < 8; ++i) Sst[i] = (f32x4){0.f, 0.f, 0.f, 0.f};
    HG_LOAD(0);
    for (int c = 0; c < n; ++c) {
        *(LAS bf16x8*)(RZ + r0 * LD + c8) = pz0; *(LAS bf16x8*)(RZ + (r0 + 32) * LD + c8) = pz1;
        *(LAS bf16x8*)(RQ + r0 * LD + c8) = pq0; *(LAS bf16x8*)(RQ + (r0 + 32) * LD + c8) = pq1;
        *(LAS bf16x8*)(RV + r0 * LD + c8) = pv0; *(LAS bf16x8*)(RV + (r0 + 32) * LD + c8) = pv1;
        wg_barrier();
        if (c + 1 < n) HG_LOAD(c + 1);
        float bl[16], kk[16]; float run = 0.f;
#pragma unroll
        for (int i = 0; i < 16; ++i) {
            const float z = clampf(bf2f(RZ[(seg * 16 + i) * LD + ch]), -80.f, 80.f);
            const float e = __expf(-z), sg = 1.f / (1.f + e);
            const float f = lb + oml * sg;
            run += __logf(f); bl[i] = run; kk[i] = oml * e * sg;
        }
        SEG[seg * 128 + ch] = run;
        asm volatile("s_waitcnt lgkmcnt(0)" ::: "memory"); __builtin_amdgcn_s_barrier(); asm volatile("" ::: "memory");
        const float t0 = SEG[ch], t1 = SEG[128 + ch], t2 = SEG[256 + ch], t3 = SEG[384 + ch];
        const float off = (seg > 0 ? t0 : 0.f) + (seg > 1 ? t1 : 0.f) + (seg > 2 ? t2 : 0.f);
        const float bref = t0 + t1, btot = (t0 + t1) + (t2 + t3);
        unsigned kdt[8], vtt[8];
#pragma unroll
        for (int i = 0; i < 16; ++i) {
            const int tau = seg * 16 + i;
            const float bb = bl[i] + off;
            const float eq = __expf(clampf(bb - bref, -80.f, 80.f)), ek = __expf(clampf(bref - bb, -80.f, 80.f));
            const float qv = bf2f(RQ[tau * LD + ch]);
            const float sq = qv / (1.f + __expf(-qv)) * 0.08838834764831845f;
            QD[tau * LD + ch] = f2bf(sq * eq);
            const bf16_t kb = f2bf(kk[i] * ek);
            KD[tau * LD + ch] = kb;
            const bf16_t vb = RV[tau * LD + ch];
            if (i & 1) { kdt[i >> 1] |= ((unsigned)kb) << 16; vtt[i >> 1] |= ((unsigned)vb) << 16; } else { kdt[i >> 1] = kb; vtt[i >> 1] = vb; }
        }
        *(LAS u32x4*)(KDT + ch * LDT + seg * 16) = (u32x4){kdt[0], kdt[1], kdt[2], kdt[3]}; *(LAS u32x4*)(KDT + ch * LDT + seg * 16 + 8) = (u32x4){kdt[4], kdt[5], kdt[6], kdt[7]};
        *(LAS u32x4*)(VT + ch * LDT + seg * 16) = (u32x4){vtt[0], vtt[1], vtt[2], vtt[3]}; *(LAS u32x4*)(VT + ch * LDT + seg * 16 + 8) = (u32x4){vtt[4], vtt[5], vtt[6], vtt[7]};
        if (seg == 0) { EV[ch] = __expf(clampf(bref, -80.f, 80.f)); EV[128 + ch] = __expf(clampf(btot, -80.f, 80.f)); EV[256 + ch] = __expf(clampf(btot - bref, -80.f, 80.f)); }
        asm volatile("s_waitcnt lgkmcnt(0)" ::: "memory"); __builtin_amdgcn_s_barrier(); asm volatile("" ::: "memory");
#pragma unroll
        for (int tt = 0; tt < 2; ++tt) {
            const int ti = wid * 2 + tt, sblk = ti >> 2, tblk = ti & 3;
            f32x4 a = (f32x4){0.f, 0.f, 0.f, 0.f};
            if (sblk <= tblk) {
#pragma unroll
                for (int ks = 0; ks < 4; ++ks) {
                    const bf16x8 af = *(LAS bf16x8*)(KD + (sblk * 16 + l15) * LD + ks * 32 + quad * 8);
                    const bf16x8 bfr = *(LAS bf16x8*)(QD + (tblk * 16 + l15) * LD + ks * 32 + quad * 8);
                    a = __builtin_amdgcn_mfma_f32_16x16x32_bf16(af, bfr, a, 0, 0, 0);
                }
            }
            const int t = tblk * 16 + l15, s0 = sblk * 16 + quad * 4;
            u32x2 w; w.x = cvtpk(s0 + 0 <= t ? a[0] : 0.f, s0 + 1 <= t ? a[1] : 0.f); w.y = cvtpk(s0 + 2 <= t ? a[2] : 0.f, s0 + 3 <= t ? a[3] : 0.f);
            *(LAS u32x2*)(PP + t * LDT + s0) = w;
        }
        asm volatile("s_waitcnt lgkmcnt(0)" ::: "memory"); __builtin_amdgcn_s_barrier(); asm volatile("" ::: "memory");
        const int dv0 = wid * 16;
        bf16x8 bv[2];
#pragma unroll
        for (int ks = 0; ks < 2; ++ks) bv[ks] = *(LAS bf16x8*)(VT + (dv0 + l15) * LDT + ks * 32 + quad * 8);
        f32x4 o[4];
#pragma unroll
        for (int i = 0; i < 4; ++i) o[i] = (f32x4){0.f, 0.f, 0.f, 0.f};
#pragma unroll
        for (int k4 = 0; k4 < 4; ++k4) {
            const f32x4 er0 = *(LAS f32x4*)(EV + 32 * k4 + 4 * quad), er1 = *(LAS f32x4*)(EV + 32 * k4 + 16 + 4 * quad);
            const f32x4 s0 = Sst[2 * k4] * er0, s1 = Sst[2 * k4 + 1] * er1;
            u32x4 bw; bw.x = cvtpk(s0[0], s0[1]); bw.y = cvtpk(s0[2], s0[3]); bw.z = cvtpk(s1[0], s1[1]); bw.w = cvtpk(s1[2], s1[3]);
            const bf16x8 bfr = *reinterpret_cast<bf16x8*>(&bw);
#pragma unroll
            for (int tb = 0; tb < 4; ++tb) {
                const u32x2 a0 = *(LAS u32x2*)(QD + (tb * 16 + l15) * LD + 32 * k4 + 4 * quad);
                const u32x2 a1 = *(LAS u32x2*)(QD + (tb * 16 + l15) * LD + 32 * k4 + 16 + 4 * quad);
                u32x4 aw; aw.x = a0.x; aw.y = a0.y; aw.z = a1.x; aw.w = a1.y;
                o[tb] = __builtin_amdgcn_mfma_f32_16x16x32_bf16(*reinterpret_cast<bf16x8*>(&aw), bfr, o[tb], 0, 0, 0);
            }
        }
#pragma unroll
        for (int ks = 0; ks < 2; ++ks)
#pragma unroll
            for (int tb = 0; tb < 4; ++tb) {
                const bf16x8 af = *(LAS bf16x8*)(PP + (tb * 16 + l15) * LDT + ks * 32 + quad * 8);
                o[tb] = __builtin_amdgcn_mfma_f32_16x16x32_bf16(af, bv[ks], o[tb], 0, 0, 0);
            }
#pragma unroll
        for (int tb = 0; tb < 4; ++tb)
#pragma unroll
            for (int j = 0; j < 4; ++j) hgb[HG_ROW(c, tb * 16 + quad * 4 + j) * HGW + zcol + dv0 + l15] = f2bf(o[tb][j]);
#pragma unroll
        for (int db = 0; db < 8; ++db) {
            f32x4 tmp = (f32x4){0.f, 0.f, 0.f, 0.f};
#pragma unroll
            for (int ks = 0; ks < 2; ++ks) {
                const bf16x8 af = *(LAS bf16x8*)(KDT + (db * 16 + l15) * LDT + ks * 32 + quad * 8);
                tmp = __builtin_amdgcn_mfma_f32_16x16x32_bf16(af, bv[ks], tmp, 0, 0, 0);
            }
            const f32x4 et = *(LAS f32x4*)(EV + 128 + db * 16 + quad * 4), etr = *(LAS f32x4*)(EV + 256 + db * 16 + quad * 4);
            Sst[db] = Sst[db] * et + tmp * etr;
        }
    }
    wg_barrier();
#undef HG_ROW
#undef HG_LOAD
}
}

struct WDesc { const float* src; const float* gain; bf16_t* dst; int K, N, R, map; };

__device__ __forceinline__ void wcvt_phase(LAS unsigned char* lds, const Params& p, int layer) {
    LAS float* tile = (LAS float*)lds;
    const int tid = ltid();
    char* ws = p.ws;
    for (int mi = 0; mi < 10; ++mi) {
        WDesc d;
        switch (mi) {
        case 0: d = {p.w_in + (size_t)layer * 2048 * 5952, p.mix_norm + layer * 2048, (bf16_t*)(ws + OFF_W_IN), 2048, 5952, INP, 1}; break;
        case 1: d = {p.w_uq + (size_t)layer * 512 * 1536, p.q_norm + layer * 512, (bf16_t*)(ws + OFF_W_UQ), 512, 1536, 1536, 0}; break;
        case 2: d = {p.w_ukv + (size_t)layer * 256 * 2048, p.kv_norm + layer * 256, (bf16_t*)(ws + OFF_W_UKV), 256, 2048, 2048, 0}; break;
        case 3: d = {p.w_out + (size_t)layer * 2048 * 2048, nullptr, (bf16_t*)(ws + OFF_W_OUT), 2048, 2048, 2048, 0}; break;
        case 4: d = {p.w_xq + (size_t)layer * 2048 * 2048, p.xattn_norm + layer * 2048, (bf16_t*)(ws + OFF_W_XQ), 2048, 2048, 2048, 0}; break;
        case 5: d = {p.w_xk + (size_t)layer * 2048 * 2048, p.mem_norm + layer * 2048, (bf16_t*)(ws + OFF_W_XK), 2048, 2048, 2048, 0}; break;
        case 6: d = {p.w_xv + (size_t)layer * 2048 * 2048, p.mem_norm + layer * 2048, (bf16_t*)(ws + OFF_W_XV), 2048, 2048, 2048, 0}; break;
        case 7: d = {p.w_xo + (size_t)layer * 2048 * 2048, nullptr, (bf16_t*)(ws + OFF_W_XO), 2048, 2048, 2048, 0}; break;
        case 8: d = {p.w_ffn1 + (size_t)layer * 2048 * 8192, p.ffn_norm + layer * 2048, (bf16_t*)(ws + OFF_W_F1), 2048, 8192, 8192, 0}; break;
        default: d = {p.w_ffn2 + (size_t)layer * 8192 * 2048, nullptr, (bf16_t*)(ws + OFF_W_F2), 8192, 2048, 2048, 0}; break;
        }
        const int nkt = d.K / 64, nrt = d.R / 64, ntile = nkt * nrt;
        for (int t = lbid(); t < ntile; t += gridDim.x) {
            const int kt = t % nkt, rt = t / nkt, k0 = kt * 64, r0 = rt * 64;
            int sc0 = r0; bool zero = false;
            if (d.map) { if (r0 < 832) sc0 = r0; else if (r0 < 1024) zero = true; else sc0 = r0 - 192; }
            {
                const int j = tid & 63, i0 = tid >> 6;
#pragma unroll
                for (int ii = 0; ii < 8; ++ii) { const int i = i0 + ii * 8;
                    float v = zero ? 0.f : d.src[(size_t)(k0 + i) * d.N + sc0 + j];
                    if (d.gain) v *= d.gain[k0 + i];
                    tile[i * 65 + j] = v; }
            }
            wg_barrier();
            {
                const int kp = tid & 31, j0 = tid >> 5;
#pragma unroll
                for (int jj = 0; jj < 4; ++jj) { const int j = j0 + jj * 16;
                    const unsigned w = cvtpk(tile[(2 * kp) * 65 + j], tile[(2 * kp + 1) * 65 + j]);
                    *(unsigned*)(d.dst + (size_t)(r0 + j) * d.K + k0 + 2 * kp) = w; }
            }
            wg_barrier();
        }
    }
}

__device__ __forceinline__ void prep_phase(const Params& p, int tr, int T, int S) {
    const int tid = ltid(), wid = tid >> 6, lane = tid & 63;
    char* ws = p.ws;
    const long gtid = (long)lbid() * 512 + tid, gstride = (long)gridDim.x * 512;
    { ssq_t* ssq = (ssq_t*)(ws + OFF_SSQ); for (long i = gtid; i < (long)10 * TMAX; i += gstride) ssq[TMAX + i] = 0ull;
      if (gtid < 64) ((unsigned*)(ws + OFF_CTR))[gtid] = 0u; }
    { float* rc = (float*)(ws + OFF_ROPE); float* rs = rc + 16384 * 32;
      for (int i = (int)gtid; i < S * 32; i += (int)gstride) { const int pos = i >> 5, f = i & 31;
          const float inv_freq = exp2f(-(float)f * (13.287712379549449f / 32.f));
          const float ang = (float)pos * inv_freq;
          const double rev = (double)ang * 0.15915494309189535; const float fr = (float)(rev - rint(rev));
          rc[i] = __builtin_amdgcn_cosf(fr); rs[i] = __builtin_amdgcn_sinf(fr); } }
    { const float* x = p.x_in[tr]; bf16_t* xb = (bf16_t*)(ws + OFF_XB); ssq_t* ssq0 = (ssq_t*)(ws + OFF_SSQ);
      for (int row = lbid() * 8 + wid; row < T; row += gridDim.x * 8) {
          float ss = 0.f;
#pragma unroll
          for (int i = 0; i < 8; ++i) { const int c = i * 256 + lane * 4; const f32x4 v = *(const f32x4*)(x + (size_t)row * DM + c);
              ss += (v[0] * v[0] + v[1] * v[1]) + (v[2] * v[2] + v[3] * v[3]);
              u32x2 w; w.x = cvtpk(v[0], v[1]); w.y = cvtpk(v[2], v[3]); *(u32x2*)(xb + (size_t)row * DM + c) = w; }
#pragma unroll
          for (int o = 32; o > 0; o >>= 1) ss += __shfl_xor(ss, o);
          if (lane == 0) ssq0[row] = ssq_fix(ss);
      } }
    { const float* mem = p.mem_in[tr]; bf16_t* mn = (bf16_t*)(ws + OFF_MEMN);
      for (int row = lbid() * 8 + wid; row < 512; row += gridDim.x * 8) {
          f32x4 v[8]; float ss = 0.f;
#pragma unroll
          for (int i = 0; i < 8; ++i) { v[i] = *(const f32x4*)(mem + (size_t)row * DM + i * 256 + lane * 4); ss += (v[i][0] * v[i][0] + v[i][1] * v[i][1]) + (v[i][2] * v[i][2] + v[i][3] * v[i][3]); }
#pragma unroll
          for (int o = 32; o > 0; o >>= 1) ss += __shfl_xor(ss, o);
          const float rs = __builtin_amdgcn_rsqf(ss * (1.f / DM) + EPS);
#pragma unroll
          for (int i = 0; i < 8; ++i) { u32x2 w; w.x = cvtpk(v[i][0] * rs, v[i][1] * rs); w.y = cvtpk(v[i][2] * rs, v[i][3] * rs); *(u32x2*)(mn + (size_t)row * DM + i * 256 + lane * 4) = w; }
      } }
}

__device__ __forceinline__ void rope_phase(const Params& p, int T, int S) {
    char* ws = p.ws;
    bf16_t* q = (bf16_t*)(ws + OFF_Q); const bf16_t* kr = (const bf16_t*)(ws + OFF_KR); bf16_t* kro = (bf16_t*)(ws + OFF_KROPE);
    const float* rc = (const float*)(ws + OFF_ROPE); const float* rs = rc + 16384 * 32;
    const int total = T * 9 * 32;
    for (int i = lbid() * 512 + ltid(); i < total; i += gridDim.x * 512) {
        const int f = i & 31; const int ru = i >> 5; const int row_i = ru / 9; const int u = ru - row_i * 9; const long row = row_i; const int pos = row_i & (S - 1);
        const float c = rc[pos * 32 + f], s = rs[pos * 32 + f];
        if (u < 8) { bf16_t* a = q + row * 1536 + u * 192 + 128 + f; const float x1 = bf2f(a[0]), x2 = bf2f(a[32]); a[0] = f2bf(x1 * c - x2 * s); a[32] = f2bf(x2 * c + x1 * s); }
        else { const bf16_t* a = kr + row * 64 + f; const float x1 = bf2f(a[0]), x2 = bf2f(a[32]); kro[row * 64 + f] = f2bf(x1 * c - x2 * s); kro[row * 64 + 32 + f] = f2bf(x2 * c + x1 * s); }
    }
}

__device__ __forceinline__ void hcomb_phase(const Params& p, int layer, int T) {
    char* ws = p.ws; const bf16_t* hgb = (const bf16_t*)(ws + OFF_HG); bf16_t* mix = (bf16_t*)(ws + OFF_MIX);
    const float* on = p.out_norm + layer * 128;
    const int l16 = ltid() & 15;
    const int total = T * 8 * 16;
    for (int i = lbid() * 512 + ltid(); i < total; i += gridDim.x * 512) {
        const int rh = i >> 4; const int h = rh & 7; const long row = rh >> 3;
        const bf16_t* base = hgb + row * HGW + h * 128 + l16 * 8;
        const bf16x8 vf = *(const bf16x8*)(base + 1024), vb = *(const bf16x8*)(base + 2048), vg = *(const bf16x8*)(base + 4096);
        float o[8]; float ss = 0.f;
#pragma unroll
        for (int j = 0; j < 8; ++j) { o[j] = bf2f((bf16_t)vf[j]) + bf2f((bf16_t)vb[j]); ss += o[j] * o[j]; }
        ss += __shfl_xor(ss, 1); ss += __shfl_xor(ss, 2); ss += __shfl_xor(ss, 4); ss += __shfl_xor(ss, 8);
        const float rs = __builtin_amdgcn_rsqf(ss * (1.f / 128.f) + EPS);
        unsigned w[4];
#pragma unroll
        for (int j = 0; j < 8; j += 2) {
            const float g0 = bf2f((bf16_t)vg[j]), g1 = bf2f((bf16_t)vg[j + 1]);
            const float y0 = o[j] * rs * on[l16 * 8 + j] * (g0 / (1.f + __expf(-g0))), y1 = o[j + 1] * rs * on[l16 * 8 + j + 1] * (g1 / (1.f + __expf(-g1)));
            w[j >> 1] = cvtpk(y0, y1);
        }
        *(u32x4*)(mix + row * 2048 + 1024 + h * 128 + l16 * 8) = (u32x4){w[0], w[1], w[2], w[3]};
    }
}

__device__ __forceinline__ void final_phase(const Params& p, float* xout, int T) {
    const int wid = ltid() >> 6, lane = ltid() & 63;
    const ssq_t* ssq = (const ssq_t*)(p.ws + OFF_SSQ) + (size_t)10 * TMAX;
    for (int row = lbid() * 8 + wid; row < T; row += gridDim.x * 8) {
        const float rs = __builtin_amdgcn_rsqf(ssq_val(ssq[row]) * (1.f / DM) + EPS);
#pragma unroll
        for (int i = 0; i < 8; ++i) { const int c = i * 256 + lane * 4; f32x4 v = *(f32x4*)(xout + (size_t)row * DM + c); const f32x4 g = *(const f32x4*)(p.final_norm + c);
            v = v * rs * g; *(f32x4*)(xout + (size_t)row * DM + c) = v; }
    }
}

__device__ __forceinline__ void mixer_phase(LAS unsigned char* lds, const Params& p, int layer, int T, int S) {
    char* ws = p.ws;
    unsigned* ctr = (unsigned*)(ws + OFF_CTR) + layer * 16;
    LAS unsigned* slot = (LAS unsigned*)(lds + LDS_BCAST);
    const int nH = 2 * 8 * 2, nQB = S / 256, nA = 2 * 8 * nQB;
    bf16_t* hgb = (bf16_t*)(ws + OFF_HG);
    const bf16_t* q = (const bf16_t*)(ws + OFF_Q); const bf16_t* kv = (const bf16_t*)(ws + OFF_KV); const bf16_t* kro = (const bf16_t*)(ws + OFF_KROPE);
    bf16_t* mix = (bf16_t*)(ws + OFF_MIX);
    for (;;) {
        if (ltid() == 0) *slot = __hip_atomic_fetch_add(ctr, 1u, __ATOMIC_RELAXED, __HIP_MEMORY_SCOPE_AGENT);
        wg_barrier();
        const int idx = (int)__builtin_amdgcn_readfirstlane(*slot);
        wg_barrier();
        if (idx >= nH + nA) break;
#ifndef MK_NO_HG
        if (idx < nH) hg::hgrn_unit(lds, hgb, p.lb_logits, layer, S, idx);
        else
#endif
        {
#ifndef MK_NO_ATT
            const int a = idx - nH, qb = a % nQB, h = (a / nQB) & 7, b = a / (nQB * 8);
            const long row0 = (long)b * S + (long)qb * 256, krow0 = (long)b * S;
            att::attn_body(q + row0 * 1536 + h * 192, kv + krow0 * 2048 + h * 256, kv + krow0 * 2048 + h * 256 + 128, kro + krow0 * 64,
                           mix + row0 * 2048 + h * 128, S, (char*)(unsigned char*)lds);
#endif
        }
    }
}

constexpr int PH_PER_TRUNK = 28, N_PHASES = 2 * PH_PER_TRUNK;

__device__ __forceinline__ GemmDesc mkgemm(const void* A, int lda, const void* B, int ldb, int K, int nM, int nN) {
    GemmDesc g{}; g.A = (const char*)A; g.B = (const char*)B; g.lda = lda; g.ldb = ldb; g.K = K; g.nM = nM; g.nN = nN; g.nZ = 1; g.perm = 1; g.epi = E_BF16; return g;
}

__device__ __forceinline__ bool make_gemm(const Params& p, int tr, int l, int k, int i, GemmDesc& g) {
    const int T = tr ? 32768 : 8192, S = tr ? 16384 : 4096, nMT = T / 256;
    char* ws = p.ws;
    float* xout = p.out + (tr ? (size_t)8192 * DM : 0);
    ssq_t* ssq = (ssq_t*)(ws + OFF_SSQ);
    ssq_t* ssq_x0 = ssq + (size_t)(l * 5 + 0) * TMAX; ssq_t* ssq_q = ssq + (size_t)(l * 5 + 1) * TMAX; ssq_t* ssq_kv = ssq + (size_t)(l * 5 + 2) * TMAX;
    ssq_t* ssq_x1 = ssq + (size_t)(l * 5 + 3) * TMAX; ssq_t* ssq_x2 = ssq + (size_t)(l * 5 + 4) * TMAX; ssq_t* ssq_nx = ssq + (size_t)((l + 1) * 5) * TMAX;
    bf16_t* xb = (bf16_t*)(ws + OFF_XB);
    if (k == 1) {
        if (i > 0) return false;
        g = mkgemm(xb, DM, ws + OFF_W_IN, DM, DM, nMT, INP / 256); g.epi = E_INPROJ; g.ssq_in = ssq_x0; g.inv_dim = 1.f / DM;
        g.out = (bf16_t*)(ws + OFF_CQ); g.out2 = (bf16_t*)(ws + OFF_KR); g.out3 = (bf16_t*)(ws + OFF_HG); g.ssq_out = ssq_q; g.ssq_out2 = ssq_kv; return true;
    } else if (k == 2) {
        if (i == 0) { g = mkgemm(ws + OFF_CQ, 768, ws + OFF_W_UQ, 512, 512, nMT, 6); g.out = (bf16_t*)(ws + OFF_Q); g.ldo = 1536; g.ssq_in = ssq_q; g.inv_dim = 1.f / 512.f; return true; }
        if (i == 1) { g = mkgemm(ws + OFF_CQ + 512 * 2, 768, ws + OFF_W_UKV, 256, 256, nMT, 8); g.out = (bf16_t*)(ws + OFF_KV); g.ldo = 2048; g.ssq_in = ssq_kv; g.inv_dim = 1.f / 256.f; return true; }
        return false;
    } else if (k == 6) {
        if (i > 0) return false;
        g = mkgemm(ws + OFF_MIX, DM, ws + OFF_W_OUT, DM, DM, nMT, 8); g.epi = E_RESID; g.perm = 0;
        g.resid = (l == 0) ? p.x_in[tr] : xout; g.xout = xout; g.xb = xb; g.ssq_out = ssq_x1; return true;
    } else if (k == 7) {
        if (i == 0) { g = mkgemm(xb, DM, ws + OFF_W_XQ, DM, DM, nMT, 8); g.out = (bf16_t*)(ws + OFF_XQ); g.ldo = DM; g.ssq_in = ssq_x1; g.inv_dim = 1.f / DM; return true; }
        if (i == 1) { g = mkgemm(ws + OFF_MEMN, DM, ws + OFF_W_XK, DM, DM, 2, 8); g.out = (bf16_t*)(ws + OFF_KMEM); g.ldo = DM; return true; }
        if (i == 2) { g = mkgemm(ws + OFF_W_XV, DM, ws + OFF_MEMN, DM, DM, 8, 1); g.nZ = 2; g.bzs = 256 * DM * 2; g.out = (bf16_t*)(ws + OFF_VT); g.ldo = 256; g.ozs = (long)2048 * 256; return true; }
        return false;
    } else if (k == 8) {
        if (i > 0) return false;
        g = mkgemm(ws + OFF_XQ, DM, ws + OFF_KMEM, DM, 512, nMT, 1); g.nZ = 4; g.azs = 512 * 2; g.bzs = 512 * 2; g.bbs = 256 * DM * 2; g.tpb = S / 256;
        g.epi = E_SOFTMAX; g.out = (bf16_t*)(ws + OFF_PBUF); g.ldo = 1024; return true;
    } else if (k == 9) {
        if (i > 0) return false;
        g = mkgemm(ws + OFF_PBUF, 1024, ws + OFF_VT, 256, 256, nMT, 2); g.nZ = 4; g.azs = 256 * 2; g.bzs = 512 * 256 * 2; g.bbs = 2048 * 256 * 2; g.tpb = S / 256;
        g.out = (bf16_t*)(ws + OFF_OBUF); g.ldo = DM; g.ozs = 512; return true;
    } else if (k == 10) {
        if (i > 0) return false;
        g = mkgemm(ws + OFF_OBUF, DM, ws + OFF_W_XO, DM, DM, nMT, 8); g.epi = E_RESID; g.perm = 0;
        g.resid = xout; g.xout = xout; g.xb = xb; g.ssq_out = ssq_x2; return true;
    } else if (k == 11) {
        if (i > 0) return false;
        g = mkgemm(xb, DM, ws + OFF_W_F1, DM, DM, nMT, 32); g.out = (bf16_t*)(ws + OFF_U); g.ldo = 8192; g.ssq_in = ssq_x2; g.inv_dim = 1.f / DM; g.relu2 = 1; return true;
    } else if (k == 12) {
        if (i > 0) return false;
        g = mkgemm(ws + OFF_U, 8192, ws + OFF_W_F2, 8192, 8192, nMT, 8); g.epi = E_RESID; g.perm = 0;
        g.resid = xout; g.xout = xout; g.xb = xb; g.ssq_out = ssq_nx; return true;
    }
    return false;
}

__device__ __forceinline__ void run_phase(const Params* kp, int ph, LAS unsigned char* lds) {
    const Params& p = *kp;
    const int tr = ph / PH_PER_TRUNK, s = ph % PH_PER_TRUNK;
    const int T = tr ? 32768 : 8192, S = tr ? 16384 : 4096;
    float* xout = p.out + (tr ? (size_t)8192 * DM : 0);
    if (s == 0) { prep_phase(p, tr, T, S); return; }
    if (s == PH_PER_TRUNK - 1) { final_phase(p, xout, T); return; }
    const int l = (s - 1) / 13, k = (s - 1) % 13;
    if (k == 0) { wcvt_phase(lds, p, l); return; }
    if (k == 3) { rope_phase(p, T, S); return; }
    if (k == 4) { mixer_phase(lds, p, l, T, S); return; }
    if (k == 5) { hcomb_phase(p, l, T); return; }
#ifndef MK_NO_GEMM
    if (k == 1) gemm_phase<E_INPROJ>(lds, kp, tr, l, k, 0);
    else if (k == 6 || k == 10 || k == 12) gemm_phase<E_RESID>(lds, kp, tr, l, k, 0);
    else if (k == 8) gemm_phase<E_SOFTMAX>(lds, kp, tr, l, k, 0);
    else for (int i = 0; i < 3; ++i) gemm_phase<E_BF16>(lds, kp, tr, l, k, i);
#endif
}

__global__ void __launch_bounds__(512, 2) mk_forward(Params p, int ph_lo, int ph_hi) {
    extern __shared__ __attribute__((aligned(16))) unsigned char shm[];
    LAS unsigned char* lds = (LAS unsigned char*)shm;
    cg::grid_group grid = cg::this_grid();
    for (int ph = ph_lo; ph < ph_hi; ++ph) {
        const Params* kp = launder_p((const Params*)__builtin_amdgcn_kernarg_segment_ptr());
        run_phase(kp, ph, lds);
        if (ph + 1 < ph_hi) grid.sync();
    }
}

extern "C" void kernel_launch(void* const* d_in, const int* in_sizes, int n_in, void* d_out, int out_size, void* d_ws, size_t ws_size, hipStream_t stream) {
    static int inited = 0; static int grid_blocks = 0;
    if (!inited) {
        hipFuncSetAttribute((const void*)mk_forward, hipFuncAttributeMaxDynamicSharedMemorySize, LDS_BYTES);
        int dev = 0, cus = 0, per_cu = 0;
        hipGetDevice(&dev); hipDeviceGetAttribute(&cus, hipDeviceAttributeMultiprocessorCount, dev);
        hipOccupancyMaxActiveBlocksPerMultiprocessor(&per_cu, mk_forward, 512, LDS_BYTES);
        if (per_cu < 1) per_cu = 1;
        grid_blocks = cus * 1;
        if (ws_size < WS_END) fprintf(stderr, "kernel_launch: workspace too small: %zu < %zu\n", ws_size, (size_t)WS_END);
        inited = 1;
    }
    Params p{};
    const float* const* in = (const float* const*)d_in;
    p.x_in[0] = in[0]; p.x_in[1] = in[1]; p.mem_in[0] = in[2]; p.mem_in[1] = in[3];
    p.mix_norm = in[4]; p.w_in = in[5]; p.q_norm = in[6]; p.w_uq = in[7]; p.kv_norm = in[8]; p.w_ukv = in[9]; p.lb_logits = in[10]; p.out_norm = in[11]; p.w_out = in[12];
    p.xattn_norm = in[13]; p.mem_norm = in[14]; p.w_xq = in[15]; p.w_xk = in[16]; p.w_xv = in[17]; p.w_xo = in[18]; p.ffn_norm = in[19]; p.w_ffn1 = in[20]; p.w_ffn2 = in[21]; p.final_norm = in[22];
    p.out = (float*)d_out; p.ws = (char*)d_ws;
#if MK_ONE_LAUNCH
    int lo = 0, hi = N_PHASES;
    void* args[] = {&p, &lo, &hi};
    hipError_t e = hipLaunchCooperativeKernel((const void*)mk_forward, dim3(grid_blocks), dim3(512), args, LDS_BYTES, stream);
    if (e != hipSuccess) fprintf(stderr, "cooperative launch failed: %s\n", hipGetErrorString(e));
#else
    for (int ph = 0; ph < N_PHASES; ++ph) hipLaunchKernelGGL(mk_forward, dim3(grid_blocks), dim3(512), LDS_BYTES, stream, p, ph, ph + 1);
#endif
}
```

```cpp
#include <hip/hip_runtime.h>
#include <hip/hip_cooperative_groups.h>
#include <cstdio>
namespace cg = cooperative_groups;

#define LAS __attribute__((address_space(3)))
typedef unsigned short bf16_t;
typedef short bf16x8 __attribute__((ext_vector_type(8)));
typedef short s16x4 __attribute__((ext_vector_type(4)));
typedef float f32x4 __attribute__((ext_vector_type(4)));
typedef float f32x8 __attribute__((ext_vector_type(8)));
typedef float f32x16 __attribute__((ext_vector_type(16)));
typedef unsigned u32x4 __attribute__((ext_vector_type(4)));
typedef unsigned u32x2 __attribute__((ext_vector_type(2)));

#ifndef MK_ONE_LAUNCH
#define MK_ONE_LAUNCH 1
#endif

constexpr int DM = 2048, NMEM = 256, DEPTH = 2;
constexpr int INP = 6144;
constexpr int HGW = 5120;
constexpr int TMAX = 32768;
constexpr float EPS = 1e-6f;
constexpr int LDS_BYTES = 144 * 1024;
constexpr int LDS_BCAST = 140 * 1024;
constexpr int LDS_EPI = 128 * 1024;

constexpr size_t al256(size_t x) { return (x + 255) / 256 * 256; }
constexpr size_t E_W_IN = (size_t)INP * 2048, E_W_UQ = 1536 * 512, E_W_UKV = 2048 * 256, E_W_SQ = 2048 * 2048, E_W_F = (size_t)8192 * 2048;
constexpr size_t OFF_W_IN = 0;
constexpr size_t OFF_W_UQ = OFF_W_IN + E_W_IN * 2;
constexpr size_t OFF_W_UKV = OFF_W_UQ + E_W_UQ * 2;
constexpr size_t OFF_W_OUT = OFF_W_UKV + E_W_UKV * 2;
constexpr size_t OFF_W_XQ = OFF_W_OUT + E_W_SQ * 2;
constexpr size_t OFF_W_XK = OFF_W_XQ + E_W_SQ * 2;
constexpr size_t OFF_W_XV = OFF_W_XK + E_W_SQ * 2;
constexpr size_t OFF_W_XO = OFF_W_XV + E_W_SQ * 2;
constexpr size_t OFF_W_F1 = OFF_W_XO + E_W_SQ * 2;
constexpr size_t OFF_W_F2 = OFF_W_F1 + E_W_F * 2;
constexpr size_t OFF_XB = OFF_W_F2 + E_W_F * 2;
constexpr size_t OFF_CQ = OFF_XB + (size_t)TMAX * 2048 * 2;
constexpr size_t OFF_KR = OFF_CQ + (size_t)TMAX * 768 * 2;
constexpr size_t OFF_KROPE = OFF_KR + (size_t)TMAX * 64 * 2;
constexpr size_t OFF_MIX = OFF_KROPE + (size_t)TMAX * 64 * 2;
constexpr size_t OFF_HG = OFF_MIX + (size_t)TMAX * 2048 * 2;
constexpr size_t OFF_Q = OFF_HG + (size_t)TMAX * HGW * 2;
constexpr size_t OFF_KV = OFF_Q + (size_t)TMAX * 1536 * 2;
constexpr size_t OFF_MEMN = OFF_KV + (size_t)TMAX * 2048 * 2;
constexpr size_t OFF_KMEM = OFF_MEMN + (size_t)512 * 2048 * 2;
constexpr size_t OFF_VT = OFF_KMEM + (size_t)512 * 2048 * 2;
constexpr size_t OFF_ROPE = OFF_VT + (size_t)512 * 2048 * 2;
constexpr size_t OFF_SSQ = OFF_ROPE + (size_t)16384 * 32 * 4 * 2;
constexpr size_t OFF_CTR = OFF_SSQ + (size_t)11 * TMAX * 8;
constexpr size_t OFF_BAR = OFF_CTR + 256;
constexpr size_t WS_END = OFF_BAR + 16384;
constexpr size_t OFF_XQ = OFF_Q;
constexpr size_t OFF_PBUF = OFF_MIX;
constexpr size_t OFF_OBUF = OFF_HG;
constexpr size_t OFF_U = OFF_HG;
static_assert((size_t)TMAX * 8192 * 2 <= OFF_MEMN - OFF_HG, "u must fit");

struct Params {
    const float* x_in[2]; const float* mem_in[2];
    const float *mix_norm, *w_in, *q_norm, *w_uq, *kv_norm, *w_ukv, *lb_logits, *out_norm, *w_out, *xattn_norm, *mem_norm, *w_xq, *w_xk, *w_xv, *w_xo,
        *ffn_norm, *w_ffn1, *w_ffn2, *final_norm;
    float* out; char* ws;
};

__device__ __forceinline__ int ltid() { int t = threadIdx.x; asm volatile("" : "+v"(t)); return t; }
__device__ __forceinline__ int lbid() { int t = blockIdx.x; asm volatile("" : "+s"(t)); return t; }
__device__ __forceinline__ float bf2f(bf16_t b) { return __uint_as_float(((unsigned)b) << 16); }
__device__ __forceinline__ bf16_t f2bf(float f) { unsigned u = __float_as_uint(f); u += 0x7FFFu + ((u >> 16) & 1u); return (bf16_t)(u >> 16); }
__device__ __forceinline__ unsigned cvtpk(float lo, float hi) { unsigned r; asm volatile("v_cvt_pk_bf16_f32 %0, %1, %2" : "=v"(r) : "v"(lo), "v"(hi)); return r; }
__device__ __forceinline__ void wg_barrier() { asm volatile("s_waitcnt vmcnt(0) lgkmcnt(0)" ::: "memory"); __builtin_amdgcn_s_barrier(); asm volatile("" ::: "memory"); }
typedef unsigned long long ssq_t;
__device__ __forceinline__ ssq_t ssq_fix(float v) { return (ssq_t)(v * 16777216.f + 0.5f); }
__device__ __forceinline__ float ssq_val(ssq_t v) { return (float)v * (1.f / 16777216.f); }
__device__ __forceinline__ void atomic_addf(ssq_t* p, float v) { __hip_atomic_fetch_add(p, ssq_fix(v), __ATOMIC_RELAXED, __HIP_MEMORY_SCOPE_AGENT); }

namespace pg8 {
constexpr int BM = 256, BK = 64, HALF = 128, HTB = HALF * BK * 2, NXCD = 8, WGM = 8;
__host__ __device__ __forceinline__ int lds_byte(int r, int c) { const int st = (r >> 4) * 2 + (c >> 5), rr = r & 15, cc = c & 31, ob = rr * 64 + cc * 2; return st * 1024 + (ob ^ (((ob >> 9) & 1) << 5)); }
__host__ __device__ __forceinline__ void stage_rc(int b, int& R, int& C) { const int st = b / 1024, sb = b % 1024, swz = sb ^ (((sb >> 9) & 1) << 5); R = (st >> 1) * 16 + swz / 64; C = (st & 1) * 32 + (swz % 64) / 2; }
__host__ __device__ __forceinline__ int perm32(int rho) { const int n = rho >> 4, i = rho & 15; return 8 * (i >> 2) + 4 * n + (i & 3); }
}
enum { E_BF16 = 0, E_INPROJ = 1, E_RESID = 2, E_SOFTMAX = 3 };
struct GemmDesc {
    const char* A; const char* B; int lda, ldb, K, nM, nN, nZ;
    int azs, bzs, bbs, tpb;
    int epi, perm;
    bf16_t* out; long ozs; int ldo;
    const ssq_t* ssq_in; float inv_dim; int relu2;
    ssq_t* ssq_out; ssq_t* ssq_out2;
    const float* resid; float* xout; bf16_t* xb;
    bf16_t* out2; bf16_t* out3;
};
struct Unit { int pm, pn, z; const char* a; const char* b; };

__device__ __forceinline__ bool make_gemm(const Params& p, int tr, int l, int k, int i, GemmDesc& g);
__device__ __forceinline__ const Params* launder_p(const Params* q) { asm volatile("" : "+s"(q)); return q; }
__device__ __forceinline__ int launder_i(int v) { asm volatile("" : "+s"(v)); return v; }
__device__ __forceinline__ bool next_unit(const Params* kp, int tr, int l, int k, int gi, int i, int G, int c, Unit& u) {
    GemmDesc g; make_gemm(*launder_p(kp), launder_i(tr), launder_i(l), launder_i(k), launder_i(gi), g);
    const int L = i * G + c; const int per = g.nM * g.nN;
    if (L >= per * g.nZ) return false;
    const int z = L / per; int wgid = L - z * per;
    { const int q = per / pg8::NXCD, r = per % pg8::NXCD, xcd = wgid % pg8::NXCD, off = wgid / pg8::NXCD; wgid = (xcd < r ? xcd * (q + 1) : r * (q + 1) + (xcd - r) * q) + off; }
    const int nig = pg8::WGM * g.nN, gid = wgid / nig, fm = gid * pg8::WGM, gsz = (g.nM - fm) < pg8::WGM ? (g.nM - fm) : pg8::WGM;
    u.pm = fm + ((wgid % nig) % gsz); u.pn = (wgid % nig) / gsz; u.z = z;
    const unsigned ao = (unsigned)z * (unsigned)g.azs + (unsigned)u.pm * (unsigned)(512 * g.lda);
    const unsigned bo = (unsigned)z * (unsigned)g.bzs + (unsigned)u.pn * (unsigned)(512 * g.ldb) + (g.tpb ? (unsigned)(u.pm / g.tpb) * (unsigned)g.bbs : 0u);
    u.a = g.A + (size_t)ao; u.b = g.B + (size_t)bo;
    return true;
}

template <int EPI> __device__ __forceinline__ void gemm_epilogue(const Params* kp, int tr, int l, int k, int gi, f32x4 (&acc)[2][2][4][2], const Unit& u, LAS unsigned char* lds) {
    const int tid_e = ltid(), wid_e = tid_e >> 6, lane_e = tid_e & 63, wr = wid_e >> 2, wc = wid_e & 3, fr = lane_e & 15, fq = lane_e >> 4;
    GemmDesc g; make_gemm(*launder_p(kp), launder_i(tr), launder_i(l), launder_i(k), launder_i(gi), g);
    const int row0 = u.pm * 256 + wr * 64 + fr;
    if constexpr (EPI == E_BF16) {
        const int col0 = u.pn * 256 + wc * 32 + 8 * fq;
#pragma unroll
        for (int ai = 0; ai < 2; ++ai)
#pragma unroll
            for (int m = 0; m < 4; ++m) {
                __builtin_amdgcn_sched_barrier(0);
                const int row = row0 + ai * 128 + m * 16;
                const float rs = g.ssq_in ? __builtin_amdgcn_rsqf(ssq_val(g.ssq_in[row]) * g.inv_dim + EPS) : 1.0f;
                bf16_t* rowp = g.out + (long)u.z * g.ozs + (long)row * g.ldo + col0;
#pragma unroll
                for (int bj = 0; bj < 2; ++bj) {
                    f32x4 v0 = acc[ai][bj][m][0] * rs, v1 = acc[ai][bj][m][1] * rs;
                    if (g.relu2) {
#pragma unroll
                        for (int j = 0; j < 4; ++j) { float a = fmaxf(v0[j], 0.f), b = fmaxf(v1[j], 0.f); v0[j] = a * a; v1[j] = b * b; }
                    }
                    u32x4 w; w.x = cvtpk(v0[0], v0[1]); w.y = cvtpk(v0[2], v0[3]); w.z = cvtpk(v1[0], v1[1]); w.w = cvtpk(v1[2], v1[3]);
                    *(u32x4*)(rowp + bj * 128) = w;
                }
            }
    } else if constexpr (EPI == E_INPROJ) {
        const int lc0 = wc * 32 + 8 * fq;
        const int pn = u.pn;
#pragma unroll
        for (int ai = 0; ai < 2; ++ai)
#pragma unroll
            for (int m = 0; m < 4; ++m) {
                __builtin_amdgcn_sched_barrier(0);
                const int row = row0 + ai * 128 + m * 16;
                const float rs = __builtin_amdgcn_rsqf(ssq_val(g.ssq_in[row]) * g.inv_dim + EPS);
                float ss = 0.f;
#pragma unroll
                for (int bj = 0; bj < 2; ++bj) {
                    const f32x4 v0 = acc[ai][bj][m][0] * rs, v1 = acc[ai][bj][m][1] * rs;
                    u32x4 w; w.x = cvtpk(v0[0], v0[1]); w.y = cvtpk(v0[2], v0[3]); w.z = cvtpk(v1[0], v1[1]); w.w = cvtpk(v1[2], v1[3]);
                    const int lc = lc0 + bj * 128;
                    if (pn < 3) {
                        *(u32x4*)(g.out + (long)row * 768 + pn * 256 + lc) = w;
                        ss += (v0[0] * v0[0] + v0[1] * v0[1]) + (v0[2] * v0[2] + v0[3] * v0[3]) + (v1[0] * v1[0] + v1[1] * v1[1]) + (v1[2] * v1[2] + v1[3] * v1[3]);
                    } else if (pn == 3) {
                        if (lc < 64) *(u32x4*)(g.out2 + (long)row * 64 + lc) = w;
                    } else {
                        *(u32x4*)(g.out3 + (long)row * HGW + (pn - 4) * 256 + lc) = w;
                    }
                }
                if (pn < 3) {
                    ss += __shfl_xor(ss, 16); ss += __shfl_xor(ss, 32);
                    if (fq == 0) atomic_addf((pn < 2 ? g.ssq_out : g.ssq_out2) + row, ss);
                }
            }
    } else if constexpr (EPI == E_RESID) {
        const int col0 = u.pn * 256 + wc * 32 + 4 * fq;
#pragma unroll
        for (int ai = 0; ai < 2; ++ai)
#pragma unroll
            for (int m = 0; m < 4; ++m) {
                __builtin_amdgcn_sched_barrier(0);
                const int row = row0 + ai * 128 + m * 16;
                float ss = 0.f;
#pragma unroll
                for (int bj = 0; bj < 2; ++bj)
#pragma unroll
                    for (int n = 0; n < 2; ++n) {
                        const long o = (long)row * DM + col0 + bj * 128 + n * 16;
                        const f32x4 v = *(const f32x4*)(g.resid + o) + acc[ai][bj][m][n];
                        *(f32x4*)(g.xout + o) = v;
                        u32x2 w; w.x = cvtpk(v[0], v[1]); w.y = cvtpk(v[2], v[3]);
                        *(u32x2*)(g.xb + o) = w;
                        ss += (v[0] * v[0] + v[1] * v[1]) + (v[2] * v[2] + v[3] * v[3]);
                    }
                ss += __shfl_xor(ss, 16); ss += __shfl_xor(ss, 32);
                if (fq == 0) atomic_addf(g.ssq_out + row, ss);
            }
    } else {
        LAS float* smax = (LAS float*)(lds + LDS_EPI);
        LAS float* ssum = (LAS float*)(lds + LDS_EPI + 4096);
        const float C = 0.044194173824159216f * 1.4426950408889634f;
#pragma unroll
        for (int ai = 0; ai < 2; ++ai)
#pragma unroll
            for (int m = 0; m < 4; ++m) {
                __builtin_amdgcn_sched_barrier(0);
                float t = -3.0e38f;
#pragma unroll
                for (int bj = 0; bj < 2; ++bj)
#pragma unroll
                    for (int n = 0; n < 2; ++n)
#pragma unroll
                        for (int j = 0; j < 4; ++j) t = fmaxf(t, acc[ai][bj][m][n][j]);
                t = fmaxf(t, __shfl_xor(t, 16)); t = fmaxf(t, __shfl_xor(t, 32));
                if (fq == 0) smax[(ai * 128 + wr * 64 + m * 16 + fr) * 4 + wc] = t;
            }
        asm volatile("s_waitcnt lgkmcnt(0)" ::: "memory"); __builtin_amdgcn_s_barrier(); asm volatile("" ::: "memory");
#pragma unroll
        for (int ai = 0; ai < 2; ++ai)
#pragma unroll
            for (int m = 0; m < 4; ++m) {
                __builtin_amdgcn_sched_barrier(0);
                const int rl = ai * 128 + wr * 64 + m * 16 + fr;
                const f32x4 q = *(LAS f32x4*)(smax + rl * 4);
                const float mm = fmaxf(fmaxf(q[0], q[1]), fmaxf(q[2], q[3])) * C;
                float s = 0.f;
#pragma unroll
                for (int bj = 0; bj < 2; ++bj)
#pragma unroll
                    for (int n = 0; n < 2; ++n)
#pragma unroll
                        for (int j = 0; j < 4; ++j) { const float e = __builtin_amdgcn_exp2f(acc[ai][bj][m][n][j] * C - mm); acc[ai][bj][m][n][j] = e; s += e; }
                s += __shfl_xor(s, 16); s += __shfl_xor(s, 32);
                if (fq == 0) ssum[rl * 4 + wc] = s;
            }
        asm volatile("s_waitcnt lgkmcnt(0)" ::: "memory"); __builtin_amdgcn_s_barrier(); asm volatile("" ::: "memory");
        const int col0 = wc * 32 + 8 * fq;
#pragma unroll
        for (int ai = 0; ai < 2; ++ai)
#pragma unroll
            for (int m = 0; m < 4; ++m) {
                __builtin_amdgcn_sched_barrier(0);
                const int rl = ai * 128 + wr * 64 + m * 16 + fr;
                const f32x4 q = *(LAS f32x4*)(ssum + rl * 4);
                const float inv = 1.0f / ((q[0] + q[1]) + (q[2] + q[3]));
                bf16_t* rowp = g.out + (long)(u.pm * 256 + rl) * g.ldo + u.z * 256 + col0;
#pragma unroll
                for (int bj = 0; bj < 2; ++bj) {
                    const f32x4 v0 = acc[ai][bj][m][0] * inv, v1 = acc[ai][bj][m][1] * inv;
                    u32x4 w; w.x = cvtpk(v0[0], v0[1]); w.y = cvtpk(v0[2], v0[3]); w.z = cvtpk(v1[0], v1[1]); w.w = cvtpk(v1[2], v1[3]);
                    *(u32x4*)(rowp + bj * 128) = w;
                }
            }
    }
}

template <int EPI> __device__ __forceinline__ void gemm_phase(LAS unsigned char* lds, const Params* kp, int tr, int l, int k, int gi) {
    using namespace pg8;
    int Kdim, lda_, ldb_, perm_;
    { GemmDesc g0; if (!make_gemm(*kp, tr, l, k, gi, g0)) return; Kdim = g0.K; lda_ = g0.lda; ldb_ = g0.ldb; perm_ = g0.perm; }
    const int tid = ltid(), wid = __builtin_amdgcn_readfirstlane(tid >> 6), lane = tid & 63, wr = wid >> 2, wc = wid & 3, fr = lane & 15, fq = lane >> 4;
    const int K = Kdim, nt = K / BK; const int G = gridDim.x, cblk = lbid();
    unsigned voffA[2], voffB[2];
#pragma unroll
    for (int i = 0; i < 2; ++i) { int R, C; stage_rc(tid * 16 + i * 8192, R, C); const int Rb = perm_ ? ((R & ~31) + perm32(R & 31)) : R;
        voffA[i] = (unsigned)(R * lda_ + C) * 2u; voffB[i] = (unsigned)(Rb * ldb_ + C) * 2u; }
    const size_t kstep = (size_t)(BK * 2);
    const size_t hstepA = (size_t)HALF * lda_ * 2, hstepB = (size_t)HALF * ldb_ * 2;
    const unsigned ldsw = (unsigned)wid * 1024u;
    const int aoff = lds_byte(wr * 64 + fr, fq * 8), boff = lds_byte(wc * 32 + fr, fq * 8);
#define PG8_SA(b, h) (((b) * 2 + (h)) * HTB)
#define PG8_SB(b, h) ((4 + (b) * 2 + (h)) * HTB)
#define PG8_STAGE(bufoff, gbase, voff) do { _Pragma("unroll") for (int _i = 0; _i < 2; ++_i) \
        __builtin_amdgcn_global_load_lds((const unsigned*)((const char*)(gbase) + (voff)[_i]), (LAS unsigned*)(lds + (bufoff) + ldsw + _i * 8192), 16, 0, 0); } while (0)
#define PG8_LDA(dst, b, h) do { _Pragma("unroll") for (int m = 0; m < 4; ++m) _Pragma("unroll") for (int k = 0; k < 2; ++k) dst[m][k] = *(const LAS bf16x8*)(lds + PG8_SA(b, h) + aoff + m * 2048 + k * 1024); } while (0)
#define PG8_LDB(dst, b, h) do { _Pragma("unroll") for (int n = 0; n < 2; ++n) _Pragma("unroll") for (int k = 0; k < 2; ++k) dst[n][k] = *(const LAS bf16x8*)(lds + PG8_SB(b, h) + boff + n * 2048 + k * 1024); } while (0)
#define PG8_MMA(ai, bj, At, Bt) do { __builtin_amdgcn_s_setprio(1); _Pragma("unroll") for (int m = 0; m < 4; ++m) _Pragma("unroll") for (int n = 0; n < 2; ++n) _Pragma("unroll") for (int k = 0; k < 2; ++k) \
        acc[ai][bj][m][n] = __builtin_amdgcn_mfma_f32_16x16x32_bf16(Bt[n][k], At[m][k], acc[ai][bj][m][n], 0, 0, 0); __builtin_amdgcn_s_setprio(0); } while (0)
#define PG8_WAIT_V(n) asm volatile("s_waitcnt vmcnt(" #n ")" ::: "memory")
#define PG8_WAIT_L(n) asm volatile("s_waitcnt lgkmcnt(" #n ")" ::: "memory")
#define PG8_BAR __builtin_amdgcn_s_barrier()
#define PG8_SCHED __builtin_amdgcn_sched_barrier(0)
    Unit cur, nxt; int ui = 0;
    if (!next_unit(kp, tr, l, k, gi, 0, G, cblk, cur)) return;
    f32x4 acc[2][2][4][2];
#pragma unroll
    for (int a = 0; a < 2; ++a)
#pragma unroll
        for (int b = 0; b < 2; ++b)
#pragma unroll
            for (int m = 0; m < 4; ++m)
#pragma unroll
                for (int n = 0; n < 2; ++n) acc[a][b][m][n] = (f32x4){0.f, 0.f, 0.f, 0.f};
    bf16x8 At[4][2], B0[2][2], B1[2][2];
    const char* cA = cur.a; const char* cB = cur.b;
    PG8_STAGE(PG8_SB(0, 0), cB, voffB); PG8_STAGE(PG8_SA(0, 0), cA, voffA); PG8_STAGE(PG8_SB(0, 1), cB + hstepB, voffB); PG8_STAGE(PG8_SA(0, 1), cA + hstepA, voffA);
    if (wr == 1) PG8_BAR;
    PG8_WAIT_V(4); PG8_BAR;
    PG8_STAGE(PG8_SB(1, 0), cB + kstep, voffB); PG8_STAGE(PG8_SA(1, 0), cA + kstep, voffA); PG8_STAGE(PG8_SB(1, 1), cB + hstepB + kstep, voffB);
    PG8_WAIT_V(6); PG8_BAR;
    for (;;) {
        const bool has_next = next_unit(kp, tr, l, k, gi, ui + 1, G, cblk, nxt);
        const char* nA = has_next ? nxt.a : cA; const char* nB = has_next ? nxt.b : cB;
        for (int t = 0; t < nt; t += 2) {
            const bool last = (t == nt - 2);
            const char* a1 = cA + (size_t)(t + 1) * kstep;
            const char* a2 = last ? nA : cA + (size_t)(t + 2) * kstep; const char* b2 = last ? nB : cB + (size_t)(t + 2) * kstep;
            const char* a3 = a2 + kstep; const char* b3 = b2 + kstep;
            PG8_LDB(B0, 0, 0); PG8_SCHED; PG8_LDA(At, 0, 0); PG8_STAGE(PG8_SA(1, 1), a1 + hstepA, voffA);
            PG8_WAIT_L(8); PG8_BAR; PG8_WAIT_L(0); PG8_MMA(0, 0, At, B0); PG8_BAR; PG8_SCHED;
            PG8_LDB(B1, 0, 1); PG8_STAGE(PG8_SB(0, 0), b2, voffB);
            PG8_BAR; PG8_WAIT_L(0); PG8_MMA(0, 1, At, B1); PG8_BAR;
            PG8_LDA(At, 0, 1); PG8_STAGE(PG8_SA(0, 0), a2, voffA);
            PG8_BAR; PG8_WAIT_L(0); PG8_MMA(1, 0, At, B0); PG8_BAR; PG8_SCHED;
            PG8_STAGE(PG8_SB(0, 1), b2 + hstepB, voffB);
            PG8_WAIT_V(6); PG8_BAR; PG8_MMA(1, 1, At, B1); PG8_BAR;
            PG8_LDB(B0, 1, 0); PG8_SCHED; PG8_LDA(At, 1, 0); PG8_STAGE(PG8_SA(0, 1), a2 + hstepA, voffA);
            PG8_WAIT_L(8); PG8_BAR; PG8_WAIT_L(0); PG8_MMA(0, 0, At, B0); PG8_BAR; PG8_SCHED;
            PG8_LDB(B1, 1, 1); PG8_STAGE(PG8_SB(1, 0), b3, voffB);
            PG8_BAR; PG8_WAIT_L(0); PG8_MMA(0, 1, At, B1); PG8_BAR;
            PG8_LDA(At, 1, 1); PG8_STAGE(PG8_SA(1, 0), a3, voffA);
            PG8_BAR; PG8_WAIT_L(0); PG8_MMA(1, 0, At, B0); PG8_BAR; PG8_SCHED;
            PG8_STAGE(PG8_SB(1, 1), b3 + hstepB, voffB);
            PG8_WAIT_V(6); PG8_BAR; PG8_MMA(1, 1, At, B1); PG8_BAR;
        }
        gemm_epilogue<EPI>(kp, tr, l, k, gi, acc, cur, lds);
        if (!has_next) break;
#pragma unroll
        for (int a = 0; a < 2; ++a)
#pragma unroll
            for (int b = 0; b < 2; ++b)
#pragma unroll
                for (int m = 0; m < 4; ++m)
#pragma unroll
                    for (int n = 0; n < 2; ++n) acc[a][b][m][n] = (f32x4){0.f, 0.f, 0.f, 0.f};
        cur = nxt; cA = nA; cB = nB; ++ui;
    }
    PG8_WAIT_V(0);
    if (wr == 0) PG8_BAR;
    PG8_BAR;
#undef PG8_SA
#undef PG8_SB
#undef PG8_STAGE
#undef PG8_LDA
#undef PG8_LDB
#undef PG8_MMA
#undef PG8_WAIT_V
#undef PG8_WAIT_L
#undef PG8_BAR
#undef PG8_SCHED
}

namespace att {
constexpr int NW = 8, QBLK = 32, KVBLK = 64;
constexpr float SCALE = 0.07216878364870322f;
constexpr float THR = 8.f;
constexpr int LDQ = 1536, LDK = 2048, LDKR = 64, LDO = 2048;
constexpr int SHM_V = KVBLK * 128 * 2, SHM_K = KVBLK * 128 * 2, SHM_KR = KVBLK * 64 * 2;
#define KSWZ(row, colB) ((row) * 256 + ((colB) ^ (((row) & 7) << 4)))
#define KRSWZ(row, colB) ((row) * 128 + ((colB) ^ (((row) & 7) << 4)))
#define SBAR() __builtin_amdgcn_sched_barrier(0)
__device__ __forceinline__ int crow(int r, int hi) { return (r & 3) + 8 * (r >> 2) + 4 * hi; }
__device__ __forceinline__ void partialSM(f32x16& p0, f32x16& p1, float& m_reg, float& mn, float& alpha) {
    constexpr float C = SCALE * 1.4426950408889634f;
    float pmax = p0[0];
#pragma unroll
    for (int r = 1; r < 16; ++r) pmax = fmaxf(pmax, p0[r]);
#pragma unroll
    for (int r = 0; r < 16; ++r) pmax = fmaxf(pmax, p1[r]);
    { auto rr = __builtin_amdgcn_permlane32_swap(__float_as_uint(pmax), __float_as_uint(pmax), false, false);
      pmax = fmaxf(__uint_as_float(rr[0]), __uint_as_float(rr[1])); }
    if (__builtin_expect(__all(pmax - m_reg <= THR / SCALE), 1)) { mn = m_reg; alpha = 1.f; }
    else { mn = fmaxf(m_reg, pmax); alpha = __builtin_amdgcn_exp2f((m_reg - mn) * C); m_reg = mn; }
    float mnC = -mn * C;
#pragma unroll
    for (int r = 0; r < 16; ++r) p0[r] = fmaf(p0[r], C, mnC);
#pragma unroll
    for (int r = 0; r < 16; ++r) p1[r] = fmaf(p1[r], C, mnC);
#pragma unroll
    for (int r = 0; r < 16; ++r) p0[r] = __builtin_amdgcn_exp2f(p0[r]);
}
__device__ __forceinline__ void finishSM(f32x16& p0, f32x16& p1, float alpha, float& l_reg, bf16x8& pa0, bf16x8& pa1, bf16x8& pa2, bf16x8& pa3) {
#pragma unroll
    for (int r = 0; r < 16; ++r) p1[r] = __builtin_amdgcn_exp2f(p1[r]);
    float ps = 0;
#pragma unroll
    for (int r = 0; r < 16; ++r) ps += p0[r];
#pragma unroll
    for (int r = 0; r < 16; ++r) ps += p1[r];
    { auto rr = __builtin_amdgcn_permlane32_swap(__float_as_uint(ps), __float_as_uint(ps), false, false);
      ps = __uint_as_float(rr[0]) + __uint_as_float(rr[1]); }
    l_reg = l_reg * alpha + ps;
#define PK4(P, BASE, OUT) do { unsigned a0 = cvtpk(P[BASE + 0], P[BASE + 1]), a1 = cvtpk(P[BASE + 2], P[BASE + 3]);   \
    unsigned b0 = cvtpk(P[BASE + 4], P[BASE + 5]), b1 = cvtpk(P[BASE + 6], P[BASE + 7]);                              \
    auto r0 = __builtin_amdgcn_permlane32_swap(a0, b0, false, false); auto r1 = __builtin_amdgcn_permlane32_swap(a1, b1, false, false); \
    u32x4 w = {r0[0], r1[0], r0[1], r1[1]}; OUT = *reinterpret_cast<bf16x8*>(&w); } while (0)
    PK4(p0, 0, pa0); PK4(p0, 8, pa1); PK4(p1, 0, pa2); PK4(p1, 8, pa3);
#undef PK4
}
__device__ __forceinline__ void qkt(f32x16& p0, f32x16& p1, const char* Ks, const char* Krs, const bf16x8* qr, const char* qrl, int r32, int hi) {
    p0 = f32x16{}; p1 = f32x16{};
#pragma unroll
    for (int d0 = 0; d0 < 8; ++d0) { int cb = (d0 * 16 + hi * 8) * 2;
        bf16x8 b0 = *reinterpret_cast<const bf16x8*>(Ks + KSWZ(r32, cb));
        bf16x8 b1 = *reinterpret_cast<const bf16x8*>(Ks + KSWZ(32 + r32, cb));
        p0 = __builtin_amdgcn_mfma_f32_32x32x16_bf16(b0, qr[d0], p0, 0, 0, 0);
        p1 = __builtin_amdgcn_mfma_f32_32x32x16_bf16(b1, qr[d0], p1, 0, 0, 0); }
#pragma unroll
    for (int d0 = 0; d0 < 4; ++d0) { int cb = (d0 * 16 + hi * 8) * 2;
        bf16x8 b0 = *reinterpret_cast<const bf16x8*>(Krs + KRSWZ(r32, cb));
        bf16x8 b1 = *reinterpret_cast<const bf16x8*>(Krs + KRSWZ(32 + r32, cb));
        const bf16x8 qv = *reinterpret_cast<const bf16x8*>(qrl + d0 * 8192);
        p0 = __builtin_amdgcn_mfma_f32_32x32x16_bf16(b0, qv, p0, 0, 0, 0);
        p1 = __builtin_amdgcn_mfma_f32_32x32x16_bf16(b1, qv, p1, 0, 0, 0); }
}
__device__ __forceinline__ int v_st(int k, int c) { const int kk = (k & ~0xC) | ((k & 4) << 1) | ((k & 8) >> 1); return ((kk >> 3) * 4 + (c >> 5)) * 512 + ((kk & 7) * 32 + (c & 31)) * 2; }
__device__ __forceinline__ int v_rd_base(int lane) { return ((lane & 3) << 3) | (((lane >> 2) & 3) << 6) | (((lane >> 4) & 1) << 5) | (((lane >> 5) & 1) << 8); }
constexpr int v_rd_off(int d0, int ks, int half) { return d0 * 512 + ks * 4096 + half * 2048; }
template <int OFF> __device__ __forceinline__ s16x4 tr_read(int vb) {
    s16x4 r; asm volatile("ds_read_b64_tr_b16 %0, %1 offset:%2" : "=&v"(r) : "v"(vb), "i"(OFF) : "memory"); return r;
}
template <int D0> __device__ __forceinline__ void pv_one(f32x16& od, int vb, bf16x8 pa0, bf16x8 pa1, bf16x8 pa2, bf16x8 pa3) {
    const s16x4 l0 = tr_read<v_rd_off(D0, 0, 0)>(vb), h0 = tr_read<v_rd_off(D0, 0, 1)>(vb), l1 = tr_read<v_rd_off(D0, 1, 0)>(vb), h1 = tr_read<v_rd_off(D0, 1, 1)>(vb);
    const s16x4 l2 = tr_read<v_rd_off(D0, 2, 0)>(vb), h2 = tr_read<v_rd_off(D0, 2, 1)>(vb), l3 = tr_read<v_rd_off(D0, 3, 0)>(vb), h3 = tr_read<v_rd_off(D0, 3, 1)>(vb);
    asm volatile("s_waitcnt lgkmcnt(0)" ::: "memory"); SBAR();
#define PK(L, H) (bf16x8){L[0], L[1], L[2], L[3], H[0], H[1], H[2], H[3]}
    od = __builtin_amdgcn_mfma_f32_32x32x16_bf16(pa0, PK(l0, h0), od, 0, 0, 0);
    od = __builtin_amdgcn_mfma_f32_32x32x16_bf16(pa1, PK(l1, h1), od, 0, 0, 0);
    od = __builtin_amdgcn_mfma_f32_32x32x16_bf16(pa2, PK(l2, h2), od, 0, 0, 0);
    od = __builtin_amdgcn_mfma_f32_32x32x16_bf16(pa3, PK(l3, h3), od, 0, 0, 0);
#undef PK
}
__device__ __forceinline__ void pv_d0(f32x16* o, int vb, bf16x8 pa0, bf16x8 pa1, bf16x8 pa2, bf16x8 pa3) {
    pv_one<0>(o[0], vb, pa0, pa1, pa2, pa3); pv_one<1>(o[1], vb, pa0, pa1, pa2, pa3); pv_one<2>(o[2], vb, pa0, pa1, pa2, pa3); pv_one<3>(o[3], vb, pa0, pa1, pa2, pa3);
}

__device__ __forceinline__ void attn_body(const bf16_t* __restrict__ Qb, const bf16_t* __restrict__ Kh, const bf16_t* __restrict__ Vh, const bf16_t* __restrict__ Kr,
                                          bf16_t* __restrict__ Ob, int seq, char* lds) {
    const int tid = ltid(), wid = tid >> 6, lane = tid & 63, r32 = lane & 31, hi = lane >> 5;
    char* V_lds = lds; char* K_lds = lds + 2 * SHM_V; char* KR_lds = lds + 2 * SHM_V + 2 * SHM_K;
    float* ws = (float*)(lds + 2 * SHM_V + 2 * SHM_K + 2 * SHM_KR) + wid * 64; float* li_l = ws; float* al_l = ws + 32;
    float m_reg = -1e30f, l_reg = 0; f32x16 o[4] = {}; bf16x8 qr[8];
    const bf16_t* Qw = Qb + (long)(wid * QBLK + r32) * LDQ + hi * 8;
#pragma unroll
    for (int d0 = 0; d0 < 8; ++d0) qr[d0] = *reinterpret_cast<const bf16x8*>(Qw + d0 * 16);
    char* qrl = lds + 84 * 1024 + tid * 16;
#pragma unroll
    for (int d0 = 0; d0 < 4; ++d0) *reinterpret_cast<bf16x8*>(qrl + d0 * 8192) = *reinterpret_cast<const bf16x8*>(Qw + (8 + d0) * 16);
    const int sr = tid >> 4, sc = (tid & 15) * 8, vst0 = v_st(sr, sc), vst1 = v_st(32 + sr, sc);
    const int krr = tid >> 3, krc = (tid & 7) * 8;
    const int vb0 = (int)(uintptr_t)V_lds + v_rd_base(lane);
    bf16x8 s_vs0, s_vs1, s_ks0, s_ks1, s_kr;
#define SLOAD(k0) do { s_vs0 = *reinterpret_cast<const bf16x8*>(&Vh[(long)((k0) + sr) * LDK + sc]); s_vs1 = *reinterpret_cast<const bf16x8*>(&Vh[(long)((k0) + 32 + sr) * LDK + sc]); \
    s_ks0 = *reinterpret_cast<const bf16x8*>(&Kh[(long)((k0) + sr) * LDK + sc]); s_ks1 = *reinterpret_cast<const bf16x8*>(&Kh[(long)((k0) + 32 + sr) * LDK + sc]); \
    s_kr = *reinterpret_cast<const bf16x8*>(&Kr[(long)((k0) + krr) * LDKR + krc]); } while (0)
#define SWRITE(b) do { *(bf16x8*)(V_lds + (b) * SHM_V + vst0) = s_vs0; *(bf16x8*)(V_lds + (b) * SHM_V + vst1) = s_vs1; int kc = sc * 2;   \
    *(bf16x8*)(K_lds + (b) * SHM_K + KSWZ(sr, kc)) = s_ks0; *(bf16x8*)(K_lds + (b) * SHM_K + KSWZ(32 + sr, kc)) = s_ks1;                  \
    *(bf16x8*)(KR_lds + (b) * SHM_KR + KRSWZ(krr, krc * 2)) = s_kr; } while (0)
#define SWAIT() asm volatile("s_waitcnt vmcnt(0)" ::: "memory")
#define RESC(a) do { if (__any((a) < 1.f)) { if (hi == 0) al_l[r32] = (a); asm volatile("s_waitcnt lgkmcnt(0)" ::: "memory"); \
    _Pragma("unroll") for (int d = 0; d < 4; ++d) _Pragma("unroll") for (int r = 0; r < 16; ++r) o[d][r] *= al_l[crow(r, hi)]; } } while (0)
    f32x16 pA0, pA1, pB0, pB1; float mnA, mnB, alA, alB; bf16x8 pa0, pa1, pa2, pa3; const int NT = seq / KVBLK;
    SLOAD(0); SWAIT(); SWRITE(0); __syncthreads();
    qkt(pA0, pA1, K_lds, KR_lds, qr, qrl, r32, hi); partialSM(pA0, pA1, m_reg, mnA, alA);
    SLOAD(KVBLK);
    SWAIT(); SWRITE(1); __syncthreads();
    for (int j = 1; j + 1 < NT; j += 2) {
        SBAR(); qkt(pB0, pB1, K_lds + SHM_K, KR_lds + SHM_KR, qr, qrl, r32, hi);
        finishSM(pA0, pA1, alA, l_reg, pa0, pa1, pa2, pa3); SBAR();
        SLOAD((j + 1) * KVBLK); SBAR();
        pv_d0(o, vb0, pa0, pa1, pa2, pa3); partialSM(pB0, pB1, m_reg, mnB, alB);
        __syncthreads(); SWAIT(); SWRITE(0);
        RESC(alB); __syncthreads();
        SBAR(); qkt(pA0, pA1, K_lds, KR_lds, qr, qrl, r32, hi);
        finishSM(pB0, pB1, alB, l_reg, pa0, pa1, pa2, pa3); SBAR();
        SLOAD((j + 2) * KVBLK); SBAR();
        pv_d0(o, vb0 + (int)SHM_V, pa0, pa1, pa2, pa3); partialSM(pA0, pA1, m_reg, mnA, alA);
        __syncthreads(); SWAIT(); SWRITE(1);
        RESC(alA); __syncthreads();
    }
    SBAR(); qkt(pB0, pB1, K_lds + SHM_K, KR_lds + SHM_KR, qr, qrl, r32, hi);
    finishSM(pA0, pA1, alA, l_reg, pa0, pa1, pa2, pa3); SBAR();
    pv_d0(o, vb0, pa0, pa1, pa2, pa3); partialSM(pB0, pB1, m_reg, mnB, alB);
    __syncthreads(); RESC(alB);
    finishSM(pB0, pB1, alB, l_reg, pa0, pa1, pa2, pa3); SBAR();
    pv_d0(o, vb0 + (int)SHM_V, pa0, pa1, pa2, pa3);
    if (hi == 0) li_l[r32] = l_reg; asm volatile("s_waitcnt lgkmcnt(0)" ::: "memory");
    float rli[16];
#pragma unroll
    for (int r = 0; r < 16; ++r) rli[r] = __builtin_amdgcn_rcpf(li_l[crow(r, hi)]);
    bf16_t* Ow = Ob + (long)(wid * QBLK) * LDO;
#pragma unroll
    for (int r = 0; r < 16; ++r) { int orow = crow(r, hi);
#pragma unroll
        for (int d0 = 0; d0 < 4; ++d0) Ow[(long)orow * LDO + d0 * 32 + r32] = f2bf(o[d0][r] * rli[r]); }
    __syncthreads();
#undef SLOAD
#undef SWRITE
#undef SWAIT
#undef RESC
}
}

namespace hg {
constexpr int LD = 136, LDT = 72;
constexpr int O_RZ = 0, O_RQ = O_RZ + 64 * LD * 2, O_RV = O_RQ + 64 * LD * 2, O_QD = O_RV + 64 * LD * 2, O_KD = O_QD + 64 * LD * 2,
              O_KDT = O_KD + 64 * LD * 2, O_VT = O_KDT + 128 * LDT * 2, O_P = O_VT + 128 * LDT * 2, O_SEG = O_P + 64 * LDT * 2, O_EV = O_SEG + 4 * 128 * 4, O_END = O_EV + 3 * 128 * 4;
static_assert(O_END <= LDS_BCAST, "hgrn LDS");
__device__ __forceinline__ float clampf(float x, float lo, float hi) { return fminf(fmaxf(x, lo), hi); }

__device__ __forceinline__ void hgrn_unit(LAS unsigned char* lds, bf16_t* hgb  , const float* lb_logits, int layer, int S, int unit) {
    const int tid = ltid(), wid = tid >> 6, lane = tid & 63, l15 = lane & 15, quad = lane >> 4;
    const int dir = unit & 1, h = (unit >> 1) & 7, b = unit >> 4;
    const int qcol = h * 128, zcol = (dir ? 2048 : 1024) + h * 128, vcol = 3072 + h * 128;
    const int ch = tid & 127, seg = tid >> 7;
    float lb = 0.f;
    if (layer > 0) {
        float mx = -3e38f; for (int l = 0; l < DEPTH; ++l) mx = fmaxf(mx, lb_logits[l * 2048 + dir * 1024 + h * 128 + ch]);
        float den = 0.f, num = 0.f; for (int l = 0; l < DEPTH; ++l) { const float e = __expf(lb_logits[l * 2048 + dir * 1024 + h * 128 + ch] - mx); den += e; if (l >= 1 && l <= layer) num += e; }
        lb = num / den;
    }
    const float oml = 1.f - lb;
    LAS bf16_t* RZ = (LAS bf16_t*)(lds + O_RZ); LAS bf16_t* RQ = (LAS bf16_t*)(lds + O_RQ); LAS bf16_t* RV = (LAS bf16_t*)(lds + O_RV);
    LAS bf16_t* QD = (LAS bf16_t*)(lds + O_QD); LAS bf16_t* KD = (LAS bf16_t*)(lds + O_KD); LAS bf16_t* KDT = (LAS bf16_t*)(lds + O_KDT);
    LAS bf16_t* VT = (LAS bf16_t*)(lds + O_VT); LAS bf16_t* PP = (LAS bf16_t*)(lds + O_P);
    LAS float* SEG = (LAS float*)(lds + O_SEG); LAS float* EV = (LAS float*)(lds + O_EV);
    const int n = S / 64;
    const int r0 = tid >> 4, c8 = (tid & 15) * 8;
    bf16x8 pz0, pz1, pq0, pq1, pv0, pv1;
#define HG_ROW(c, tau) ((long)b * S + (dir ? (S - 1 - ((c) * 64 + (tau))) : ((c) * 64 + (tau))))
#define HG_LOAD(c) do { const bf16_t* ra = hgb + HG_ROW(c, r0) * HGW; const bf16_t* rb = hgb + HG_ROW(c, r0 + 32) * HGW; \
    pz0 = *(const bf16x8*)(ra + zcol + c8); pz1 = *(const bf16x8*)(rb + zcol + c8); pq0 = *(const bf16x8*)(ra + qcol + c8); pq1 = *(const bf16x8*)(rb + qcol + c8); \
    pv0 = *(const bf16x8*)(ra + vcol + c8); pv1 = *(const bf16x8*)(rb + vcol + c8); } while (0)
    f32x4 Sst[8];
#pragma unroll
    for (int i = 0; i < 8; ++i) Sst[i] = (f32x4){0.f, 0.f, 0.f, 0.f};
    HG_LOAD(0);
    for (int c = 0; c < n; ++c) {
        *(LAS bf16x8*)(RZ + r0 * LD + c8) = pz0; *(LAS bf16x8*)(RZ + (r0 + 32) * LD + c8) = pz1;
        *(LAS bf16x8*)(RQ + r0 * LD + c8) = pq0; *(LAS bf16x8*)(RQ + (r0 + 32) * LD + c8) = pq1;
        *(LAS bf16x8*)(RV + r0 * LD + c8) = pv0; *(LAS bf16x8*)(RV + (r0 + 32) * LD + c8) = pv1;
        wg_barrier();
        if (c + 1 < n) HG_LOAD(c + 1);
        float bl[16], kk[16]; float run = 0.f;
#pragma unroll
        for (int i = 0; i < 16; ++i) {
            const float z = clampf(bf2f(RZ[(seg * 16 + i) * LD + ch]), -80.f, 80.f);
            const float e = __expf(-z), sg = 1.f / (1.f + e);
            const float f = lb + oml * sg;
            run += __logf(f); bl[i] = run; kk[i] = oml * e * sg;
        }
        SEG[seg * 128 + ch] = run;
        asm volatile("s_waitcnt lgkmcnt(0)" ::: "memory"); __builtin_amdgcn_s_barrier(); asm volatile("" ::: "memory");
        const float t0 = SEG[ch], t1 = SEG[128 + ch], t2 = SEG[256 + ch], t3 = SEG[384 + ch];
        const float off = (seg > 0 ? t0 : 0.f) + (seg > 1 ? t1 : 0.f) + (seg > 2 ? t2 : 0.f);
        const float bref = t0 + t1, btot = (t0 + t1) + (t2 + t3);
        unsigned kdt[8], vtt[8];
#pragma unroll
        for (int i = 0; i < 16; ++i) {
            const int tau = seg * 16 + i;
            const float bb = bl[i] + off;
            const float eq = __expf(clampf(bb - bref, -80.f, 80.f)), ek = __expf(clampf(bref - bb, -80.f, 80.f));
            const float qv = bf2f(RQ[tau * LD + ch]);
            const float sq = qv / (1.f + __expf(-qv)) * 0.08838834764831845f;
            QD[tau * LD + ch] = f2bf(sq * eq);
            const bf16_t kb = f2bf(kk[i] * ek);
            KD[tau * LD + ch] = kb;
            const bf16_t vb = RV[tau * LD + ch];
            if (i & 1) { kdt[i >> 1] |= ((unsigned)kb) << 16; vtt[i >> 1] |= ((unsigned)vb) << 16; } else { kdt[i >> 1] = kb; vtt[i >> 1] = vb; }
        }
        *(LAS u32x4*)(KDT + ch * LDT + seg * 16) = (u32x4){kdt[0], kdt[1], kdt[2], kdt[3]}; *(LAS u32x4*)(KDT + ch * LDT + seg * 16 + 8) = (u32x4){kdt[4], kdt[5], kdt[6], kdt[7]};
        *(LAS u32x4*)(VT + ch * LDT + seg * 16) = (u32x4){vtt[0], vtt[1], vtt[2], vtt[3]}; *(LAS u32x4*)(VT + ch * LDT + seg * 16 + 8) = (u32x4){vtt[4], vtt[5], vtt[6], vtt[7]};
        if (seg == 0) { EV[ch] = __expf(clampf(bref, -80.f, 80.f)); EV[128 + ch] = __expf(clampf(btot, -80.f, 80.f)); EV[256 + ch] = __expf(clampf(btot - bref, -80.f, 80.f)); }
        asm volatile("s_waitcnt lgkmcnt(0)" ::: "memory"); __builtin_amdgcn_s_barrier(); asm volatile("" ::: "memory");
#pragma unroll
        for (int tt = 0; tt < 2; ++tt) {
            const int ti = wid * 2 + tt, sblk = ti >> 2, tblk = ti & 3;
            f32x4 a = (f32x4){0.f, 0.f, 0.f, 0.f};
            if (sblk <= tblk) {
#pragma unroll
                for (int ks = 0; ks < 4; ++ks) {
                    const bf16x8 af = *(LAS bf16x8*)(KD + (sblk * 16 + l15) * LD + ks * 32 + quad * 8);
                    const bf16x8 bfr = *(LAS bf16x8*)(QD + (tblk * 16 + l15) * LD + ks * 32 + quad * 8);
                    a = __builtin_amdgcn_mfma_f32_16x16x32_bf16(af, bfr, a, 0, 0, 0);
                }
            }
            const int t = tblk * 16 + l15, s0 = sblk * 16 + quad * 4;
            u32x2 w; w.x = cvtpk(s0 + 0 <= t ? a[0] : 0.f, s0 + 1 <= t ? a[1] : 0.f); w.y = cvtpk(s0 + 2 <= t ? a[2] : 0.f, s0 + 3 <= t ? a[3] : 0.f);
            *(LAS u32x2*)(PP + t * LDT + s0) = w;
        }
        asm volatile("s_waitcnt lgkmcnt(0)" ::: "memory"); __builtin_amdgcn_s_barrier(); asm volatile("" ::: "memory");
        const int dv0 = wid * 16;
        bf16x8 bv[2];
#pragma unroll
        for (int ks = 0; ks < 2; ++ks) bv[ks] = *(LAS bf16x8*)(VT + (dv0 + l15) * LDT + ks * 32 + quad * 8);
        f32x4 o[4];
#pragma unroll
        for (int i = 0; i < 4; ++i) o[i] = (f32x4){0.f, 0.f, 0.f, 0.f};
#pragma unroll
        for (int k4 = 0; k4 < 4; ++k4) {
            const f32x4 er0 = *(LAS f32x4*)(EV + 32 * k4 + 4 * quad), er1 = *(LAS f32x4*)(EV + 32 * k4 + 16 + 4 * quad);
            const f32x4 s0 = Sst[2 * k4] * er0, s1 = Sst[2 * k4 + 1] * er1;
            u32x4 bw; bw.x = cvtpk(s0[0], s0[1]); bw.y = cvtpk(s0[2], s0[3]); bw.z = cvtpk(s1[0], s1[1]); bw.w = cvtpk(s1[2], s1[3]);
            const bf16x8 bfr = *reinterpret_cast<bf16x8*>(&bw);
#pragma unroll
            for (int tb = 0; tb < 4; ++tb) {
                const u32x2 a0 = *(LAS u32x2*)(QD + (tb * 16 + l15) * LD + 32 * k4 + 4 * quad);
                const u32x2 a1 = *(LAS u32x2*)(QD + (tb * 16 + l15) * LD + 32 * k4 + 16 + 4 * quad);
                u32x4 aw; aw.x = a0.x; aw.y = a0.y; aw.z = a1.x; aw.w = a1.y;
                o[tb] = __builtin_amdgcn_mfma_f32_16x16x32_bf16(*reinterpret_cast<bf16x8*>(&aw), bfr, o[tb], 0, 0, 0);
            }
        }
#pragma unroll
        for (int ks = 0; ks < 2; ++ks)
#pragma unroll
            for (int tb = 0; tb < 4; ++tb) {
                const bf16x8 af = *(LAS bf16x8*)(PP + (tb * 16 + l15) * LDT + ks * 32 + quad * 8);
                o[tb] = __builtin_amdgcn_mfma_f32_16x16x32_bf16(af, bv[ks], o[tb], 0, 0, 0);
            }
#pragma unroll
        for (int tb = 0; tb < 4; ++tb)
#pragma unroll
            for (int j = 0; j < 4; ++j) hgb[HG_ROW(c, tb * 16 + quad * 4 + j) * HGW + zcol + dv0 + l15] = f2bf(o[tb][j]);
#pragma unroll
        for (int db = 0; db < 8; ++db) {
            f32x4 tmp = (f32x4){0.f, 0.f, 0.f, 0.f};
#pragma unroll
            for (int ks = 0; ks < 2; ++ks) {
                const bf16x8 af = *(LAS bf16x8*)(KDT + (db * 16 + l15) * LDT + ks * 32 + quad * 8);
                tmp = __builtin_amdgcn_mfma_f32_16x16x32_bf16(af, bv[ks], tmp, 0, 0, 0);
            }
            const f32x4 et = *(LAS f32x4*)(EV + 128 + db * 16 + quad * 4), etr = *(LAS f32x4*)(EV + 256 + db * 16 + quad * 4);
            Sst[db] = Sst[db] * et + tmp * etr;
        }
    }
    wg_barrier();
#undef HG_ROW
#undef HG_LOAD
}
}

struct WDesc { const float* src; const float* gain; bf16_t* dst; int K, N, R, map; };

__device__ __forceinline__ void wcvt_phase(LAS unsigned char* lds, const Params& p, int layer) {
    LAS float* tile = (LAS float*)lds;
    const int tid = ltid();
    char* ws = p.ws;
    for (int mi = 0; mi < 10; ++mi) {
        WDesc d;
        switch (mi) {
        case 0: d = {p.w_in + (size_t)layer * 2048 * 5952, p.mix_norm + layer * 2048, (bf16_t*)(ws + OFF_W_IN), 2048, 5952, INP, 1}; break;
        case 1: d = {p.w_uq + (size_t)layer * 512 * 1536, p.q_norm + layer * 512, (bf16_t*)(ws + OFF_W_UQ), 512, 1536, 1536, 0}; break;
        case 2: d = {p.w_ukv + (size_t)layer * 256 * 2048, p.kv_norm + layer * 256, (bf16_t*)(ws + OFF_W_UKV), 256, 2048, 2048, 0}; break;
        case 3: d = {p.w_out + (size_t)layer * 2048 * 2048, nullptr, (bf16_t*)(ws + OFF_W_OUT), 2048, 2048, 2048, 0}; break;
        case 4: d = {p.w_xq + (size_t)layer * 2048 * 2048, p.xattn_norm + layer * 2048, (bf16_t*)(ws + OFF_W_XQ), 2048, 2048, 2048, 0}; break;
        case 5: d = {p.w_xk + (size_t)layer * 2048 * 2048, p.mem_norm + layer * 2048, (bf16_t*)(ws + OFF_W_XK), 2048, 2048, 2048, 0}; break;
        case 6: d = {p.w_xv + (size_t)layer * 2048 * 2048, p.mem_norm + layer * 2048, (bf16_t*)(ws + OFF_W_XV), 2048, 2048, 2048, 0}; break;
        case 7: d = {p.w_xo + (size_t)layer * 2048 * 2048, nullptr, (bf16_t*)(ws + OFF_W_XO), 2048, 2048, 2048, 0}; break;
        case 8: d = {p.w_ffn1 + (size_t)layer * 2048 * 8192, p.ffn_norm + layer * 2048, (bf16_t*)(ws + OFF_W_F1), 2048, 8192, 8192, 0}; break;
        default: d = {p.w_ffn2 + (size_t)layer * 8192 * 2048, nullptr, (bf16_t*)(ws + OFF_W_F2), 8192, 2048, 2048, 0}; break;
        }
        const int nkt = d.K / 64, nrt = d.R / 64, ntile = nkt * nrt;
        for (int t = lbid(); t < ntile; t += gridDim.x) {
            const int kt = t % nkt, rt = t / nkt, k0 = kt * 64, r0 = rt * 64;
            int sc0 = r0; bool zero = false;
            if (d.map) { if (r0 < 832) sc0 = r0; else if (r0 < 1024) zero = true; else sc0 = r0 - 192; }
            {
                const int j = tid & 63, i0 = tid >> 6;
#pragma unroll
                for (int ii = 0; ii < 8; ++ii) { const int i = i0 + ii * 8;
                    float v = zero ? 0.f : d.src[(size_t)(k0 + i) * d.N + sc0 + j];
                    if (d.gain) v *= d.gain[k0 + i];
                    tile[i * 65 + j] = v; }
            }
            wg_barrier();
            {
                const int kp = tid & 31, j0 = tid >> 5;
#pragma unroll
                for (int jj = 0; jj < 4; ++jj) { const int j = j0 + jj * 16;
                    const unsigned w = cvtpk(tile[(2 * kp) * 65 + j], tile[(2 * kp + 1) * 65 + j]);
                    *(unsigned*)(d.dst + (size_t)(r0 + j) * d.K + k0 + 2 * kp) = w; }
            }
            wg_barrier();
        }
    }
}

__device__ __forceinline__ void prep_phase(const Params& p, int tr, int T, int S) {
    const int tid = ltid(), wid = tid >> 6, lane = tid & 63;
    char* ws = p.ws;
    const long gtid = (long)lbid() * 512 + tid, gstride = (long)gridDim.x * 512;
    { ssq_t* ssq = (ssq_t*)(ws + OFF_SSQ); for (long i = gtid; i < (long)10 * TMAX; i += gstride) ssq[TMAX + i] = 0ull;
      if (gtid < 64) ((unsigned*)(ws + OFF_CTR))[gtid] = 0u; }
    { float* rc = (float*)(ws + OFF_ROPE); float* rs = rc + 16384 * 32;
      for (int i = (int)gtid; i < S * 32; i += (int)gstride) { const int pos = i >> 5, f = i & 31;
          const float inv_freq = exp2f(-(float)f * (13.287712379549449f / 32.f));
          const float ang = (float)pos * inv_freq;
          const double rev = (double)ang * 0.15915494309189535; const float fr = (float)(rev - rint(rev));
          rc[i] = __builtin_amdgcn_cosf(fr); rs[i] = __builtin_amdgcn_sinf(fr); } }
    { const float* x = p.x_in[tr]; bf16_t* xb = (bf16_t*)(ws + OFF_XB); ssq_t* ssq0 = (ssq_t*)(ws + OFF_SSQ);
      for (int row = lbid() * 8 + wid; row < T; row += gridDim.x * 8) {
          float ss = 0.f;
#pragma unroll
          for (int i = 0; i < 8; ++i) { const int c = i * 256 + lane * 4; const f32x4 v = *(const f32x4*)(x + (size_t)row * DM + c);
              ss += (v[0] * v[0] + v[1] * v[1]) + (v[2] * v[2] + v[3] * v[3]);
              u32x2 w; w.x = cvtpk(v[0], v[1]); w.y = cvtpk(v[2], v[3]); *(u32x2*)(xb + (size_t)row * DM + c) = w; }
#pragma unroll
          for (int o = 32; o > 0; o >>= 1) ss += __shfl_xor(ss, o);
          if (lane == 0) ssq0[row] = ssq_fix(ss);
      } }
    { const float* mem = p.mem_in[tr]; bf16_t* mn = (bf16_t*)(ws + OFF_MEMN);
      for (int row = lbid() * 8 + wid; row < 512; row += gridDim.x * 8) {
          f32x4 v[8]; float ss = 0.f;
#pragma unroll
          for (int i = 0; i < 8; ++i) { v[i] = *(const f32x4*)(mem + (size_t)row * DM + i * 256 + lane * 4); ss += (v[i][0] * v[i][0] + v[i][1] * v[i][1]) + (v[i][2] * v[i][2] + v[i][3] * v[i][3]); }
#pragma unroll
          for (int o = 32; o > 0; o >>= 1) ss += __shfl_xor(ss, o);
          const float rs = __builtin_amdgcn_rsqf(ss * (1.f / DM) + EPS);
#pragma unroll
          for (int i = 0; i < 8; ++i) { u32x2 w; w.x = cvtpk(v[i][0] * rs, v[i][1] * rs); w.y = cvtpk(v[i][2] * rs, v[i][3] * rs); *(u32x2*)(mn + (size_t)row * DM + i * 256 + lane * 4) = w; }
      } }
}

__device__ __forceinline__ void rope_phase(const Params& p, int T, int S) {
    char* ws = p.ws;
    bf16_t* q = (bf16_t*)(ws + OFF_Q); const bf16_t* kr = (const bf16_t*)(ws + OFF_KR); bf16_t* kro = (bf16_t*)(ws + OFF_KROPE);
    const float* rc = (const float*)(ws + OFF_ROPE); const float* rs = rc + 16384 * 32;
    const int total = T * 9 * 32;
    for (int i = lbid() * 512 + ltid(); i < total; i += gridDim.x * 512) {
        const int f = i & 31; const int ru = i >> 5; const int row_i = ru / 9; const int u = ru - row_i * 9; const long row = row_i; const int pos = row_i & (S - 1);
        const float c = rc[pos * 32 + f], s = rs[pos * 32 + f];
        if (u < 8) { bf16_t* a = q + row * 1536 + u * 192 + 128 + f; const float x1 = bf2f(a[0]), x2 = bf2f(a[32]); a[0] = f2bf(x1 * c - x2 * s); a[32] = f2bf(x2 * c + x1 * s); }
        else { const bf16_t* a = kr + row * 64 + f; const float x1 = bf2f(a[0]), x2 = bf2f(a[32]); kro[row * 64 + f] = f2bf(x1 * c - x2 * s); kro[row * 64 + 32 + f] = f2bf(x2 * c + x1 * s); }
    }
}

__device__ __forceinline__ void hcomb_phase(const Params& p, int layer, int T) {
    char* ws = p.ws; const bf16_t* hgb = (const bf16_t*)(ws + OFF_HG); bf16_t* mix = (bf16_t*)(ws + OFF_MIX);
    const float* on = p.out_norm + layer * 128;
    const int l16 = ltid() & 15;
    const int total = T * 8 * 16;
    for (int i = lbid() * 512 + ltid(); i < total; i += gridDim.x * 512) {
        const int rh = i >> 4; const int h = rh & 7; const long row = rh >> 3;
        const bf16_t* base = hgb + row * HGW + h * 128 + l16 * 8;
        const bf16x8 vf = *(const bf16x8*)(base + 1024), vb = *(const bf16x8*)(base + 2048), vg = *(const bf16x8*)(base + 4096);
        float o[8]; float ss = 0.f;
#pragma unroll
        for (int j = 0; j < 8; ++j) { o[j] = bf2f((bf16_t)vf[j]) + bf2f((bf16_t)vb[j]); ss += o[j] * o[j]; }
        ss += __shfl_xor(ss, 1); ss += __shfl_xor(ss, 2); ss += __shfl_xor(ss, 4); ss += __shfl_xor(ss, 8);
        const float rs = __builtin_amdgcn_rsqf(ss * (1.f / 128.f) + EPS);
        unsigned w[4];
#pragma unroll
        for (int j = 0; j < 8; j += 2) {
            const float g0 = bf2f((bf16_t)vg[j]), g1 = bf2f((bf16_t)vg[j + 1]);
            const float y0 = o[j] * rs * on[l16 * 8 + j] * (g0 / (1.f + __expf(-g0))), y1 = o[j + 1] * rs * on[l16 * 8 + j + 1] * (g1 / (1.f + __expf(-g1)));
            w[j >> 1] = cvtpk(y0, y1);
        }
        *(u32x4*)(mix + row * 2048 + 1024 + h * 128 + l16 * 8) = (u32x4){w[0], w[1], w[2], w[3]};
    }
}

__device__ __forceinline__ void final_phase(const Params& p, float* xout, int T) {
    const int wid = ltid() >> 6, lane = ltid() & 63;
    const ssq_t* ssq = (const ssq_t*)(p.ws + OFF_SSQ) + (size_t)10 * TMAX;
    for (int row = lbid() * 8 + wid; row < T; row += gridDim.x * 8) {
        const float rs = __builtin_amdgcn_rsqf(ssq_val(ssq[row]) * (1.f / DM) + EPS);
#pragma unroll
        for (int i = 0; i < 8; ++i) { const int c = i * 256 + lane * 4; f32x4 v = *(f32x4*)(xout + (size_t)row * DM + c); const f32x4 g = *(const f32x4*)(p.final_norm + c);
            v = v * rs * g; *(f32x4*)(xout + (size_t)row * DM + c) = v; }
    }
}

__device__ __forceinline__ void mixer_phase(LAS unsigned char* lds, const Params& p, int layer, int T, int S, int skip_h) {
    char* ws = p.ws;
    unsigned* ctr = (unsigned*)(ws + OFF_CTR) + layer * 16 + skip_h * 32;
    LAS unsigned* slot = (LAS unsigned*)(lds + LDS_BCAST);
    const int nH = skip_h ? 0 : 2 * 8 * 2, nQB = S / 256, nA = 2 * 8 * nQB;
    bf16_t* hgb = (bf16_t*)(ws + OFF_HG);
    const bf16_t* q = (const bf16_t*)(ws + OFF_Q); const bf16_t* kv = (const bf16_t*)(ws + OFF_KV); const bf16_t* kro = (const bf16_t*)(ws + OFF_KROPE);
    bf16_t* mix = (bf16_t*)(ws + OFF_MIX);
    for (;;) {
        if (ltid() == 0) *slot = __hip_atomic_fetch_add(ctr, 1u, __ATOMIC_RELAXED, __HIP_MEMORY_SCOPE_AGENT);
        wg_barrier();
        const int idx = (int)__builtin_amdgcn_readfirstlane(*slot);
        wg_barrier();
        if (idx >= nH + nA) break;
#ifndef MK_NO_HG
        if (idx < nH) hg::hgrn_unit(lds, hgb, p.lb_logits, layer, S, idx);
        else
#endif
        {
#ifndef MK_NO_ATT
            const int a = idx - nH, qb = a % nQB, h = (a / nQB) & 7, b = a / (nQB * 8);
            const long row0 = (long)b * S + (long)qb * 256, krow0 = (long)b * S;
            att::attn_body(q + row0 * 1536 + h * 192, kv + krow0 * 2048 + h * 256, kv + krow0 * 2048 + h * 256 + 128, kro + krow0 * 64,
                           mix + row0 * 2048 + h * 128, S, (char*)(unsigned char*)lds);
#endif
        }
    }
}

#define XB_TMO      128
#define XB_XCNT(j)  (256  + 64 * (j))
#define XB_XSUB(j)  (1280 + 64 * (j))
#define XB_XGEN(j)  (2304 + 64 * (j))
#define XB_TOP      3328
#define XB_TOPGEN   3392
#define XCD_BAR_WORDS 3456
#define XB_SPIN_CAP (1u << 22)
__device__ __forceinline__ unsigned xb_ld(unsigned* p)              { return __hip_atomic_load(p, __ATOMIC_RELAXED, __HIP_MEMORY_SCOPE_AGENT); }
__device__ __forceinline__ unsigned xb_add(unsigned* p, unsigned v) { return __hip_atomic_fetch_add(p, v, __ATOMIC_RELAXED, __HIP_MEMORY_SCOPE_AGENT); }
__device__ __forceinline__ unsigned xb_xcc_id() { return (unsigned)__builtin_amdgcn_s_getreg((3 << 11) | 20) & 0xFu; }
#define XB_SPIN(cond, bar) do { unsigned _sp = 0; while (cond) { __builtin_amdgcn_s_sleep(1); \
    if ((++_sp & 255u) == 0u) { if (xb_ld(&(bar)[XB_TMO])) break; if (_sp > XB_SPIN_CAP) { atomicAdd(&(bar)[XB_TMO], 1u); break; } } } } while (0)
struct XcdBarrier { unsigned* bar; unsigned x; volatile LAS unsigned* st; };
__device__ __forceinline__ XcdBarrier xcd_barrier_post(unsigned* bar, volatile LAS unsigned* st) {
    XcdBarrier b; b.bar = bar; b.x = xb_xcc_id(); b.st = st;
    if (threadIdx.x == 0) (void)xb_add(&bar[XB_XCNT(b.x)], 1u);
    return b;
}
__device__ __forceinline__ void xcd_barrier_complete(unsigned* bar, unsigned x, unsigned& nloc, unsigned& nx) {
    const unsigned G = gridDim.x * gridDim.y * gridDim.z;
    unsigned sum, cnt, mine, sp = 0u;
    for (;;) {
        sum = 0u; cnt = 0u; mine = 0u;
#pragma unroll
        for (unsigned j = 0; j < 16; ++j) { const unsigned c = xb_ld(&bar[XB_XCNT(j)]); sum += c; cnt += (c > 0u) ? 1u : 0u; mine = (j == x) ? c : mine; }
        if (sum == G) break;
        __builtin_amdgcn_s_sleep(1);
        if ((++sp & 255u) == 0u) { if (xb_ld(&bar[XB_TMO])) break; if (sp > XB_SPIN_CAP) { atomicAdd(&bar[XB_TMO], 1u); break; } }
    }
    nloc = mine > 0u ? mine : 1u; nx = cnt > 0u ? cnt : 1u;
}
__device__ __forceinline__ void xcd_barrier(const XcdBarrier& b) {
    asm volatile("s_waitcnt vmcnt(0)" ::: "memory");
    __syncthreads();
    if (threadIdx.x == 0) {
        unsigned* bar = b.bar;
        __builtin_amdgcn_s_waitcnt(0);
        unsigned nloc = b.st[0], nx = b.st[1];
        if (nloc == 0u) { xcd_barrier_complete(bar, b.x, nloc, nx); b.st[0] = nloc; b.st[1] = nx; }
        const unsigned old = xb_add(&bar[XB_XSUB(b.x)], 1u);
        const unsigned gen = old / nloc;
        if (old + 1u == (gen + 1u) * nloc) {
            __builtin_amdgcn_fence(__ATOMIC_RELEASE, "agent");
            asm volatile("s_waitcnt vmcnt(0)" ::: "memory");
            const unsigned og = xb_add(&bar[XB_TOP], 1u);
            const unsigned tg = og / nx;
            if (og + 1u == (tg + 1u) * nx) xb_add(&bar[XB_TOPGEN], 1u);
            else XB_SPIN(xb_ld(&bar[XB_TOPGEN]) == tg, bar);
            __builtin_amdgcn_fence(__ATOMIC_ACQUIRE, "agent");
            xb_add(&bar[XB_XGEN(b.x)], 1u);
            asm volatile("s_waitcnt vmcnt(0)" ::: "memory");
        } else {
            XB_SPIN(xb_ld(&bar[XB_XGEN(b.x)]) == gen, bar);
            __builtin_amdgcn_fence(__ATOMIC_ACQUIRE, "agent");
            asm volatile("s_waitcnt vmcnt(0)" ::: "memory");
        }
    }
    __syncthreads();
}

constexpr int PH_PER_TRUNK = 28, N_PHASES = 2 * PH_PER_TRUNK;

__device__ __forceinline__ GemmDesc mkgemm(const void* A, int lda, const void* B, int ldb, int K, int nM, int nN) {
    GemmDesc g{}; g.A = (const char*)A; g.B = (const char*)B; g.lda = lda; g.ldb = ldb; g.K = K; g.nM = nM; g.nN = nN; g.nZ = 1; g.perm = 1; g.epi = E_BF16; return g;
}

__device__ __forceinline__ bool make_gemm(const Params& p, int tr, int l, int k, int i, GemmDesc& g) {
    const int T = tr ? 32768 : 8192, S = tr ? 16384 : 4096, nMT = T / 256;
    char* ws = p.ws;
    float* xout = p.out + (tr ? (size_t)8192 * DM : 0);
    ssq_t* ssq = (ssq_t*)(ws + OFF_SSQ);
    ssq_t* ssq_x0 = ssq + (size_t)(l * 5 + 0) * TMAX; ssq_t* ssq_q = ssq + (size_t)(l * 5 + 1) * TMAX; ssq_t* ssq_kv = ssq + (size_t)(l * 5 + 2) * TMAX;
    ssq_t* ssq_x1 = ssq + (size_t)(l * 5 + 3) * TMAX; ssq_t* ssq_x2 = ssq + (size_t)(l * 5 + 4) * TMAX; ssq_t* ssq_nx = ssq + (size_t)((l + 1) * 5) * TMAX;
    bf16_t* xb = (bf16_t*)(ws + OFF_XB);
    if (k == 1) {
        if (i > 0) return false;
        g = mkgemm(xb, DM, ws + OFF_W_IN, DM, DM, nMT, INP / 256); g.epi = E_INPROJ; g.ssq_in = ssq_x0; g.inv_dim = 1.f / DM;
        g.out = (bf16_t*)(ws + OFF_CQ); g.out2 = (bf16_t*)(ws + OFF_KR); g.out3 = (bf16_t*)(ws + OFF_HG); g.ssq_out = ssq_q; g.ssq_out2 = ssq_kv; return true;
    } else if (k == 2) {
        if (i == 0) { g = mkgemm(ws + OFF_CQ, 768, ws + OFF_W_UQ, 512, 512, nMT, 6); g.out = (bf16_t*)(ws + OFF_Q); g.ldo = 1536; g.ssq_in = ssq_q; g.inv_dim = 1.f / 512.f; return true; }
        if (i == 1) { g = mkgemm(ws + OFF_CQ + 512 * 2, 768, ws + OFF_W_UKV, 256, 256, nMT, 8); g.out = (bf16_t*)(ws + OFF_KV); g.ldo = 2048; g.ssq_in = ssq_kv; g.inv_dim = 1.f / 256.f; return true; }
        return false;
    } else if (k == 6) {
        if (i > 0) return false;
        g = mkgemm(ws + OFF_MIX, DM, ws + OFF_W_OUT, DM, DM, nMT, 8); g.epi = E_RESID; g.perm = 0;
        g.resid = (l == 0) ? p.x_in[tr] : xout; g.xout = xout; g.xb = xb; g.ssq_out = ssq_x1; return true;
    } else if (k == 7) {
        if (i == 0) { g = mkgemm(xb, DM, ws + OFF_W_XQ, DM, DM, nMT, 8); g.out = (bf16_t*)(ws + OFF_XQ); g.ldo = DM; g.ssq_in = ssq_x1; g.inv_dim = 1.f / DM; return true; }
        if (i == 1) { g = mkgemm(ws + OFF_MEMN, DM, ws + OFF_W_XK, DM, DM, 2, 8); g.out = (bf16_t*)(ws + OFF_KMEM); g.ldo = DM; return true; }
        if (i == 2) { g = mkgemm(ws + OFF_W_XV, DM, ws + OFF_MEMN, DM, DM, 8, 1); g.nZ = 2; g.bzs = 256 * DM * 2; g.out = (bf16_t*)(ws + OFF_VT); g.ldo = 256; g.ozs = (long)2048 * 256; return true; }
        return false;
    } else if (k == 8) {
        if (i > 0) return false;
        g = mkgemm(ws + OFF_XQ, DM, ws + OFF_KMEM, DM, 512, nMT, 1); g.nZ = 4; g.azs = 512 * 2; g.bzs = 512 * 2; g.bbs = 256 * DM * 2; g.tpb = S / 256;
        g.epi = E_SOFTMAX; g.out = (bf16_t*)(ws + OFF_PBUF); g.ldo = 1024; return true;
    } else if (k == 9) {
        if (i > 0) return false;
        g = mkgemm(ws + OFF_PBUF, 1024, ws + OFF_VT, 256, 256, nMT, 2); g.nZ = 4; g.azs = 256 * 2; g.bzs = 512 * 256 * 2; g.bbs = 2048 * 256 * 2; g.tpb = S / 256;
        g.out = (bf16_t*)(ws + OFF_OBUF); g.ldo = DM; g.ozs = 512; return true;
    } else if (k == 10) {
        if (i > 0) return false;
        g = mkgemm(ws + OFF_OBUF, DM, ws + OFF_W_XO, DM, DM, nMT, 8); g.epi = E_RESID; g.perm = 0;
        g.resid = xout; g.xout = xout; g.xb = xb; g.ssq_out = ssq_x2; return true;
    } else if (k == 11) {
        if (i > 0) return false;
        g = mkgemm(xb, DM, ws + OFF_W_F1, DM, DM, nMT, 32); g.out = (bf16_t*)(ws + OFF_U); g.ldo = 8192; g.ssq_in = ssq_x2; g.inv_dim = 1.f / DM; g.relu2 = 1; return true;
    } else if (k == 12) {
        if (i > 0) return false;
        g = mkgemm(ws + OFF_U, 8192, ws + OFF_W_F2, 8192, 8192, nMT, 8); g.epi = E_RESID; g.perm = 0;
        g.resid = xout; g.xout = xout; g.xb = xb; g.ssq_out = ssq_nx; return true;
    }
    return false;
}

__device__ __forceinline__ void run_phase(const Params* kp, int ph, LAS unsigned char* lds) {
    const Params& p = *kp;
    const int tr = ph / PH_PER_TRUNK, s = ph % PH_PER_TRUNK;
    const int T = tr ? 32768 : 8192, S = tr ? 16384 : 4096;
    float* xout = p.out + (tr ? (size_t)8192 * DM : 0);
    if (s == 0) { prep_phase(p, tr, T, S); return; }
    if (s == PH_PER_TRUNK - 1) { final_phase(p, xout, T); return; }
    const int l = (s - 1) / 13, k = (s - 1) % 13;
    if (k == 0) { wcvt_phase(lds, p, l); return; }
    if (k == 3) { rope_phase(p, T, S); return; }
    if (k == 4) { mixer_phase(lds, p, l, T, S, 0);
#ifdef MK_DBL_ATT
        cg::this_grid().sync(); mixer_phase(lds, p, l, T, S, 1);
#endif
        return; }
    if (k == 5) { hcomb_phase(p, l, T); return; }
#ifndef MK_NO_GEMM
    if (k == 1) gemm_phase<E_INPROJ>(lds, kp, tr, l, k, 0);
    else if (k == 6 || k == 10 || k == 12) gemm_phase<E_RESID>(lds, kp, tr, l, k, 0);
    else if (k == 8) gemm_phase<E_SOFTMAX>(lds, kp, tr, l, k, 0);
    else for (int i = 0; i < 3; ++i) gemm_phase<E_BF16>(lds, kp, tr, l, k, i);
#endif
}

__global__ void __launch_bounds__(512, 2) mk_forward(Params p, int ph_lo, int ph_hi) {
    extern __shared__ __attribute__((aligned(16))) unsigned char shm[];
    LAS unsigned char* lds = (LAS unsigned char*)shm;
    cg::grid_group grid = cg::this_grid();
    volatile LAS unsigned* xst = (volatile LAS unsigned*)(lds + LDS_BCAST + 64);
    if (threadIdx.x == 0) { xst[0] = 0u; xst[1] = 0u; }
    __syncthreads();
    XcdBarrier xb = xcd_barrier_post((unsigned*)(p.ws + OFF_BAR), xst);
    for (int ph = ph_lo; ph < ph_hi; ++ph) {
        const Params* kp = launder_p((const Params*)__builtin_amdgcn_kernarg_segment_ptr());
        run_phase(kp, ph, lds);
#ifdef MK_DBL_K
        { const int s_ = ph % PH_PER_TRUNK; if (s_ != 0 && s_ != PH_PER_TRUNK - 1 && (s_ - 1) % 13 == MK_DBL_K) { xcd_barrier(xb); run_phase(kp, ph, lds); } }
#endif
        if (ph + 1 < ph_hi) { if (ph == ph_lo) grid.sync(); else xcd_barrier(xb); }
    }
}

extern "C" void kernel_launch(void* const* d_in, const int* in_sizes, int n_in, void* d_out, int out_size, void* d_ws, size_t ws_size, hipStream_t stream) {
    static int inited = 0; static int grid_blocks = 0;
    if (!inited) {
        hipFuncSetAttribute((const void*)mk_forward, hipFuncAttributeMaxDynamicSharedMemorySize, LDS_BYTES);
        int dev = 0, cus = 0, per_cu = 0;
        hipGetDevice(&dev); hipDeviceGetAttribute(&cus, hipDeviceAttributeMultiprocessorCount, dev);
        hipOccupancyMaxActiveBlocksPerMultiprocessor(&per_cu, mk_forward, 512, LDS_BYTES);
        if (per_cu < 1) per_cu = 1;
        grid_blocks = cus * 1;
        if (ws_size < WS_END) fprintf(stderr, "kernel_launch: workspace too small: %zu < %zu\n", ws_size, (size_t)WS_END);
        inited = 1;
    }
    Params p{};
    const float* const* in = (const float* const*)d_in;
    p.x_in[0] = in[0]; p.x_in[1] = in[1]; p.mem_in[0] = in[2]; p.mem_in[1] = in[3];
    p.mix_norm = in[4]; p.w_in = in[5]; p.q_norm = in[6]; p.w_uq = in[7]; p.kv_norm = in[8]; p.w_ukv = in[9]; p.lb_logits = in[10]; p.out_norm = in[11]; p.w_out = in[12];
    p.xattn_norm = in[13]; p.mem_norm = in[14]; p.w_xq = in[15]; p.w_xk = in[16]; p.w_xv = in[17]; p.w_xo = in[18]; p.ffn_norm = in[19]; p.w_ffn1 = in[20]; p.w_ffn2 = in[21]; p.final_norm = in[22];
    p.out = (float*)d_out; p.ws = (char*)d_ws;
#if MK_ONE_LAUNCH
    hipMemsetAsync((char*)d_ws + OFF_BAR, 0, 16384, stream);
    int lo = 0, hi = N_PHASES;
    void* args[] = {&p, &lo, &hi};
    hipError_t e = hipLaunchCooperativeKernel((const void*)mk_forward, dim3(grid_blocks), dim3(512), args, LDS_BYTES, stream);
    if (e != hipSuccess) fprintf(stderr, "cooperative launch failed: %s\n", hipGetErrorString(e));
#else
    for (int ph = 0; ph < N_PHASES; ++ph) hipLaunchKernelGGL(mk_forward, dim3(grid_blocks), dim3(512), LDS_BYTES, stream, p, ph, ph + 1);
#endif
}
```

```cpp
#include <hip/hip_runtime.h>
#include <hip/hip_cooperative_groups.h>
#include <cstdio>
namespace cg = cooperative_groups;

#define LAS __attribute__((address_space(3)))
typedef unsigned short bf16_t;
typedef short bf16x8 __attribute__((ext_vector_type(8)));
typedef short s16x4 __attribute__((ext_vector_type(4)));
typedef float f32x4 __attribute__((ext_vector_type(4)));
typedef float f32x8 __attribute__((ext_vector_type(8)));
typedef float f32x16 __attribute__((ext_vector_type(16)));
typedef unsigned u32x4 __attribute__((ext_vector_type(4)));
typedef unsigned u32x2 __attribute__((ext_vector_type(2)));

#ifndef MK_ONE_LAUNCH
#define MK_ONE_LAUNCH 1
#endif

constexpr int DM = 2048, NMEM = 256, DEPTH = 2;
constexpr int INP = 6144;
constexpr int HGW = 5120;
constexpr int TMAX = 32768;
constexpr float EPS = 1e-6f;
constexpr int LDS_BYTES = 144 * 1024;
constexpr int LDS_BCAST = 140 * 1024;
constexpr int LDS_EPI = 128 * 1024;

constexpr size_t al256(size_t x) { return (x + 255) / 256 * 256; }
constexpr size_t E_W_IN = (size_t)INP * 2048, E_W_UQ = 1536 * 512, E_W_UKV = 2048 * 256, E_W_SQ = 2048 * 2048, E_W_F = (size_t)8192 * 2048;
constexpr size_t OFF_W_IN = 0;
constexpr size_t OFF_W_UQ = OFF_W_IN + E_W_IN * 2;
constexpr size_t OFF_W_UKV = OFF_W_UQ + E_W_UQ * 2;
constexpr size_t OFF_W_OUT = OFF_W_UKV + E_W_UKV * 2;
constexpr size_t OFF_W_XQ = OFF_W_OUT + E_W_SQ * 2;
constexpr size_t OFF_W_XK = OFF_W_XQ + E_W_SQ * 2;
constexpr size_t OFF_W_XV = OFF_W_XK + E_W_SQ * 2;
constexpr size_t OFF_W_XO = OFF_W_XV + E_W_SQ * 2;
constexpr size_t OFF_W_F1 = OFF_W_XO + E_W_SQ * 2;
constexpr size_t OFF_W_F2 = OFF_W_F1 + E_W_F * 2;
constexpr size_t OFF_XB = OFF_W_F2 + E_W_F * 2;
constexpr size_t OFF_KR = OFF_XB + (size_t)TMAX * 2048 * 2;
constexpr size_t OFF_KROPE = OFF_KR + (size_t)TMAX * 64 * 2;
constexpr size_t OFF_MIX = OFF_KROPE + (size_t)TMAX * 64 * 2;
constexpr size_t OFF_HG = OFF_MIX + (size_t)TMAX * 2048 * 2;
constexpr size_t OFF_Q = OFF_HG + (size_t)TMAX * HGW * 2;
constexpr size_t OFF_KV = OFF_Q + (size_t)TMAX * 1536 * 2;
constexpr size_t OFF_MEMN = OFF_KV + (size_t)TMAX * 2048 * 2;
constexpr size_t OFF_KMEM = OFF_MEMN + (size_t)2 * 512 * 2048 * 2;
constexpr size_t OFF_VT = OFF_KMEM + (size_t)512 * 2048 * 2;
constexpr size_t OFF_ROPE = OFF_VT + (size_t)512 * 2048 * 2;
constexpr size_t OFF_SSQ = OFF_ROPE + (size_t)16384 * 32 * 4 * 2;
constexpr size_t OFF_CTR = OFF_SSQ + (size_t)22 * TMAX * 8;
constexpr size_t OFF_BAR = OFF_CTR + 256;
constexpr size_t OFF_LB = OFF_BAR + 16384;
constexpr size_t OFF_TS = OFF_LB + 8192;
constexpr size_t OFF_XB0 = OFF_TS + 1024;
constexpr size_t WS_END = OFF_XB0 + (size_t)8192 * 2048 * 2;
constexpr size_t OFF_CQ = OFF_MIX;
constexpr size_t OFF_XQ = OFF_Q;
constexpr size_t OFF_PBUF = OFF_MIX;
constexpr size_t OFF_OBUF = OFF_HG;
constexpr size_t OFF_U = OFF_HG;
static_assert((size_t)TMAX * 8192 * 2 <= OFF_MEMN - OFF_HG, "u must fit");

struct Params {
    const float* x_in[2]; const float* mem_in[2];
    const float *mix_norm, *w_in, *q_norm, *w_uq, *kv_norm, *w_ukv, *lb_logits, *out_norm, *w_out, *xattn_norm, *mem_norm, *w_xq, *w_xk, *w_xv, *w_xo,
        *ffn_norm, *w_ffn1, *w_ffn2, *final_norm;
    float* out; char* ws;
};

__device__ __forceinline__ int ltid() { int t = threadIdx.x; asm volatile("" : "+v"(t)); return t; }
__device__ __forceinline__ int lbid() { int t = blockIdx.x; asm volatile("" : "+s"(t)); return t; }
__device__ __forceinline__ float bf2f(bf16_t b) { return __uint_as_float(((unsigned)b) << 16); }
__device__ __forceinline__ bf16_t f2bf(float f) { unsigned u = __float_as_uint(f); u += 0x7FFFu + ((u >> 16) & 1u); return (bf16_t)(u >> 16); }
__device__ __forceinline__ unsigned cvtpk(float lo, float hi) { unsigned r; asm volatile("v_cvt_pk_bf16_f32 %0, %1, %2" : "=v"(r) : "v"(lo), "v"(hi)); return r; }
__device__ __forceinline__ void wg_barrier() { asm volatile("s_waitcnt vmcnt(0) lgkmcnt(0)" ::: "memory"); __builtin_amdgcn_s_barrier(); asm volatile("" ::: "memory"); }
typedef unsigned long long ssq_t;
__device__ __forceinline__ ssq_t ssq_fix(float v) { return (ssq_t)(v * 16777216.f + 0.5f); }
__device__ __forceinline__ float ssq_val(ssq_t v) { return (float)v * (1.f / 16777216.f); }
__device__ __forceinline__ void atomic_addf(ssq_t* p, float v) { __hip_atomic_fetch_add(p, ssq_fix(v), __ATOMIC_RELAXED, __HIP_MEMORY_SCOPE_AGENT); }

namespace pg8 {
constexpr int BM = 256, BK = 64, HALF = 128, HTB = HALF * BK * 2, NXCD = 8, WGM = 8;
__host__ __device__ __forceinline__ int lds_byte(int r, int c) { const int st = (r >> 4) * 2 + (c >> 5), rr = r & 15, cc = c & 31, ob = rr * 64 + cc * 2; return st * 1024 + (ob ^ (((ob >> 9) & 1) << 5)); }
__host__ __device__ __forceinline__ void stage_rc(int b, int& R, int& C) { const int st = b / 1024, sb = b % 1024, swz = sb ^ (((sb >> 9) & 1) << 5); R = (st >> 1) * 16 + swz / 64; C = (st & 1) * 32 + (swz % 64) / 2; }
__host__ __device__ __forceinline__ int perm32(int rho) { const int n = rho >> 4, i = rho & 15; return 8 * (i >> 2) + 4 * n + (i & 3); }
}
enum { E_BF16 = 0, E_INPROJ = 1, E_RESID = 2, E_SOFTMAX = 3 };
struct GemmDesc {
    const char* A; const char* B; int lda, ldb, K, nM, nN, nZ;
    int azs, bzs, bbs, tpb;
    int epi, perm;
    bf16_t* out; long ozs; int ldo;
    const ssq_t* ssq_in; float inv_dim; int relu2;
    ssq_t* ssq_out; ssq_t* ssq_out2;
    const float* resid; float* xout; bf16_t* xb;
    bf16_t* out2; bf16_t* out3;
};
struct Unit { int pm, pn, z; const char* a; const char* b; };

__device__ __forceinline__ bool make_gemm(const Params& p, int tr, int l, int k, int i, GemmDesc& g);
__device__ __forceinline__ const Params* launder_p(const Params* q) { asm volatile("" : "+s"(q)); return q; }
__device__ __forceinline__ int launder_i(int v) { asm volatile("" : "+s"(v)); return v; }
__device__ __forceinline__ bool next_unit(const Params* kp, int tr, int l, int k, int gi, int i, int G, int c, Unit& u) {
    GemmDesc g; make_gemm(*launder_p(kp), launder_i(tr), launder_i(l), launder_i(k), launder_i(gi), g);
    const int L = i * G + c; const int per = g.nM * g.nN;
    if (L >= per * g.nZ) return false;
    const int z = L / per; int wgid = L - z * per;
    { const int q = per / pg8::NXCD, r = per % pg8::NXCD, xcd = wgid % pg8::NXCD, off = wgid / pg8::NXCD; wgid = (xcd < r ? xcd * (q + 1) : r * (q + 1) + (xcd - r) * q) + off; }
    const int nig = pg8::WGM * g.nN, gid = wgid / nig, fm = gid * pg8::WGM, gsz = (g.nM - fm) < pg8::WGM ? (g.nM - fm) : pg8::WGM;
    u.pm = fm + ((wgid % nig) % gsz); u.pn = (wgid % nig) / gsz; u.z = z;
    const unsigned ao = (unsigned)z * (unsigned)g.azs + (unsigned)u.pm * (unsigned)(512 * g.lda);
    const unsigned bo = (unsigned)z * (unsigned)g.bzs + (unsigned)u.pn * (unsigned)(512 * g.ldb) + (g.tpb ? (unsigned)(u.pm / g.tpb) * (unsigned)g.bbs : 0u);
    u.a = g.A + (size_t)ao; u.b = g.B + (size_t)bo;
    return true;
}

template <int EPI> __device__ __forceinline__ void gemm_epilogue(const Params* kp, int tr, int l, int k, int gi, f32x4 (&acc)[2][2][4][2], const Unit& u, LAS unsigned char* lds) {
    const int tid_e = ltid(), wid_e = tid_e >> 6, lane_e = tid_e & 63, wr = wid_e >> 2, wc = wid_e & 3, fr = lane_e & 15, fq = lane_e >> 4;
    GemmDesc g; make_gemm(*launder_p(kp), launder_i(tr), launder_i(l), launder_i(k), launder_i(gi), g);
    const int row0 = u.pm * 256 + wr * 64 + fr;
    if constexpr (EPI == E_BF16) {
        const int col0 = u.pn * 256 + wc * 32 + 8 * fq;
        float rsv[2][4];
#pragma unroll
        for (int ai = 0; ai < 2; ++ai)
#pragma unroll
            for (int m = 0; m < 4; ++m) rsv[ai][m] = g.ssq_in ? __builtin_amdgcn_rsqf(ssq_val(g.ssq_in[row0 + ai * 128 + m * 16]) * g.inv_dim + EPS) : 1.0f;
#pragma unroll
        for (int ai = 0; ai < 2; ++ai)
#pragma unroll
            for (int m = 0; m < 4; ++m) {
                const int row = row0 + ai * 128 + m * 16;
                const float rs = rsv[ai][m];
                bf16_t* rowp = g.out + (long)u.z * g.ozs + (long)row * g.ldo + col0;
#pragma unroll
                for (int bj = 0; bj < 2; ++bj) {
                    f32x4 v0 = acc[ai][bj][m][0] * rs, v1 = acc[ai][bj][m][1] * rs;
                    if (g.relu2) {
#pragma unroll
                        for (int j = 0; j < 4; ++j) { float a = fmaxf(v0[j], 0.f), b = fmaxf(v1[j], 0.f); v0[j] = a * a; v1[j] = b * b; }
                    }
                    u32x4 w; w.x = cvtpk(v0[0], v0[1]); w.y = cvtpk(v0[2], v0[3]); w.z = cvtpk(v1[0], v1[1]); w.w = cvtpk(v1[2], v1[3]);
                    *(u32x4*)(rowp + bj * 128) = w;
                }
            }
    } else if constexpr (EPI == E_INPROJ) {
        const int lc0 = wc * 32 + 8 * fq;
        const int pn = u.pn;
        const int hseg = (pn >= 4) ? ((pn - 4) >> 2) : 9;
        f32x4 lbv[2][2];
        if (hseg == 1 || hseg == 2) {
            const float* lbt = (const float*)(kp->ws + OFF_LB) + (hseg - 1) * 1024 + ((pn - 4) & 3) * 256 + lc0;
#pragma unroll
            for (int bj = 0; bj < 2; ++bj) { lbv[bj][0] = *(const f32x4*)(lbt + bj * 128); lbv[bj][1] = *(const f32x4*)(lbt + bj * 128 + 4); }
        } else {
#pragma unroll
            for (int bj = 0; bj < 2; ++bj) { lbv[bj][0] = (f32x4){0.f, 0.f, 0.f, 0.f}; lbv[bj][1] = lbv[bj][0]; }
        }
        float rsv[2][4];
#pragma unroll
        for (int ai = 0; ai < 2; ++ai)
#pragma unroll
            for (int m = 0; m < 4; ++m) rsv[ai][m] = __builtin_amdgcn_rsqf(ssq_val(g.ssq_in[row0 + ai * 128 + m * 16]) * g.inv_dim + EPS);
#pragma unroll
        for (int ai = 0; ai < 2; ++ai)
#pragma unroll
            for (int m = 0; m < 4; ++m) {
                const int row = row0 + ai * 128 + m * 16;
                const float rs = rsv[ai][m];
                float ss = 0.f;
#pragma unroll
                for (int bj = 0; bj < 2; ++bj) {
                    f32x4 v0 = acc[ai][bj][m][0] * rs, v1 = acc[ai][bj][m][1] * rs;
                    if (hseg == 0) {
#pragma unroll
                        for (int j = 0; j < 4; ++j) { v0[j] = v0[j] * __builtin_amdgcn_rcpf(1.f + __expf(-v0[j])) * 0.08838834764831845f; v1[j] = v1[j] * __builtin_amdgcn_rcpf(1.f + __expf(-v1[j])) * 0.08838834764831845f; }
                    } else if (hseg == 1 || hseg == 2) {
#pragma unroll
                        for (int j = 0; j < 4; ++j) {
                            const float l0 = lbv[bj][0][j], l1 = lbv[bj][1][j];
                            v0[j] = __logf(l0 + (1.f - l0) * __builtin_amdgcn_rcpf(1.f + __expf(-fmaxf(v0[j], -80.f))));
                            v1[j] = __logf(l1 + (1.f - l1) * __builtin_amdgcn_rcpf(1.f + __expf(-fmaxf(v1[j], -80.f))));
                        }
                    }
                    u32x4 w; w.x = cvtpk(v0[0], v0[1]); w.y = cvtpk(v0[2], v0[3]); w.z = cvtpk(v1[0], v1[1]); w.w = cvtpk(v1[2], v1[3]);
                    const int lc = lc0 + bj * 128;
                    if (pn < 3) {
                        *(u32x4*)(g.out + (long)row * 768 + pn * 256 + lc) = w;
                        ss += (v0[0] * v0[0] + v0[1] * v0[1]) + (v0[2] * v0[2] + v0[3] * v0[3]) + (v1[0] * v1[0] + v1[1] * v1[1]) + (v1[2] * v1[2] + v1[3] * v1[3]);
                    } else if (pn == 3) {
                        if (lc < 64) *(u32x4*)(g.out2 + (long)row * 64 + lc) = w;
                    } else {
                        *(u32x4*)(g.out3 + (long)row * HGW + (pn - 4) * 256 + lc) = w;
                    }
                }
                if (pn < 3) {
                    ss += __shfl_xor(ss, 16); ss += __shfl_xor(ss, 32);
                    if (fq == 0) atomic_addf((pn < 2 ? g.ssq_out : g.ssq_out2) + row, ss);
                }
            }
    } else if constexpr (EPI == E_RESID) {
        const int col0 = u.pn * 256 + wc * 32 + 4 * fq;
#pragma unroll
        for (int ai = 0; ai < 2; ++ai) {
            f32x4 rv[4][2][2];
#pragma unroll
            for (int m = 0; m < 4; ++m)
#pragma unroll
                for (int bj = 0; bj < 2; ++bj)
#pragma unroll
                    for (int n = 0; n < 2; ++n) rv[m][bj][n] = *(const f32x4*)(g.resid + (long)(row0 + ai * 128 + m * 16) * DM + col0 + bj * 128 + n * 16);
#pragma unroll
            for (int m = 0; m < 4; ++m) {
                const int row = row0 + ai * 128 + m * 16;
                float ss = 0.f;
#pragma unroll
                for (int bj = 0; bj < 2; ++bj)
#pragma unroll
                    for (int n = 0; n < 2; ++n) {
                        const long o = (long)row * DM + col0 + bj * 128 + n * 16;
                        const f32x4 v = rv[m][bj][n] + acc[ai][bj][m][n];
                        *(f32x4*)(g.xout + o) = v;
                        u32x2 w; w.x = cvtpk(v[0], v[1]); w.y = cvtpk(v[2], v[3]);
                        *(u32x2*)(g.xb + o) = w;
                        ss += (v[0] * v[0] + v[1] * v[1]) + (v[2] * v[2] + v[3] * v[3]);
                    }
                ss += __shfl_xor(ss, 16); ss += __shfl_xor(ss, 32);
                if (fq == 0) atomic_addf(g.ssq_out + row, ss);
            }
        }
    } else {
        LAS float* smax = (LAS float*)(lds + LDS_EPI);
        LAS float* ssum = (LAS float*)(lds + LDS_EPI + 4096);
        const float C = 0.044194173824159216f * 1.4426950408889634f;
#pragma unroll
        for (int ai = 0; ai < 2; ++ai)
#pragma unroll
            for (int m = 0; m < 4; ++m) {
                __builtin_amdgcn_sched_barrier(0);
                float t = -3.0e38f;
#pragma unroll
                for (int bj = 0; bj < 2; ++bj)
#pragma unroll
                    for (int n = 0; n < 2; ++n)
#pragma unroll
                        for (int j = 0; j < 4; ++j) t = fmaxf(t, acc[ai][bj][m][n][j]);
                t = fmaxf(t, __shfl_xor(t, 16)); t = fmaxf(t, __shfl_xor(t, 32));
                if (fq == 0) smax[(ai * 128 + wr * 64 + m * 16 + fr) * 4 + wc] = t;
            }
        asm volatile("s_waitcnt lgkmcnt(0)" ::: "memory"); __builtin_amdgcn_s_barrier(); asm volatile("" ::: "memory");
#pragma unroll
        for (int ai = 0; ai < 2; ++ai)
#pragma unroll
            for (int m = 0; m < 4; ++m) {
                __builtin_amdgcn_sched_barrier(0);
                const int rl = ai * 128 + wr * 64 + m * 16 + fr;
                const f32x4 q = *(LAS f32x4*)(smax + rl * 4);
                const float mm = fmaxf(fmaxf(q[0], q[1]), fmaxf(q[2], q[3])) * C;
                float s = 0.f;
#pragma unroll
                for (int bj = 0; bj < 2; ++bj)
#pragma unroll
                    for (int n = 0; n < 2; ++n)
#pragma unroll
                        for (int j = 0; j < 4; ++j) { const float e = __builtin_amdgcn_exp2f(acc[ai][bj][m][n][j] * C - mm); acc[ai][bj][m][n][j] = e; s += e; }
                s += __shfl_xor(s, 16); s += __shfl_xor(s, 32);
                if (fq == 0) ssum[rl * 4 + wc] = s;
            }
        asm volatile("s_waitcnt lgkmcnt(0)" ::: "memory"); __builtin_amdgcn_s_barrier(); asm volatile("" ::: "memory");
        const int col0 = wc * 32 + 8 * fq;
#pragma unroll
        for (int ai = 0; ai < 2; ++ai)
#pragma unroll
            for (int m = 0; m < 4; ++m) {
                __builtin_amdgcn_sched_barrier(0);
                const int rl = ai * 128 + wr * 64 + m * 16 + fr;
                const f32x4 q = *(LAS f32x4*)(ssum + rl * 4);
                const float inv = 1.0f / ((q[0] + q[1]) + (q[2] + q[3]));
                bf16_t* rowp = g.out + (long)(u.pm * 256 + rl) * g.ldo + u.z * 256 + col0;
#pragma unroll
                for (int bj = 0; bj < 2; ++bj) {
                    const f32x4 v0 = acc[ai][bj][m][0] * inv, v1 = acc[ai][bj][m][1] * inv;
                    u32x4 w; w.x = cvtpk(v0[0], v0[1]); w.y = cvtpk(v0[2], v0[3]); w.z = cvtpk(v1[0], v1[1]); w.w = cvtpk(v1[2], v1[3]);
                    *(u32x4*)(rowp + bj * 128) = w;
                }
            }
    }
}

template <int EPI> __device__ __forceinline__ void gemm_phase(LAS unsigned char* lds, const Params* kp, int tr, int l, int k, int gi, int G, int cblk) {
    using namespace pg8;
    int Kdim, lda_, ldb_, perm_;
    { GemmDesc g0; if (!make_gemm(*kp, tr, l, k, gi, g0)) return; Kdim = g0.K; lda_ = g0.lda; ldb_ = g0.ldb; perm_ = g0.perm; }
    const int tid = ltid(), wid = __builtin_amdgcn_readfirstlane(tid >> 6), lane = tid & 63, wr = wid >> 2, wc = wid & 3, fr = lane & 15, fq = lane >> 4;
    const int K = Kdim, nt = K / BK;
    unsigned voffA[2], voffB[2];
#pragma unroll
    for (int i = 0; i < 2; ++i) { int R, C; stage_rc(tid * 16 + i * 8192, R, C); const int Rb = perm_ ? ((R & ~31) + perm32(R & 31)) : R;
        voffA[i] = (unsigned)(R * lda_ + C) * 2u; voffB[i] = (unsigned)(Rb * ldb_ + C) * 2u; }
    const size_t kstep = (size_t)(BK * 2);
    const size_t hstepA = (size_t)HALF * lda_ * 2, hstepB = (size_t)HALF * ldb_ * 2;
    const unsigned ldsw = (unsigned)wid * 1024u;
    const int aoff = lds_byte(wr * 64 + fr, fq * 8), boff = lds_byte(wc * 32 + fr, fq * 8);
#define PG8_SA(b, h) (((b) * 2 + (h)) * HTB)
#define PG8_SB(b, h) ((4 + (b) * 2 + (h)) * HTB)
#define PG8_STAGE(bufoff, gbase, voff) do { _Pragma("unroll") for (int _i = 0; _i < 2; ++_i) \
        __builtin_amdgcn_global_load_lds((const unsigned*)((const char*)(gbase) + (voff)[_i]), (LAS unsigned*)(lds + (bufoff) + ldsw + _i * 8192), 16, 0, 0); } while (0)
#define PG8_LDA(dst, b, h) do { _Pragma("unroll") for (int m = 0; m < 4; ++m) _Pragma("unroll") for (int k = 0; k < 2; ++k) dst[m][k] = *(const LAS bf16x8*)(lds + PG8_SA(b, h) + aoff + m * 2048 + k * 1024); } while (0)
#define PG8_LDB(dst, b, h) do { _Pragma("unroll") for (int n = 0; n < 2; ++n) _Pragma("unroll") for (int k = 0; k < 2; ++k) dst[n][k] = *(const LAS bf16x8*)(lds + PG8_SB(b, h) + boff + n * 2048 + k * 1024); } while (0)
#define PG8_MMA(ai, bj, At, Bt) do { __builtin_amdgcn_s_setprio(1); _Pragma("unroll") for (int m = 0; m < 4; ++m) _Pragma("unroll") for (int n = 0; n < 2; ++n) _Pragma("unroll") for (int k = 0; k < 2; ++k) \
        acc[ai][bj][m][n] = __builtin_amdgcn_mfma_f32_16x16x32_bf16(Bt[n][k], At[m][k], acc[ai][bj][m][n], 0, 0, 0); __builtin_amdgcn_s_setprio(0); } while (0)
#define PG8_WAIT_V(n) asm volatile("s_waitcnt vmcnt(" #n ")" ::: "memory")
#define PG8_WAIT_L(n) asm volatile("s_waitcnt lgkmcnt(" #n ")" ::: "memory")
#define PG8_BAR __builtin_amdgcn_s_barrier()
#define PG8_SCHED __builtin_amdgcn_sched_barrier(0)
    Unit cur, nxt; int ui = 0;
    if (!next_unit(kp, tr, l, k, gi, 0, G, cblk, cur)) return;
    f32x4 acc[2][2][4][2];
#pragma unroll
    for (int a = 0; a < 2; ++a)
#pragma unroll
        for (int b = 0; b < 2; ++b)
#pragma unroll
            for (int m = 0; m < 4; ++m)
#pragma unroll
                for (int n = 0; n < 2; ++n) acc[a][b][m][n] = (f32x4){0.f, 0.f, 0.f, 0.f};
    bf16x8 At[4][2], B0[2][2], B1[2][2];
    const char* cA = cur.a; const char* cB = cur.b;
    PG8_STAGE(PG8_SB(0, 0), cB, voffB); PG8_STAGE(PG8_SA(0, 0), cA, voffA); PG8_STAGE(PG8_SB(0, 1), cB + hstepB, voffB); PG8_STAGE(PG8_SA(0, 1), cA + hstepA, voffA);
    if (wr == 1) PG8_BAR;
    PG8_WAIT_V(4); PG8_BAR;
    PG8_STAGE(PG8_SB(1, 0), cB + kstep, voffB); PG8_STAGE(PG8_SA(1, 0), cA + kstep, voffA); PG8_STAGE(PG8_SB(1, 1), cB + hstepB + kstep, voffB);
    PG8_WAIT_V(6); PG8_BAR;
    for (;;) {
        const bool has_next = next_unit(kp, tr, l, k, gi, ui + 1, G, cblk, nxt);
        const char* nA = has_next ? nxt.a : cA; const char* nB = has_next ? nxt.b : cB;
        for (int t = 0; t < nt; t += 2) {
            const bool last = (t == nt - 2);
            const char* a1 = cA + (size_t)(t + 1) * kstep;
            const char* a2 = last ? nA : cA + (size_t)(t + 2) * kstep; const char* b2 = last ? nB : cB + (size_t)(t + 2) * kstep;
            const char* a3 = a2 + kstep; const char* b3 = b2 + kstep;
            PG8_LDB(B0, 0, 0); PG8_SCHED; PG8_LDA(At, 0, 0); PG8_STAGE(PG8_SA(1, 1), a1 + hstepA, voffA);
            PG8_WAIT_L(8); PG8_BAR; PG8_WAIT_L(0); PG8_MMA(0, 0, At, B0); PG8_BAR; PG8_SCHED;
            PG8_LDB(B1, 0, 1); PG8_STAGE(PG8_SB(0, 0), b2, voffB);
            PG8_BAR; PG8_WAIT_L(0); PG8_MMA(0, 1, At, B1); PG8_BAR;
            PG8_LDA(At, 0, 1); PG8_STAGE(PG8_SA(0, 0), a2, voffA);
            PG8_BAR; PG8_WAIT_L(0); PG8_MMA(1, 0, At, B0); PG8_BAR; PG8_SCHED;
            PG8_STAGE(PG8_SB(0, 1), b2 + hstepB, voffB);
            PG8_WAIT_V(6); PG8_BAR; PG8_MMA(1, 1, At, B1); PG8_BAR;
            PG8_LDB(B0, 1, 0); PG8_SCHED; PG8_LDA(At, 1, 0); PG8_STAGE(PG8_SA(0, 1), a2 + hstepA, voffA);
            PG8_WAIT_L(8); PG8_BAR; PG8_WAIT_L(0); PG8_MMA(0, 0, At, B0); PG8_BAR; PG8_SCHED;
            PG8_LDB(B1, 1, 1); PG8_STAGE(PG8_SB(1, 0), b3, voffB);
            PG8_BAR; PG8_WAIT_L(0); PG8_MMA(0, 1, At, B1); PG8_BAR;
            PG8_LDA(At, 1, 1); PG8_STAGE(PG8_SA(1, 0), a3, voffA);
            PG8_BAR; PG8_WAIT_L(0); PG8_MMA(1, 0, At, B0); PG8_BAR; PG8_SCHED;
            PG8_STAGE(PG8_SB(1, 1), b3 + hstepB, voffB);
            PG8_WAIT_V(6); PG8_BAR; PG8_MMA(1, 1, At, B1); PG8_BAR;
        }
        gemm_epilogue<EPI>(kp, tr, l, k, gi, acc, cur, lds);
        if (!has_next) break;
#pragma unroll
        for (int a = 0; a < 2; ++a)
#pragma unroll
            for (int b = 0; b < 2; ++b)
#pragma unroll
                for (int m = 0; m < 4; ++m)
#pragma unroll
                    for (int n = 0; n < 2; ++n) acc[a][b][m][n] = (f32x4){0.f, 0.f, 0.f, 0.f};
        cur = nxt; cA = nA; cB = nB; ++ui;
    }
    PG8_WAIT_V(0);
    if (wr == 0) PG8_BAR;
    PG8_BAR;
#undef PG8_SA
#undef PG8_SB
#undef PG8_STAGE
#undef PG8_LDA
#undef PG8_LDB
#undef PG8_MMA
#undef PG8_WAIT_V
#undef PG8_WAIT_L
#undef PG8_BAR
#undef PG8_SCHED
}

namespace att {
constexpr int NW = 8, QBLK = 32, KVBLK = 64;
constexpr float SCALE = 0.07216878364870322f;
constexpr float THR = 8.f;
constexpr int LDQ = 1536, LDK = 2048, LDKR = 64, LDO = 2048;
constexpr int SHM_V = KVBLK * 128 * 2, SHM_K = KVBLK * 128 * 2, SHM_KR = KVBLK * 64 * 2;
#define KSWZ(row, colB) ((row) * 256 + ((colB) ^ (((row) & 7) << 4)))
#define KRSWZ(row, colB) ((row) * 128 + ((colB) ^ (((row) & 7) << 4)))
#define SBAR() __builtin_amdgcn_sched_barrier(0)
__device__ __forceinline__ int crow(int r, int hi) { return (r & 3) + 8 * (r >> 2) + 4 * hi; }
__device__ __forceinline__ void partialSM(f32x16& p0, f32x16& p1, float& m_reg, float& mn, float& alpha) {
    constexpr float C = SCALE * 1.4426950408889634f;
    float pmax = p0[0];
#pragma unroll
    for (int r = 1; r < 16; ++r) pmax = fmaxf(pmax, p0[r]);
#pragma unroll
    for (int r = 0; r < 16; ++r) pmax = fmaxf(pmax, p1[r]);
    { auto rr = __builtin_amdgcn_permlane32_swap(__float_as_uint(pmax), __float_as_uint(pmax), false, false);
      pmax = fmaxf(__uint_as_float(rr[0]), __uint_as_float(rr[1])); }
    if (__builtin_expect(__all(pmax - m_reg <= THR / SCALE), 1)) { mn = m_reg; alpha = 1.f; }
    else { mn = fmaxf(m_reg, pmax); alpha = __builtin_amdgcn_exp2f((m_reg - mn) * C); m_reg = mn; }
    float mnC = -mn * C;
#pragma unroll
    for (int r = 0; r < 16; ++r) p0[r] = fmaf(p0[r], C, mnC);
#pragma unroll
    for (int r = 0; r < 16; ++r) p1[r] = fmaf(p1[r], C, mnC);
#pragma unroll
    for (int r = 0; r < 16; ++r) p0[r] = __builtin_amdgcn_exp2f(p0[r]);
}
__device__ __forceinline__ void finishSM(f32x16& p0, f32x16& p1, float alpha, float& l_reg, bf16x8& pa0, bf16x8& pa1, bf16x8& pa2, bf16x8& pa3) {
#pragma unroll
    for (int r = 0; r < 16; ++r) p1[r] = __builtin_amdgcn_exp2f(p1[r]);
    float ps = 0;
#pragma unroll
    for (int r = 0; r < 16; ++r) ps += p0[r];
#pragma unroll
    for (int r = 0; r < 16; ++r) ps += p1[r];
    { auto rr = __builtin_amdgcn_permlane32_swap(__float_as_uint(ps), __float_as_uint(ps), false, false);
      ps = __uint_as_float(rr[0]) + __uint_as_float(rr[1]); }
    l_reg = l_reg * alpha + ps;
#define PK4(P, BASE, OUT) do { unsigned a0 = cvtpk(P[BASE + 0], P[BASE + 1]), a1 = cvtpk(P[BASE + 2], P[BASE + 3]);   \
    unsigned b0 = cvtpk(P[BASE + 4], P[BASE + 5]), b1 = cvtpk(P[BASE + 6], P[BASE + 7]);                              \
    auto r0 = __builtin_amdgcn_permlane32_swap(a0, b0, false, false); auto r1 = __builtin_amdgcn_permlane32_swap(a1, b1, false, false); \
    u32x4 w = {r0[0], r1[0], r0[1], r1[1]}; OUT = *reinterpret_cast<bf16x8*>(&w); } while (0)
    PK4(p0, 0, pa0); PK4(p0, 8, pa1); PK4(p1, 0, pa2); PK4(p1, 8, pa3);
#undef PK4
}
__device__ __forceinline__ void qkt(f32x16& p0, f32x16& p1, const char* Ks, const char* Krs, const bf16x8* qr, const char* qrl, int r32, int hi) {
    p0 = f32x16{}; p1 = f32x16{};
#pragma unroll
    for (int d0 = 0; d0 < 8; ++d0) { int cb = (d0 * 16 + hi * 8) * 2;
        bf16x8 b0 = *reinterpret_cast<const bf16x8*>(Ks + KSWZ(r32, cb));
        bf16x8 b1 = *reinterpret_cast<const bf16x8*>(Ks + KSWZ(32 + r32, cb));
        p0 = __builtin_amdgcn_mfma_f32_32x32x16_bf16(b0, qr[d0], p0, 0, 0, 0);
        p1 = __builtin_amdgcn_mfma_f32_32x32x16_bf16(b1, qr[d0], p1, 0, 0, 0); }
#pragma unroll
    for (int d0 = 0; d0 < 4; ++d0) { int cb = (d0 * 16 + hi * 8) * 2;
        bf16x8 b0 = *reinterpret_cast<const bf16x8*>(Krs + KRSWZ(r32, cb));
        bf16x8 b1 = *reinterpret_cast<const bf16x8*>(Krs + KRSWZ(32 + r32, cb));
        const bf16x8 qv = *reinterpret_cast<const bf16x8*>(qrl + d0 * 8192);
        p0 = __builtin_amdgcn_mfma_f32_32x32x16_bf16(b0, qv, p0, 0, 0, 0);
        p1 = __builtin_amdgcn_mfma_f32_32x32x16_bf16(b1, qv, p1, 0, 0, 0); }
}
__device__ __forceinline__ int v_st(int k, int c) { const int kk = (k & ~0xC) | ((k & 4) << 1) | ((k & 8) >> 1); return ((kk >> 3) * 4 + (c >> 5)) * 512 + ((kk & 7) * 32 + (c & 31)) * 2; }
__device__ __forceinline__ int v_rd_base(int lane) { return ((lane & 3) << 3) | (((lane >> 2) & 3) << 6) | (((lane >> 4) & 1) << 5) | (((lane >> 5) & 1) << 8); }
constexpr int v_rd_off(int d0, int ks, int half) { return d0 * 512 + ks * 4096 + half * 2048; }
template <int OFF> __device__ __forceinline__ s16x4 tr_read(int vb) {
    s16x4 r; asm volatile("ds_read_b64_tr_b16 %0, %1 offset:%2" : "=&v"(r) : "v"(vb), "i"(OFF) : "memory"); return r;
}
template <int D0> __device__ __forceinline__ void pv_one(f32x16& od, int vb, bf16x8 pa0, bf16x8 pa1, bf16x8 pa2, bf16x8 pa3) {
    const s16x4 l0 = tr_read<v_rd_off(D0, 0, 0)>(vb), h0 = tr_read<v_rd_off(D0, 0, 1)>(vb), l1 = tr_read<v_rd_off(D0, 1, 0)>(vb), h1 = tr_read<v_rd_off(D0, 1, 1)>(vb);
    const s16x4 l2 = tr_read<v_rd_off(D0, 2, 0)>(vb), h2 = tr_read<v_rd_off(D0, 2, 1)>(vb), l3 = tr_read<v_rd_off(D0, 3, 0)>(vb), h3 = tr_read<v_rd_off(D0, 3, 1)>(vb);
    asm volatile("s_waitcnt lgkmcnt(0)" ::: "memory"); SBAR();
#define PK(L, H) (bf16x8){L[0], L[1], L[2], L[3], H[0], H[1], H[2], H[3]}
    od = __builtin_amdgcn_mfma_f32_32x32x16_bf16(pa0, PK(l0, h0), od, 0, 0, 0);
    od = __builtin_amdgcn_mfma_f32_32x32x16_bf16(pa1, PK(l1, h1), od, 0, 0, 0);
    od = __builtin_amdgcn_mfma_f32_32x32x16_bf16(pa2, PK(l2, h2), od, 0, 0, 0);
    od = __builtin_amdgcn_mfma_f32_32x32x16_bf16(pa3, PK(l3, h3), od, 0, 0, 0);
#undef PK
}
__device__ __forceinline__ void pv_d0(f32x16* o, int vb, bf16x8 pa0, bf16x8 pa1, bf16x8 pa2, bf16x8 pa3) {
    pv_one<0>(o[0], vb, pa0, pa1, pa2, pa3); pv_one<1>(o[1], vb, pa0, pa1, pa2, pa3); pv_one<2>(o[2], vb, pa0, pa1, pa2, pa3); pv_one<3>(o[3], vb, pa0, pa1, pa2, pa3);
}

__device__ __forceinline__ void attn_body(const bf16_t* __restrict__ Qb, const bf16_t* __restrict__ Kh, const bf16_t* __restrict__ Kr,
                                          bf16_t* __restrict__ Ob, int ml_off, int seq, char* lds) {
    const int tid = ltid(), wid = tid >> 6, lane = tid & 63, r32 = lane & 31, hi = lane >> 5;
    char* V_lds = lds; char* K_lds = lds + 2 * SHM_V; char* KR_lds = lds + 2 * SHM_V + 2 * SHM_K;
    float* ws = (float*)(lds + 2 * SHM_V + 2 * SHM_K + 2 * SHM_KR) + wid * 64; float* li_l = ws; float* al_l = ws + 32;
    float m_reg = -1e30f, l_reg = 0; f32x16 o[4] = {}; bf16x8 qr[8];
    const bf16_t* Qw = Qb + (long)(wid * QBLK + r32) * LDQ + hi * 8;
#pragma unroll
    for (int d0 = 0; d0 < 8; ++d0) qr[d0] = *reinterpret_cast<const bf16x8*>(Qw + d0 * 16);
    char* qrl = lds + 84 * 1024 + tid * 16;
#pragma unroll
    for (int d0 = 0; d0 < 4; ++d0) *reinterpret_cast<bf16x8*>(qrl + d0 * 8192) = *reinterpret_cast<const bf16x8*>(Qw + (8 + d0) * 16);
    const int sr = tid >> 4, sc = (tid & 15) * 8, vst0 = v_st(sr, sc), vst1 = v_st(32 + sr, sc);
    const int krr = tid >> 3, krc = (tid & 7) * 8;
    const int vb0 = (int)(uintptr_t)V_lds + v_rd_base(lane);
    bf16x8 s_vs0, s_vs1, s_ks0, s_ks1, s_kr;
#define SLOAD(k0) do { s_vs0 = *reinterpret_cast<const bf16x8*>(&Kh[(long)((k0) + sr) * LDK + sc + 128]); s_vs1 = *reinterpret_cast<const bf16x8*>(&Kh[(long)((k0) + 32 + sr) * LDK + sc + 128]); \
    s_ks0 = *reinterpret_cast<const bf16x8*>(&Kh[(long)((k0) + sr) * LDK + sc]); s_ks1 = *reinterpret_cast<const bf16x8*>(&Kh[(long)((k0) + 32 + sr) * LDK + sc]); \
    s_kr = *reinterpret_cast<const bf16x8*>(&Kr[(long)((k0) + krr) * LDKR + krc]); } while (0)
#define SWRITE(b) do { *(bf16x8*)(V_lds + (b) * SHM_V + vst0) = s_vs0; *(bf16x8*)(V_lds + (b) * SHM_V + vst1) = s_vs1; int kc = sc * 2;   \
    *(bf16x8*)(K_lds + (b) * SHM_K + KSWZ(sr, kc)) = s_ks0; *(bf16x8*)(K_lds + (b) * SHM_K + KSWZ(32 + sr, kc)) = s_ks1;                  \
    *(bf16x8*)(KR_lds + (b) * SHM_KR + KRSWZ(krr, krc * 2)) = s_kr; } while (0)
#define SWAIT() asm volatile("s_waitcnt vmcnt(0)" ::: "memory")
#define RESC(a) do { if (__any((a) < 1.f)) { if (hi == 0) al_l[r32] = (a); asm volatile("s_waitcnt lgkmcnt(0)" ::: "memory"); \
    _Pragma("unroll") for (int d = 0; d < 4; ++d) _Pragma("unroll") for (int r = 0; r < 16; ++r) o[d][r] *= al_l[crow(r, hi)]; } } while (0)
    f32x16 pA0, pA1, pB0, pB1; float mnA, mnB, alA, alB; bf16x8 pa0, pa1, pa2, pa3; const int NT = seq / KVBLK;
    SLOAD(0); SWAIT(); SWRITE(0); __syncthreads();
    qkt(pA0, pA1, K_lds, KR_lds, qr, qrl, r32, hi); partialSM(pA0, pA1, m_reg, mnA, alA);
    SLOAD(KVBLK);
    SWAIT(); SWRITE(1); __syncthreads();
    for (int j = 1; j + 1 < NT; j += 2) {
        SBAR(); qkt(pB0, pB1, K_lds + SHM_K, KR_lds + SHM_KR, qr, qrl, r32, hi);
        finishSM(pA0, pA1, alA, l_reg, pa0, pa1, pa2, pa3); SBAR();
        SLOAD((j + 1) * KVBLK); SBAR();
        pv_d0(o, vb0, pa0, pa1, pa2, pa3); partialSM(pB0, pB1, m_reg, mnB, alB);
        __syncthreads(); SWAIT(); SWRITE(0);
        RESC(alB); __syncthreads();
        SBAR(); qkt(pA0, pA1, K_lds, KR_lds, qr, qrl, r32, hi);
        finishSM(pB0, pB1, alB, l_reg, pa0, pa1, pa2, pa3); SBAR();
        SLOAD((j + 2) * KVBLK); SBAR();
        pv_d0(o, vb0 + (int)SHM_V, pa0, pa1, pa2, pa3); partialSM(pA0, pA1, m_reg, mnA, alA);
        __syncthreads(); SWAIT(); SWRITE(1);
        RESC(alA); __syncthreads();
    }
    SBAR(); qkt(pB0, pB1, K_lds + SHM_K, KR_lds + SHM_KR, qr, qrl, r32, hi);
    finishSM(pA0, pA1, alA, l_reg, pa0, pa1, pa2, pa3); SBAR();
    pv_d0(o, vb0, pa0, pa1, pa2, pa3); partialSM(pB0, pB1, m_reg, mnB, alB);
    __syncthreads(); RESC(alB);
    finishSM(pB0, pB1, alB, l_reg, pa0, pa1, pa2, pa3); SBAR();
    pv_d0(o, vb0 + (int)SHM_V, pa0, pa1, pa2, pa3);
    if (hi == 0) li_l[r32] = l_reg; asm volatile("s_waitcnt lgkmcnt(0)" ::: "memory");
    if (ml_off >= 0 && hi == 0) {
        const Params* kpa = (const Params*)__builtin_amdgcn_kernarg_segment_ptr(); asm volatile("" : "+s"(kpa));
        float* d = (float*)(kpa->ws + OFF_XB + 2048) + ml_off + (wid * QBLK + r32) * 1024; d[0] = m_reg; d[1] = l_reg; }
    float rli[16];
#pragma unroll
    for (int r = 0; r < 16; ++r) rli[r] = __builtin_amdgcn_rcpf(li_l[crow(r, hi)]);
    bf16_t* Ow = Ob + (long)(wid * QBLK) * LDO;
#pragma unroll
    for (int r = 0; r < 16; ++r) { int orow = crow(r, hi);
#pragma unroll
        for (int d0 = 0; d0 < 4; ++d0) Ow[(long)orow * LDO + d0 * 32 + r32] = f2bf(o[d0][r] * rli[r]); }
    __syncthreads();
#undef SLOAD
#undef SWRITE
#undef SWAIT
#undef RESC
}
}

namespace hg {
constexpr int LD = 136, LDT = 72;
constexpr int O_RZ = 0, O_RQ = O_RZ + 64 * LD * 2, O_RV = O_RQ + 64 * LD * 2, O_QD = O_RV + 64 * LD * 2, O_KD = O_QD + 64 * LD * 2,
              O_KDT = O_KD + 64 * LD * 2, O_VT = O_KDT + 128 * LDT * 2, O_P = O_VT + 128 * LDT * 2, O_SEG = O_P + 64 * LDT * 2, O_EV = O_SEG + 4 * 128 * 4, O_END = O_EV + 3 * 128 * 4;
static_assert(O_END <= LDS_BCAST, "hgrn LDS");
__device__ __forceinline__ float clampf(float x, float lo, float hi) { return fminf(fmaxf(x, lo), hi); }

__device__ __forceinline__ void hgrn_unit(LAS unsigned char* lds, bf16_t* hgb  , const float* lb_logits, int layer, int S, int unit) {
    const int tid = ltid(), wid = tid >> 6, lane = tid & 63, l15 = lane & 15, quad = lane >> 4;
    const int dir = unit & 1, h = (unit >> 1) & 7, b = unit >> 4;
    const int qcol = h * 128, zcol = (dir ? 2048 : 1024) + h * 128, vcol = 3072 + h * 128;
    const int ch = tid & 127, seg = tid >> 7;
    LAS bf16_t* RZ = (LAS bf16_t*)(lds + O_RZ); LAS bf16_t* RQ = (LAS bf16_t*)(lds + O_RQ); LAS bf16_t* RV = (LAS bf16_t*)(lds + O_RV);
    LAS bf16_t* QD = (LAS bf16_t*)(lds + O_QD); LAS bf16_t* KD = (LAS bf16_t*)(lds + O_KD); LAS bf16_t* KDT = (LAS bf16_t*)(lds + O_KDT);
    LAS bf16_t* VT = (LAS bf16_t*)(lds + O_VT); LAS bf16_t* PP = (LAS bf16_t*)(lds + O_P);
    LAS float* SEG = (LAS float*)(lds + O_SEG); LAS float* EV = (LAS float*)(lds + O_EV);
    const int n = S / 64;
    const int r0 = tid >> 4, c8 = (tid & 15) * 8;
    bf16x8 pz0, pz1, pq0, pq1, pv0, pv1;
#define HG_ROW(c, tau) ((long)b * S + (dir ? (S - 1 - ((c) * 64 + (tau))) : ((c) * 64 + (tau))))
#define HG_LOAD(c) do { const bf16_t* ra = hgb + HG_ROW(c, r0) * HGW; const bf16_t* rb = hgb + HG_ROW(c, r0 + 32) * HGW; \
    pz0 = *(const bf16x8*)(ra + zcol + c8); pz1 = *(const bf16x8*)(rb + zcol + c8); pq0 = *(const bf16x8*)(ra + qcol + c8); pq1 = *(const bf16x8*)(rb + qcol + c8); \
    pv0 = *(const bf16x8*)(ra + vcol + c8); pv1 = *(const bf16x8*)(rb + vcol + c8); } while (0)
    f32x4 Sst[8];
#pragma unroll
    for (int i = 0; i < 8; ++i) Sst[i] = (f32x4){0.f, 0.f, 0.f, 0.f};
    HG_LOAD(0);
    for (int c = 0; c < n; ++c) {
        *(LAS bf16x8*)(RZ + r0 * LD + c8) = pz0; *(LAS bf16x8*)(RZ + (r0 + 32) * LD + c8) = pz1;
        *(LAS bf16x8*)(RQ + r0 * LD + c8) = pq0; *(LAS bf16x8*)(RQ + (r0 + 32) * LD + c8) = pq1;
        *(LAS bf16x8*)(RV + r0 * LD + c8) = pv0; *(LAS bf16x8*)(RV + (r0 + 32) * LD + c8) = pv1;
        asm volatile("s_waitcnt lgkmcnt(0)" ::: "memory"); __builtin_amdgcn_s_barrier(); asm volatile("" ::: "memory");
        if (c + 1 < n) HG_LOAD(c + 1);
        float bl[16], kk[16]; float run = 0.f;
#pragma unroll
        for (int i = 0; i < 16; ++i) {
            const float lf = bf2f(RZ[(seg * 16 + i) * LD + ch]);
            run += lf; bl[i] = run; kk[i] = 1.f - __expf(lf);
        }
        SEG[seg * 128 + ch] = run;
        asm volatile("s_waitcnt lgkmcnt(0)" ::: "memory"); __builtin_amdgcn_s_barrier(); asm volatile("" ::: "memory");
        const float t0 = SEG[ch], t1 = SEG[128 + ch], t2 = SEG[256 + ch], t3 = SEG[384 + ch];
        const float off = (seg > 0 ? t0 : 0.f) + (seg > 1 ? t1 : 0.f) + (seg > 2 ? t2 : 0.f);
        const float bref = t0 + t1, btot = (t0 + t1) + (t2 + t3);
        unsigned kdt[8], vtt[8];
#pragma unroll
        for (int i = 0; i < 16; ++i) {
            const int tau = seg * 16 + i;
            const float bb = bl[i] + off;
            const float eq = __expf(clampf(bb - bref, -80.f, 80.f)), ek = __builtin_amdgcn_rcpf(eq);
            const float sq = bf2f(RQ[tau * LD + ch]);
            QD[tau * LD + ch] = f2bf(sq * eq);
            const bf16_t kb = f2bf(kk[i] * ek);
            KD[tau * LD + ch] = kb;
            const bf16_t vb = RV[tau * LD + ch];
            if (i & 1) { kdt[i >> 1] |= ((unsigned)kb) << 16; vtt[i >> 1] |= ((unsigned)vb) << 16; } else { kdt[i >> 1] = kb; vtt[i >> 1] = vb; }
        }
        *(LAS u32x4*)(KDT + ch * LDT + seg * 16) = (u32x4){kdt[0], kdt[1], kdt[2], kdt[3]}; *(LAS u32x4*)(KDT + ch * LDT + seg * 16 + 8) = (u32x4){kdt[4], kdt[5], kdt[6], kdt[7]};
        *(LAS u32x4*)(VT + ch * LDT + seg * 16) = (u32x4){vtt[0], vtt[1], vtt[2], vtt[3]}; *(LAS u32x4*)(VT + ch * LDT + seg * 16 + 8) = (u32x4){vtt[4], vtt[5], vtt[6], vtt[7]};
        if (seg == 0) { EV[ch] = __expf(clampf(bref, -80.f, 80.f)); EV[128 + ch] = __expf(clampf(btot, -80.f, 80.f)); EV[256 + ch] = __expf(clampf(btot - bref, -80.f, 80.f)); }
        asm volatile("s_waitcnt lgkmcnt(0)" ::: "memory"); __builtin_amdgcn_s_barrier(); asm volatile("" ::: "memory");
#pragma unroll
        for (int tt = 0; tt < 2; ++tt) {
            const int ti = wid * 2 + tt, sblk = ti >> 2, tblk = ti & 3;
            f32x4 a = (f32x4){0.f, 0.f, 0.f, 0.f};
            if (sblk <= tblk) {
#pragma unroll
                for (int ks = 0; ks < 4; ++ks) {
                    const bf16x8 af = *(LAS bf16x8*)(KD + (sblk * 16 + l15) * LD + ks * 32 + quad * 8);
                    const bf16x8 bfr = *(LAS bf16x8*)(QD + (tblk * 16 + l15) * LD + ks * 32 + quad * 8);
                    a = __builtin_amdgcn_mfma_f32_16x16x32_bf16(af, bfr, a, 0, 0, 0);
                }
            }
            const int t = tblk * 16 + l15, s0 = sblk * 16 + quad * 4;
            u32x2 w; w.x = cvtpk(s0 + 0 <= t ? a[0] : 0.f, s0 + 1 <= t ? a[1] : 0.f); w.y = cvtpk(s0 + 2 <= t ? a[2] : 0.f, s0 + 3 <= t ? a[3] : 0.f);
            *(LAS u32x2*)(PP + t * LDT + s0) = w;
        }
        asm volatile("s_waitcnt lgkmcnt(0)" ::: "memory"); __builtin_amdgcn_s_barrier(); asm volatile("" ::: "memory");
        const int dv0 = wid * 16;
        bf16x8 bv[2];
#pragma unroll
        for (int ks = 0; ks < 2; ++ks) bv[ks] = *(LAS bf16x8*)(VT + (dv0 + l15) * LDT + ks * 32 + quad * 8);
        f32x4 o[4];
#pragma unroll
        for (int i = 0; i < 4; ++i) o[i] = (f32x4){0.f, 0.f, 0.f, 0.f};
#pragma unroll
        for (int k4 = 0; k4 < 4; ++k4) {
            const f32x4 er0 = *(LAS f32x4*)(EV + 32 * k4 + 4 * quad), er1 = *(LAS f32x4*)(EV + 32 * k4 + 16 + 4 * quad);
            const f32x4 s0 = Sst[2 * k4] * er0, s1 = Sst[2 * k4 + 1] * er1;
            u32x4 bw; bw.x = cvtpk(s0[0], s0[1]); bw.y = cvtpk(s0[2], s0[3]); bw.z = cvtpk(s1[0], s1[1]); bw.w = cvtpk(s1[2], s1[3]);
            const bf16x8 bfr = *reinterpret_cast<bf16x8*>(&bw);
#pragma unroll
            for (int tb = 0; tb < 4; ++tb) {
                const u32x2 a0 = *(LAS u32x2*)(QD + (tb * 16 + l15) * LD + 32 * k4 + 4 * quad);
                const u32x2 a1 = *(LAS u32x2*)(QD + (tb * 16 + l15) * LD + 32 * k4 + 16 + 4 * quad);
                u32x4 aw; aw.x = a0.x; aw.y = a0.y; aw.z = a1.x; aw.w = a1.y;
                o[tb] = __builtin_amdgcn_mfma_f32_16x16x32_bf16(*reinterpret_cast<bf16x8*>(&aw), bfr, o[tb], 0, 0, 0);
            }
        }
#pragma unroll
        for (int ks = 0; ks < 2; ++ks)
#pragma unroll
            for (int tb = 0; tb < 4; ++tb) {
                const bf16x8 af = *(LAS bf16x8*)(PP + (tb * 16 + l15) * LDT + ks * 32 + quad * 8);
                o[tb] = __builtin_amdgcn_mfma_f32_16x16x32_bf16(af, bv[ks], o[tb], 0, 0, 0);
            }
#pragma unroll
        for (int tb = 0; tb < 4; ++tb)
#pragma unroll
            for (int j = 0; j < 4; ++j) hgb[HG_ROW(c, tb * 16 + quad * 4 + j) * HGW + zcol + dv0 + l15] = f2bf(o[tb][j]);
#pragma unroll
        for (int db = 0; db < 8; ++db) {
            f32x4 tmp = (f32x4){0.f, 0.f, 0.f, 0.f};
#pragma unroll
            for (int ks = 0; ks < 2; ++ks) {
                const bf16x8 af = *(LAS bf16x8*)(KDT + (db * 16 + l15) * LDT + ks * 32 + quad * 8);
                tmp = __builtin_amdgcn_mfma_f32_16x16x32_bf16(af, bv[ks], tmp, 0, 0, 0);
            }
            const f32x4 et = *(LAS f32x4*)(EV + 128 + db * 16 + quad * 4), etr = *(LAS f32x4*)(EV + 256 + db * 16 + quad * 4);
            Sst[db] = Sst[db] * et + tmp * etr;
        }
    }
    wg_barrier();
#undef HG_ROW
#undef HG_LOAD
}
}

struct WDesc { const float* src; const float* gain; bf16_t* dst; int K, N, R, map; };

__device__ __forceinline__ void wcvt_phase(LAS unsigned char* lds, const Params& p, int layer) {
    LAS float* tile = (LAS float*)lds;
    const int tid = ltid();
    char* ws = p.ws;
    if (lbid() == 0) {
        float* lbt = (float*)(ws + OFF_LB);
        for (int i = tid; i < 2048; i += 512) {
            float mx = -3e38f; for (int l = 0; l < DEPTH; ++l) mx = fmaxf(mx, p.lb_logits[l * 2048 + i]);
            float den = 0.f, num = 0.f; for (int l = 0; l < DEPTH; ++l) { const float e = __expf(p.lb_logits[l * 2048 + i] - mx); den += e; if (l >= 1 && l <= layer) num += e; }
            lbt[i] = num / den;
        }
    }
    for (int mi = 0; mi < 10; ++mi) {
        WDesc d;
        switch (mi) {
        case 0: d = {p.w_in + (size_t)layer * 2048 * 5952, p.mix_norm + layer * 2048, (bf16_t*)(ws + OFF_W_IN), 2048, 5952, INP, 1}; break;
        case 1: d = {p.w_uq + (size_t)layer * 512 * 1536, p.q_norm + layer * 512, (bf16_t*)(ws + OFF_W_UQ), 512, 1536, 1536, 0}; break;
        case 2: d = {p.w_ukv + (size_t)layer * 256 * 2048, p.kv_norm + layer * 256, (bf16_t*)(ws + OFF_W_UKV), 256, 2048, 2048, 0}; break;
        case 3: d = {p.w_out + (size_t)layer * 2048 * 2048, nullptr, (bf16_t*)(ws + OFF_W_OUT), 2048, 2048, 2048, 0}; break;
        case 4: d = {p.w_xq + (size_t)layer * 2048 * 2048, p.xattn_norm + layer * 2048, (bf16_t*)(ws + OFF_W_XQ), 2048, 2048, 2048, 0}; break;
        case 5: d = {p.w_xk + (size_t)layer * 2048 * 2048, p.mem_norm + layer * 2048, (bf16_t*)(ws + OFF_W_XK), 2048, 2048, 2048, 0}; break;
        case 6: d = {p.w_xv + (size_t)layer * 2048 * 2048, p.mem_norm + layer * 2048, (bf16_t*)(ws + OFF_W_XV), 2048, 2048, 2048, 0}; break;
        case 7: d = {p.w_xo + (size_t)layer * 2048 * 2048, nullptr, (bf16_t*)(ws + OFF_W_XO), 2048, 2048, 2048, 0}; break;
        case 8: d = {p.w_ffn1 + (size_t)layer * 2048 * 8192, p.ffn_norm + layer * 2048, (bf16_t*)(ws + OFF_W_F1), 2048, 8192, 8192, 0}; break;
        default: d = {p.w_ffn2 + (size_t)layer * 8192 * 2048, nullptr, (bf16_t*)(ws + OFF_W_F2), 8192, 2048, 2048, 0}; break;
        }
        const int nkt = d.K / 64, nrt = d.R / 256, ntile = nkt * nrt;
        for (int t = lbid(); t < ntile; t += gridDim.x) {
            const int kt = t % nkt, rt = t / nkt, k0 = kt * 64, r0 = rt * 256;
            {
                const int c4 = tid & 63, rr = tid >> 6; const int col = r0 + 4 * c4;
                int sc = col; bool zero = false;
                if (d.map) { if (col < 832) sc = col; else if (col < 1024) zero = true; else sc = col - 192; }
#pragma unroll
                for (int ii = 0; ii < 8; ++ii) { const int i = rr + ii * 8;
                    f32x4 v = zero ? (f32x4){0.f, 0.f, 0.f, 0.f} : *(const f32x4*)(d.src + (size_t)(k0 + i) * d.N + sc);
                    if (d.gain) v = v * d.gain[k0 + i];
                    *(LAS f32x4*)(tile + i * 260 + 4 * c4) = v; }
            }
            wg_barrier();
            {
                const int n = tid >> 1, kh = (tid & 1) * 32;
#pragma unroll
                for (int j = 0; j < 4; ++j) {
                    unsigned w[4];
#pragma unroll
                    for (int e = 0; e < 8; e += 2) w[e >> 1] = cvtpk(tile[(kh + j * 8 + e) * 260 + n], tile[(kh + j * 8 + e + 1) * 260 + n]);
                    *(u32x4*)(d.dst + (size_t)(r0 + n) * d.K + k0 + kh + j * 8) = (u32x4){w[0], w[1], w[2], w[3]};
                }
            }
            wg_barrier();
        }
    }
}

__device__ __forceinline__ void prep_phase(const Params& p, int tr, int T, int S) {
    const size_t xb_off = tr ? OFF_XB : OFF_XB0;
    const int tid = ltid(), wid = tid >> 6, lane = tid & 63;
    char* ws = p.ws;
    const long gtid = (long)lbid() * 512 + tid, gstride = (long)gridDim.x * 512;
    { ssq_t* ssq = (ssq_t*)(ws + OFF_SSQ) + (size_t)tr * 11 * TMAX; for (long i = gtid; i < (long)10 * TMAX; i += gstride) ssq[TMAX + i] = 0ull;
      if (gtid < 64) ((unsigned*)(ws + OFF_CTR))[gtid] = 0u; }
    { float* rc = (float*)(ws + OFF_ROPE); float* rs = rc + 16384 * 32;
      for (int i = (int)gtid; i < S * 32; i += (int)gstride) { const int pos = i >> 5, f = i & 31;
          const float inv_freq = exp2f(-(float)f * (13.287712379549449f / 32.f));
          const float ang = (float)pos * inv_freq;
          const double rev = (double)ang * 0.15915494309189535; const float fr = (float)(rev - rint(rev));
          rc[i] = __builtin_amdgcn_cosf(fr); rs[i] = __builtin_amdgcn_sinf(fr); } }
    { const float* x = p.x_in[tr]; bf16_t* xb = (bf16_t*)(ws + xb_off); ssq_t* ssq0 = (ssq_t*)(ws + OFF_SSQ) + (size_t)tr * 11 * TMAX;
      for (int row = lbid() * 8 + wid; row < T; row += gridDim.x * 8) {
          float ss = 0.f;
#pragma unroll
          for (int i = 0; i < 8; ++i) { const int c = i * 256 + lane * 4; const f32x4 v = *(const f32x4*)(x + (size_t)row * DM + c);
              ss += (v[0] * v[0] + v[1] * v[1]) + (v[2] * v[2] + v[3] * v[3]);
              u32x2 w; w.x = cvtpk(v[0], v[1]); w.y = cvtpk(v[2], v[3]); *(u32x2*)(xb + (size_t)row * DM + c) = w; }
#pragma unroll
          for (int o = 32; o > 0; o >>= 1) ss += __shfl_xor(ss, o);
          if (lane == 0) ssq0[row] = ssq_fix(ss);
      } }
    { const float* mem = p.mem_in[tr]; bf16_t* mn = (bf16_t*)(ws + OFF_MEMN) + (size_t)tr * 512 * 2048;
      for (int row = lbid() * 8 + wid; row < 512; row += gridDim.x * 8) {
          f32x4 v[8]; float ss = 0.f;
#pragma unroll
          for (int i = 0; i < 8; ++i) { v[i] = *(const f32x4*)(mem + (size_t)row * DM + i * 256 + lane * 4); ss += (v[i][0] * v[i][0] + v[i][1] * v[i][1]) + (v[i][2] * v[i][2] + v[i][3] * v[i][3]); }
#pragma unroll
          for (int o = 32; o > 0; o >>= 1) ss += __shfl_xor(ss, o);
          const float rs = __builtin_amdgcn_rsqf(ss * (1.f / DM) + EPS);
#pragma unroll
          for (int i = 0; i < 8; ++i) { u32x2 w; w.x = cvtpk(v[i][0] * rs, v[i][1] * rs); w.y = cvtpk(v[i][2] * rs, v[i][3] * rs); *(u32x2*)(mn + (size_t)row * DM + i * 256 + lane * 4) = w; }
      } }
}

__device__ __forceinline__ void rope_phase(const Params& p, int T, int S) {
    char* ws = p.ws;
    bf16_t* q = (bf16_t*)(ws + OFF_Q); const bf16_t* kr = (const bf16_t*)(ws + OFF_KR); bf16_t* kro = (bf16_t*)(ws + OFF_KROPE);
    const float* rc = (const float*)(ws + OFF_ROPE); const float* rs = rc + 16384 * 32;
    const int total = T * 9 * 4;
    for (int i = lbid() * 512 + ltid(); i < total; i += gridDim.x * 512) {
        const int f8 = (i & 3) * 8; const int ru = i >> 2; const int row_i = ru / 9; const int u = ru - row_i * 9; const long row = row_i; const int pos = row_i & (S - 1);
        const f32x8 c = *(const f32x8*)(rc + pos * 32 + f8), s = *(const f32x8*)(rs + pos * 32 + f8);
        const bf16_t* src = (u < 8) ? (q + row * 1536 + u * 192 + 128 + f8) : (kr + row * 64 + f8);
        bf16_t* dst = (u < 8) ? (q + row * 1536 + u * 192 + 128 + f8) : (kro + row * 64 + f8);
        const bf16x8 a1 = *(const bf16x8*)src, a2 = *(const bf16x8*)(src + 32);
        unsigned w1[4], w2[4];
#pragma unroll
        for (int j = 0; j < 8; j += 2) {
            const float x1a = bf2f((bf16_t)a1[j]), x2a = bf2f((bf16_t)a2[j]), x1b = bf2f((bf16_t)a1[j + 1]), x2b = bf2f((bf16_t)a2[j + 1]);
            w1[j >> 1] = cvtpk(x1a * c[j] - x2a * s[j], x1b * c[j + 1] - x2b * s[j + 1]);
            w2[j >> 1] = cvtpk(x2a * c[j] + x1a * s[j], x2b * c[j + 1] + x1b * s[j + 1]);
        }
        *(u32x4*)dst = (u32x4){w1[0], w1[1], w1[2], w1[3]}; *(u32x4*)(dst + 32) = (u32x4){w2[0], w2[1], w2[2], w2[3]};
    }
}

__device__ __forceinline__ void hcomb_phase(const Params& p, int layer, int T, int nblk, int bid, int nsplit) {
    char* ws = p.ws; const bf16_t* hgb = (const bf16_t*)(ws + OFF_HG); bf16_t* mix = (bf16_t*)(ws + OFF_MIX);
    const float* on = p.out_norm + layer * 128;
    const int l16 = ltid() & 15;
    const int total = T * 8 * 16;
    for (int i = bid * 512 + ltid(); i < total; i += nblk * 512) {
        const int rh = i >> 4; const int h = rh & 7; const long row = rh >> 3;
        const bf16_t* base = hgb + row * HGW + h * 128 + l16 * 8;
        const bf16x8 vf = *(const bf16x8*)(base + 1024), vb = *(const bf16x8*)(base + 2048), vg = *(const bf16x8*)(base + 4096);
        float o[8]; float ss = 0.f;
#pragma unroll
        for (int j = 0; j < 8; ++j) { o[j] = bf2f((bf16_t)vf[j]) + bf2f((bf16_t)vb[j]); ss += o[j] * o[j]; }
        ss += __shfl_xor(ss, 1); ss += __shfl_xor(ss, 2); ss += __shfl_xor(ss, 4); ss += __shfl_xor(ss, 8);
        const float rs = __builtin_amdgcn_rsqf(ss * (1.f / 128.f) + EPS);
        unsigned w[4];
#pragma unroll
        for (int j = 0; j < 8; j += 2) {
            const float g0 = bf2f((bf16_t)vg[j]), g1 = bf2f((bf16_t)vg[j + 1]);
            const float y0 = o[j] * rs * on[l16 * 8 + j] * (g0 / (1.f + __expf(-g0))), y1 = o[j + 1] * rs * on[l16 * 8 + j + 1] * (g1 / (1.f + __expf(-g1)));
            w[j >> 1] = cvtpk(y0, y1);
        }
        *(u32x4*)(mix + row * 2048 + 1024 + h * 128 + l16 * 8) = (u32x4){w[0], w[1], w[2], w[3]};
        if (nsplit == 2) {
            const f32x4 mlv = *(const f32x4*)((const float*)(ws + OFF_XB + 2048) + row * 1024 + h * 4);
            const float C = att::SCALE * 1.4426950408889634f;
            const float M = fmaxf(mlv[0], mlv[2]);
            const float w1 = mlv[1] * __builtin_amdgcn_exp2f((mlv[0] - M) * C), w2 = mlv[3] * __builtin_amdgcn_exp2f((mlv[2] - M) * C);
            const float inv = 1.f / (w1 + w2), c1 = w1 * inv, c2 = w2 * inv;
            bf16_t* pa = mix + row * 2048 + h * 128 + l16 * 8; const bf16_t* pb = (const bf16_t*)(ws + OFF_XB) + row * 2048 + h * 128 + l16 * 8;
            const bf16x8 va = *(const bf16x8*)pa, vb2 = *(const bf16x8*)pb;
            unsigned wo[4];
#pragma unroll
            for (int j = 0; j < 8; j += 2) wo[j >> 1] = cvtpk(c1 * bf2f((bf16_t)va[j]) + c2 * bf2f((bf16_t)vb2[j]), c1 * bf2f((bf16_t)va[j + 1]) + c2 * bf2f((bf16_t)vb2[j + 1]));
            *(u32x4*)pa = (u32x4){wo[0], wo[1], wo[2], wo[3]};
        }
    }
}

__device__ __forceinline__ void final_phase(const Params& p, float* xout, int T, int tr) {
    const int wid = ltid() >> 6, lane = ltid() & 63;
    const ssq_t* ssq = (const ssq_t*)(p.ws + OFF_SSQ) + (size_t)(tr * 11 + 10) * TMAX;
    for (int row = lbid() * 8 + wid; row < T; row += gridDim.x * 8) {
        const float rs = __builtin_amdgcn_rsqf(ssq_val(ssq[row]) * (1.f / DM) + EPS);
#pragma unroll
        for (int i = 0; i < 8; ++i) { const int c = i * 256 + lane * 4; f32x4 v = *(f32x4*)(xout + (size_t)row * DM + c); const f32x4 g = *(const f32x4*)(p.final_norm + c);
            v = v * rs * g; *(f32x4*)(xout + (size_t)row * DM + c) = v; }
    }
}

__device__ __forceinline__ void mixer_phase(LAS unsigned char* lds, const Params& p, int layer, int T, int S, int tr) {
    char* ws = p.ws;
    unsigned* ctr = (unsigned*)(ws + OFF_CTR) + (tr * 2 + layer) * 16;
    LAS unsigned* slot = (LAS unsigned*)(lds + LDS_BCAST);
    const int nsplit = (S >= 16384) ? 2 : 1;
    const int nH = 2 * 8 * 2, nQB = S / 256, nA = 2 * 8 * nQB * nsplit;
    for (;;) {
        if (ltid() == 0) *slot = __hip_atomic_fetch_add(ctr, 1u, __ATOMIC_RELAXED, __HIP_MEMORY_SCOPE_AGENT);
        wg_barrier();
        const int idx = (int)__builtin_amdgcn_readfirstlane(*slot);
        wg_barrier();
        if (idx >= nH + nA) break;
        const Params* kq = launder_p((const Params*)__builtin_amdgcn_kernarg_segment_ptr());
        char* wsu = kq->ws;
        bf16_t* hgb = (bf16_t*)(wsu + OFF_HG);
        const bf16_t* q = (const bf16_t*)(wsu + OFF_Q); const bf16_t* kv = (const bf16_t*)(wsu + OFF_KV); const bf16_t* kro = (const bf16_t*)(wsu + OFF_KROPE);
        bf16_t* mix = (bf16_t*)(wsu + OFF_MIX); bf16_t* o2 = (bf16_t*)(wsu + OFF_XB);
#ifndef MK_NO_HG
        if (idx < nH) hg::hgrn_unit(lds, hgb, kq->lb_logits, layer, S, idx);
        else
#endif
        {
#ifndef MK_NO_ATT
            const int a = idx - nH, qb = a % nQB, a1 = a / nQB, half = a1 % nsplit, a2 = a1 / nsplit, h = a2 & 7, b = a2 >> 3;
            const int sseq = S / nsplit;
            const long row0 = (long)b * S + (long)qb * 256, krow0 = (long)b * S + (long)half * sseq;
            bf16_t* ob = (half == 0 ? mix : o2) + row0 * 2048 + h * 128;
            const int ml = (nsplit == 2) ? (int)(row0 * 1024 + h * 4 + half * 2) : -1;
            att::attn_body(q + row0 * 1536 + h * 192, kv + krow0 * 2048 + h * 256, kro + krow0 * 64, ob, ml, sseq, (char*)(unsigned char*)lds);
#endif
        }
    }
}

#define XB_TMO      128
#define XB_XCNT(j)  (256  + 64 * (j))
#define XB_XSUB(j)  (1280 + 64 * (j))
#define XB_XGEN(j)  (2304 + 64 * (j))
#define XB_TOP      3328
#define XB_TOPGEN   3392
#define XCD_BAR_WORDS 3456
#define XB_SPIN_CAP (1u << 22)
__device__ __forceinline__ unsigned xb_ld(unsigned* p)              { return __hip_atomic_load(p, __ATOMIC_RELAXED, __HIP_MEMORY_SCOPE_AGENT); }
__device__ __forceinline__ unsigned xb_add(unsigned* p, unsigned v) { return __hip_atomic_fetch_add(p, v, __ATOMIC_RELAXED, __HIP_MEMORY_SCOPE_AGENT); }
__device__ __forceinline__ unsigned xb_xcc_id() { return (unsigned)__builtin_amdgcn_s_getreg((3 << 11) | 20) & 0xFu; }
#define XB_SPIN(cond, bar) do { unsigned _sp = 0; while (cond) { __builtin_amdgcn_s_sleep(1); \
    if ((++_sp & 255u) == 0u) { if (xb_ld(&(bar)[XB_TMO])) break; if (_sp > XB_SPIN_CAP) { atomicAdd(&(bar)[XB_TMO], 1u); break; } } } } while (0)
struct XcdBarrier { unsigned* bar; unsigned x; volatile LAS unsigned* st; };
__device__ __forceinline__ XcdBarrier xcd_barrier_post(unsigned* bar, volatile LAS unsigned* st) {
    XcdBarrier b; b.bar = bar; b.x = xb_xcc_id(); b.st = st;
    if (threadIdx.x == 0) (void)xb_add(&bar[XB_XCNT(b.x)], 1u);
    return b;
}
__device__ __forceinline__ void xcd_barrier_complete(unsigned* bar, unsigned x, unsigned& nloc, unsigned& nx) {
    const unsigned G = gridDim.x * gridDim.y * gridDim.z;
    unsigned sum, cnt, mine, sp = 0u;
    for (;;) {
        sum = 0u; cnt = 0u; mine = 0u;
#pragma unroll
        for (unsigned j = 0; j < 16; ++j) { const unsigned c = xb_ld(&bar[XB_XCNT(j)]); sum += c; cnt += (c > 0u) ? 1u : 0u; mine = (j == x) ? c : mine; }
        if (sum == G) break;
        __builtin_amdgcn_s_sleep(1);
        if ((++sp & 255u) == 0u) { if (xb_ld(&bar[XB_TMO])) break; if (sp > XB_SPIN_CAP) { atomicAdd(&bar[XB_TMO], 1u); break; } }
    }
    nloc = mine > 0u ? mine : 1u; nx = cnt > 0u ? cnt : 1u;
}
__device__ __forceinline__ void xcd_barrier_(const XcdBarrier& b) {
    asm volatile("s_waitcnt vmcnt(0)" ::: "memory");
    __syncthreads();
    if (threadIdx.x == 0) {
        unsigned* bar = b.bar;
        __builtin_amdgcn_s_waitcnt(0);
        unsigned nloc = b.st[0], nx = b.st[1];
        if (nloc == 0u) { xcd_barrier_complete(bar, b.x, nloc, nx); b.st[0] = nloc; b.st[1] = nx; }
        const unsigned old = xb_add(&bar[XB_XSUB(b.x)], 1u);
        const unsigned gen = old / nloc;
        if (old + 1u == (gen + 1u) * nloc) {
            __builtin_amdgcn_fence(__ATOMIC_RELEASE, "agent");
            asm volatile("s_waitcnt vmcnt(0)" ::: "memory");
            const unsigned og = xb_add(&bar[XB_TOP], 1u);
            const unsigned tg = og / nx;
            if (og + 1u == (tg + 1u) * nx) xb_add(&bar[XB_TOPGEN], 1u);
            else XB_SPIN(xb_ld(&bar[XB_TOPGEN]) == tg, bar);
            __builtin_amdgcn_fence(__ATOMIC_ACQUIRE, "agent");
            xb_add(&bar[XB_XGEN(b.x)], 1u);
            asm volatile("s_waitcnt vmcnt(0)" ::: "memory");
        } else {
            XB_SPIN(xb_ld(&bar[XB_XGEN(b.x)]) == gen, bar);
            __builtin_amdgcn_fence(__ATOMIC_ACQUIRE, "agent");
            asm volatile("s_waitcnt vmcnt(0)" ::: "memory");
        }
    }
    __syncthreads();
}

__device__ __forceinline__ void xcd_barrier(LAS unsigned char* lds) {
    const Params* kp = launder_p((const Params*)__builtin_amdgcn_kernarg_segment_ptr());
    XcdBarrier b; b.bar = (unsigned*)(kp->ws + OFF_BAR); b.x = xb_xcc_id(); b.st = (volatile LAS unsigned*)(lds + LDS_BCAST + 64);
    xcd_barrier_(b);
}
constexpr int N_PHASES = 52;

__device__ __forceinline__ GemmDesc mkgemm(const void* A, int lda, const void* B, int ldb, int K, int nM, int nN) {
    GemmDesc g{}; g.A = (const char*)A; g.B = (const char*)B; g.lda = lda; g.ldb = ldb; g.K = K; g.nM = nM; g.nN = nN; g.nZ = 1; g.perm = 1; g.epi = E_BF16; return g;
}

__device__ __forceinline__ bool make_gemm(const Params& p, int tr, int l, int k, int i, GemmDesc& g) {
    const int T = tr ? 32768 : 8192, S = tr ? 16384 : 4096, nMT = T / 256;
    char* ws = p.ws;
    float* xout = p.out + (tr ? (size_t)8192 * DM : 0);
    ssq_t* ssq = (ssq_t*)(ws + OFF_SSQ) + (size_t)tr * 11 * TMAX;
    ssq_t* ssq_x0 = ssq + (size_t)(l * 5 + 0) * TMAX; ssq_t* ssq_q = ssq + (size_t)(l * 5 + 1) * TMAX; ssq_t* ssq_kv = ssq + (size_t)(l * 5 + 2) * TMAX;
    ssq_t* ssq_x1 = ssq + (size_t)(l * 5 + 3) * TMAX; ssq_t* ssq_x2 = ssq + (size_t)(l * 5 + 4) * TMAX; ssq_t* ssq_nx = ssq + (size_t)((l + 1) * 5) * TMAX;
    bf16_t* xb = (bf16_t*)(ws + (tr ? OFF_XB : OFF_XB0));
    const char* memn = ws + OFF_MEMN + (size_t)tr * 512 * 2048 * 2;
    if (k == 1) {
        if (i > 0) return false;
        g = mkgemm(xb, DM, ws + OFF_W_IN, DM, DM, nMT, INP / 256); g.epi = E_INPROJ; g.ssq_in = ssq_x0; g.inv_dim = 1.f / DM;
        g.out = (bf16_t*)(ws + OFF_CQ); g.out2 = (bf16_t*)(ws + OFF_KR); g.out3 = (bf16_t*)(ws + OFF_HG); g.ssq_out = ssq_q; g.ssq_out2 = ssq_kv; return true;
    } else if (k == 2) {
        if (i == 0) { g = mkgemm(ws + OFF_CQ, 768, ws + OFF_W_UQ, 512, 512, nMT, 6); g.out = (bf16_t*)(ws + OFF_Q); g.ldo = 1536; g.ssq_in = ssq_q; g.inv_dim = 1.f / 512.f; return true; }
        if (i == 1) { g = mkgemm(ws + OFF_CQ + 512 * 2, 768, ws + OFF_W_UKV, 256, 256, nMT, 8); g.out = (bf16_t*)(ws + OFF_KV); g.ldo = 2048; g.ssq_in = ssq_kv; g.inv_dim = 1.f / 256.f; return true; }
        return false;
    } else if (k == 6) {
        if (i > 0) return false;
        g = mkgemm(ws + OFF_MIX, DM, ws + OFF_W_OUT, DM, DM, nMT, 8); g.epi = E_RESID; g.perm = 0;
        g.resid = (l == 0) ? p.x_in[tr] : xout; g.xout = xout; g.xb = xb; g.ssq_out = ssq_x1; return true;
    } else if (k == 7) {
        if (i == 0) { g = mkgemm(xb, DM, ws + OFF_W_XQ, DM, DM, nMT, 8); g.out = (bf16_t*)(ws + OFF_XQ); g.ldo = DM; g.ssq_in = ssq_x1; g.inv_dim = 1.f / DM; return true; }
        return false;
    } else if (k == 5) {
        if (i == 0) { g = mkgemm(memn, DM, ws + OFF_W_XK, DM, DM, 2, 8); g.out = (bf16_t*)(ws + OFF_KMEM); g.ldo = DM; return true; }
        if (i == 1) { g = mkgemm(ws + OFF_W_XV, DM, memn, DM, DM, 8, 1); g.nZ = 2; g.bzs = 256 * DM * 2; g.out = (bf16_t*)(ws + OFF_VT); g.ldo = 256; g.ozs = (long)2048 * 256; return true; }
        return false;
    } else if (k == 8) {
        if (i > 0) return false;
        g = mkgemm(ws + OFF_XQ, DM, ws + OFF_KMEM, DM, 512, nMT, 1); g.nZ = 4; g.azs = 512 * 2; g.bzs = 512 * 2; g.bbs = 256 * DM * 2; g.tpb = S / 256;
        g.epi = E_SOFTMAX; g.out = (bf16_t*)(ws + OFF_PBUF); g.ldo = 1024; return true;
    } else if (k == 9) {
        if (i > 0) return false;
        g = mkgemm(ws + OFF_PBUF, 1024, ws + OFF_VT, 256, 256, nMT, 2); g.nZ = 4; g.azs = 256 * 2; g.bzs = 512 * 256 * 2; g.bbs = 2048 * 256 * 2; g.tpb = S / 256;
        g.out = (bf16_t*)(ws + OFF_OBUF); g.ldo = DM; g.ozs = 512; return true;
    } else if (k == 10) {
        if (i > 0) return false;
        g = mkgemm(ws + OFF_OBUF, DM, ws + OFF_W_XO, DM, DM, nMT, 8); g.epi = E_RESID; g.perm = 0;
        g.resid = xout; g.xout = xout; g.xb = xb; g.ssq_out = ssq_x2; return true;
    } else if (k == 11) {
        if (i > 0) return false;
        g = mkgemm(xb, DM, ws + OFF_W_F1, DM, DM, nMT, 32); g.out = (bf16_t*)(ws + OFF_U); g.ldo = 8192; g.ssq_in = ssq_x2; g.inv_dim = 1.f / DM; g.relu2 = 1; return true;
    } else if (k == 12) {
        if (i > 0) return false;
        g = mkgemm(ws + OFF_U, 8192, ws + OFF_W_F2, 8192, 8192, nMT, 8); g.epi = E_RESID; g.perm = 0;
        g.resid = xout; g.xout = xout; g.xb = xb; g.ssq_out = ssq_nx; return true;
    }
    return false;
}

__device__ __forceinline__ void run_phase(const Params* kp, int ph, LAS unsigned char* lds) {
    const Params& p = *kp;
    if (ph == 0) { prep_phase(p, 0, 8192, 4096); prep_phase(p, 1, 32768, 16384); return; }
    if (ph == N_PHASES - 1) { final_phase(p, p.out, 8192, 0); final_phase(p, p.out + (size_t)8192 * DM, 32768, 1); return; }
    const int l = (ph - 1) / 25, r = (ph - 1) % 25;
    if (r == 0) { wcvt_phase(lds, p, l); return; }
    const int tr = (r - 1) / 12, k = (r - 1) % 12 + 1;
    const int T = tr ? 32768 : 8192, S = tr ? 16384 : 4096;
    if (k == 3) { rope_phase(p, T, S); return; }
    if (k == 4) { mixer_phase(lds, p, l, T, S, tr); return; }
    if (k == 5) {
        const int c = lbid(), G = gridDim.x;
        if (G >= 64) {
            if (c < 16) gemm_phase<E_BF16>(lds, kp, tr, l, 5, 0, 16, c);
            else if (c < 32) gemm_phase<E_BF16>(lds, kp, tr, l, 5, 1, 16, c - 16);
            else hcomb_phase(p, l, T, G - 32, c - 32, S >= 16384 ? 2 : 1);
        } else { gemm_phase<E_BF16>(lds, kp, tr, l, 5, 0, G, c); gemm_phase<E_BF16>(lds, kp, tr, l, 5, 1, G, c); hcomb_phase(p, l, T, G, c, S >= 16384 ? 2 : 1); }
        return; }
#ifndef MK_NO_GEMM
    { const int c = lbid(), G = gridDim.x;
    if (k == 1) gemm_phase<E_INPROJ>(lds, kp, tr, l, k, 0, G, c);
    else if (k == 6 || k == 10 || k == 12) gemm_phase<E_RESID>(lds, kp, tr, l, k, 0, G, c);
    else if (k == 8) gemm_phase<E_SOFTMAX>(lds, kp, tr, l, k, 0, G, c);
    else for (int i = 0; i < 2; ++i) gemm_phase<E_BF16>(lds, kp, tr, l, k, i, G, c); }
#endif
}

__global__ void __launch_bounds__(512, 2) mk_forward(Params p, int ph_lo, int ph_hi) {
    extern __shared__ __attribute__((aligned(16))) unsigned char shm[];
    LAS unsigned char* lds = (LAS unsigned char*)shm;
    cg::grid_group grid = cg::this_grid();
    volatile LAS unsigned* xst = (volatile LAS unsigned*)(lds + LDS_BCAST + 64);
    if (threadIdx.x == 0) { xst[0] = 0u; xst[1] = 0u; }
    __syncthreads();
    { const Params* kp0 = launder_p((const Params*)__builtin_amdgcn_kernarg_segment_ptr()); (void)xcd_barrier_post((unsigned*)(kp0->ws + OFF_BAR), xst); }
    for (int ph = ph_lo; ph < ph_hi; ++ph) {
        const Params* kp = launder_p((const Params*)__builtin_amdgcn_kernarg_segment_ptr());
        run_phase(kp, ph, lds);
        if (ph + 1 < ph_hi) { if (ph == ph_lo) grid.sync(); else xcd_barrier(lds); }
    }

}

extern "C" void kernel_launch(void* const* d_in, const int* in_sizes, int n_in, void* d_out, int out_size, void* d_ws, size_t ws_size, hipStream_t stream) {
    static int inited = 0; static int grid_blocks = 0;
    if (!inited) {
        hipFuncSetAttribute((const void*)mk_forward, hipFuncAttributeMaxDynamicSharedMemorySize, LDS_BYTES);
        int dev = 0, cus = 0, per_cu = 0;
        hipGetDevice(&dev); hipDeviceGetAttribute(&cus, hipDeviceAttributeMultiprocessorCount, dev);
        hipOccupancyMaxActiveBlocksPerMultiprocessor(&per_cu, mk_forward, 512, LDS_BYTES);
        if (per_cu < 1) per_cu = 1;
        grid_blocks = cus * 1;
        if (ws_size < WS_END) fprintf(stderr, "kernel_launch: workspace too small: %zu < %zu\n", ws_size, (size_t)WS_END);
        inited = 1;
    }
    Params p{};
    const float* const* in = (const float* const*)d_in;
    p.x_in[0] = in[0]; p.x_in[1] = in[1]; p.mem_in[0] = in[2]; p.mem_in[1] = in[3];
    p.mix_norm = in[4]; p.w_in = in[5]; p.q_norm = in[6]; p.w_uq = in[7]; p.kv_norm = in[8]; p.w_ukv = in[9]; p.lb_logits = in[10]; p.out_norm = in[11]; p.w_out = in[12];
    p.xattn_norm = in[13]; p.mem_norm = in[14]; p.w_xq = in[15]; p.w_xk = in[16]; p.w_xv = in[17]; p.w_xo = in[18]; p.ffn_norm = in[19]; p.w_ffn1 = in[20]; p.w_ffn2 = in[21]; p.final_norm = in[22];
    p.out = (float*)d_out; p.ws = (char*)d_ws;
#if MK_ONE_LAUNCH
    hipMemsetAsync((char*)d_ws + OFF_BAR, 0, 16384, stream);
    int lo = 0, hi = N_PHASES;
    void* args[] = {&p, &lo, &hi};
    hipError_t e = hipLaunchCooperativeKernel((const void*)mk_forward, dim3(grid_blocks), dim3(512), args, LDS_BYTES, stream);
    if (e != hipSuccess) fprintf(stderr, "cooperative launch failed: %s\n", hipGetErrorString(e));
#else
    for (int ph = 0; ph < N_PHASES; ++ph) hipLaunchKernelGGL(mk_forward, dim3(grid_blocks), dim3(512), LDS_BYTES, stream, p, ph, ph + 1);
#endif
}
```

```cpp
#include <hip/hip_runtime.h>
#include <hip/hip_cooperative_groups.h>
#include <cstdio>
namespace cg = cooperative_groups;

#define LAS __attribute__((address_space(3)))
typedef unsigned short bf16_t;
typedef short bf16x8 __attribute__((ext_vector_type(8)));
typedef short s16x4 __attribute__((ext_vector_type(4)));
typedef float f32x4 __attribute__((ext_vector_type(4)));
typedef float f32x8 __attribute__((ext_vector_type(8)));
typedef float f32x16 __attribute__((ext_vector_type(16)));
typedef unsigned u32x4 __attribute__((ext_vector_type(4)));
typedef unsigned u32x2 __attribute__((ext_vector_type(2)));

#ifndef MK_ONE_LAUNCH
#define MK_ONE_LAUNCH 1
#endif

constexpr int DM = 2048, NMEM = 256, DEPTH = 2;
constexpr int INP = 6144;
constexpr int HGW = 5120;
constexpr int TMAX = 32768;
constexpr float EPS = 1e-6f;
constexpr int LDS_BYTES = 144 * 1024;
constexpr int LDS_BCAST = 140 * 1024;
constexpr int LDS_EPI = 128 * 1024;

constexpr size_t al256(size_t x) { return (x + 255) / 256 * 256; }
constexpr size_t E_W_IN = (size_t)INP * 2048, E_W_UQ = 1536 * 512, E_W_UKV = 2048 * 256, E_W_SQ = 2048 * 2048, E_W_F = (size_t)8192 * 2048;
constexpr size_t OFF_W_IN = 0;
constexpr size_t OFF_W_UQ = OFF_W_IN + E_W_IN * 2;
constexpr size_t OFF_W_UKV = OFF_W_UQ + E_W_UQ * 2;
constexpr size_t OFF_W_OUT = OFF_W_UKV + E_W_UKV * 2;
constexpr size_t OFF_W_XQ = OFF_W_OUT + E_W_SQ * 2;
constexpr size_t OFF_W_XK = OFF_W_XQ + E_W_SQ * 2;
constexpr size_t OFF_W_XV = OFF_W_XK + E_W_SQ * 2;
constexpr size_t OFF_W_XO = OFF_W_XV + E_W_SQ * 2;
constexpr size_t OFF_W_F1 = OFF_W_XO + E_W_SQ * 2;
constexpr size_t OFF_W_F2 = OFF_W_F1 + E_W_F * 2;
constexpr size_t OFF_XB = OFF_W_F2 + E_W_F * 2;
constexpr size_t OFF_KR = OFF_XB + (size_t)TMAX * 2048 * 2;
constexpr size_t OFF_KROPE = OFF_KR + (size_t)TMAX * 64 * 2;
constexpr size_t OFF_MIX = OFF_KROPE + (size_t)TMAX * 64 * 2;
constexpr size_t OFF_HG = OFF_MIX + (size_t)TMAX * 2048 * 2;
constexpr size_t OFF_Q = OFF_HG + (size_t)TMAX * HGW * 2;
constexpr size_t OFF_KV = OFF_Q + (size_t)TMAX * 1536 * 2;
constexpr size_t OFF_MEMN = OFF_KV + (size_t)TMAX * 2048 * 2;
constexpr size_t OFF_KMEM = OFF_MEMN + (size_t)2 * 512 * 2048 * 2;
constexpr size_t OFF_VT = OFF_KMEM + (size_t)512 * 2048 * 2;
constexpr size_t OFF_ROPE = OFF_VT + (size_t)512 * 2048 * 2;
constexpr size_t OFF_SSQ = OFF_ROPE + (size_t)16384 * 32 * 4 * 2;
constexpr size_t OFF_CTR = OFF_SSQ + (size_t)22 * TMAX * 8;
constexpr size_t OFF_BAR = OFF_CTR + 256;
constexpr size_t OFF_LB = OFF_BAR + 16384;
constexpr size_t OFF_TS = OFF_LB + 8192;
constexpr size_t OFF_XB0 = OFF_TS + 1024;
constexpr size_t WS_END = OFF_XB0 + (size_t)8192 * 2048 * 2;
constexpr size_t OFF_CQ = OFF_MIX;
constexpr size_t OFF_XQ = OFF_Q;
constexpr size_t OFF_PBUF = OFF_MIX;
constexpr size_t OFF_OBUF = OFF_HG;
constexpr size_t OFF_U = OFF_HG;
static_assert((size_t)TMAX * 8192 * 2 <= OFF_MEMN - OFF_HG, "u must fit");

struct Params {
    const float* x_in[2]; const float* mem_in[2];
    const float *mix_norm, *w_in, *q_norm, *w_uq, *kv_norm, *w_ukv, *lb_logits, *out_norm, *w_out, *xattn_norm, *mem_norm, *w_xq, *w_xk, *w_xv, *w_xo,
        *ffn_norm, *w_ffn1, *w_ffn2, *final_norm;
    float* out; char* ws;
};

__device__ __forceinline__ int ltid() { int t = threadIdx.x; asm volatile("" : "+v"(t)); return t; }
__device__ __forceinline__ int lbid() { int t = blockIdx.x; asm volatile("" : "+s"(t)); return t; }
__device__ __forceinline__ float bf2f(bf16_t b) { return __uint_as_float(((unsigned)b) << 16); }
__device__ __forceinline__ bf16_t f2bf(float f) { unsigned u = __float_as_uint(f); u += 0x7FFFu + ((u >> 16) & 1u); return (bf16_t)(u >> 16); }
__device__ __forceinline__ unsigned cvtpk(float lo, float hi) { unsigned r; asm volatile("v_cvt_pk_bf16_f32 %0, %1, %2" : "=v"(r) : "v"(lo), "v"(hi)); return r; }
__device__ __forceinline__ void wg_barrier() { asm volatile("s_waitcnt vmcnt(0) lgkmcnt(0)" ::: "memory"); __builtin_amdgcn_s_barrier(); asm volatile("" ::: "memory"); }
typedef unsigned long long ssq_t;
__device__ __forceinline__ ssq_t ssq_fix(float v) { return (ssq_t)(v * 16777216.f + 0.5f); }
__device__ __forceinline__ float ssq_val(ssq_t v) { return (float)v * (1.f / 16777216.f); }
__device__ __forceinline__ void atomic_addf(ssq_t* p, float v) { __hip_atomic_fetch_add(p, ssq_fix(v), __ATOMIC_RELAXED, __HIP_MEMORY_SCOPE_AGENT); }

namespace pg8 {
constexpr int BM = 256, BK = 64, HALF = 128, HTB = HALF * BK * 2, NXCD = 8, WGM = 8;
__host__ __device__ __forceinline__ int lds_byte(int r, int c) { const int st = (r >> 4) * 2 + (c >> 5), rr = r & 15, cc = c & 31, ob = rr * 64 + cc * 2; return st * 1024 + (ob ^ (((ob >> 9) & 1) << 5)); }
__host__ __device__ __forceinline__ void stage_rc(int b, int& R, int& C) { const int st = b / 1024, sb = b % 1024, swz = sb ^ (((sb >> 9) & 1) << 5); R = (st >> 1) * 16 + swz / 64; C = (st & 1) * 32 + (swz % 64) / 2; }
__host__ __device__ __forceinline__ int perm32(int rho) { const int n = rho >> 4, i = rho & 15; return 8 * (i >> 2) + 4 * n + (i & 3); }
}
enum { E_BF16 = 0, E_INPROJ = 1, E_RESID = 2, E_SOFTMAX = 3, E_QROPE = 4 };
struct GemmDesc {
    const char* A; const char* B; int lda, ldb, K, nM, nN, nZ;
    int azs, bzs, bbs, tpb;
    int epi, perm;
    bf16_t* out; long ozs; int ldo;
    const ssq_t* ssq_in; float inv_dim; int relu2;
    ssq_t* ssq_out; ssq_t* ssq_out2;
    const float* resid; float* xout; bf16_t* xb;
    bf16_t* out2; bf16_t* out3;
};
struct Unit { int pm, pn, z; const char* a; const char* b; };

__device__ __forceinline__ bool make_gemm(const Params& p, int tr, int l, int k, int i, GemmDesc& g);
__device__ __forceinline__ const Params* launder_p(const Params* q) { asm volatile("" : "+s"(q)); return q; }
__device__ __forceinline__ int launder_i(int v) { asm volatile("" : "+s"(v)); return v; }
__device__ __forceinline__ bool next_unit(const Params* kp, int tr, int l, int k, int gi, int i, int G, int c, Unit& u) {
    GemmDesc g; make_gemm(*launder_p(kp), launder_i(tr), launder_i(l), launder_i(k), launder_i(gi), g);
    const int L = i * G + c; const int per = g.nM * g.nN;
    if (L >= per * g.nZ) return false;
    const int z = L / per; int wgid = L - z * per;
    { const int q = per / pg8::NXCD, r = per % pg8::NXCD, xcd = wgid % pg8::NXCD, off = wgid / pg8::NXCD; wgid = (xcd < r ? xcd * (q + 1) : r * (q + 1) + (xcd - r) * q) + off; }
    const int nig = pg8::WGM * g.nN, gid = wgid / nig, fm = gid * pg8::WGM, gsz = (g.nM - fm) < pg8::WGM ? (g.nM - fm) : pg8::WGM;
    u.pm = fm + ((wgid % nig) % gsz); u.pn = (wgid % nig) / gsz; u.z = z;
    const unsigned ao = (unsigned)z * (unsigned)g.azs + (unsigned)u.pm * (unsigned)(512 * g.lda);
    const unsigned bo = (unsigned)z * (unsigned)g.bzs + (unsigned)u.pn * (unsigned)(512 * g.ldb) + (g.tpb ? (unsigned)(u.pm / g.tpb) * (unsigned)g.bbs : 0u);
    u.a = g.A + (size_t)ao; u.b = g.B + (size_t)bo;
    return true;
}

template <int EPI> __device__ __forceinline__ void gemm_epilogue(const Params* kp, int tr, int l, int k, int gi, f32x4 (&acc)[2][2][4][2], const Unit& u, LAS unsigned char* lds) {
    const int tid_e = ltid(), wid_e = tid_e >> 6, lane_e = tid_e & 63, wr = wid_e >> 2, wc = wid_e & 3, fr = lane_e & 15, fq = lane_e >> 4;
    GemmDesc g; make_gemm(*launder_p(kp), launder_i(tr), launder_i(l), launder_i(k), launder_i(gi), g);
    const int row0 = u.pm * 256 + wr * 64 + fr;
    if constexpr (EPI == E_BF16) {
        const int col0 = u.pn * 256 + wc * 32 + 8 * fq;
        float rsv[2][4];
#pragma unroll
        for (int ai = 0; ai < 2; ++ai)
#pragma unroll
            for (int m = 0; m < 4; ++m) rsv[ai][m] = g.ssq_in ? __builtin_amdgcn_rsqf(ssq_val(g.ssq_in[row0 + ai * 128 + m * 16]) * g.inv_dim + EPS) : 1.0f;
#pragma unroll
        for (int ai = 0; ai < 2; ++ai)
#pragma unroll
            for (int m = 0; m < 4; ++m) {
                const int row = row0 + ai * 128 + m * 16;
                const float rs = rsv[ai][m];
                bf16_t* rowp = g.out + (long)u.z * g.ozs + (long)row * g.ldo + col0;
#pragma unroll
                for (int bj = 0; bj < 2; ++bj) {
                    f32x4 v0 = acc[ai][bj][m][0] * rs, v1 = acc[ai][bj][m][1] * rs;
                    if (g.relu2) {
#pragma unroll
                        for (int j = 0; j < 4; ++j) { float a = fmaxf(v0[j], 0.f), b = fmaxf(v1[j], 0.f); v0[j] = a * a; v1[j] = b * b; }
                    }
                    u32x4 w; w.x = cvtpk(v0[0], v0[1]); w.y = cvtpk(v0[2], v0[3]); w.z = cvtpk(v1[0], v1[1]); w.w = cvtpk(v1[2], v1[3]);
                    *(u32x4*)(rowp + bj * 128) = w;
                }
            }
    } else if constexpr (EPI == E_QROPE) {
        const int col0 = u.pn * 256 + wc * 32 + 8 * fq;
        float rsv[2][4];
#pragma unroll
        for (int ai = 0; ai < 2; ++ai)
#pragma unroll
            for (int m = 0; m < 4; ++m) rsv[ai][m] = __builtin_amdgcn_rsqf(ssq_val(g.ssq_in[row0 + ai * 128 + m * 16]) * g.inv_dim + EPS);
        const float* rcb = (const float*)(kp->ws + OFF_ROPE) + 16 * (wc & 1) + 4 * fq;
#pragma unroll
        for (int bj = 0; bj < 2; ++bj) {
            const int cs = u.pn * 256 + bj * 128 + (wc >> 1) * 64;
            const int hh = cs / 192; const bool isr = (cs - hh * 192) == 128;
#pragma unroll
            for (int ai = 0; ai < 2; ++ai)
#pragma unroll
                for (int m = 0; m < 4; ++m) {
                    const int row = row0 + ai * 128 + m * 16;
                    const float rs = rsv[ai][m];
                    const f32x4 v0 = acc[ai][bj][m][0] * rs, v1 = acc[ai][bj][m][1] * rs;
                    if (isr) {
                        const int pos = row & (g.relu2 - 1);
                        const f32x4 c = *(const f32x4*)(rcb + pos * 32), s = *(const f32x4*)(rcb + pos * 32 + 16384 * 32);
                        const f32x4 r1 = v0 * c - v1 * s, r2 = v1 * c + v0 * s;
                        u32x2 w1, w2; w1.x = cvtpk(r1[0], r1[1]); w1.y = cvtpk(r1[2], r1[3]); w2.x = cvtpk(r2[0], r2[1]); w2.y = cvtpk(r2[2], r2[3]);
                        bf16_t* dq = g.out + (long)row * g.ldo + hh * 192 + 128 + 16 * (wc & 1) + 4 * fq;
                        *(u32x2*)dq = w1; *(u32x2*)(dq + 32) = w2;
                    } else {
                        u32x4 w; w.x = cvtpk(v0[0], v0[1]); w.y = cvtpk(v0[2], v0[3]); w.z = cvtpk(v1[0], v1[1]); w.w = cvtpk(v1[2], v1[3]);
                        *(u32x4*)(g.out + (long)row * g.ldo + col0 + bj * 128) = w;
                    }
                }
        }
    } else if constexpr (EPI == E_INPROJ) {
        const int lc0 = wc * 32 + 8 * fq;
        const int pn = u.pn;
        const int hseg = (pn >= 4) ? ((pn - 4) >> 2) : 9;
        f32x4 lbv[2][2];
        if (hseg == 1 || hseg == 2) {
            const float* lbt = (const float*)(kp->ws + OFF_LB) + (hseg - 1) * 1024 + ((pn - 4) & 3) * 256 + lc0;
#pragma unroll
            for (int bj = 0; bj < 2; ++bj) { lbv[bj][0] = *(const f32x4*)(lbt + bj * 128); lbv[bj][1] = *(const f32x4*)(lbt + bj * 128 + 4); }
        } else {
#pragma unroll
            for (int bj = 0; bj < 2; ++bj) { lbv[bj][0] = (f32x4){0.f, 0.f, 0.f, 0.f}; lbv[bj][1] = lbv[bj][0]; }
        }
        float rsv[2][4];
#pragma unroll
        for (int ai = 0; ai < 2; ++ai)
#pragma unroll
            for (int m = 0; m < 4; ++m) rsv[ai][m] = __builtin_amdgcn_rsqf(ssq_val(g.ssq_in[row0 + ai * 128 + m * 16]) * g.inv_dim + EPS);
#pragma unroll
        for (int ai = 0; ai < 2; ++ai)
#pragma unroll
            for (int m = 0; m < 4; ++m) {
                const int row = row0 + ai * 128 + m * 16;
                const float rs = rsv[ai][m];
                float ss = 0.f;
#pragma unroll
                for (int bj = 0; bj < 2; ++bj) {
                    f32x4 v0 = acc[ai][bj][m][0] * rs, v1 = acc[ai][bj][m][1] * rs;
                    if (hseg == 0) {
#pragma unroll
                        for (int j = 0; j < 4; ++j) { v0[j] = v0[j] * __builtin_amdgcn_rcpf(1.f + __expf(-v0[j])) * 0.08838834764831845f; v1[j] = v1[j] * __builtin_amdgcn_rcpf(1.f + __expf(-v1[j])) * 0.08838834764831845f; }
                    } else if (hseg == 1 || hseg == 2) {
#pragma unroll
                        for (int j = 0; j < 4; ++j) {
                            const float l0 = lbv[bj][0][j], l1 = lbv[bj][1][j];
                            v0[j] = __logf(l0 + (1.f - l0) * __builtin_amdgcn_rcpf(1.f + __expf(-fmaxf(v0[j], -80.f))));
                            v1[j] = __logf(l1 + (1.f - l1) * __builtin_amdgcn_rcpf(1.f + __expf(-fmaxf(v1[j], -80.f))));
                        }
                    }
                    u32x4 w; w.x = cvtpk(v0[0], v0[1]); w.y = cvtpk(v0[2], v0[3]); w.z = cvtpk(v1[0], v1[1]); w.w = cvtpk(v1[2], v1[3]);
                    const int lc = lc0 + bj * 128;
                    if (pn < 3) {
                        *(u32x4*)(g.out + (long)row * 768 + pn * 256 + lc) = w;
                        ss += (v0[0] * v0[0] + v0[1] * v0[1]) + (v0[2] * v0[2] + v0[3] * v0[3]) + (v1[0] * v1[0] + v1[1] * v1[1]) + (v1[2] * v1[2] + v1[3] * v1[3]);
                    } else if (pn == 3) {
                        if (lc < 64) {
                            const int i0 = 16 * (wc & 1) + 4 * fq; const int pos = row & (g.relu2 - 1);
                            const float* rc = (const float*)(kp->ws + OFF_ROPE) + pos * 32 + i0;
                            const f32x4 c = *(const f32x4*)rc, s = *(const f32x4*)(rc + 16384 * 32);
                            const f32x4 r1 = v0 * c - v1 * s, r2 = v1 * c + v0 * s;
                            u32x2 w1, w2; w1.x = cvtpk(r1[0], r1[1]); w1.y = cvtpk(r1[2], r1[3]); w2.x = cvtpk(r2[0], r2[1]); w2.y = cvtpk(r2[2], r2[3]);
                            *(u32x2*)(g.out2 + (long)row * 64 + i0) = w1; *(u32x2*)(g.out2 + (long)row * 64 + 32 + i0) = w2;
                        }
                    } else {
                        *(u32x4*)(g.out3 + (long)row * HGW + (pn - 4) * 256 + lc) = w;
                    }
                }
                if (pn < 3) {
                    ss += __shfl_xor(ss, 16); ss += __shfl_xor(ss, 32);
                    if (fq == 0) atomic_addf((pn < 2 ? g.ssq_out : g.ssq_out2) + row, ss);
                }
            }
    } else if constexpr (EPI == E_RESID) {
        const int col0 = u.pn * 256 + wc * 32 + 8 * fq;
#pragma unroll
        for (int ai = 0; ai < 2; ++ai) {
            f32x4 rv[4][2][2];
#pragma unroll
            for (int m = 0; m < 4; ++m)
#pragma unroll
                for (int bj = 0; bj < 2; ++bj)
#pragma unroll
                    for (int n = 0; n < 2; ++n) rv[m][bj][n] = *(const f32x4*)(g.resid + (long)(row0 + ai * 128 + m * 16) * DM + col0 + bj * 128 + n * 4);
#pragma unroll
            for (int m = 0; m < 4; ++m) {
                const int row = row0 + ai * 128 + m * 16;
                float ss = 0.f;
#pragma unroll
                for (int bj = 0; bj < 2; ++bj) {
                    const long o = (long)row * DM + col0 + bj * 128;
                    const f32x4 v0 = rv[m][bj][0] + acc[ai][bj][m][0], v1 = rv[m][bj][1] + acc[ai][bj][m][1];
                    *(f32x4*)(g.xout + o) = v0; *(f32x4*)(g.xout + o + 4) = v1;
                    u32x4 w; w.x = cvtpk(v0[0], v0[1]); w.y = cvtpk(v0[2], v0[3]); w.z = cvtpk(v1[0], v1[1]); w.w = cvtpk(v1[2], v1[3]);
                    *(u32x4*)(g.xb + o) = w;
                    ss += (v0[0] * v0[0] + v0[1] * v0[1]) + (v0[2] * v0[2] + v0[3] * v0[3]) + (v1[0] * v1[0] + v1[1] * v1[1]) + (v1[2] * v1[2] + v1[3] * v1[3]);
                }
                ss += __shfl_xor(ss, 16); ss += __shfl_xor(ss, 32);
                if (fq == 0) atomic_addf(g.ssq_out + row, ss);
            }
        }
    } else {
        LAS float* smax = (LAS float*)(lds + LDS_EPI);
        LAS float* ssum = (LAS float*)(lds + LDS_EPI + 4096);
        const float C = 0.044194173824159216f * 1.4426950408889634f;
#pragma unroll
        for (int ai = 0; ai < 2; ++ai)
#pragma unroll
            for (int m = 0; m < 4; ++m) {
                __builtin_amdgcn_sched_barrier(0);
                float t = -3.0e38f;
#pragma unroll
                for (int bj = 0; bj < 2; ++bj)
#pragma unroll
                    for (int n = 0; n < 2; ++n)
#pragma unroll
                        for (int j = 0; j < 4; ++j) t = fmaxf(t, acc[ai][bj][m][n][j]);
                t = fmaxf(t, __shfl_xor(t, 16)); t = fmaxf(t, __shfl_xor(t, 32));
                if (fq == 0) smax[(ai * 128 + wr * 64 + m * 16 + fr) * 4 + wc] = t;
            }
        asm volatile("s_waitcnt lgkmcnt(0)" ::: "memory"); __builtin_amdgcn_s_barrier(); asm volatile("" ::: "memory");
#pragma unroll
        for (int ai = 0; ai < 2; ++ai)
#pragma unroll
            for (int m = 0; m < 4; ++m) {
                __builtin_amdgcn_sched_barrier(0);
                const int rl = ai * 128 + wr * 64 + m * 16 + fr;
                const f32x4 q = *(LAS f32x4*)(smax + rl * 4);
                const float mm = fmaxf(fmaxf(q[0], q[1]), fmaxf(q[2], q[3])) * C;
                float s = 0.f;
#pragma unroll
                for (int bj = 0; bj < 2; ++bj)
#pragma unroll
                    for (int n = 0; n < 2; ++n)
#pragma unroll
                        for (int j = 0; j < 4; ++j) { const float e = __builtin_amdgcn_exp2f(acc[ai][bj][m][n][j] * C - mm); acc[ai][bj][m][n][j] = e; s += e; }
                s += __shfl_xor(s, 16); s += __shfl_xor(s, 32);
                if (fq == 0) ssum[rl * 4 + wc] = s;
            }
        asm volatile("s_waitcnt lgkmcnt(0)" ::: "memory"); __builtin_amdgcn_s_barrier(); asm volatile("" ::: "memory");
        const int col0 = wc * 32 + 8 * fq;
#pragma unroll
        for (int ai = 0; ai < 2; ++ai)
#pragma unroll
            for (int m = 0; m < 4; ++m) {
                __builtin_amdgcn_sched_barrier(0);
                const int rl = ai * 128 + wr * 64 + m * 16 + fr;
                const f32x4 q = *(LAS f32x4*)(ssum + rl * 4);
                const float inv = 1.0f / ((q[0] + q[1]) + (q[2] + q[3]));
                bf16_t* rowp = g.out + (long)(u.pm * 256 + rl) * g.ldo + u.z * 256 + col0;
#pragma unroll
                for (int bj = 0; bj < 2; ++bj) {
                    const f32x4 v0 = acc[ai][bj][m][0] * inv, v1 = acc[ai][bj][m][1] * inv;
                    u32x4 w; w.x = cvtpk(v0[0], v0[1]); w.y = cvtpk(v0[2], v0[3]); w.z = cvtpk(v1[0], v1[1]); w.w = cvtpk(v1[2], v1[3]);
                    *(u32x4*)(rowp + bj * 128) = w;
                }
            }
    }
}

template <int EPI> __device__ __forceinline__ void gemm_phase(LAS unsigned char* lds, const Params* kp, int tr, int l, int k, int gi, int G, int cblk) {
    using namespace pg8;
    int Kdim, lda_, ldb_, perm_;
    { GemmDesc g0; if (!make_gemm(*kp, tr, l, k, gi, g0)) return; Kdim = g0.K; lda_ = g0.lda; ldb_ = g0.ldb; perm_ = g0.perm; }
    const int tid = ltid(), wid = __builtin_amdgcn_readfirstlane(tid >> 6), lane = tid & 63, wr = wid >> 2, wc = wid & 3, fr = lane & 15, fq = lane >> 4;
    const int K = Kdim, nt = K / BK;
    unsigned voffA[2], voffB[2];
#pragma unroll
    for (int i = 0; i < 2; ++i) { int R, C; stage_rc(tid * 16 + i * 8192, R, C); const int Rb = perm_ ? ((R & ~31) + perm32(R & 31)) : R;
        voffA[i] = (unsigned)(R * lda_ + C) * 2u; voffB[i] = (unsigned)(Rb * ldb_ + C) * 2u; }
    const size_t kstep = (size_t)(BK * 2);
    const size_t hstepA = (size_t)HALF * lda_ * 2, hstepB = (size_t)HALF * ldb_ * 2;
    const unsigned ldsw = (unsigned)wid * 1024u;
    const int aoff = lds_byte(wr * 64 + fr, fq * 8), boff = lds_byte(wc * 32 + fr, fq * 8);
#define PG8_SA(b, h) (((b) * 2 + (h)) * HTB)
#define PG8_SB(b, h) ((4 + (b) * 2 + (h)) * HTB)
#define PG8_STAGE(bufoff, gbase, voff) do { _Pragma("unroll") for (int _i = 0; _i < 2; ++_i) \
        __builtin_amdgcn_global_load_lds((const unsigned*)((const char*)(gbase) + (voff)[_i]), (LAS unsigned*)(lds + (bufoff) + ldsw + _i * 8192), 16, 0, 0); } while (0)
#define PG8_LDA(dst, b, h) do { _Pragma("unroll") for (int m = 0; m < 4; ++m) _Pragma("unroll") for (int k = 0; k < 2; ++k) dst[m][k] = *(const LAS bf16x8*)(lds + PG8_SA(b, h) + aoff + m * 2048 + k * 1024); } while (0)
#define PG8_LDB(dst, b, h) do { _Pragma("unroll") for (int n = 0; n < 2; ++n) _Pragma("unroll") for (int k = 0; k < 2; ++k) dst[n][k] = *(const LAS bf16x8*)(lds + PG8_SB(b, h) + boff + n * 2048 + k * 1024); } while (0)
#define PG8_MMA(ai, bj, At, Bt) do { __builtin_amdgcn_s_setprio(1); _Pragma("unroll") for (int m = 0; m < 4; ++m) _Pragma("unroll") for (int n = 0; n < 2; ++n) _Pragma("unroll") for (int k = 0; k < 2; ++k) \
        acc[ai][bj][m][n] = __builtin_amdgcn_mfma_f32_16x16x32_bf16(Bt[n][k], At[m][k], acc[ai][bj][m][n], 0, 0, 0); __builtin_amdgcn_s_setprio(0); } while (0)
#define PG8_WAIT_V(n) asm volatile("s_waitcnt vmcnt(" #n ")" ::: "memory")
#define PG8_WAIT_L(n) asm volatile("s_waitcnt lgkmcnt(" #n ")" ::: "memory")
#define PG8_BAR __builtin_amdgcn_s_barrier()
#define PG8_SCHED __builtin_amdgcn_sched_barrier(0)
    Unit cur, nxt; int ui = 0;
    if (!next_unit(kp, tr, l, k, gi, 0, G, cblk, cur)) return;
    f32x4 acc[2][2][4][2];
#pragma unroll
    for (int a = 0; a < 2; ++a)
#pragma unroll
        for (int b = 0; b < 2; ++b)
#pragma unroll
            for (int m = 0; m < 4; ++m)
#pragma unroll
                for (int n = 0; n < 2; ++n) acc[a][b][m][n] = (f32x4){0.f, 0.f, 0.f, 0.f};
    bf16x8 At[4][2], B0[2][2], B1[2][2];
    const char* cA = cur.a; const char* cB = cur.b;
    PG8_STAGE(PG8_SB(0, 0), cB, voffB); PG8_STAGE(PG8_SA(0, 0), cA, voffA); PG8_STAGE(PG8_SB(0, 1), cB + hstepB, voffB); PG8_STAGE(PG8_SA(0, 1), cA + hstepA, voffA);
    if (wr == 1) PG8_BAR;
    PG8_WAIT_V(4); PG8_BAR;
    PG8_STAGE(PG8_SB(1, 0), cB + kstep, voffB); PG8_STAGE(PG8_SA(1, 0), cA + kstep, voffA); PG8_STAGE(PG8_SB(1, 1), cB + hstepB + kstep, voffB);
    PG8_WAIT_V(6); PG8_BAR;
    for (;;) {
        const bool has_next = next_unit(kp, tr, l, k, gi, ui + 1, G, cblk, nxt);
        const char* nA = has_next ? nxt.a : cA; const char* nB = has_next ? nxt.b : cB;
        for (int t = 0; t < nt; t += 2) {
            const bool last = (t == nt - 2);
            const char* a1 = cA + (size_t)(t + 1) * kstep;
            const char* a2 = last ? nA : cA + (size_t)(t + 2) * kstep; const char* b2 = last ? nB : cB + (size_t)(t + 2) * kstep;
            const char* a3 = a2 + kstep; const char* b3 = b2 + kstep;
            PG8_LDB(B0, 0, 0); PG8_SCHED; PG8_LDA(At, 0, 0); PG8_STAGE(PG8_SA(1, 1), a1 + hstepA, voffA);
            PG8_WAIT_L(8); PG8_BAR; PG8_WAIT_L(0); PG8_MMA(0, 0, At, B0); PG8_BAR; PG8_SCHED;
            PG8_LDB(B1, 0, 1); PG8_STAGE(PG8_SB(0, 0), b2, voffB);
            PG8_BAR; PG8_WAIT_L(0); PG8_MMA(0, 1, At, B1); PG8_BAR;
            PG8_LDA(At, 0, 1); PG8_STAGE(PG8_SA(0, 0), a2, voffA);
            PG8_BAR; PG8_WAIT_L(0); PG8_MMA(1, 0, At, B0); PG8_BAR; PG8_SCHED;
            PG8_STAGE(PG8_SB(0, 1), b2 + hstepB, voffB);
            PG8_WAIT_V(6); PG8_BAR; PG8_MMA(1, 1, At, B1); PG8_BAR;
            PG8_LDB(B0, 1, 0); PG8_SCHED; PG8_LDA(At, 1, 0); PG8_STAGE(PG8_SA(0, 1), a2 + hstepA, voffA);
            PG8_WAIT_L(8); PG8_BAR; PG8_WAIT_L(0); PG8_MMA(0, 0, At, B0); PG8_BAR; PG8_SCHED;
            PG8_LDB(B1, 1, 1); PG8_STAGE(PG8_SB(1, 0), b3, voffB);
            PG8_BAR; PG8_WAIT_L(0); PG8_MMA(0, 1, At, B1); PG8_BAR;
            PG8_LDA(At, 1, 1); PG8_STAGE(PG8_SA(1, 0), a3, voffA);
            PG8_BAR; PG8_WAIT_L(0); PG8_MMA(1, 0, At, B0); PG8_BAR; PG8_SCHED;
            PG8_STAGE(PG8_SB(1, 1), b3 + hstepB, voffB);
            PG8_WAIT_V(6); PG8_BAR; PG8_MMA(1, 1, At, B1); PG8_BAR;
        }
        gemm_epilogue<EPI>(kp, tr, l, k, gi, acc, cur, lds);
        if (!has_next) break;
#pragma unroll
        for (int a = 0; a < 2; ++a)
#pragma unroll
            for (int b = 0; b < 2; ++b)
#pragma unroll
                for (int m = 0; m < 4; ++m)
#pragma unroll
                    for (int n = 0; n < 2; ++n) acc[a][b][m][n] = (f32x4){0.f, 0.f, 0.f, 0.f};
        cur = nxt; cA = nA; cB = nB; ++ui;
    }
    PG8_WAIT_V(0);
    if (wr == 0) PG8_BAR;
    PG8_BAR;
#undef PG8_SA
#undef PG8_SB
#undef PG8_STAGE
#undef PG8_LDA
#undef PG8_LDB
#undef PG8_MMA
#undef PG8_WAIT_V
#undef PG8_WAIT_L
#undef PG8_BAR
#undef PG8_SCHED
}

namespace att {
constexpr int NW = 8, QBLK = 32, KVBLK = 64;
constexpr float SCALE = 0.07216878364870322f;
constexpr float THR = 8.f;
constexpr int LDQ = 1536, LDK = 2048, LDKR = 64, LDO = 2048;
constexpr int SHM_V = KVBLK * 128 * 2, SHM_K = KVBLK * 128 * 2, SHM_KR = KVBLK * 64 * 2;
#define KSWZ(row, colB) ((row) * 256 + ((colB) ^ (((row) & 7) << 4)))
#define KRSWZ(row, colB) ((row) * 128 + ((colB) ^ (((row) & 7) << 4)))
#define SBAR() __builtin_amdgcn_sched_barrier(0)
__device__ __forceinline__ int crow(int r, int hi) { return (r & 3) + 8 * (r >> 2) + 4 * hi; }
__device__ __forceinline__ void partialSM(f32x16& p0, f32x16& p1, float& m_reg, float& mn, float& alpha) {
    constexpr float C = SCALE * 1.4426950408889634f;
    float pmax = p0[0];
#pragma unroll
    for (int r = 1; r < 16; ++r) pmax = fmaxf(pmax, p0[r]);
#pragma unroll
    for (int r = 0; r < 16; ++r) pmax = fmaxf(pmax, p1[r]);
    { auto rr = __builtin_amdgcn_permlane32_swap(__float_as_uint(pmax), __float_as_uint(pmax), false, false);
      pmax = fmaxf(__uint_as_float(rr[0]), __uint_as_float(rr[1])); }
    if (__builtin_expect(__all(pmax - m_reg <= THR / SCALE), 1)) { mn = m_reg; alpha = 1.f; }
    else { mn = fmaxf(m_reg, pmax); alpha = __builtin_amdgcn_exp2f((m_reg - mn) * C); m_reg = mn; }
    float mnC = -mn * C;
#pragma unroll
    for (int r = 0; r < 16; ++r) p0[r] = fmaf(p0[r], C, mnC);
#pragma unroll
    for (int r = 0; r < 16; ++r) p1[r] = fmaf(p1[r], C, mnC);
#pragma unroll
    for (int r = 0; r < 16; ++r) p0[r] = __builtin_amdgcn_exp2f(p0[r]);
}
__device__ __forceinline__ void finishSM(f32x16& p0, f32x16& p1, float alpha, float& l_reg, bf16x8& pa0, bf16x8& pa1, bf16x8& pa2, bf16x8& pa3) {
#pragma unroll
    for (int r = 0; r < 16; ++r) p1[r] = __builtin_amdgcn_exp2f(p1[r]);
    float ps = 0;
#pragma unroll
    for (int r = 0; r < 16; ++r) ps += p0[r];
#pragma unroll
    for (int r = 0; r < 16; ++r) ps += p1[r];
    { auto rr = __builtin_amdgcn_permlane32_swap(__float_as_uint(ps), __float_as_uint(ps), false, false);
      ps = __uint_as_float(rr[0]) + __uint_as_float(rr[1]); }
    l_reg = l_reg * alpha + ps;
#define PK4(P, BASE, OUT) do { unsigned a0 = cvtpk(P[BASE + 0], P[BASE + 1]), a1 = cvtpk(P[BASE + 2], P[BASE + 3]);   \
    unsigned b0 = cvtpk(P[BASE + 4], P[BASE + 5]), b1 = cvtpk(P[BASE + 6], P[BASE + 7]);                              \
    auto r0 = __builtin_amdgcn_permlane32_swap(a0, b0, false, false); auto r1 = __builtin_amdgcn_permlane32_swap(a1, b1, false, false); \
    u32x4 w = {r0[0], r1[0], r0[1], r1[1]}; OUT = *reinterpret_cast<bf16x8*>(&w); } while (0)
    PK4(p0, 0, pa0); PK4(p0, 8, pa1); PK4(p1, 0, pa2); PK4(p1, 8, pa3);
#undef PK4
}
__device__ __forceinline__ void qkt(f32x16& p0, f32x16& p1, const char* Ks, const char* Krs, const bf16x8* qr, const char* qrl, int r32, int hi) {
    p0 = f32x16{}; p1 = f32x16{};
#pragma unroll
    for (int d0 = 0; d0 < 8; ++d0) { int cb = (d0 * 16 + hi * 8) * 2;
        bf16x8 b0 = *reinterpret_cast<const bf16x8*>(Ks + KSWZ(r32, cb));
        bf16x8 b1 = *reinterpret_cast<const bf16x8*>(Ks + KSWZ(32 + r32, cb));
        p0 = __builtin_amdgcn_mfma_f32_32x32x16_bf16(b0, qr[d0], p0, 0, 0, 0);
        p1 = __builtin_amdgcn_mfma_f32_32x32x16_bf16(b1, qr[d0], p1, 0, 0, 0); }
#pragma unroll
    for (int d0 = 0; d0 < 4; ++d0) { int cb = (d0 * 16 + hi * 8) * 2;
        bf16x8 b0 = *reinterpret_cast<const bf16x8*>(Krs + KRSWZ(r32, cb));
        bf16x8 b1 = *reinterpret_cast<const bf16x8*>(Krs + KRSWZ(32 + r32, cb));
        const bf16x8 qv = *reinterpret_cast<const bf16x8*>(qrl + d0 * 8192);
        p0 = __builtin_amdgcn_mfma_f32_32x32x16_bf16(b0, qv, p0, 0, 0, 0);
        p1 = __builtin_amdgcn_mfma_f32_32x32x16_bf16(b1, qv, p1, 0, 0, 0); }
}
__device__ __forceinline__ int v_st(int k, int c) { const int kk = (k & ~0xC) | ((k & 4) << 1) | ((k & 8) >> 1); return ((kk >> 3) * 4 + (c >> 5)) * 512 + ((kk & 7) * 32 + (c & 31)) * 2; }
__device__ __forceinline__ int v_rd_base(int lane) { return ((lane & 3) << 3) | (((lane >> 2) & 3) << 6) | (((lane >> 4) & 1) << 5) | (((lane >> 5) & 1) << 8); }
constexpr int v_rd_off(int d0, int ks, int half) { return d0 * 512 + ks * 4096 + half * 2048; }
template <int OFF> __device__ __forceinline__ s16x4 tr_read(int vb) {
    s16x4 r; asm volatile("ds_read_b64_tr_b16 %0, %1 offset:%2" : "=&v"(r) : "v"(vb), "i"(OFF) : "memory"); return r;
}
template <int D0> __device__ __forceinline__ void pv_one(f32x16& od, int vb, bf16x8 pa0, bf16x8 pa1, bf16x8 pa2, bf16x8 pa3) {
    const s16x4 l0 = tr_read<v_rd_off(D0, 0, 0)>(vb), h0 = tr_read<v_rd_off(D0, 0, 1)>(vb), l1 = tr_read<v_rd_off(D0, 1, 0)>(vb), h1 = tr_read<v_rd_off(D0, 1, 1)>(vb);
    const s16x4 l2 = tr_read<v_rd_off(D0, 2, 0)>(vb), h2 = tr_read<v_rd_off(D0, 2, 1)>(vb), l3 = tr_read<v_rd_off(D0, 3, 0)>(vb), h3 = tr_read<v_rd_off(D0, 3, 1)>(vb);
    asm volatile("s_waitcnt lgkmcnt(0)" ::: "memory"); SBAR();
#define PK(L, H) (bf16x8){L[0], L[1], L[2], L[3], H[0], H[1], H[2], H[3]}
    od = __builtin_amdgcn_mfma_f32_32x32x16_bf16(pa0, PK(l0, h0), od, 0, 0, 0);
    od = __builtin_amdgcn_mfma_f32_32x32x16_bf16(pa1, PK(l1, h1), od, 0, 0, 0);
    od = __builtin_amdgcn_mfma_f32_32x32x16_bf16(pa2, PK(l2, h2), od, 0, 0, 0);
    od = __builtin_amdgcn_mfma_f32_32x32x16_bf16(pa3, PK(l3, h3), od, 0, 0, 0);
#undef PK
}
__device__ __forceinline__ void pv_d0(f32x16* o, int vb, bf16x8 pa0, bf16x8 pa1, bf16x8 pa2, bf16x8 pa3) {
    pv_one<0>(o[0], vb, pa0, pa1, pa2, pa3); pv_one<1>(o[1], vb, pa0, pa1, pa2, pa3); pv_one<2>(o[2], vb, pa0, pa1, pa2, pa3); pv_one<3>(o[3], vb, pa0, pa1, pa2, pa3);
}

__device__ __forceinline__ void attn_body(const bf16_t* __restrict__ Qb, const bf16_t* __restrict__ Kh, const bf16_t* __restrict__ Kr,
                                          bf16_t* __restrict__ Ob, int ml_off, int seq, char* lds) {
    const int tid = ltid(), wid = tid >> 6, lane = tid & 63, r32 = lane & 31, hi = lane >> 5;
    char* V_lds = lds; char* K_lds = lds + 2 * SHM_V; char* KR_lds = lds + 2 * SHM_V + 2 * SHM_K;
    float* ws = (float*)(lds + 2 * SHM_V + 2 * SHM_K + 2 * SHM_KR) + wid * 64; float* li_l = ws; float* al_l = ws + 32;
    float m_reg = -1e30f, l_reg = 0; f32x16 o[4] = {}; bf16x8 qr[8];
    const bf16_t* Qw = Qb + (long)(wid * QBLK + r32) * LDQ + hi * 8;
#pragma unroll
    for (int d0 = 0; d0 < 8; ++d0) qr[d0] = *reinterpret_cast<const bf16x8*>(Qw + d0 * 16);
    char* qrl = lds + 84 * 1024 + tid * 16;
#pragma unroll
    for (int d0 = 0; d0 < 4; ++d0) *reinterpret_cast<bf16x8*>(qrl + d0 * 8192) = *reinterpret_cast<const bf16x8*>(Qw + (8 + d0) * 16);
    const int sr = tid >> 4, sc = (tid & 15) * 8, vst0 = v_st(sr, sc), vst1 = v_st(32 + sr, sc);
    const int krr = tid >> 3, krc = (tid & 7) * 8;
    const int vb0 = (int)(uintptr_t)V_lds + v_rd_base(lane);
    bf16x8 s_vs0, s_vs1, s_ks0, s_ks1, s_kr;
#define SLOAD(k0) do { s_vs0 = *reinterpret_cast<const bf16x8*>(&Kh[(long)((k0) + sr) * LDK + sc + 128]); s_vs1 = *reinterpret_cast<const bf16x8*>(&Kh[(long)((k0) + 32 + sr) * LDK + sc + 128]); \
    s_ks0 = *reinterpret_cast<const bf16x8*>(&Kh[(long)((k0) + sr) * LDK + sc]); s_ks1 = *reinterpret_cast<const bf16x8*>(&Kh[(long)((k0) + 32 + sr) * LDK + sc]); \
    s_kr = *reinterpret_cast<const bf16x8*>(&Kr[(long)((k0) + krr) * LDKR + krc]); } while (0)
#define SWRITE(b) do { *(bf16x8*)(V_lds + (b) * SHM_V + vst0) = s_vs0; *(bf16x8*)(V_lds + (b) * SHM_V + vst1) = s_vs1; int kc = sc * 2;   \
    *(bf16x8*)(K_lds + (b) * SHM_K + KSWZ(sr, kc)) = s_ks0; *(bf16x8*)(K_lds + (b) * SHM_K + KSWZ(32 + sr, kc)) = s_ks1;                  \
    *(bf16x8*)(KR_lds + (b) * SHM_KR + KRSWZ(krr, krc * 2)) = s_kr; } while (0)
#define SWAIT() asm volatile("s_waitcnt vmcnt(0)" ::: "memory")
#define RESC(a) do { if (__any((a) < 1.f)) { if (hi == 0) al_l[r32] = (a); asm volatile("s_waitcnt lgkmcnt(0)" ::: "memory"); \
    _Pragma("unroll") for (int d = 0; d < 4; ++d) _Pragma("unroll") for (int r = 0; r < 16; ++r) o[d][r] *= al_l[crow(r, hi)]; } } while (0)
    f32x16 pA0, pA1, pB0, pB1; float mnA, mnB, alA, alB; bf16x8 pa0, pa1, pa2, pa3; const int NT = seq / KVBLK;
    SLOAD(0); SWAIT(); SWRITE(0); __syncthreads();
    qkt(pA0, pA1, K_lds, KR_lds, qr, qrl, r32, hi); partialSM(pA0, pA1, m_reg, mnA, alA);
    SLOAD(KVBLK);
    SWAIT(); SWRITE(1); __syncthreads();
    for (int j = 1; j + 1 < NT; j += 2) {
        SBAR(); qkt(pB0, pB1, K_lds + SHM_K, KR_lds + SHM_KR, qr, qrl, r32, hi);
        finishSM(pA0, pA1, alA, l_reg, pa0, pa1, pa2, pa3); SBAR();
        SLOAD((j + 1) * KVBLK); SBAR();
        pv_d0(o, vb0, pa0, pa1, pa2, pa3); partialSM(pB0, pB1, m_reg, mnB, alB);
        __syncthreads(); SWAIT(); SWRITE(0);
        RESC(alB); __syncthreads();
        SBAR(); qkt(pA0, pA1, K_lds, KR_lds, qr, qrl, r32, hi);
        finishSM(pB0, pB1, alB, l_reg, pa0, pa1, pa2, pa3); SBAR();
        SLOAD((j + 2) * KVBLK); SBAR();
        pv_d0(o, vb0 + (int)SHM_V, pa0, pa1, pa2, pa3); partialSM(pA0, pA1, m_reg, mnA, alA);
        __syncthreads(); SWAIT(); SWRITE(1);
        RESC(alA); __syncthreads();
    }
    SBAR(); qkt(pB0, pB1, K_lds + SHM_K, KR_lds + SHM_KR, qr, qrl, r32, hi);
    finishSM(pA0, pA1, alA, l_reg, pa0, pa1, pa2, pa3); SBAR();
    pv_d0(o, vb0, pa0, pa1, pa2, pa3); partialSM(pB0, pB1, m_reg, mnB, alB);
    __syncthreads(); RESC(alB);
    finishSM(pB0, pB1, alB, l_reg, pa0, pa1, pa2, pa3); SBAR();
    pv_d0(o, vb0 + (int)SHM_V, pa0, pa1, pa2, pa3);
    if (hi == 0) li_l[r32] = l_reg; asm volatile("s_waitcnt lgkmcnt(0)" ::: "memory");
    if (ml_off >= 0 && hi == 0) {
        const Params* kpa = (const Params*)__builtin_amdgcn_kernarg_segment_ptr(); asm volatile("" : "+s"(kpa));
        float* d = (float*)(kpa->ws + OFF_XB + 2048) + ml_off + (wid * QBLK + r32) * 1024; d[0] = m_reg; d[1] = l_reg; }
    float rli[16];
#pragma unroll
    for (int r = 0; r < 16; ++r) rli[r] = __builtin_amdgcn_rcpf(li_l[crow(r, hi)]);
    bf16_t* Ow = Ob + (long)(wid * QBLK) * LDO;
#pragma unroll
    for (int r = 0; r < 16; ++r) { int orow = crow(r, hi);
#pragma unroll
        for (int d0 = 0; d0 < 4; ++d0) Ow[(long)orow * LDO + d0 * 32 + r32] = f2bf(o[d0][r] * rli[r]); }
    __syncthreads();
#undef SLOAD
#undef SWRITE
#undef SWAIT
#undef RESC
}
}

namespace hg {
constexpr int LD = 136, LDT = 72;
constexpr int O_RZ = 0, O_RQ = O_RZ + 64 * LD * 2, O_RV = O_RQ + 64 * LD * 2, O_QD = O_RV + 64 * LD * 2, O_KD = O_QD + 64 * LD * 2,
              O_KDT = O_KD + 64 * LD * 2, O_VT = O_KDT + 128 * LDT * 2, O_P = O_VT + 128 * LDT * 2, O_SEG = O_P + 64 * LDT * 2, O_EV = O_SEG + 4 * 128 * 4, O_END = O_EV + 3 * 128 * 4;
static_assert(O_END <= LDS_BCAST, "hgrn LDS");
__device__ __forceinline__ float clampf(float x, float lo, float hi) { return fminf(fmaxf(x, lo), hi); }

__device__ __forceinline__ void hgrn_unit(LAS unsigned char* lds, bf16_t* hgb  , const float* lb_logits, int layer, int S, int unit) {
    const int tid = ltid(), wid = tid >> 6, lane = tid & 63, l15 = lane & 15, quad = lane >> 4;
    const int dir = unit & 1, h = (unit >> 1) & 7, b = unit >> 4;
    const int qcol = h * 128, zcol = (dir ? 2048 : 1024) + h * 128, vcol = 3072 + h * 128;
    const int ch = tid & 127, seg = tid >> 7;
    LAS bf16_t* RZ = (LAS bf16_t*)(lds + O_RZ); LAS bf16_t* RQ = (LAS bf16_t*)(lds + O_RQ); LAS bf16_t* RV = (LAS bf16_t*)(lds + O_RV);
    LAS bf16_t* QD = (LAS bf16_t*)(lds + O_QD); LAS bf16_t* KD = (LAS bf16_t*)(lds + O_KD); LAS bf16_t* KDT = (LAS bf16_t*)(lds + O_KDT);
    LAS bf16_t* VT = (LAS bf16_t*)(lds + O_VT); LAS bf16_t* PP = (LAS bf16_t*)(lds + O_P);
    LAS float* SEG = (LAS float*)(lds + O_SEG); LAS float* EV = (LAS float*)(lds + O_EV);
    const int n = S / 64;
    const int r0 = tid >> 4, c8 = (tid & 15) * 8;
    bf16x8 pz0, pz1, pq0, pq1, pv0, pv1;
#define HG_ROW(c, tau) ((long)b * S + (dir ? (S - 1 - ((c) * 64 + (tau))) : ((c) * 64 + (tau))))
#define HG_LOAD(c) do { const bf16_t* ra = hgb + HG_ROW(c, r0) * HGW; const bf16_t* rb = hgb + HG_ROW(c, r0 + 32) * HGW; \
    pz0 = *(const bf16x8*)(ra + zcol + c8); pz1 = *(const bf16x8*)(rb + zcol + c8); pq0 = *(const bf16x8*)(ra + qcol + c8); pq1 = *(const bf16x8*)(rb + qcol + c8); \
    pv0 = *(const bf16x8*)(ra + vcol + c8); pv1 = *(const bf16x8*)(rb + vcol + c8); } while (0)
    f32x4 Sst[8];
#pragma unroll
    for (int i = 0; i < 8; ++i) Sst[i] = (f32x4){0.f, 0.f, 0.f, 0.f};
    HG_LOAD(0);
    for (int c = 0; c < n; ++c) {
        *(LAS bf16x8*)(RZ + r0 * LD + c8) = pz0; *(LAS bf16x8*)(RZ + (r0 + 32) * LD + c8) = pz1;
        *(LAS bf16x8*)(RQ + r0 * LD + c8) = pq0; *(LAS bf16x8*)(RQ + (r0 + 32) * LD + c8) = pq1;
        *(LAS bf16x8*)(RV + r0 * LD + c8) = pv0; *(LAS bf16x8*)(RV + (r0 + 32) * LD + c8) = pv1;
        asm volatile("s_waitcnt lgkmcnt(0)" ::: "memory"); __builtin_amdgcn_s_barrier(); asm volatile("" ::: "memory");
        if (c + 1 < n) HG_LOAD(c + 1);
        float bl[16], kk[16]; float run = 0.f;
#pragma unroll
        for (int i = 0; i < 16; ++i) {
            const float lf = bf2f(RZ[(seg * 16 + i) * LD + ch]);
            run += lf; bl[i] = run; kk[i] = 1.f - __expf(lf);
        }
        SEG[seg * 128 + ch] = run;
        asm volatile("s_waitcnt lgkmcnt(0)" ::: "memory"); __builtin_amdgcn_s_barrier(); asm volatile("" ::: "memory");
        const float t0 = SEG[ch], t1 = SEG[128 + ch], t2 = SEG[256 + ch], t3 = SEG[384 + ch];
        const float off = (seg > 0 ? t0 : 0.f) + (seg > 1 ? t1 : 0.f) + (seg > 2 ? t2 : 0.f);
        const float bref = t0 + t1, btot = (t0 + t1) + (t2 + t3);
        unsigned kdt[8], vtt[8];
#pragma unroll
        for (int i = 0; i < 16; ++i) {
            const int tau = seg * 16 + i;
            const float bb = bl[i] + off;
            const float eq = __expf(clampf(bb - bref, -80.f, 80.f)), ek = __builtin_amdgcn_rcpf(eq);
            const float sq = bf2f(RQ[tau * LD + ch]);
            QD[tau * LD + ch] = f2bf(sq * eq);
            const bf16_t kb = f2bf(kk[i] * ek);
            KD[tau * LD + ch] = kb;
            const bf16_t vb = RV[tau * LD + ch];
            if (i & 1) { kdt[i >> 1] |= ((unsigned)kb) << 16; vtt[i >> 1] |= ((unsigned)vb) << 16; } else { kdt[i >> 1] = kb; vtt[i >> 1] = vb; }
        }
        *(LAS u32x4*)(KDT + ch * LDT + seg * 16) = (u32x4){kdt[0], kdt[1], kdt[2], kdt[3]}; *(LAS u32x4*)(KDT + ch * LDT + seg * 16 + 8) = (u32x4){kdt[4], kdt[5], kdt[6], kdt[7]};
        *(LAS u32x4*)(VT + ch * LDT + seg * 16) = (u32x4){vtt[0], vtt[1], vtt[2], vtt[3]}; *(LAS u32x4*)(VT + ch * LDT + seg * 16 + 8) = (u32x4){vtt[4], vtt[5], vtt[6], vtt[7]};
        if (seg == 0) { EV[ch] = __expf(clampf(bref, -80.f, 80.f)); EV[128 + ch] = __expf(clampf(btot, -80.f, 80.f)); EV[256 + ch] = __expf(clampf(btot - bref, -80.f, 80.f)); }
        asm volatile("s_waitcnt lgkmcnt(0)" ::: "memory"); __builtin_amdgcn_s_barrier(); asm volatile("" ::: "memory");
#pragma unroll
        for (int tt = 0; tt < 2; ++tt) {
            const int ti = wid * 2 + tt, sblk = ti >> 2, tblk = ti & 3;
            f32x4 a = (f32x4){0.f, 0.f, 0.f, 0.f};
            if (sblk <= tblk) {
#pragma unroll
                for (int ks = 0; ks < 4; ++ks) {
                    const bf16x8 af = *(LAS bf16x8*)(KD + (sblk * 16 + l15) * LD + ks * 32 + quad * 8);
                    const bf16x8 bfr = *(LAS bf16x8*)(QD + (tblk * 16 + l15) * LD + ks * 32 + quad * 8);
                    a = __builtin_amdgcn_mfma_f32_16x16x32_bf16(af, bfr, a, 0, 0, 0);
                }
            }
            const int t = tblk * 16 + l15, s0 = sblk * 16 + quad * 4;
            u32x2 w; w.x = cvtpk(s0 + 0 <= t ? a[0] : 0.f, s0 + 1 <= t ? a[1] : 0.f); w.y = cvtpk(s0 + 2 <= t ? a[2] : 0.f, s0 + 3 <= t ? a[3] : 0.f);
            *(LAS u32x2*)(PP + t * LDT + s0) = w;
        }
        asm volatile("s_waitcnt lgkmcnt(0)" ::: "memory"); __builtin_amdgcn_s_barrier(); asm volatile("" ::: "memory");
        const int dv0 = wid * 16;
        bf16x8 bv[2];
#pragma unroll
        for (int ks = 0; ks < 2; ++ks) bv[ks] = *(LAS bf16x8*)(VT + (dv0 + l15) * LDT + ks * 32 + quad * 8);
        f32x4 o[4];
#pragma unroll
        for (int i = 0; i < 4; ++i) o[i] = (f32x4){0.f, 0.f, 0.f, 0.f};
#pragma unroll
        for (int k4 = 0; k4 < 4; ++k4) {
            const f32x4 er0 = *(LAS f32x4*)(EV + 32 * k4 + 4 * quad), er1 = *(LAS f32x4*)(EV + 32 * k4 + 16 + 4 * quad);
            const f32x4 s0 = Sst[2 * k4] * er0, s1 = Sst[2 * k4 + 1] * er1;
            u32x4 bw; bw.x = cvtpk(s0[0], s0[1]); bw.y = cvtpk(s0[2], s0[3]); bw.z = cvtpk(s1[0], s1[1]); bw.w = cvtpk(s1[2], s1[3]);
            const bf16x8 bfr = *reinterpret_cast<bf16x8*>(&bw);
#pragma unroll
            for (int tb = 0; tb < 4; ++tb) {
                const u32x2 a0 = *(LAS u32x2*)(QD + (tb * 16 + l15) * LD + 32 * k4 + 4 * quad);
                const u32x2 a1 = *(LAS u32x2*)(QD + (tb * 16 + l15) * LD + 32 * k4 + 16 + 4 * quad);
                u32x4 aw; aw.x = a0.x; aw.y = a0.y; aw.z = a1.x; aw.w = a1.y;
                o[tb] = __builtin_amdgcn_mfma_f32_16x16x32_bf16(*reinterpret_cast<bf16x8*>(&aw), bfr, o[tb], 0, 0, 0);
            }
        }
#pragma unroll
        for (int ks = 0; ks < 2; ++ks)
#pragma unroll
            for (int tb = 0; tb < 4; ++tb) {
                const bf16x8 af = *(LAS bf16x8*)(PP + (tb * 16 + l15) * LDT + ks * 32 + quad * 8);
                o[tb] = __builtin_amdgcn_mfma_f32_16x16x32_bf16(af, bv[ks], o[tb], 0, 0, 0);
            }
#pragma unroll
        for (int tb = 0; tb < 4; ++tb)
#pragma unroll
            for (int j = 0; j < 4; ++j) hgb[HG_ROW(c, tb * 16 + quad * 4 + j) * HGW + zcol + dv0 + l15] = f2bf(o[tb][j]);
#pragma unroll
        for (int db = 0; db < 8; ++db) {
            f32x4 tmp = (f32x4){0.f, 0.f, 0.f, 0.f};
#pragma unroll
            for (int ks = 0; ks < 2; ++ks) {
                const bf16x8 af = *(LAS bf16x8*)(KDT + (db * 16 + l15) * LDT + ks * 32 + quad * 8);
                tmp = __builtin_amdgcn_mfma_f32_16x16x32_bf16(af, bv[ks], tmp, 0, 0, 0);
            }
            const f32x4 et = *(LAS f32x4*)(EV + 128 + db * 16 + quad * 4), etr = *(LAS f32x4*)(EV + 256 + db * 16 + quad * 4);
            Sst[db] = Sst[db] * et + tmp * etr;
        }
    }
    wg_barrier();
#undef HG_ROW
#undef HG_LOAD
}
}

__device__ __forceinline__ int rope_perm(int p) { const int i = 16 * (p >> 5) + 4 * ((p >> 3) & 3) + (p & 3); return (p & 4) ? 32 + i : i; }
struct WDesc { const float* src; const float* gain; bf16_t* dst; int K, N, R, map; };

__device__ __forceinline__ void wcvt_phase(LAS unsigned char* lds, const Params& p, int layer) {
    LAS float* tile = (LAS float*)lds;
    const int tid = ltid();
    char* ws = p.ws;
    if (lbid() == 0) {
        float* lbt = (float*)(ws + OFF_LB);
        for (int i = tid; i < 2048; i += 512) {
            float mx = -3e38f; for (int l = 0; l < DEPTH; ++l) mx = fmaxf(mx, p.lb_logits[l * 2048 + i]);
            float den = 0.f, num = 0.f; for (int l = 0; l < DEPTH; ++l) { const float e = __expf(p.lb_logits[l * 2048 + i] - mx); den += e; if (l >= 1 && l <= layer) num += e; }
            lbt[i] = num / den;
        }
    }
    for (int mi = 0; mi < 10; ++mi) {
        WDesc d;
        switch (mi) {
        case 0: d = {p.w_in + (size_t)layer * 2048 * 5952, p.mix_norm + layer * 2048, (bf16_t*)(ws + OFF_W_IN), 2048, 5952, INP, 1}; break;
        case 1: d = {p.w_uq + (size_t)layer * 512 * 1536, p.q_norm + layer * 512, (bf16_t*)(ws + OFF_W_UQ), 512, 1536, 1536, 2}; break;
        case 2: d = {p.w_ukv + (size_t)layer * 256 * 2048, p.kv_norm + layer * 256, (bf16_t*)(ws + OFF_W_UKV), 256, 2048, 2048, 0}; break;
        case 3: d = {p.w_out + (size_t)layer * 2048 * 2048, nullptr, (bf16_t*)(ws + OFF_W_OUT), 2048, 2048, 2048, 0}; break;
        case 4: d = {p.w_xq + (size_t)layer * 2048 * 2048, p.xattn_norm + layer * 2048, (bf16_t*)(ws + OFF_W_XQ), 2048, 2048, 2048, 0}; break;
        case 5: d = {p.w_xk + (size_t)layer * 2048 * 2048, p.mem_norm + layer * 2048, (bf16_t*)(ws + OFF_W_XK), 2048, 2048, 2048, 0}; break;
        case 6: d = {p.w_xv + (size_t)layer * 2048 * 2048, p.mem_norm + layer * 2048, (bf16_t*)(ws + OFF_W_XV), 2048, 2048, 2048, 0}; break;
        case 7: d = {p.w_xo + (size_t)layer * 2048 * 2048, nullptr, (bf16_t*)(ws + OFF_W_XO), 2048, 2048, 2048, 0}; break;
        case 8: d = {p.w_ffn1 + (size_t)layer * 2048 * 8192, p.ffn_norm + layer * 2048, (bf16_t*)(ws + OFF_W_F1), 2048, 8192, 8192, 0}; break;
        default: d = {p.w_ffn2 + (size_t)layer * 8192 * 2048, nullptr, (bf16_t*)(ws + OFF_W_F2), 8192, 2048, 2048, 0}; break;
        }
        const int nkt = d.K / 64, nrt = d.R / 256, ntile = nkt * nrt;
        for (int t = lbid(); t < ntile; t += gridDim.x) {
            const int kt = t % nkt, rt = t / nkt, k0 = kt * 64, r0 = rt * 256;
            {
                const int c4 = tid & 63, rr = tid >> 6; const int col = r0 + 4 * c4;
                int sc = col; bool zero = false;
                if (d.map == 1) { if (col < 768) sc = col; else if (col < 832) sc = 768 + rope_perm(col - 768); else if (col < 1024) zero = true; else sc = col - 192; }
                else if (d.map == 2) { const int hh = col / 192, oo = col - hh * 192; if (oo >= 128) sc = hh * 192 + 128 + rope_perm(oo - 128); }
#pragma unroll
                for (int ii = 0; ii < 8; ++ii) { const int i = rr + ii * 8;
                    f32x4 v = zero ? (f32x4){0.f, 0.f, 0.f, 0.f} : *(const f32x4*)(d.src + (size_t)(k0 + i) * d.N + sc);
                    if (d.gain) v = v * d.gain[k0 + i];
                    *(LAS f32x4*)(tile + i * 260 + 4 * c4) = v; }
            }
            wg_barrier();
            {
                const int n = tid >> 1, kh = (tid & 1) * 32;
#pragma unroll
                for (int j = 0; j < 4; ++j) {
                    unsigned w[4];
#pragma unroll
                    for (int e = 0; e < 8; e += 2) w[e >> 1] = cvtpk(tile[(kh + j * 8 + e) * 260 + n], tile[(kh + j * 8 + e + 1) * 260 + n]);
                    *(u32x4*)(d.dst + (size_t)(r0 + n) * d.K + k0 + kh + j * 8) = (u32x4){w[0], w[1], w[2], w[3]};
                }
            }
            wg_barrier();
        }
    }
}

__device__ __forceinline__ void prep_phase(const Params& p, int tr, int T, int S) {
    const size_t xb_off = tr ? OFF_XB : OFF_XB0;
    const int tid = ltid(), wid = tid >> 6, lane = tid & 63;
    char* ws = p.ws;
    const long gtid = (long)lbid() * 512 + tid, gstride = (long)gridDim.x * 512;
    { ssq_t* ssq = (ssq_t*)(ws + OFF_SSQ) + (size_t)tr * 11 * TMAX; for (long i = gtid; i < (long)10 * TMAX; i += gstride) ssq[TMAX + i] = 0ull;
      if (gtid < 64) ((unsigned*)(ws + OFF_CTR))[gtid] = 0u; }
    { float* rc = (float*)(ws + OFF_ROPE); float* rs = rc + 16384 * 32;
      for (int i = (int)gtid; i < S * 32; i += (int)gstride) { const int pos = i >> 5, f = i & 31;
          const float inv_freq = exp2f(-(float)f * (13.287712379549449f / 32.f));
          const float ang = (float)pos * inv_freq;
          const double rev = (double)ang * 0.15915494309189535; const float fr = (float)(rev - rint(rev));
          rc[i] = __builtin_amdgcn_cosf(fr); rs[i] = __builtin_amdgcn_sinf(fr); } }
    { const float* x = p.x_in[tr]; bf16_t* xb = (bf16_t*)(ws + xb_off); ssq_t* ssq0 = (ssq_t*)(ws + OFF_SSQ) + (size_t)tr * 11 * TMAX;
      for (int row = lbid() * 8 + wid; row < T; row += gridDim.x * 8) {
          float ss = 0.f;
#pragma unroll
          for (int i = 0; i < 8; ++i) { const int c = i * 256 + lane * 4; const f32x4 v = *(const f32x4*)(x + (size_t)row * DM + c);
              ss += (v[0] * v[0] + v[1] * v[1]) + (v[2] * v[2] + v[3] * v[3]);
              u32x2 w; w.x = cvtpk(v[0], v[1]); w.y = cvtpk(v[2], v[3]); *(u32x2*)(xb + (size_t)row * DM + c) = w; }
#pragma unroll
          for (int o = 32; o > 0; o >>= 1) ss += __shfl_xor(ss, o);
          if (lane == 0) ssq0[row] = ssq_fix(ss);
      } }
    { const float* mem = p.mem_in[tr]; bf16_t* mn = (bf16_t*)(ws + OFF_MEMN) + (size_t)tr * 512 * 2048;
      for (int row = lbid() * 8 + wid; row < 512; row += gridDim.x * 8) {
          f32x4 v[8]; float ss = 0.f;
#pragma unroll
          for (int i = 0; i < 8; ++i) { v[i] = *(const f32x4*)(mem + (size_t)row * DM + i * 256 + lane * 4); ss += (v[i][0] * v[i][0] + v[i][1] * v[i][1]) + (v[i][2] * v[i][2] + v[i][3] * v[i][3]); }
#pragma unroll
          for (int o = 32; o > 0; o >>= 1) ss += __shfl_xor(ss, o);
          const float rs = __builtin_amdgcn_rsqf(ss * (1.f / DM) + EPS);
#pragma unroll
          for (int i = 0; i < 8; ++i) { u32x2 w; w.x = cvtpk(v[i][0] * rs, v[i][1] * rs); w.y = cvtpk(v[i][2] * rs, v[i][3] * rs); *(u32x2*)(mn + (size_t)row * DM + i * 256 + lane * 4) = w; }
      } }
}

__device__ __forceinline__ void rope_phase(const Params& p, int T, int S) {
    char* ws = p.ws;
    bf16_t* q = (bf16_t*)(ws + OFF_Q); const bf16_t* kr = (const bf16_t*)(ws + OFF_KR); bf16_t* kro = (bf16_t*)(ws + OFF_KROPE);
    const float* rc = (const float*)(ws + OFF_ROPE); const float* rs = rc + 16384 * 32;
    const int total = T * 9 * 4;
    for (int i = lbid() * 512 + ltid(); i < total; i += gridDim.x * 512) {
        const int f8 = (i & 3) * 8; const int ru = i >> 2; const int row_i = ru / 9; const int u = ru - row_i * 9; const long row = row_i; const int pos = row_i & (S - 1);
        const f32x8 c = *(const f32x8*)(rc + pos * 32 + f8), s = *(const f32x8*)(rs + pos * 32 + f8);
        const bf16_t* src = (u < 8) ? (q + row * 1536 + u * 192 + 128 + f8) : (kr + row * 64 + f8);
        bf16_t* dst = (u < 8) ? (q + row * 1536 + u * 192 + 128 + f8) : (kro + row * 64 + f8);
        const bf16x8 a1 = *(const bf16x8*)src, a2 = *(const bf16x8*)(src + 32);
        unsigned w1[4], w2[4];
#pragma unroll
        for (int j = 0; j < 8; j += 2) {
            const float x1a = bf2f((bf16_t)a1[j]), x2a = bf2f((bf16_t)a2[j]), x1b = bf2f((bf16_t)a1[j + 1]), x2b = bf2f((bf16_t)a2[j + 1]);
            w1[j >> 1] = cvtpk(x1a * c[j] - x2a * s[j], x1b * c[j + 1] - x2b * s[j + 1]);
            w2[j >> 1] = cvtpk(x2a * c[j] + x1a * s[j], x2b * c[j + 1] + x1b * s[j + 1]);
        }
        *(u32x4*)dst = (u32x4){w1[0], w1[1], w1[2], w1[3]}; *(u32x4*)(dst + 32) = (u32x4){w2[0], w2[1], w2[2], w2[3]};
    }
}

__device__ __forceinline__ void hcomb_phase(const Params& p, int layer, int T, int nblk, int bid, int nsplit) {
    char* ws = p.ws; const bf16_t* hgb = (const bf16_t*)(ws + OFF_HG); bf16_t* mix = (bf16_t*)(ws + OFF_MIX);
    const float* on = p.out_norm + layer * 128;
    const int l16 = ltid() & 15;
    const int total = T * 8 * 16;
    for (int i = bid * 512 + ltid(); i < total; i += nblk * 512) {
        const int rh = i >> 4; const int h = rh & 7; const long row = rh >> 3;
        const bf16_t* base = hgb + row * HGW + h * 128 + l16 * 8;
        const bf16x8 vf = *(const bf16x8*)(base + 1024), vb = *(const bf16x8*)(base + 2048), vg = *(const bf16x8*)(base + 4096);
        float o[8]; float ss = 0.f;
#pragma unroll
        for (int j = 0; j < 8; ++j) { o[j] = bf2f((bf16_t)vf[j]) + bf2f((bf16_t)vb[j]); ss += o[j] * o[j]; }
        ss += __shfl_xor(ss, 1); ss += __shfl_xor(ss, 2); ss += __shfl_xor(ss, 4); ss += __shfl_xor(ss, 8);
        const float rs = __builtin_amdgcn_rsqf(ss * (1.f / 128.f) + EPS);
        unsigned w[4];
#pragma unroll
        for (int j = 0; j < 8; j += 2) {
            const float g0 = bf2f((bf16_t)vg[j]), g1 = bf2f((bf16_t)vg[j + 1]);
            const float y0 = o[j] * rs * on[l16 * 8 + j] * (g0 / (1.f + __expf(-g0))), y1 = o[j + 1] * rs * on[l16 * 8 + j + 1] * (g1 / (1.f + __expf(-g1)));
            w[j >> 1] = cvtpk(y0, y1);
        }
        *(u32x4*)(mix + row * 2048 + 1024 + h * 128 + l16 * 8) = (u32x4){w[0], w[1], w[2], w[3]};
        if (nsplit == 2) {
            const f32x4 mlv = *(const f32x4*)((const float*)(ws + OFF_XB + 2048) + row * 1024 + h * 4);
            const float C = att::SCALE * 1.4426950408889634f;
            const float M = fmaxf(mlv[0], mlv[2]);
            const float w1 = mlv[1] * __builtin_amdgcn_exp2f((mlv[0] - M) * C), w2 = mlv[3] * __builtin_amdgcn_exp2f((mlv[2] - M) * C);
            const float inv = 1.f / (w1 + w2), c1 = w1 * inv, c2 = w2 * inv;
            bf16_t* pa = mix + row * 2048 + h * 128 + l16 * 8; const bf16_t* pb = (const bf16_t*)(ws + OFF_XB) + row * 2048 + h * 128 + l16 * 8;
            const bf16x8 va = *(const bf16x8*)pa, vb2 = *(const bf16x8*)pb;
            unsigned wo[4];
#pragma unroll
            for (int j = 0; j < 8; j += 2) wo[j >> 1] = cvtpk(c1 * bf2f((bf16_t)va[j]) + c2 * bf2f((bf16_t)vb2[j]), c1 * bf2f((bf16_t)va[j + 1]) + c2 * bf2f((bf16_t)vb2[j + 1]));
            *(u32x4*)pa = (u32x4){wo[0], wo[1], wo[2], wo[3]};
        }
    }
}

__device__ __forceinline__ void final_phase(const Params& p, float* xout, int T, int tr) {
    const int wid = ltid() >> 6, lane = ltid() & 63;
    const ssq_t* ssq = (const ssq_t*)(p.ws + OFF_SSQ) + (size_t)(tr * 11 + 10) * TMAX;
    for (int row = lbid() * 8 + wid; row < T; row += gridDim.x * 8) {
        const float rs = __builtin_amdgcn_rsqf(ssq_val(ssq[row]) * (1.f / DM) + EPS);
#pragma unroll
        for (int i = 0; i < 8; ++i) { const int c = i * 256 + lane * 4; f32x4 v = *(f32x4*)(xout + (size_t)row * DM + c); const f32x4 g = *(const f32x4*)(p.final_norm + c);
            v = v * rs * g; *(f32x4*)(xout + (size_t)row * DM + c) = v; }
    }
}

__device__ __forceinline__ void mixer_phase(LAS unsigned char* lds, const Params& p, int layer, int T, int S, int tr) {
    char* ws = p.ws;
    unsigned* ctr = (unsigned*)(ws + OFF_CTR) + (tr * 2 + layer) * 16;
    LAS unsigned* slot = (LAS unsigned*)(lds + LDS_BCAST);
    const int nsplit = (S >= 16384) ? 2 : 1;
    const int nH = 2 * 8 * 2, nQB = S / 256, nA = 2 * 8 * nQB * nsplit;
    for (;;) {
        if (ltid() == 0) *slot = __hip_atomic_fetch_add(ctr, 1u, __ATOMIC_RELAXED, __HIP_MEMORY_SCOPE_AGENT);
        wg_barrier();
        const int idx = (int)__builtin_amdgcn_readfirstlane(*slot);
        wg_barrier();
        if (idx >= nH + nA) break;
        const Params* kq = launder_p((const Params*)__builtin_amdgcn_kernarg_segment_ptr());
        char* wsu = kq->ws;
        bf16_t* hgb = (bf16_t*)(wsu + OFF_HG);
        const bf16_t* q = (const bf16_t*)(wsu + OFF_Q); const bf16_t* kv = (const bf16_t*)(wsu + OFF_KV); const bf16_t* kro = (const bf16_t*)(wsu + OFF_KROPE);
        bf16_t* mix = (bf16_t*)(wsu + OFF_MIX); bf16_t* o2 = (bf16_t*)(wsu + OFF_XB);
#ifndef MK_NO_HG
        if (idx < nH) hg::hgrn_unit(lds, hgb, kq->lb_logits, layer, S, idx);
        else
#endif
        {
#ifndef MK_NO_ATT
            const int a = idx - nH, qb = a % nQB, a1 = a / nQB, half = a1 % nsplit, a2 = a1 / nsplit, h = a2 & 7, b = a2 >> 3;
            const int sseq = S / nsplit;
            const long row0 = (long)b * S + (long)qb * 256, krow0 = (long)b * S + (long)half * sseq;
            bf16_t* ob = (half == 0 ? mix : o2) + row0 * 2048 + h * 128;
            const int ml = (nsplit == 2) ? (int)(row0 * 1024 + h * 4 + half * 2) : -1;
            att::attn_body(q + row0 * 1536 + h * 192, kv + krow0 * 2048 + h * 256, kro + krow0 * 64, ob, ml, sseq, (char*)(unsigned char*)lds);
#endif
        }
    }
}

#define XB_TMO      128
#define XB_XCNT(j)  (256  + 64 * (j))
#define XB_XSUB(j)  (1280 + 64 * (j))
#define XB_XGEN(j)  (2304 + 64 * (j))
#define XB_TOP      3328
#define XB_TOPGEN   3392
#define XCD_BAR_WORDS 3456
#define XB_SPIN_CAP (1u << 22)
__device__ __forceinline__ unsigned xb_ld(unsigned* p)              { return __hip_atomic_load(p, __ATOMIC_RELAXED, __HIP_MEMORY_SCOPE_AGENT); }
__device__ __forceinline__ unsigned xb_add(unsigned* p, unsigned v) { return __hip_atomic_fetch_add(p, v, __ATOMIC_RELAXED, __HIP_MEMORY_SCOPE_AGENT); }
__device__ __forceinline__ unsigned xb_xcc_id() { return (unsigned)__builtin_amdgcn_s_getreg((3 << 11) | 20) & 0xFu; }
#define XB_SPIN(cond, bar) do { unsigned _sp = 0; while (cond) { __builtin_amdgcn_s_sleep(1); \
    if ((++_sp & 255u) == 0u) { if (xb_ld(&(bar)[XB_TMO])) break; if (_sp > XB_SPIN_CAP) { atomicAdd(&(bar)[XB_TMO], 1u); break; } } } } while (0)
struct XcdBarrier { unsigned* bar; unsigned x; volatile LAS unsigned* st; };
__device__ __forceinline__ XcdBarrier xcd_barrier_post(unsigned* bar, volatile LAS unsigned* st) {
    XcdBarrier b; b.bar = bar; b.x = xb_xcc_id(); b.st = st;
    if (threadIdx.x == 0) (void)xb_add(&bar[XB_XCNT(b.x)], 1u);
    return b;
}
__device__ __forceinline__ void xcd_barrier_complete(unsigned* bar, unsigned x, unsigned& nloc, unsigned& nx) {
    const unsigned G = gridDim.x * gridDim.y * gridDim.z;
    unsigned sum, cnt, mine, sp = 0u;
    for (;;) {
        sum = 0u; cnt = 0u; mine = 0u;
#pragma unroll
        for (unsigned j = 0; j < 16; ++j) { const unsigned c = xb_ld(&bar[XB_XCNT(j)]); sum += c; cnt += (c > 0u) ? 1u : 0u; mine = (j == x) ? c : mine; }
        if (sum == G) break;
        __builtin_amdgcn_s_sleep(1);
        if ((++sp & 255u) == 0u) { if (xb_ld(&bar[XB_TMO])) break; if (sp > XB_SPIN_CAP) { atomicAdd(&bar[XB_TMO], 1u); break; } }
    }
    nloc = mine > 0u ? mine : 1u; nx = cnt > 0u ? cnt : 1u;
}
__device__ __forceinline__ void xcd_barrier_(const XcdBarrier& b) {
    asm volatile("s_waitcnt vmcnt(0)" ::: "memory");
    __syncthreads();
    if (threadIdx.x == 0) {
        unsigned* bar = b.bar;
        __builtin_amdgcn_s_waitcnt(0);
        unsigned nloc = b.st[0], nx = b.st[1];
        if (nloc == 0u) { xcd_barrier_complete(bar, b.x, nloc, nx); b.st[0] = nloc; b.st[1] = nx; }
        const unsigned old = xb_add(&bar[XB_XSUB(b.x)], 1u);
        const unsigned gen = old / nloc;
        if (old + 1u == (gen + 1u) * nloc) {
            __builtin_amdgcn_fence(__ATOMIC_RELEASE, "agent");
            asm volatile("s_waitcnt vmcnt(0)" ::: "memory");
            const unsigned og = xb_add(&bar[XB_TOP], 1u);
            const unsigned tg = og / nx;
            if (og + 1u == (tg + 1u) * nx) xb_add(&bar[XB_TOPGEN], 1u);
            else XB_SPIN(xb_ld(&bar[XB_TOPGEN]) == tg, bar);
            __builtin_amdgcn_fence(__ATOMIC_ACQUIRE, "agent");
            xb_add(&bar[XB_XGEN(b.x)], 1u);
            asm volatile("s_waitcnt vmcnt(0)" ::: "memory");
        } else {
            XB_SPIN(xb_ld(&bar[XB_XGEN(b.x)]) == gen, bar);
            __builtin_amdgcn_fence(__ATOMIC_ACQUIRE, "agent");
            asm volatile("s_waitcnt vmcnt(0)" ::: "memory");
        }
    }
    __syncthreads();
}

__device__ __forceinline__ void xcd_barrier(LAS unsigned char* lds) {
    const Params* kp = launder_p((const Params*)__builtin_amdgcn_kernarg_segment_ptr());
    XcdBarrier b; b.bar = (unsigned*)(kp->ws + OFF_BAR); b.x = xb_xcc_id(); b.st = (volatile LAS unsigned*)(lds + LDS_BCAST + 64);
    xcd_barrier_(b);
}
constexpr int N_PHASES = 48;

__device__ __forceinline__ GemmDesc mkgemm(const void* A, int lda, const void* B, int ldb, int K, int nM, int nN) {
    GemmDesc g{}; g.A = (const char*)A; g.B = (const char*)B; g.lda = lda; g.ldb = ldb; g.K = K; g.nM = nM; g.nN = nN; g.nZ = 1; g.perm = 1; g.epi = E_BF16; return g;
}

__device__ __forceinline__ bool make_gemm(const Params& p, int tr, int l, int k, int i, GemmDesc& g) {
    const int T = tr ? 32768 : 8192, S = tr ? 16384 : 4096, nMT = T / 256;
    char* ws = p.ws;
    float* xout = p.out + (tr ? (size_t)8192 * DM : 0);
    ssq_t* ssq = (ssq_t*)(ws + OFF_SSQ) + (size_t)tr * 11 * TMAX;
    ssq_t* ssq_x0 = ssq + (size_t)(l * 5 + 0) * TMAX; ssq_t* ssq_q = ssq + (size_t)(l * 5 + 1) * TMAX; ssq_t* ssq_kv = ssq + (size_t)(l * 5 + 2) * TMAX;
    ssq_t* ssq_x1 = ssq + (size_t)(l * 5 + 3) * TMAX; ssq_t* ssq_x2 = ssq + (size_t)(l * 5 + 4) * TMAX; ssq_t* ssq_nx = ssq + (size_t)((l + 1) * 5) * TMAX;
    bf16_t* xb = (bf16_t*)(ws + (tr ? OFF_XB : OFF_XB0));
    const char* memn = ws + OFF_MEMN + (size_t)tr * 512 * 2048 * 2;
    if (k == 1) {
        if (i > 0) return false;
        g = mkgemm(xb, DM, ws + OFF_W_IN, DM, DM, nMT, INP / 256); g.epi = E_INPROJ; g.ssq_in = ssq_x0; g.inv_dim = 1.f / DM;
        g.out = (bf16_t*)(ws + OFF_CQ); g.out2 = (bf16_t*)(ws + OFF_KROPE); g.out3 = (bf16_t*)(ws + OFF_HG); g.ssq_out = ssq_q; g.ssq_out2 = ssq_kv; g.relu2 = S; return true;
    } else if (k == 2) {
        if (i == 0) { g = mkgemm(ws + OFF_CQ, 768, ws + OFF_W_UQ, 512, 512, nMT, 6); g.out = (bf16_t*)(ws + OFF_Q); g.ldo = 1536; g.ssq_in = ssq_q; g.inv_dim = 1.f / 512.f; g.epi = E_QROPE; g.relu2 = S; return true; }
        if (i == 1) { g = mkgemm(ws + OFF_CQ + 512 * 2, 768, ws + OFF_W_UKV, 256, 256, nMT, 8); g.out = (bf16_t*)(ws + OFF_KV); g.ldo = 2048; g.ssq_in = ssq_kv; g.inv_dim = 1.f / 256.f; return true; }
        return false;
    } else if (k == 6) {
        if (i > 0) return false;
        g = mkgemm(ws + OFF_MIX, DM, ws + OFF_W_OUT, DM, DM, nMT, 8); g.epi = E_RESID;
        g.resid = (l == 0) ? p.x_in[tr] : xout; g.xout = xout; g.xb = xb; g.ssq_out = ssq_x1; return true;
    } else if (k == 7) {
        if (i == 0) { g = mkgemm(xb, DM, ws + OFF_W_XQ, DM, DM, nMT, 8); g.out = (bf16_t*)(ws + OFF_XQ); g.ldo = DM; g.ssq_in = ssq_x1; g.inv_dim = 1.f / DM; return true; }
        return false;
    } else if (k == 5) {
        if (i == 0) { g = mkgemm(memn, DM, ws + OFF_W_XK, DM, DM, 2, 8); g.out = (bf16_t*)(ws + OFF_KMEM); g.ldo = DM; return true; }
        if (i == 1) { g = mkgemm(ws + OFF_W_XV, DM, memn, DM, DM, 8, 1); g.nZ = 2; g.bzs = 256 * DM * 2; g.out = (bf16_t*)(ws + OFF_VT); g.ldo = 256; g.ozs = (long)2048 * 256; return true; }
        return false;
    } else if (k == 8) {
        if (i > 0) return false;
        g = mkgemm(ws + OFF_XQ, DM, ws + OFF_KMEM, DM, 512, nMT, 1); g.nZ = 4; g.azs = 512 * 2; g.bzs = 512 * 2; g.bbs = 256 * DM * 2; g.tpb = S / 256;
        g.epi = E_SOFTMAX; g.out = (bf16_t*)(ws + OFF_PBUF); g.ldo = 1024; return true;
    } else if (k == 9) {
        if (i > 0) return false;
        g = mkgemm(ws + OFF_PBUF, 1024, ws + OFF_VT, 256, 256, nMT, 2); g.nZ = 4; g.azs = 256 * 2; g.bzs = 512 * 256 * 2; g.bbs = 2048 * 256 * 2; g.tpb = S / 256;
        g.out = (bf16_t*)(ws + OFF_OBUF); g.ldo = DM; g.ozs = 512; return true;
    } else if (k == 10) {
        if (i > 0) return false;
        g = mkgemm(ws + OFF_OBUF, DM, ws + OFF_W_XO, DM, DM, nMT, 8); g.epi = E_RESID;
        g.resid = xout; g.xout = xout; g.xb = xb; g.ssq_out = ssq_x2; return true;
    } else if (k == 11) {
        if (i > 0) return false;
        g = mkgemm(xb, DM, ws + OFF_W_F1, DM, DM, nMT, 32); g.out = (bf16_t*)(ws + OFF_U); g.ldo = 8192; g.ssq_in = ssq_x2; g.inv_dim = 1.f / DM; g.relu2 = 1; return true;
    } else if (k == 12) {
        if (i > 0) return false;
        g = mkgemm(ws + OFF_U, 8192, ws + OFF_W_F2, 8192, 8192, nMT, 8); g.epi = E_RESID;
        g.resid = xout; g.xout = xout; g.xb = xb; g.ssq_out = ssq_nx; return true;
    }
    return false;
}

__device__ __forceinline__ void run_phase(const Params* kp, int ph, LAS unsigned char* lds) {
    const Params& p = *kp;
    if (ph == 0) { prep_phase(p, 0, 8192, 4096); prep_phase(p, 1, 32768, 16384); return; }
    if (ph == N_PHASES - 1) { final_phase(p, p.out, 8192, 0); final_phase(p, p.out + (size_t)8192 * DM, 32768, 1); return; }
    const int l = (ph - 1) / 23, r = (ph - 1) % 23;
    if (r == 0) { wcvt_phase(lds, p, l); return; }
    const int tr = (r - 1) / 11, kk = (r - 1) % 11; const int k = kk < 2 ? kk + 1 : kk + 2;
    const int T = tr ? 32768 : 8192, S = tr ? 16384 : 4096;
    if (k == 4) { mixer_phase(lds, p, l, T, S, tr); return; }
    if (k == 5) {
        const int c = lbid(), G = gridDim.x;
        if (G >= 64) {
            if (c < 16) gemm_phase<E_BF16>(lds, kp, tr, l, 5, 0, 16, c);
            else if (c < 32) gemm_phase<E_BF16>(lds, kp, tr, l, 5, 1, 16, c - 16);
            else hcomb_phase(p, l, T, G - 32, c - 32, S >= 16384 ? 2 : 1);
        } else { gemm_phase<E_BF16>(lds, kp, tr, l, 5, 0, G, c); gemm_phase<E_BF16>(lds, kp, tr, l, 5, 1, G, c); hcomb_phase(p, l, T, G, c, S >= 16384 ? 2 : 1); }
        return; }
#ifndef MK_NO_GEMM
    { const int c = lbid(), G = gridDim.x;
    if (k == 1) gemm_phase<E_INPROJ>(lds, kp, tr, l, k, 0, G, c);
    else if (k == 6 || k == 10 || k == 12) gemm_phase<E_RESID>(lds, kp, tr, l, k, 0, G, c);
    else if (k == 8) gemm_phase<E_SOFTMAX>(lds, kp, tr, l, k, 0, G, c);
    else if (k == 2) { gemm_phase<E_QROPE>(lds, kp, tr, l, k, 0, G, c); gemm_phase<E_BF16>(lds, kp, tr, l, k, 1, G, c); }
    else for (int i = 0; i < 2; ++i) gemm_phase<E_BF16>(lds, kp, tr, l, k, i, G, c); }
#endif
}

__global__ void __launch_bounds__(512, 2) mk_forward(Params p, int ph_lo, int ph_hi) {
    extern __shared__ __attribute__((aligned(16))) unsigned char shm[];
    LAS unsigned char* lds = (LAS unsigned char*)shm;
    cg::grid_group grid = cg::this_grid();
    volatile LAS unsigned* xst = (volatile LAS unsigned*)(lds + LDS_BCAST + 64);
    if (threadIdx.x == 0) { xst[0] = 0u; xst[1] = 0u; }
    __syncthreads();
    { const Params* kp0 = launder_p((const Params*)__builtin_amdgcn_kernarg_segment_ptr()); (void)xcd_barrier_post((unsigned*)(kp0->ws + OFF_BAR), xst); }
    for (int ph = ph_lo; ph < ph_hi; ++ph) {
        const Params* kp = launder_p((const Params*)__builtin_amdgcn_kernarg_segment_ptr());
#ifdef MK_TIME_KIND
        if (blockIdx.x == 0 && threadIdx.x == 0) ((unsigned long long*)(kp->ws + OFF_TS))[ph] = __builtin_amdgcn_s_memrealtime();
#endif
        run_phase(kp, ph, lds);
        if (ph + 1 < ph_hi) { if (ph_hi > N_PHASES) grid.sync(); else xcd_barrier(lds); }
    }
#ifdef MK_TIME_KIND
    xcd_barrier(lds);
    if (blockIdx.x == 0) {
        const Params* kp = launder_p((const Params*)__builtin_amdgcn_kernarg_segment_ptr());
        unsigned long long* ts = (unsigned long long*)(kp->ws + OFF_TS); float* outp = kp->out;
        if (threadIdx.x == 0) ts[ph_hi] = __builtin_amdgcn_s_memrealtime();
        __syncthreads();
        unsigned tot = 0;
        for (int ph = ph_lo; ph < ph_hi; ++ph) { const int r_ = (ph - 1) % 23; const int kk_ = (r_ - 1) % 11; const int kind = (ph == 0) ? 100 : (ph == N_PHASES - 1 ? 101 : (r_ == 0 ? 0 : (kk_ < 2 ? kk_ + 1 : kk_ + 2)));
            if (kind == MK_TIME_KIND || MK_TIME_KIND == 200) tot += (unsigned)(ts[ph + 1] - ts[ph]); }
        const int n = (int)(tot / 100u);
        for (int i = threadIdx.x; i < n; i += 512) outp[i] += 0.25f;
        for (int i = threadIdx.x; i < 4 * n; i += 512) outp[(size_t)8192 * DM + i] += 0.25f;
    }
#endif

}

extern "C" void kernel_launch(void* const* d_in, const int* in_sizes, int n_in, void* d_out, int out_size, void* d_ws, size_t ws_size, hipStream_t stream) {
    static int inited = 0; static int grid_blocks = 0;
    if (!inited) {
        hipFuncSetAttribute((const void*)mk_forward, hipFuncAttributeMaxDynamicSharedMemorySize, LDS_BYTES);
        int dev = 0, cus = 0, per_cu = 0;
        hipGetDevice(&dev); hipDeviceGetAttribute(&cus, hipDeviceAttributeMultiprocessorCount, dev);
        hipOccupancyMaxActiveBlocksPerMultiprocessor(&per_cu, mk_forward, 512, LDS_BYTES);
        if (per_cu < 1) per_cu = 1;
        grid_blocks = cus * 1;
        if (ws_size < WS_END) fprintf(stderr, "kernel_launch: workspace too small: %zu < %zu\n", ws_size, (size_t)WS_END);
        inited = 1;
    }
    Params p{};
    const float* const* in = (const float* const*)d_in;
    p.x_in[0] = in[0]; p.x_in[1] = in[1]; p.mem_in[0] = in[2]; p.mem_in[1] = in[3];
    p.mix_norm = in[4]; p.w_in = in[5]; p.q_norm = in[6]; p.w_uq = in[7]; p.kv_norm = in[8]; p.w_ukv = in[9]; p.lb_logits = in[10]; p.out_norm = in[11]; p.w_out = in[12];
    p.xattn_norm = in[13]; p.mem_norm = in[14]; p.w_xq = in[15]; p.w_xk = in[16]; p.w_xv = in[17]; p.w_xo = in[18]; p.ffn_norm = in[19]; p.w_ffn1 = in[20]; p.w_ffn2 = in[21]; p.final_norm = in[22];
    p.out = (float*)d_out; p.ws = (char*)d_ws;
#if MK_ONE_LAUNCH
    hipMemsetAsync((char*)d_ws + OFF_BAR, 0, 16384, stream);
    int lo = 0, hi = N_PHASES;
    void* args[] = {&p, &lo, &hi};
    hipError_t e = hipLaunchCooperativeKernel((const void*)mk_forward, dim3(grid_blocks), dim3(512), args, LDS_BYTES, stream);
    if (e != hipSuccess) fprintf(stderr, "cooperative launch failed: %s\n", hipGetErrorString(e));
#else
    for (int ph = 0; ph < N_PHASES; ++ph) hipLaunchKernelGGL(mk_forward, dim3(grid_blocks), dim3(512), LDS_BYTES, stream, p, ph, ph + 1);
#endif
}
```

```cpp
#include <hip/hip_runtime.h>
#include <hip/hip_cooperative_groups.h>
#include <cstdio>
namespace cg = cooperative_groups;

#define LAS __attribute__((address_space(3)))
typedef unsigned short bf16_t;
typedef short bf16x8 __attribute__((ext_vector_type(8)));
typedef short s16x4 __attribute__((ext_vector_type(4)));
typedef float f32x4 __attribute__((ext_vector_type(4)));
typedef float f32x8 __attribute__((ext_vector_type(8)));
typedef float f32x16 __attribute__((ext_vector_type(16)));
typedef unsigned u32x4 __attribute__((ext_vector_type(4)));
typedef unsigned u32x2 __attribute__((ext_vector_type(2)));

#ifndef MK_QF
#define MK_QF 52
#endif
#ifndef MK_ONE_LAUNCH
#define MK_ONE_LAUNCH 1
#endif

constexpr int DM = 2048, NMEM = 256, DEPTH = 2;
constexpr int INP = 6144;
constexpr int HGW = 5120;
constexpr int TMAX = 32768;
constexpr float EPS = 1e-6f;
constexpr int LDS_BYTES = 144 * 1024;
constexpr int LDS_BCAST = 140 * 1024;
constexpr int LDS_EPI = 128 * 1024;

constexpr size_t al256(size_t x) { return (x + 255) / 256 * 256; }
constexpr size_t E_W_IN = (size_t)INP * 2048, E_W_UQ = 1536 * 512, E_W_UKV = 2048 * 256, E_W_SQ = 2048 * 2048, E_W_F = (size_t)8192 * 2048;
constexpr size_t OFF_W_IN = 0;
constexpr size_t OFF_W_UQ = OFF_W_IN + E_W_IN * 2;
constexpr size_t OFF_W_UKV = OFF_W_UQ + E_W_UQ * 2;
constexpr size_t OFF_W_OUT = OFF_W_UKV + E_W_UKV * 2;
constexpr size_t OFF_W_XQ = OFF_W_OUT + E_W_SQ * 2;
constexpr size_t OFF_W_XK = OFF_W_XQ + E_W_SQ * 2;
constexpr size_t OFF_W_XV = OFF_W_XK + E_W_SQ * 2;
constexpr size_t OFF_W_XO = OFF_W_XV + E_W_SQ * 2;
constexpr size_t OFF_W_F1 = OFF_W_XO + E_W_SQ * 2;
constexpr size_t OFF_W_F2 = OFF_W_F1 + E_W_F * 2;
constexpr size_t OFF_XB = OFF_W_F2 + E_W_F * 2;
constexpr size_t OFF_KR = OFF_XB + (size_t)TMAX * 2048 * 2;
constexpr size_t OFF_KROPE = OFF_KR + (size_t)TMAX * 64 * 2;
constexpr size_t OFF_MIX = OFF_KROPE + (size_t)TMAX * 64 * 2;
constexpr size_t OFF_HG = OFF_MIX + (size_t)TMAX * 2048 * 2;
constexpr size_t OFF_Q = OFF_HG + (size_t)TMAX * HGW * 2;
constexpr size_t OFF_KV = OFF_Q + (size_t)TMAX * 1536 * 2;
constexpr size_t OFF_MEMN = OFF_KV + (size_t)TMAX * 2048 * 2;
constexpr size_t OFF_KMEM = OFF_MEMN + (size_t)2 * 512 * 2048 * 2;
constexpr size_t OFF_VT = OFF_KMEM + (size_t)512 * 2048 * 2;
constexpr size_t OFF_ROPE = OFF_VT + (size_t)512 * 2048 * 2;
constexpr size_t OFF_SSQ = OFF_ROPE + (size_t)16384 * 32 * 4 * 2;
constexpr size_t OFF_CTR = OFF_SSQ + (size_t)22 * TMAX * 8;
constexpr size_t OFF_BAR = OFF_CTR + 256;
constexpr size_t OFF_LB = OFF_BAR + 16384;
constexpr size_t OFF_TS = OFF_LB + 8192;
constexpr size_t OFF_XB0 = OFF_TS + 1024;
constexpr size_t WS_END = OFF_XB0 + (size_t)8192 * 2048 * 2;
constexpr size_t OFF_CQ = OFF_MIX;
constexpr size_t OFF_XQ = OFF_Q;
constexpr size_t OFF_PBUF = OFF_MIX;
constexpr size_t OFF_OBUF = OFF_HG;
constexpr size_t OFF_U = OFF_HG;
static_assert((size_t)TMAX * 8192 * 2 <= OFF_MEMN - OFF_HG, "u must fit");

struct Params {
    const float* x_in[2]; const float* mem_in[2];
    const float *mix_norm, *w_in, *q_norm, *w_uq, *kv_norm, *w_ukv, *lb_logits, *out_norm, *w_out, *xattn_norm, *mem_norm, *w_xq, *w_xk, *w_xv, *w_xo,
        *ffn_norm, *w_ffn1, *w_ffn2, *final_norm;
    float* out; char* ws;
};

__device__ __forceinline__ int ltid() { int t = threadIdx.x; asm volatile("" : "+v"(t)); return t; }
__device__ __forceinline__ int lbid() { int t = blockIdx.x; asm volatile("" : "+s"(t)); return t; }
__device__ __forceinline__ float bf2f(bf16_t b) { return __uint_as_float(((unsigned)b) << 16); }
__device__ __forceinline__ bf16_t f2bf(float f) { unsigned u = __float_as_uint(f); u += 0x7FFFu + ((u >> 16) & 1u); return (bf16_t)(u >> 16); }
__device__ __forceinline__ unsigned cvtpk(float lo, float hi) { unsigned r; asm volatile("v_cvt_pk_bf16_f32 %0, %1, %2" : "=v"(r) : "v"(lo), "v"(hi)); return r; }
__device__ __forceinline__ void wg_barrier() { asm volatile("s_waitcnt vmcnt(0) lgkmcnt(0)" ::: "memory"); __builtin_amdgcn_s_barrier(); asm volatile("" ::: "memory"); }
typedef unsigned long long ssq_t;
__device__ __forceinline__ ssq_t ssq_fix(float v) { return (ssq_t)(v * 16777216.f + 0.5f); }
__device__ __forceinline__ float ssq_val(ssq_t v) { return (float)v * (1.f / 16777216.f); }
__device__ __forceinline__ void atomic_addf(ssq_t* p, float v) { __hip_atomic_fetch_add(p, ssq_fix(v), __ATOMIC_RELAXED, __HIP_MEMORY_SCOPE_AGENT); }

namespace pg8 {
constexpr int BM = 256, BK = 64, HALF = 128, HTB = HALF * BK * 2, NXCD = 8, WGM = 8;
__host__ __device__ __forceinline__ int lds_byte(int r, int c) { const int st = (r >> 4) * 2 + (c >> 5), rr = r & 15, cc = c & 31, ob = rr * 64 + cc * 2; return st * 1024 + (ob ^ (((ob >> 9) & 1) << 5)); }
__host__ __device__ __forceinline__ void stage_rc(int b, int& R, int& C) { const int st = b / 1024, sb = b % 1024, swz = sb ^ (((sb >> 9) & 1) << 5); R = (st >> 1) * 16 + swz / 64; C = (st & 1) * 32 + (swz % 64) / 2; }
__host__ __device__ __forceinline__ int perm32(int rho) { const int n = rho >> 4, i = rho & 15; return 8 * (i >> 2) + 4 * n + (i & 3); }
}
enum { E_BF16 = 0, E_INPROJ = 1, E_RESID = 2, E_SOFTMAX = 3 };
struct GemmDesc {
    const char* A; const char* B; int lda, ldb, K, nM, nN, nZ;
    int azs, bzs, bbs, tpb;
    int epi, perm;
    bf16_t* out; long ozs; int ldo;
    const ssq_t* ssq_in; float inv_dim; int relu2;
    ssq_t* ssq_out; ssq_t* ssq_out2;
    const float* resid; float* xout; bf16_t* xb;
    bf16_t* out2; bf16_t* out3;
};
struct Unit { int pm, pn, z; const char* a; const char* b; };

__device__ __forceinline__ bool make_gemm(const Params& p, int tr, int l, int k, int i, GemmDesc& g);
__device__ __forceinline__ const Params* launder_p(const Params* q) { asm volatile("" : "+s"(q)); return q; }
__device__ __forceinline__ int launder_i(int v) { asm volatile("" : "+s"(v)); return v; }
__device__ __forceinline__ bool next_unit(const Params* kp, int tr, int l, int k, int gi, int i, int G, int c, Unit& u) {
    GemmDesc g; make_gemm(*launder_p(kp), launder_i(tr), launder_i(l), launder_i(k), launder_i(gi), g);
    const int L = i * G + c; const int per = g.nM * g.nN;
    if (L >= per * g.nZ) return false;
    const int z = L / per; int wgid = L - z * per;
    { const int q = per / pg8::NXCD, r = per % pg8::NXCD, xcd = wgid % pg8::NXCD, off = wgid / pg8::NXCD; wgid = (xcd < r ? xcd * (q + 1) : r * (q + 1) + (xcd - r) * q) + off; }
    const int nig = pg8::WGM * g.nN, gid = wgid / nig, fm = gid * pg8::WGM, gsz = (g.nM - fm) < pg8::WGM ? (g.nM - fm) : pg8::WGM;
    u.pm = fm + ((wgid % nig) % gsz); u.pn = (wgid % nig) / gsz; u.z = z;
    const unsigned ao = (unsigned)z * (unsigned)g.azs + (unsigned)u.pm * (unsigned)(512 * g.lda);
    const unsigned bo = (unsigned)z * (unsigned)g.bzs + (unsigned)u.pn * (unsigned)(512 * g.ldb) + (g.tpb ? (unsigned)(u.pm / g.tpb) * (unsigned)g.bbs : 0u);
    u.a = g.A + (size_t)ao; u.b = g.B + (size_t)bo;
    return true;
}

template <int EPI> __device__ __forceinline__ void gemm_epilogue(const Params* kp, int tr, int l, int k, int gi, f32x4 (&acc)[2][2][4][2], const Unit& u, LAS unsigned char* lds) {
    const int tid_e = ltid(), wid_e = tid_e >> 6, lane_e = tid_e & 63, wr = wid_e >> 2, wc = wid_e & 3, fr = lane_e & 15, fq = lane_e >> 4;
    GemmDesc g; make_gemm(*launder_p(kp), launder_i(tr), launder_i(l), launder_i(k), launder_i(gi), g);
    const int row0 = u.pm * 256 + wr * 64 + fr;
    if constexpr (EPI == E_BF16) {
        const int col0 = u.pn * 256 + wc * 32 + 8 * fq;
        float rsv[2][4];
#pragma unroll
        for (int ai = 0; ai < 2; ++ai)
#pragma unroll
            for (int m = 0; m < 4; ++m) rsv[ai][m] = g.ssq_in ? __builtin_amdgcn_rsqf(ssq_val(g.ssq_in[row0 + ai * 128 + m * 16]) * g.inv_dim + EPS) : 1.0f;
#pragma unroll
        for (int ai = 0; ai < 2; ++ai)
#pragma unroll
            for (int m = 0; m < 4; ++m) {
                const int row = row0 + ai * 128 + m * 16;
                const float rs = rsv[ai][m];
                bf16_t* rowp = g.out + (long)u.z * g.ozs + (long)row * g.ldo + col0;
#pragma unroll
                for (int bj = 0; bj < 2; ++bj) {
                    f32x4 v0 = acc[ai][bj][m][0] * rs, v1 = acc[ai][bj][m][1] * rs;
                    if (g.relu2) {
#pragma unroll
                        for (int j = 0; j < 4; ++j) { float a = fmaxf(v0[j], 0.f), b = fmaxf(v1[j], 0.f); v0[j] = a * a; v1[j] = b * b; }
                    }
                    u32x4 w; w.x = cvtpk(v0[0], v0[1]); w.y = cvtpk(v0[2], v0[3]); w.z = cvtpk(v1[0], v1[1]); w.w = cvtpk(v1[2], v1[3]);
                    *(u32x4*)(rowp + bj * 128) = w;
                }
            }
    } else if constexpr (EPI == E_INPROJ) {
        const int lc0 = wc * 32 + 8 * fq;
        const int pn = u.pn;
        const int hseg = (pn >= 4) ? ((pn - 4) >> 2) : 9;
        f32x4 lbv[2][2];
        if (hseg == 1 || hseg == 2) {
            const float* lbt = (const float*)(kp->ws + OFF_LB) + (hseg - 1) * 1024 + ((pn - 4) & 3) * 256 + lc0;
#pragma unroll
            for (int bj = 0; bj < 2; ++bj) { lbv[bj][0] = *(const f32x4*)(lbt + bj * 128); lbv[bj][1] = *(const f32x4*)(lbt + bj * 128 + 4); }
        } else {
#pragma unroll
            for (int bj = 0; bj < 2; ++bj) { lbv[bj][0] = (f32x4){0.f, 0.f, 0.f, 0.f}; lbv[bj][1] = lbv[bj][0]; }
        }
        float rsv[2][4];
#pragma unroll
        for (int ai = 0; ai < 2; ++ai)
#pragma unroll
            for (int m = 0; m < 4; ++m) rsv[ai][m] = __builtin_amdgcn_rsqf(ssq_val(g.ssq_in[row0 + ai * 128 + m * 16]) * g.inv_dim + EPS);
#pragma unroll
        for (int ai = 0; ai < 2; ++ai)
#pragma unroll
            for (int m = 0; m < 4; ++m) {
                const int row = row0 + ai * 128 + m * 16;
                const float rs = rsv[ai][m];
                float ss = 0.f;
#pragma unroll
                for (int bj = 0; bj < 2; ++bj) {
                    f32x4 v0 = acc[ai][bj][m][0] * rs, v1 = acc[ai][bj][m][1] * rs;
                    if (hseg == 0) {
#pragma unroll
                        for (int j = 0; j < 4; ++j) { v0[j] = v0[j] * __builtin_amdgcn_rcpf(1.f + __expf(-v0[j])) * 0.08838834764831845f; v1[j] = v1[j] * __builtin_amdgcn_rcpf(1.f + __expf(-v1[j])) * 0.08838834764831845f; }
                    } else if (hseg == 1 || hseg == 2) {
#pragma unroll
                        for (int j = 0; j < 4; ++j) {
                            const float l0 = lbv[bj][0][j], l1 = lbv[bj][1][j];
                            v0[j] = __logf(l0 + (1.f - l0) * __builtin_amdgcn_rcpf(1.f + __expf(-fmaxf(v0[j], -80.f))));
                            v1[j] = __logf(l1 + (1.f - l1) * __builtin_amdgcn_rcpf(1.f + __expf(-fmaxf(v1[j], -80.f))));
                        }
                    }
                    u32x4 w; w.x = cvtpk(v0[0], v0[1]); w.y = cvtpk(v0[2], v0[3]); w.z = cvtpk(v1[0], v1[1]); w.w = cvtpk(v1[2], v1[3]);
                    const int lc = lc0 + bj * 128;
                    if (pn < 3) {
                        *(u32x4*)(g.out + (long)row * 768 + pn * 256 + lc) = w;
                        ss += (v0[0] * v0[0] + v0[1] * v0[1]) + (v0[2] * v0[2] + v0[3] * v0[3]) + (v1[0] * v1[0] + v1[1] * v1[1]) + (v1[2] * v1[2] + v1[3] * v1[3]);
                    } else if (pn == 3) {
                        if (lc < 64) *(u32x4*)(g.out2 + (long)row * 64 + lc) = w;
                    } else {
                        *(u32x4*)(g.out3 + (long)row * HGW + (pn - 4) * 256 + lc) = w;
                    }
                }
                if (pn < 3) {
                    ss += __shfl_xor(ss, 16); ss += __shfl_xor(ss, 32);
                    if (fq == 0) atomic_addf((pn < 2 ? g.ssq_out : g.ssq_out2) + row, ss);
                }
            }
    } else if constexpr (EPI == E_RESID) {
        const int col0 = u.pn * 256 + wc * 32 + 8 * fq;
#pragma unroll
        for (int ai = 0; ai < 2; ++ai) {
            f32x4 rv[4][2][2];
#pragma unroll
            for (int m = 0; m < 4; ++m)
#pragma unroll
                for (int bj = 0; bj < 2; ++bj)
#pragma unroll
                    for (int n = 0; n < 2; ++n) rv[m][bj][n] = *(const f32x4*)(g.resid + (long)(row0 + ai * 128 + m * 16) * DM + col0 + bj * 128 + n * 4);
#pragma unroll
            for (int m = 0; m < 4; ++m) {
                const int row = row0 + ai * 128 + m * 16;
                float ss = 0.f;
#pragma unroll
                for (int bj = 0; bj < 2; ++bj) {
                    const long o = (long)row * DM + col0 + bj * 128;
                    const f32x4 v0 = rv[m][bj][0] + acc[ai][bj][m][0], v1 = rv[m][bj][1] + acc[ai][bj][m][1];
                    *(f32x4*)(g.xout + o) = v0; *(f32x4*)(g.xout + o + 4) = v1;
                    u32x4 w; w.x = cvtpk(v0[0], v0[1]); w.y = cvtpk(v0[2], v0[3]); w.z = cvtpk(v1[0], v1[1]); w.w = cvtpk(v1[2], v1[3]);
                    *(u32x4*)(g.xb + o) = w;
                    ss += (v0[0] * v0[0] + v0[1] * v0[1]) + (v0[2] * v0[2] + v0[3] * v0[3]) + (v1[0] * v1[0] + v1[1] * v1[1]) + (v1[2] * v1[2] + v1[3] * v1[3]);
                }
                ss += __shfl_xor(ss, 16); ss += __shfl_xor(ss, 32);
                if (fq == 0) atomic_addf(g.ssq_out + row, ss);
            }
        }
    } else {
        LAS float* smax = (LAS float*)(lds + LDS_EPI);
        LAS float* ssum = (LAS float*)(lds + LDS_EPI + 4096);
        const float C = 0.044194173824159216f * 1.4426950408889634f;
#pragma unroll
        for (int ai = 0; ai < 2; ++ai)
#pragma unroll
            for (int m = 0; m < 4; ++m) {
                __builtin_amdgcn_sched_barrier(0);
                float t = -3.0e38f;
#pragma unroll
                for (int bj = 0; bj < 2; ++bj)
#pragma unroll
                    for (int n = 0; n < 2; ++n)
#pragma unroll
                        for (int j = 0; j < 4; ++j) t = fmaxf(t, acc[ai][bj][m][n][j]);
                t = fmaxf(t, __shfl_xor(t, 16)); t = fmaxf(t, __shfl_xor(t, 32));
                if (fq == 0) smax[(ai * 128 + wr * 64 + m * 16 + fr) * 4 + wc] = t;
            }
        asm volatile("s_waitcnt lgkmcnt(0)" ::: "memory"); __builtin_amdgcn_s_barrier(); asm volatile("" ::: "memory");
#pragma unroll
        for (int ai = 0; ai < 2; ++ai)
#pragma unroll
            for (int m = 0; m < 4; ++m) {
                __builtin_amdgcn_sched_barrier(0);
                const int rl = ai * 128 + wr * 64 + m * 16 + fr;
                const f32x4 q = *(LAS f32x4*)(smax + rl * 4);
                const float mm = fmaxf(fmaxf(q[0], q[1]), fmaxf(q[2], q[3])) * C;
                float s = 0.f;
#pragma unroll
                for (int bj = 0; bj < 2; ++bj)
#pragma unroll
                    for (int n = 0; n < 2; ++n)
#pragma unroll
                        for (int j = 0; j < 4; ++j) { const float e = __builtin_amdgcn_exp2f(acc[ai][bj][m][n][j] * C - mm); acc[ai][bj][m][n][j] = e; s += e; }
                s += __shfl_xor(s, 16); s += __shfl_xor(s, 32);
                if (fq == 0) ssum[rl * 4 + wc] = s;
            }
        asm volatile("s_waitcnt lgkmcnt(0)" ::: "memory"); __builtin_amdgcn_s_barrier(); asm volatile("" ::: "memory");
        const int col0 = wc * 32 + 8 * fq;
#pragma unroll
        for (int ai = 0; ai < 2; ++ai)
#pragma unroll
            for (int m = 0; m < 4; ++m) {
                __builtin_amdgcn_sched_barrier(0);
                const int rl = ai * 128 + wr * 64 + m * 16 + fr;
                const f32x4 q = *(LAS f32x4*)(ssum + rl * 4);
                const float inv = 1.0f / ((q[0] + q[1]) + (q[2] + q[3]));
                bf16_t* rowp = g.out + (long)(u.pm * 256 + rl) * g.ldo + u.z * 256 + col0;
#pragma unroll
                for (int bj = 0; bj < 2; ++bj) {
                    const f32x4 v0 = acc[ai][bj][m][0] * inv, v1 = acc[ai][bj][m][1] * inv;
                    u32x4 w; w.x = cvtpk(v0[0], v0[1]); w.y = cvtpk(v0[2], v0[3]); w.z = cvtpk(v1[0], v1[1]); w.w = cvtpk(v1[2], v1[3]);
                    *(u32x4*)(rowp + bj * 128) = w;
                }
            }
    }
}

template <int EPI> __device__ __forceinline__ void gemm_phase(LAS unsigned char* lds, const Params* kp, int tr, int l, int k, int gi, int G, int cblk) {
    using namespace pg8;
    int Kdim, lda_, ldb_, perm_;
    { GemmDesc g0; if (!make_gemm(*kp, tr, l, k, gi, g0)) return; Kdim = g0.K; lda_ = g0.lda; ldb_ = g0.ldb; perm_ = g0.perm; }
    const int tid = ltid(), wid = __builtin_amdgcn_readfirstlane(tid >> 6), lane = tid & 63, wr = wid >> 2, wc = wid & 3, fr = lane & 15, fq = lane >> 4;
    const int K = Kdim, nt = K / BK;
    unsigned voffA[2], voffB[2];
#pragma unroll
    for (int i = 0; i < 2; ++i) { int R, C; stage_rc(tid * 16 + i * 8192, R, C); const int Rb = perm_ ? ((R & ~31) + perm32(R & 31)) : R;
        voffA[i] = (unsigned)(R * lda_ + C) * 2u; voffB[i] = (unsigned)(Rb * ldb_ + C) * 2u; }
    const size_t kstep = (size_t)(BK * 2);
    const size_t hstepA = (size_t)HALF * lda_ * 2, hstepB = (size_t)HALF * ldb_ * 2;
    const unsigned ldsw = (unsigned)wid * 1024u;
    const int aoff = lds_byte(wr * 64 + fr, fq * 8), boff = lds_byte(wc * 32 + fr, fq * 8);
#define PG8_SA(b, h) (((b) * 2 + (h)) * HTB)
#define PG8_SB(b, h) ((4 + (b) * 2 + (h)) * HTB)
#define PG8_STAGE(bufoff, gbase, voff) do { _Pragma("unroll") for (int _i = 0; _i < 2; ++_i) \
        __builtin_amdgcn_global_load_lds((const unsigned*)((const char*)(gbase) + (voff)[_i]), (LAS unsigned*)(lds + (bufoff) + ldsw + _i * 8192), 16, 0, 0); } while (0)
#define PG8_LDA(dst, b, h) do { _Pragma("unroll") for (int m = 0; m < 4; ++m) _Pragma("unroll") for (int k = 0; k < 2; ++k) dst[m][k] = *(const LAS bf16x8*)(lds + PG8_SA(b, h) + aoff + m * 2048 + k * 1024); } while (0)
#define PG8_LDB(dst, b, h) do { _Pragma("unroll") for (int n = 0; n < 2; ++n) _Pragma("unroll") for (int k = 0; k < 2; ++k) dst[n][k] = *(const LAS bf16x8*)(lds + PG8_SB(b, h) + boff + n * 2048 + k * 1024); } while (0)
#define PG8_MMA(ai, bj, At, Bt) do { __builtin_amdgcn_s_setprio(1); _Pragma("unroll") for (int m = 0; m < 4; ++m) _Pragma("unroll") for (int n = 0; n < 2; ++n) _Pragma("unroll") for (int k = 0; k < 2; ++k) \
        acc[ai][bj][m][n] = __builtin_amdgcn_mfma_f32_16x16x32_bf16(Bt[n][k], At[m][k], acc[ai][bj][m][n], 0, 0, 0); __builtin_amdgcn_s_setprio(0); } while (0)
#define PG8_WAIT_V(n) asm volatile("s_waitcnt vmcnt(" #n ")" ::: "memory")
#define PG8_WAIT_L(n) asm volatile("s_waitcnt lgkmcnt(" #n ")" ::: "memory")
#define PG8_BAR __builtin_amdgcn_s_barrier()
#define PG8_SCHED __builtin_amdgcn_sched_barrier(0)
    Unit cur, nxt; int ui = 0;
    if (!next_unit(kp, tr, l, k, gi, 0, G, cblk, cur)) return;
    f32x4 acc[2][2][4][2];
#pragma unroll
    for (int a = 0; a < 2; ++a)
#pragma unroll
        for (int b = 0; b < 2; ++b)
#pragma unroll
            for (int m = 0; m < 4; ++m)
#pragma unroll
                for (int n = 0; n < 2; ++n) acc[a][b][m][n] = (f32x4){0.f, 0.f, 0.f, 0.f};
    bf16x8 At[4][2], B0[2][2], B1[2][2];
    const char* cA = cur.a; const char* cB = cur.b;
    PG8_STAGE(PG8_SB(0, 0), cB, voffB); PG8_STAGE(PG8_SA(0, 0), cA, voffA); PG8_STAGE(PG8_SB(0, 1), cB + hstepB, voffB); PG8_STAGE(PG8_SA(0, 1), cA + hstepA, voffA);
    if (wr == 1) PG8_BAR;
    PG8_WAIT_V(4); PG8_BAR;
    PG8_STAGE(PG8_SB(1, 0), cB + kstep, voffB); PG8_STAGE(PG8_SA(1, 0), cA + kstep, voffA); PG8_STAGE(PG8_SB(1, 1), cB + hstepB + kstep, voffB);
    PG8_WAIT_V(6); PG8_BAR;
    for (;;) {
        const bool has_next = next_unit(kp, tr, l, k, gi, ui + 1, G, cblk, nxt);
        const char* nA = has_next ? nxt.a : cA; const char* nB = has_next ? nxt.b : cB;
        for (int t = 0; t < nt; t += 2) {
            const bool last = (t == nt - 2);
            const char* a1 = cA + (size_t)(t + 1) * kstep;
            const char* a2 = last ? nA : cA + (size_t)(t + 2) * kstep; const char* b2 = last ? nB : cB + (size_t)(t + 2) * kstep;
            const char* a3 = a2 + kstep; const char* b3 = b2 + kstep;
            PG8_LDB(B0, 0, 0); PG8_SCHED; PG8_LDA(At, 0, 0); PG8_STAGE(PG8_SA(1, 1), a1 + hstepA, voffA);
            PG8_WAIT_L(8); PG8_BAR; PG8_WAIT_L(0); PG8_MMA(0, 0, At, B0); PG8_BAR; PG8_SCHED;
            PG8_LDB(B1, 0, 1); PG8_STAGE(PG8_SB(0, 0), b2, voffB);
            PG8_BAR; PG8_WAIT_L(0); PG8_MMA(0, 1, At, B1); PG8_BAR;
            PG8_LDA(At, 0, 1); PG8_STAGE(PG8_SA(0, 0), a2, voffA);
            PG8_BAR; PG8_WAIT_L(0); PG8_MMA(1, 0, At, B0); PG8_BAR; PG8_SCHED;
            PG8_STAGE(PG8_SB(0, 1), b2 + hstepB, voffB);
            PG8_WAIT_V(6); PG8_BAR; PG8_MMA(1, 1, At, B1); PG8_BAR;
            PG8_LDB(B0, 1, 0); PG8_SCHED; PG8_LDA(At, 1, 0); PG8_STAGE(PG8_SA(0, 1), a2 + hstepA, voffA);
            PG8_WAIT_L(8); PG8_BAR; PG8_WAIT_L(0); PG8_MMA(0, 0, At, B0); PG8_BAR; PG8_SCHED;
            PG8_LDB(B1, 1, 1); PG8_STAGE(PG8_SB(1, 0), b3, voffB);
            PG8_BAR; PG8_WAIT_L(0); PG8_MMA(0, 1, At, B1); PG8_BAR;
            PG8_LDA(At, 1, 1); PG8_STAGE(PG8_SA(1, 0), a3, voffA);
            PG8_BAR; PG8_WAIT_L(0); PG8_MMA(1, 0, At, B0); PG8_BAR; PG8_SCHED;
            PG8_STAGE(PG8_SB(1, 1), b3 + hstepB, voffB);
            PG8_WAIT_V(6); PG8_BAR; PG8_MMA(1, 1, At, B1); PG8_BAR;
        }
        gemm_epilogue<EPI>(kp, tr, l, k, gi, acc, cur, lds);
        if (!has_next) break;
#pragma unroll
        for (int a = 0; a < 2; ++a)
#pragma unroll
            for (int b = 0; b < 2; ++b)
#pragma unroll
                for (int m = 0; m < 4; ++m)
#pragma unroll
                    for (int n = 0; n < 2; ++n) acc[a][b][m][n] = (f32x4){0.f, 0.f, 0.f, 0.f};
        cur = nxt; cA = nA; cB = nB; ++ui;
    }
    PG8_WAIT_V(0);
    if (wr == 0) PG8_BAR;
    PG8_BAR;
#undef PG8_SA
#undef PG8_SB
#undef PG8_STAGE
#undef PG8_LDA
#undef PG8_LDB
#undef PG8_MMA
#undef PG8_WAIT_V
#undef PG8_WAIT_L
#undef PG8_BAR
#undef PG8_SCHED
}

namespace att {
constexpr int NW = 8, QBLK = 32, KVBLK = 64;
constexpr float SCALE = 0.07216878364870322f;
constexpr float THR = 8.f;
constexpr int LDQ = 1536, LDK = 2048, LDKR = 64, LDO = 2048;
constexpr int SHM_V = KVBLK * 128 * 2, SHM_K = KVBLK * 128 * 2, SHM_KR = KVBLK * 64 * 2;
#define KSWZ(row, colB) ((row) * 256 + ((colB) ^ (((row) & 7) << 4)))
#define KRSWZ(row, colB) ((row) * 128 + ((colB) ^ (((row) & 7) << 4)))
#define SBAR() __builtin_amdgcn_sched_barrier(0)
__device__ __forceinline__ int crow(int r, int hi) { return (r & 3) + 8 * (r >> 2) + 4 * hi; }
__device__ __forceinline__ void partialSM(f32x16& p0, f32x16& p1, float& m_reg, float& mn, float& alpha) {
    constexpr float C = SCALE * 1.4426950408889634f;
    float pmax = p0[0];
#pragma unroll
    for (int r = 1; r < 16; ++r) pmax = fmaxf(pmax, p0[r]);
#pragma unroll
    for (int r = 0; r < 16; ++r) pmax = fmaxf(pmax, p1[r]);
    { auto rr = __builtin_amdgcn_permlane32_swap(__float_as_uint(pmax), __float_as_uint(pmax), false, false);
      pmax = fmaxf(__uint_as_float(rr[0]), __uint_as_float(rr[1])); }
    if (__builtin_expect(__all(pmax - m_reg <= THR / SCALE), 1)) { mn = m_reg; alpha = 1.f; }
    else { mn = fmaxf(m_reg, pmax); alpha = __builtin_amdgcn_exp2f((m_reg - mn) * C); m_reg = mn; }
    float mnC = -mn * C;
#pragma unroll
    for (int r = 0; r < 16; ++r) p0[r] = fmaf(p0[r], C, mnC);
#pragma unroll
    for (int r = 0; r < 16; ++r) p1[r] = fmaf(p1[r], C, mnC);
#pragma unroll
    for (int r = 0; r < 16; ++r) p0[r] = __builtin_amdgcn_exp2f(p0[r]);
}
__device__ __forceinline__ void finishSM(f32x16& p0, f32x16& p1, float alpha, float& l_reg, bf16x8& pa0, bf16x8& pa1, bf16x8& pa2, bf16x8& pa3) {
#pragma unroll
    for (int r = 0; r < 16; ++r) p1[r] = __builtin_amdgcn_exp2f(p1[r]);
    float ps = 0;
#pragma unroll
    for (int r = 0; r < 16; ++r) ps += p0[r];
#pragma unroll
    for (int r = 0; r < 16; ++r) ps += p1[r];
    { auto rr = __builtin_amdgcn_permlane32_swap(__float_as_uint(ps), __float_as_uint(ps), false, false);
      ps = __uint_as_float(rr[0]) + __uint_as_float(rr[1]); }
    l_reg = l_reg * alpha + ps;
#define PK4(P, BASE, OUT) do { unsigned a0 = cvtpk(P[BASE + 0], P[BASE + 1]), a1 = cvtpk(P[BASE + 2], P[BASE + 3]);   \
    unsigned b0 = cvtpk(P[BASE + 4], P[BASE + 5]), b1 = cvtpk(P[BASE + 6], P[BASE + 7]);                              \
    auto r0 = __builtin_amdgcn_permlane32_swap(a0, b0, false, false); auto r1 = __builtin_amdgcn_permlane32_swap(a1, b1, false, false); \
    u32x4 w = {r0[0], r1[0], r0[1], r1[1]}; OUT = *reinterpret_cast<bf16x8*>(&w); } while (0)
    PK4(p0, 0, pa0); PK4(p0, 8, pa1); PK4(p1, 0, pa2); PK4(p1, 8, pa3);
#undef PK4
}
__device__ __forceinline__ void qkt(f32x16& p0, f32x16& p1, const char* Ks, const char* Krs, const bf16x8* qr, const char* qrl, int r32, int hi) {
    p0 = f32x16{}; p1 = f32x16{};
#pragma unroll
    for (int d0 = 0; d0 < 8; ++d0) { int cb = (d0 * 16 + hi * 8) * 2;
        bf16x8 b0 = *reinterpret_cast<const bf16x8*>(Ks + KSWZ(r32, cb));
        bf16x8 b1 = *reinterpret_cast<const bf16x8*>(Ks + KSWZ(32 + r32, cb));
        p0 = __builtin_amdgcn_mfma_f32_32x32x16_bf16(b0, qr[d0], p0, 0, 0, 0);
        p1 = __builtin_amdgcn_mfma_f32_32x32x16_bf16(b1, qr[d0], p1, 0, 0, 0); }
#pragma unroll
    for (int d0 = 0; d0 < 4; ++d0) { int cb = (d0 * 16 + hi * 8) * 2;
        bf16x8 b0 = *reinterpret_cast<const bf16x8*>(Krs + KRSWZ(r32, cb));
        bf16x8 b1 = *reinterpret_cast<const bf16x8*>(Krs + KRSWZ(32 + r32, cb));
        const bf16x8 qv = *reinterpret_cast<const bf16x8*>(qrl + d0 * 8192);
        p0 = __builtin_amdgcn_mfma_f32_32x32x16_bf16(b0, qv, p0, 0, 0, 0);
        p1 = __builtin_amdgcn_mfma_f32_32x32x16_bf16(b1, qv, p1, 0, 0, 0); }
}
__device__ __forceinline__ int v_st(int k, int c) { const int kk = (k & ~0xC) | ((k & 4) << 1) | ((k & 8) >> 1); return ((kk >> 3) * 4 + (c >> 5)) * 512 + ((kk & 7) * 32 + (c & 31)) * 2; }
__device__ __forceinline__ int v_rd_base(int lane) { return ((lane & 3) << 3) | (((lane >> 2) & 3) << 6) | (((lane >> 4) & 1) << 5) | (((lane >> 5) & 1) << 8); }
constexpr int v_rd_off(int d0, int ks, int half) { return d0 * 512 + ks * 4096 + half * 2048; }
template <int OFF> __device__ __forceinline__ s16x4 tr_read(int vb) {
    s16x4 r; asm volatile("ds_read_b64_tr_b16 %0, %1 offset:%2" : "=&v"(r) : "v"(vb), "i"(OFF) : "memory"); return r;
}
template <int D0> __device__ __forceinline__ void pv_one(f32x16& od, int vb, bf16x8 pa0, bf16x8 pa1, bf16x8 pa2, bf16x8 pa3) {
    const s16x4 l0 = tr_read<v_rd_off(D0, 0, 0)>(vb), h0 = tr_read<v_rd_off(D0, 0, 1)>(vb), l1 = tr_read<v_rd_off(D0, 1, 0)>(vb), h1 = tr_read<v_rd_off(D0, 1, 1)>(vb);
    const s16x4 l2 = tr_read<v_rd_off(D0, 2, 0)>(vb), h2 = tr_read<v_rd_off(D0, 2, 1)>(vb), l3 = tr_read<v_rd_off(D0, 3, 0)>(vb), h3 = tr_read<v_rd_off(D0, 3, 1)>(vb);
    asm volatile("s_waitcnt lgkmcnt(0)" ::: "memory"); SBAR();
#define PK(L, H) (bf16x8){L[0], L[1], L[2], L[3], H[0], H[1], H[2], H[3]}
    od = __builtin_amdgcn_mfma_f32_32x32x16_bf16(pa0, PK(l0, h0), od, 0, 0, 0);
    od = __builtin_amdgcn_mfma_f32_32x32x16_bf16(pa1, PK(l1, h1), od, 0, 0, 0);
    od = __builtin_amdgcn_mfma_f32_32x32x16_bf16(pa2, PK(l2, h2), od, 0, 0, 0);
    od = __builtin_amdgcn_mfma_f32_32x32x16_bf16(pa3, PK(l3, h3), od, 0, 0, 0);
#undef PK
}
__device__ __forceinline__ void pv_d0(f32x16* o, int vb, bf16x8 pa0, bf16x8 pa1, bf16x8 pa2, bf16x8 pa3) {
    pv_one<0>(o[0], vb, pa0, pa1, pa2, pa3); pv_one<1>(o[1], vb, pa0, pa1, pa2, pa3); pv_one<2>(o[2], vb, pa0, pa1, pa2, pa3); pv_one<3>(o[3], vb, pa0, pa1, pa2, pa3);
}

__device__ __forceinline__ void attn_body(const bf16_t* __restrict__ Qb, const bf16_t* __restrict__ Kh, const bf16_t* __restrict__ Kr,
                                          bf16_t* __restrict__ Ob, int ml_off, int seq, char* lds) {
    const int tid = ltid(), wid = tid >> 6, lane = tid & 63, r32 = lane & 31, hi = lane >> 5;
    char* V_lds = lds; char* K_lds = lds + 2 * SHM_V; char* KR_lds = lds + 2 * SHM_V + 2 * SHM_K;
    float* ws = (float*)(lds + 2 * SHM_V + 2 * SHM_K + 2 * SHM_KR) + wid * 64; float* li_l = ws; float* al_l = ws + 32;
    float m_reg = -1e30f, l_reg = 0; f32x16 o[4] = {}; bf16x8 qr[8];
    const bf16_t* Qw = Qb + (long)(wid * QBLK + r32) * LDQ + hi * 8;
#pragma unroll
    for (int d0 = 0; d0 < 8; ++d0) qr[d0] = *reinterpret_cast<const bf16x8*>(Qw + d0 * 16);
    char* qrl = lds + 84 * 1024 + tid * 16;
#pragma unroll
    for (int d0 = 0; d0 < 4; ++d0) *reinterpret_cast<bf16x8*>(qrl + d0 * 8192) = *reinterpret_cast<const bf16x8*>(Qw + (8 + d0) * 16);
    const int sr = tid >> 4, sc = (tid & 15) * 8, vst0 = v_st(sr, sc), vst1 = v_st(32 + sr, sc);
    const int krr = tid >> 3, krc = (tid & 7) * 8;
    const int vb0 = (int)(uintptr_t)V_lds + v_rd_base(lane);
    bf16x8 s_vs0, s_vs1, s_ks0, s_ks1, s_kr;
#define SLOAD(k0) do { s_vs0 = *reinterpret_cast<const bf16x8*>(&Kh[(long)((k0) + sr) * LDK + sc + 128]); s_vs1 = *reinterpret_cast<const bf16x8*>(&Kh[(long)((k0) + 32 + sr) * LDK + sc + 128]); \
    s_ks0 = *reinterpret_cast<const bf16x8*>(&Kh[(long)((k0) + sr) * LDK + sc]); s_ks1 = *reinterpret_cast<const bf16x8*>(&Kh[(long)((k0) + 32 + sr) * LDK + sc]); \
    s_kr = *reinterpret_cast<const bf16x8*>(&Kr[(long)((k0) + krr) * LDKR + krc]); } while (0)
#define SWRITE(b) do { *(bf16x8*)(V_lds + (b) * SHM_V + vst0) = s_vs0; *(bf16x8*)(V_lds + (b) * SHM_V + vst1) = s_vs1; int kc = sc * 2;   \
    *(bf16x8*)(K_lds + (b) * SHM_K + KSWZ(sr, kc)) = s_ks0; *(bf16x8*)(K_lds + (b) * SHM_K + KSWZ(32 + sr, kc)) = s_ks1;                  \
    *(bf16x8*)(KR_lds + (b) * SHM_KR + KRSWZ(krr, krc * 2)) = s_kr; } while (0)
#define SWAIT() asm volatile("s_waitcnt vmcnt(0)" ::: "memory")
#define RESC(a) do { if (__any((a) < 1.f)) { if (hi == 0) al_l[r32] = (a); asm volatile("s_waitcnt lgkmcnt(0)" ::: "memory"); \
    _Pragma("unroll") for (int d = 0; d < 4; ++d) _Pragma("unroll") for (int r = 0; r < 16; ++r) o[d][r] *= al_l[crow(r, hi)]; } } while (0)
    f32x16 pA0, pA1, pB0, pB1; float mnA, mnB, alA, alB; bf16x8 pa0, pa1, pa2, pa3; const int NT = seq / KVBLK;
    SLOAD(0); SWAIT(); SWRITE(0); __syncthreads();
    qkt(pA0, pA1, K_lds, KR_lds, qr, qrl, r32, hi); partialSM(pA0, pA1, m_reg, mnA, alA);
    SLOAD(KVBLK);
    SWAIT(); SWRITE(1); __syncthreads();
    for (int j = 1; j + 1 < NT; j += 2) {
        SBAR(); qkt(pB0, pB1, K_lds + SHM_K, KR_lds + SHM_KR, qr, qrl, r32, hi);
        finishSM(pA0, pA1, alA, l_reg, pa0, pa1, pa2, pa3); SBAR();
        SLOAD((j + 1) * KVBLK); SBAR();
        pv_d0(o, vb0, pa0, pa1, pa2, pa3); partialSM(pB0, pB1, m_reg, mnB, alB);
        __syncthreads(); SWAIT(); SWRITE(0);
        RESC(alB); __syncthreads();
        SBAR(); qkt(pA0, pA1, K_lds, KR_lds, qr, qrl, r32, hi);
        finishSM(pB0, pB1, alB, l_reg, pa0, pa1, pa2, pa3); SBAR();
        SLOAD((j + 2) * KVBLK); SBAR();
        pv_d0(o, vb0 + (int)SHM_V, pa0, pa1, pa2, pa3); partialSM(pA0, pA1, m_reg, mnA, alA);
        __syncthreads(); SWAIT(); SWRITE(1);
        RESC(alA); __syncthreads();
    }
    SBAR(); qkt(pB0, pB1, K_lds + SHM_K, KR_lds + SHM_KR, qr, qrl, r32, hi);
    finishSM(pA0, pA1, alA, l_reg, pa0, pa1, pa2, pa3); SBAR();
    pv_d0(o, vb0, pa0, pa1, pa2, pa3); partialSM(pB0, pB1, m_reg, mnB, alB);
    __syncthreads(); RESC(alB);
    finishSM(pB0, pB1, alB, l_reg, pa0, pa1, pa2, pa3); SBAR();
    pv_d0(o, vb0 + (int)SHM_V, pa0, pa1, pa2, pa3);
    if (hi == 0) li_l[r32] = l_reg; asm volatile("s_waitcnt lgkmcnt(0)" ::: "memory");
    if (ml_off >= 0 && hi == 0) {
        const Params* kpa = (const Params*)__builtin_amdgcn_kernarg_segment_ptr(); asm volatile("" : "+s"(kpa));
        float* d = (float*)(kpa->ws + OFF_XB + 2048) + ml_off + (wid * QBLK + r32) * 1024; d[0] = m_reg; d[1] = l_reg; }
    float rli[16];
#pragma unroll
    for (int r = 0; r < 16; ++r) rli[r] = __builtin_amdgcn_rcpf(li_l[crow(r, hi)]);
    bf16_t* Ow = Ob + (long)(wid * QBLK) * LDO;
#pragma unroll
    for (int r = 0; r < 16; ++r) { int orow = crow(r, hi);
#pragma unroll
        for (int d0 = 0; d0 < 4; ++d0) Ow[(long)orow * LDO + d0 * 32 + r32] = f2bf(o[d0][r] * rli[r]); }
    __syncthreads();
#undef SLOAD
#undef SWRITE
#undef SWAIT
#undef RESC
}
}

namespace hg {
constexpr int LD = 136, LDT = 72;
constexpr int O_RZ = 0, O_RQ = O_RZ + 64 * LD * 2, O_RV = O_RQ + 64 * LD * 2, O_QD = O_RV + 64 * LD * 2, O_KD = O_QD + 64 * LD * 2,
              O_KDT = O_KD + 64 * LD * 2, O_VT = O_KDT + 128 * LDT * 2, O_P = O_VT + 128 * LDT * 2, O_SEG = O_P + 64 * LDT * 2, O_EV = O_SEG + 4 * 128 * 4, O_END = O_EV + 3 * 128 * 4;
static_assert(O_END <= LDS_BCAST, "hgrn LDS");
__device__ __forceinline__ float clampf(float x, float lo, float hi) { return fminf(fmaxf(x, lo), hi); }

__device__ __forceinline__ void hgrn_unit(LAS unsigned char* lds, bf16_t* hgb  , const float* lb_logits, int layer, int S, int unit) {
    const int tid = ltid(), wid = tid >> 6, lane = tid & 63, l15 = lane & 15, quad = lane >> 4;
    const int dir = unit & 1, h = (unit >> 1) & 7, b = unit >> 4;
    const int qcol = h * 128, zcol = (dir ? 2048 : 1024) + h * 128, vcol = 3072 + h * 128;
    const int ch = tid & 127, seg = tid >> 7;
    LAS bf16_t* RZ = (LAS bf16_t*)(lds + O_RZ); LAS bf16_t* RQ = (LAS bf16_t*)(lds + O_RQ); LAS bf16_t* RV = (LAS bf16_t*)(lds + O_RV);
    LAS bf16_t* QD = (LAS bf16_t*)(lds + O_QD); LAS bf16_t* KD = (LAS bf16_t*)(lds + O_KD); LAS bf16_t* KDT = (LAS bf16_t*)(lds + O_KDT);
    LAS bf16_t* VT = (LAS bf16_t*)(lds + O_VT); LAS bf16_t* PP = (LAS bf16_t*)(lds + O_P);
    LAS float* SEG = (LAS float*)(lds + O_SEG); LAS float* EV = (LAS float*)(lds + O_EV);
    const int n = S / 64;
    const int r0 = tid >> 4, c8 = (tid & 15) * 8;
    bf16x8 pz0, pz1, pq0, pq1, pv0, pv1;
#define HG_ROW(c, tau) ((long)b * S + (dir ? (S - 1 - ((c) * 64 + (tau))) : ((c) * 64 + (tau))))
#define HG_LOAD(c) do { const bf16_t* ra = hgb + HG_ROW(c, r0) * HGW; const bf16_t* rb = hgb + HG_ROW(c, r0 + 32) * HGW; \
    pz0 = *(const bf16x8*)(ra + zcol + c8); pz1 = *(const bf16x8*)(rb + zcol + c8); pq0 = *(const bf16x8*)(ra + qcol + c8); pq1 = *(const bf16x8*)(rb + qcol + c8); \
    pv0 = *(const bf16x8*)(ra + vcol + c8); pv1 = *(const bf16x8*)(rb + vcol + c8); } while (0)
    f32x4 Sst[8];
#pragma unroll
    for (int i = 0; i < 8; ++i) Sst[i] = (f32x4){0.f, 0.f, 0.f, 0.f};
    HG_LOAD(0);
    for (int c = 0; c < n; ++c) {
        *(LAS bf16x8*)(RZ + r0 * LD + c8) = pz0; *(LAS bf16x8*)(RZ + (r0 + 32) * LD + c8) = pz1;
        *(LAS bf16x8*)(RQ + r0 * LD + c8) = pq0; *(LAS bf16x8*)(RQ + (r0 + 32) * LD + c8) = pq1;
        *(LAS bf16x8*)(RV + r0 * LD + c8) = pv0; *(LAS bf16x8*)(RV + (r0 + 32) * LD + c8) = pv1;
        asm volatile("s_waitcnt lgkmcnt(0)" ::: "memory"); __builtin_amdgcn_s_barrier(); asm volatile("" ::: "memory");
        if (c + 1 < n) HG_LOAD(c + 1);
        float bl[16], kk[16]; float run = 0.f;
#pragma unroll
        for (int i = 0; i < 16; ++i) {
            const float lf = bf2f(RZ[(seg * 16 + i) * LD + ch]);
            run += lf; bl[i] = run; kk[i] = 1.f - __expf(lf);
        }
        SEG[seg * 128 + ch] = run;
        asm volatile("s_waitcnt lgkmcnt(0)" ::: "memory"); __builtin_amdgcn_s_barrier(); asm volatile("" ::: "memory");
        const float t0 = SEG[ch], t1 = SEG[128 + ch], t2 = SEG[256 + ch], t3 = SEG[384 + ch];
        const float off = (seg > 0 ? t0 : 0.f) + (seg > 1 ? t1 : 0.f) + (seg > 2 ? t2 : 0.f);
        const float bref = t0 + t1, btot = (t0 + t1) + (t2 + t3);
        unsigned kdt[8], vtt[8];
#pragma unroll
        for (int i = 0; i < 16; ++i) {
            const int tau = seg * 16 + i;
            const float bb = bl[i] + off;
            const float eq = __expf(clampf(bb - bref, -80.f, 80.f)), ek = __builtin_amdgcn_rcpf(eq);
            const float sq = bf2f(RQ[tau * LD + ch]);
            QD[tau * LD + ch] = f2bf(sq * eq);
            const bf16_t kb = f2bf(kk[i] * ek);
            KD[tau * LD + ch] = kb;
            const bf16_t vb = RV[tau * LD + ch];
            if (i & 1) { kdt[i >> 1] |= ((unsigned)kb) << 16; vtt[i >> 1] |= ((unsigned)vb) << 16; } else { kdt[i >> 1] = kb; vtt[i >> 1] = vb; }
        }
        *(LAS u32x4*)(KDT + ch * LDT + seg * 16) = (u32x4){kdt[0], kdt[1], kdt[2], kdt[3]}; *(LAS u32x4*)(KDT + ch * LDT + seg * 16 + 8) = (u32x4){kdt[4], kdt[5], kdt[6], kdt[7]};
        *(LAS u32x4*)(VT + ch * LDT + seg * 16) = (u32x4){vtt[0], vtt[1], vtt[2], vtt[3]}; *(LAS u32x4*)(VT + ch * LDT + seg * 16 + 8) = (u32x4){vtt[4], vtt[5], vtt[6], vtt[7]};
        if (seg == 0) { EV[ch] = __expf(clampf(bref, -80.f, 80.f)); EV[128 + ch] = __expf(clampf(btot, -80.f, 80.f)); EV[256 + ch] = __expf(clampf(btot - bref, -80.f, 80.f)); }
        asm volatile("s_waitcnt lgkmcnt(0)" ::: "memory"); __builtin_amdgcn_s_barrier(); asm volatile("" ::: "memory");
#pragma unroll
        for (int tt = 0; tt < 2; ++tt) {
            const int ti = wid * 2 + tt, sblk = ti >> 2, tblk = ti & 3;
            f32x4 a = (f32x4){0.f, 0.f, 0.f, 0.f};
            if (sblk <= tblk) {
#pragma unroll
                for (int ks = 0; ks < 4; ++ks) {
                    const bf16x8 af = *(LAS bf16x8*)(KD + (sblk * 16 + l15) * LD + ks * 32 + quad * 8);
                    const bf16x8 bfr = *(LAS bf16x8*)(QD + (tblk * 16 + l15) * LD + ks * 32 + quad * 8);
                    a = __builtin_amdgcn_mfma_f32_16x16x32_bf16(af, bfr, a, 0, 0, 0);
                }
            }
            const int t = tblk * 16 + l15, s0 = sblk * 16 + quad * 4;
            u32x2 w; w.x = cvtpk(s0 + 0 <= t ? a[0] : 0.f, s0 + 1 <= t ? a[1] : 0.f); w.y = cvtpk(s0 + 2 <= t ? a[2] : 0.f, s0 + 3 <= t ? a[3] : 0.f);
            *(LAS u32x2*)(PP + t * LDT + s0) = w;
        }
        asm volatile("s_waitcnt lgkmcnt(0)" ::: "memory"); __builtin_amdgcn_s_barrier(); asm volatile("" ::: "memory");
        const int dv0 = wid * 16;
        bf16x8 bv[2];
#pragma unroll
        for (int ks = 0; ks < 2; ++ks) bv[ks] = *(LAS bf16x8*)(VT + (dv0 + l15) * LDT + ks * 32 + quad * 8);
        f32x4 o[4];
#pragma unroll
        for (int i = 0; i < 4; ++i) o[i] = (f32x4){0.f, 0.f, 0.f, 0.f};
#pragma unroll
        for (int k4 = 0; k4 < 4; ++k4) {
            const f32x4 er0 = *(LAS f32x4*)(EV + 32 * k4 + 4 * quad), er1 = *(LAS f32x4*)(EV + 32 * k4 + 16 + 4 * quad);
            const f32x4 s0 = Sst[2 * k4] * er0, s1 = Sst[2 * k4 + 1] * er1;
            u32x4 bw; bw.x = cvtpk(s0[0], s0[1]); bw.y = cvtpk(s0[2], s0[3]); bw.z = cvtpk(s1[0], s1[1]); bw.w = cvtpk(s1[2], s1[3]);
            const bf16x8 bfr = *reinterpret_cast<bf16x8*>(&bw);
#pragma unroll
            for (int tb = 0; tb < 4; ++tb) {
                const u32x2 a0 = *(LAS u32x2*)(QD + (tb * 16 + l15) * LD + 32 * k4 + 4 * quad);
                const u32x2 a1 = *(LAS u32x2*)(QD + (tb * 16 + l15) * LD + 32 * k4 + 16 + 4 * quad);
                u32x4 aw; aw.x = a0.x; aw.y = a0.y; aw.z = a1.x; aw.w = a1.y;
                o[tb] = __builtin_amdgcn_mfma_f32_16x16x32_bf16(*reinterpret_cast<bf16x8*>(&aw), bfr, o[tb], 0, 0, 0);
            }
        }
#pragma unroll
        for (int ks = 0; ks < 2; ++ks)
#pragma unroll
            for (int tb = 0; tb < 4; ++tb) {
                const bf16x8 af = *(LAS bf16x8*)(PP + (tb * 16 + l15) * LDT + ks * 32 + quad * 8);
                o[tb] = __builtin_amdgcn_mfma_f32_16x16x32_bf16(af, bv[ks], o[tb], 0, 0, 0);
            }
#pragma unroll
        for (int tb = 0; tb < 4; ++tb)
#pragma unroll
            for (int j = 0; j < 4; ++j) hgb[HG_ROW(c, tb * 16 + quad * 4 + j) * HGW + zcol + dv0 + l15] = f2bf(o[tb][j]);
#pragma unroll
        for (int db = 0; db < 8; ++db) {
            f32x4 tmp = (f32x4){0.f, 0.f, 0.f, 0.f};
#pragma unroll
            for (int ks = 0; ks < 2; ++ks) {
                const bf16x8 af = *(LAS bf16x8*)(KDT + (db * 16 + l15) * LDT + ks * 32 + quad * 8);
                tmp = __builtin_amdgcn_mfma_f32_16x16x32_bf16(af, bv[ks], tmp, 0, 0, 0);
            }
            const f32x4 et = *(LAS f32x4*)(EV + 128 + db * 16 + quad * 4), etr = *(LAS f32x4*)(EV + 256 + db * 16 + quad * 4);
            Sst[db] = Sst[db] * et + tmp * etr;
        }
    }
    wg_barrier();
#undef HG_ROW
#undef HG_LOAD
}
}

struct WDesc { const float* src; const float* gain; bf16_t* dst; int K, N, R, map; };

__device__ __forceinline__ void wcvt_phase(LAS unsigned char* lds, const Params& p, int layer) {
    LAS float* tile = (LAS float*)lds;
    const int tid = ltid();
    char* ws = p.ws;
    if (lbid() == 0) {
        float* lbt = (float*)(ws + OFF_LB);
        for (int i = tid; i < 2048; i += 512) {
            float mx = -3e38f; for (int l = 0; l < DEPTH; ++l) mx = fmaxf(mx, p.lb_logits[l * 2048 + i]);
            float den = 0.f, num = 0.f; for (int l = 0; l < DEPTH; ++l) { const float e = __expf(p.lb_logits[l * 2048 + i] - mx); den += e; if (l >= 1 && l <= layer) num += e; }
            lbt[i] = num / den;
        }
    }
    for (int mi = 0; mi < 10; ++mi) {
        WDesc d;
        switch (mi) {
        case 0: d = {p.w_in + (size_t)layer * 2048 * 5952, p.mix_norm + layer * 2048, (bf16_t*)(ws + OFF_W_IN), 2048, 5952, INP, 1}; break;
        case 1: d = {p.w_uq + (size_t)layer * 512 * 1536, p.q_norm + layer * 512, (bf16_t*)(ws + OFF_W_UQ), 512, 1536, 1536, 0}; break;
        case 2: d = {p.w_ukv + (size_t)layer * 256 * 2048, p.kv_norm + layer * 256, (bf16_t*)(ws + OFF_W_UKV), 256, 2048, 2048, 0}; break;
        case 3: d = {p.w_out + (size_t)layer * 2048 * 2048, nullptr, (bf16_t*)(ws + OFF_W_OUT), 2048, 2048, 2048, 0}; break;
        case 4: d = {p.w_xq + (size_t)layer * 2048 * 2048, p.xattn_norm + layer * 2048, (bf16_t*)(ws + OFF_W_XQ), 2048, 2048, 2048, 0}; break;
        case 5: d = {p.w_xk + (size_t)layer * 2048 * 2048, p.mem_norm + layer * 2048, (bf16_t*)(ws + OFF_W_XK), 2048, 2048, 2048, 0}; break;
        case 6: d = {p.w_xv + (size_t)layer * 2048 * 2048, p.mem_norm + layer * 2048, (bf16_t*)(ws + OFF_W_XV), 2048, 2048, 2048, 0}; break;
        case 7: d = {p.w_xo + (size_t)layer * 2048 * 2048, nullptr, (bf16_t*)(ws + OFF_W_XO), 2048, 2048, 2048, 0}; break;
        case 8: d = {p.w_ffn1 + (size_t)layer * 2048 * 8192, p.ffn_norm + layer * 2048, (bf16_t*)(ws + OFF_W_F1), 2048, 8192, 8192, 0}; break;
        default: d = {p.w_ffn2 + (size_t)layer * 8192 * 2048, nullptr, (bf16_t*)(ws + OFF_W_F2), 8192, 2048, 2048, 0}; break;
        }
        const int nkt = d.K / 64, nrt = d.R / 256, ntile = nkt * nrt;
        for (int t = lbid(); t < ntile; t += gridDim.x) {
            const int kt = t % nkt, rt = t / nkt, k0 = kt * 64, r0 = rt * 256;
            {
                const int c4 = tid & 63, rr = tid >> 6; const int col = r0 + 4 * c4;
                int sc = col; bool zero = false;
                if (d.map) { if (col < 832) sc = col; else if (col < 1024) zero = true; else sc = col - 192; }
#pragma unroll
                for (int ii = 0; ii < 8; ++ii) { const int i = rr + ii * 8;
                    f32x4 v = zero ? (f32x4){0.f, 0.f, 0.f, 0.f} : *(const f32x4*)(d.src + (size_t)(k0 + i) * d.N + sc);
                    if (d.gain) v = v * d.gain[k0 + i];
                    *(LAS f32x4*)(tile + i * 260 + 4 * c4) = v; }
            }
            wg_barrier();
            {
                const int n = tid >> 1, kh = (tid & 1) * 32;
#pragma unroll
                for (int j = 0; j < 4; ++j) {
                    unsigned w[4];
#pragma unroll
                    for (int e = 0; e < 8; e += 2) w[e >> 1] = cvtpk(tile[(kh + j * 8 + e) * 260 + n], tile[(kh + j * 8 + e + 1) * 260 + n]);
                    *(u32x4*)(d.dst + (size_t)(r0 + n) * d.K + k0 + kh + j * 8) = (u32x4){w[0], w[1], w[2], w[3]};
                }
            }
            wg_barrier();
        }
    }
}

__device__ __forceinline__ void prep_phase(const Params& p, int tr, int T, int S) {
    const size_t xb_off = tr ? OFF_XB : OFF_XB0;
    const int tid = ltid(), wid = tid >> 6, lane = tid & 63;
    char* ws = p.ws;
    const long gtid = (long)lbid() * 512 + tid, gstride = (long)gridDim.x * 512;
    { ssq_t* ssq = (ssq_t*)(ws + OFF_SSQ) + (size_t)tr * 11 * TMAX; for (long i = gtid; i < (long)10 * TMAX; i += gstride) ssq[TMAX + i] = 0ull;
      if (gtid < 64) ((unsigned*)(ws + OFF_CTR))[gtid] = 0u; }
    { float* rc = (float*)(ws + OFF_ROPE); float* rs = rc + 16384 * 32;
      for (int i = (int)gtid; i < S * 32; i += (int)gstride) { const int pos = i >> 5, f = i & 31;
          const float inv_freq = exp2f(-(float)f * (13.287712379549449f / 32.f));
          const float ang = (float)pos * inv_freq;
          const double rev = (double)ang * 0.15915494309189535; const float fr = (float)(rev - rint(rev));
          rc[i] = __builtin_amdgcn_cosf(fr); rs[i] = __builtin_amdgcn_sinf(fr); } }
    { const float* x = p.x_in[tr]; bf16_t* xb = (bf16_t*)(ws + xb_off); ssq_t* ssq0 = (ssq_t*)(ws + OFF_SSQ) + (size_t)tr * 11 * TMAX;
      for (int row = lbid() * 8 + wid; row < T; row += gridDim.x * 8) {
          float ss = 0.f;
#pragma unroll
          for (int i = 0; i < 8; ++i) { const int c = i * 256 + lane * 4; const f32x4 v = *(const f32x4*)(x + (size_t)row * DM + c);
              ss += (v[0] * v[0] + v[1] * v[1]) + (v[2] * v[2] + v[3] * v[3]);
              u32x2 w; w.x = cvtpk(v[0], v[1]); w.y = cvtpk(v[2], v[3]); *(u32x2*)(xb + (size_t)row * DM + c) = w; }
#pragma unroll
          for (int o = 32; o > 0; o >>= 1) ss += __shfl_xor(ss, o);
          if (lane == 0) ssq0[row] = ssq_fix(ss);
      } }
    { const float* mem = p.mem_in[tr]; bf16_t* mn = (bf16_t*)(ws + OFF_MEMN) + (size_t)tr * 512 * 2048;
      for (int row = lbid() * 8 + wid; row < 512; row += gridDim.x * 8) {
          f32x4 v[8]; float ss = 0.f;
#pragma unroll
          for (int i = 0; i < 8; ++i) { v[i] = *(const f32x4*)(mem + (size_t)row * DM + i * 256 + lane * 4); ss += (v[i][0] * v[i][0] + v[i][1] * v[i][1]) + (v[i][2] * v[i][2] + v[i][3] * v[i][3]); }
#pragma unroll
          for (int o = 32; o > 0; o >>= 1) ss += __shfl_xor(ss, o);
          const float rs = __builtin_amdgcn_rsqf(ss * (1.f / DM) + EPS);
#pragma unroll
          for (int i = 0; i < 8; ++i) { u32x2 w; w.x = cvtpk(v[i][0] * rs, v[i][1] * rs); w.y = cvtpk(v[i][2] * rs, v[i][3] * rs); *(u32x2*)(mn + (size_t)row * DM + i * 256 + lane * 4) = w; }
      } }
}

__device__ __forceinline__ void rope_phase(const Params& p, int T, int S) {
    char* ws = p.ws;
    bf16_t* q = (bf16_t*)(ws + OFF_Q); const bf16_t* kr = (const bf16_t*)(ws + OFF_KR); bf16_t* kro = (bf16_t*)(ws + OFF_KROPE);
    const float* rc = (const float*)(ws + OFF_ROPE); const float* rs = rc + 16384 * 32;
    const int total = T * 9 * 4;
    for (int i = lbid() * 512 + ltid(); i < total; i += gridDim.x * 512) {
        const int f8 = (i & 3) * 8; const int ru = i >> 2; const int row_i = ru / 9; const int u = ru - row_i * 9; const long row = row_i; const int pos = row_i & (S - 1);
        const f32x8 c = *(const f32x8*)(rc + pos * 32 + f8), s = *(const f32x8*)(rs + pos * 32 + f8);
        const bf16_t* src = (u < 8) ? (q + row * 1536 + u * 192 + 128 + f8) : (kr + row * 64 + f8);
        bf16_t* dst = (u < 8) ? (q + row * 1536 + u * 192 + 128 + f8) : (kro + row * 64 + f8);
        const bf16x8 a1 = *(const bf16x8*)src, a2 = *(const bf16x8*)(src + 32);
        unsigned w1[4], w2[4];
#pragma unroll
        for (int j = 0; j < 8; j += 2) {
            const float x1a = bf2f((bf16_t)a1[j]), x2a = bf2f((bf16_t)a2[j]), x1b = bf2f((bf16_t)a1[j + 1]), x2b = bf2f((bf16_t)a2[j + 1]);
            w1[j >> 1] = cvtpk(x1a * c[j] - x2a * s[j], x1b * c[j + 1] - x2b * s[j + 1]);
            w2[j >> 1] = cvtpk(x2a * c[j] + x1a * s[j], x2b * c[j + 1] + x1b * s[j + 1]);
        }
        *(u32x4*)dst = (u32x4){w1[0], w1[1], w1[2], w1[3]}; *(u32x4*)(dst + 32) = (u32x4){w2[0], w2[1], w2[2], w2[3]};
    }
}

__device__ __forceinline__ void hcomb_phase(const Params& p, int layer, int T, int nblk, int bid, int nsplit) {
    char* ws = p.ws; const bf16_t* hgb = (const bf16_t*)(ws + OFF_HG); bf16_t* mix = (bf16_t*)(ws + OFF_MIX);
    const float* on = p.out_norm + layer * 128;
    const int l16 = ltid() & 15;
    const int total = T * 8 * 16;
    for (int i = bid * 512 + ltid(); i < total; i += nblk * 512) {
        const int rh = i >> 4; const int h = rh & 7; const long row = rh >> 3;
        const bf16_t* base = hgb + row * HGW + h * 128 + l16 * 8;
        const bf16x8 vf = *(const bf16x8*)(base + 1024), vb = *(const bf16x8*)(base + 2048), vg = *(const bf16x8*)(base + 4096);
        float o[8]; float ss = 0.f;
#pragma unroll
        for (int j = 0; j < 8; ++j) { o[j] = bf2f((bf16_t)vf[j]) + bf2f((bf16_t)vb[j]); ss += o[j] * o[j]; }
        ss += __shfl_xor(ss, 1); ss += __shfl_xor(ss, 2); ss += __shfl_xor(ss, 4); ss += __shfl_xor(ss, 8);
        const float rs = __builtin_amdgcn_rsqf(ss * (1.f / 128.f) + EPS);
        unsigned w[4];
#pragma unroll
        for (int j = 0; j < 8; j += 2) {
            const float g0 = bf2f((bf16_t)vg[j]), g1 = bf2f((bf16_t)vg[j + 1]);
            const float y0 = o[j] * rs * on[l16 * 8 + j] * (g0 / (1.f + __expf(-g0))), y1 = o[j + 1] * rs * on[l16 * 8 + j + 1] * (g1 / (1.f + __expf(-g1)));
            w[j >> 1] = cvtpk(y0, y1);
        }
        *(u32x4*)(mix + row * 2048 + 1024 + h * 128 + l16 * 8) = (u32x4){w[0], w[1], w[2], w[3]};
        if (nsplit == 2 && (((int)row & 16383) >> 8) >= MK_QF) {
            const f32x4 mlv = *(const f32x4*)((const float*)(ws + OFF_XB + 2048) + row * 1024 + h * 4);
            const float C = att::SCALE * 1.4426950408889634f;
            const float M = fmaxf(mlv[0], mlv[2]);
            const float w1 = mlv[1] * __builtin_amdgcn_exp2f((mlv[0] - M) * C), w2 = mlv[3] * __builtin_amdgcn_exp2f((mlv[2] - M) * C);
            const float inv = 1.f / (w1 + w2), c1 = w1 * inv, c2 = w2 * inv;
            bf16_t* pa = mix + row * 2048 + h * 128 + l16 * 8; const bf16_t* pb = (const bf16_t*)(ws + OFF_XB) + row * 2048 + h * 128 + l16 * 8;
            const bf16x8 va = *(const bf16x8*)pa, vb2 = *(const bf16x8*)pb;
            unsigned wo[4];
#pragma unroll
            for (int j = 0; j < 8; j += 2) wo[j >> 1] = cvtpk(c1 * bf2f((bf16_t)va[j]) + c2 * bf2f((bf16_t)vb2[j]), c1 * bf2f((bf16_t)va[j + 1]) + c2 * bf2f((bf16_t)vb2[j + 1]));
            *(u32x4*)pa = (u32x4){wo[0], wo[1], wo[2], wo[3]};
        }
    }
}

__device__ __forceinline__ void final_phase(const Params& p, float* xout, int T, int tr) {
    const int wid = ltid() >> 6, lane = ltid() & 63;
    const ssq_t* ssq = (const ssq_t*)(p.ws + OFF_SSQ) + (size_t)(tr * 11 + 10) * TMAX;
    for (int row = lbid() * 8 + wid; row < T; row += gridDim.x * 8) {
        const float rs = __builtin_amdgcn_rsqf(ssq_val(ssq[row]) * (1.f / DM) + EPS);
#pragma unroll
        for (int i = 0; i < 8; ++i) { const int c = i * 256 + lane * 4; f32x4 v = *(f32x4*)(xout + (size_t)row * DM + c); const f32x4 g = *(const f32x4*)(p.final_norm + c);
            v = v * rs * g; *(f32x4*)(xout + (size_t)row * DM + c) = v; }
    }
}

__device__ __forceinline__ void mixer_phase(LAS unsigned char* lds, const Params& p, int layer, int T, int S, int tr) {
    char* ws = p.ws;
    unsigned* ctr = (unsigned*)(ws + OFF_CTR) + (tr * 2 + layer) * 16;
    const int nQB = S / 256, QF = (S >= 16384) ? MK_QF : nQB, nQS = nQB - QF;
    const int nH = 2 * 8 * 2, nFull = 16 * QF, nA = nFull + 16 * 2 * nQS;
    LAS unsigned* slot = (LAS unsigned*)(lds + LDS_BCAST);
    for (;;) {
        if (ltid() == 0) *slot = __hip_atomic_fetch_add(ctr, 1u, __ATOMIC_RELAXED, __HIP_MEMORY_SCOPE_AGENT);
        wg_barrier();
        const int idx = (int)__builtin_amdgcn_readfirstlane(*slot);
        wg_barrier();
        if (idx >= nH + nA) break;
        const Params* kq = launder_p((const Params*)__builtin_amdgcn_kernarg_segment_ptr());
        char* wsu = kq->ws;
        bf16_t* hgb = (bf16_t*)(wsu + OFF_HG);
        const bf16_t* q = (const bf16_t*)(wsu + OFF_Q); const bf16_t* kv = (const bf16_t*)(wsu + OFF_KV); const bf16_t* kro = (const bf16_t*)(wsu + OFF_KROPE);
        bf16_t* mix = (bf16_t*)(wsu + OFF_MIX); bf16_t* o2 = (bf16_t*)(wsu + OFF_XB);
#ifndef MK_NO_HG
        if (idx < nH) hg::hgrn_unit(lds, hgb, kq->lb_logits, layer, S, idx);
        else
#endif
        {
#ifndef MK_NO_ATT
            const int a = idx - nH; int qb, half, bh, nsplit;
            if (a < nFull) { qb = a % QF; bh = a / QF; half = 0; nsplit = 1; }
            else { const int a1 = a - nFull; qb = QF + a1 % nQS; const int a2 = a1 / nQS; half = a2 & 1; bh = a2 >> 1; nsplit = 2; }
            const int h = bh & 7, b = bh >> 3;
            const int sseq = S / nsplit;
            const long row0 = (long)b * S + (long)qb * 256, krow0 = (long)b * S + (long)half * sseq;
            bf16_t* ob = (half == 0 ? mix : o2) + row0 * 2048 + h * 128;
            const int ml = (nsplit == 2) ? (int)(row0 * 1024 + h * 4 + half * 2) : -1;
            att::attn_body(q + row0 * 1536 + h * 192, kv + krow0 * 2048 + h * 256, kro + krow0 * 64, ob, ml, sseq, (char*)(unsigned char*)lds);
#endif
        }
    }
}

#define XB_TMO      128
#define XB_XCNT(j)  (256  + 64 * (j))
#define XB_XSUB(j)  (1280 + 64 * (j))
#define XB_XGEN(j)  (2304 + 64 * (j))
#define XB_TOP      3328
#define XB_TOPGEN   3392
#define XCD_BAR_WORDS 3456
#define XB_SPIN_CAP (1u << 22)
__device__ __forceinline__ unsigned xb_ld(unsigned* p)              { return __hip_atomic_load(p, __ATOMIC_RELAXED, __HIP_MEMORY_SCOPE_AGENT); }
__device__ __forceinline__ unsigned xb_add(unsigned* p, unsigned v) { return __hip_atomic_fetch_add(p, v, __ATOMIC_RELAXED, __HIP_MEMORY_SCOPE_AGENT); }
__device__ __forceinline__ unsigned xb_xcc_id() { return (unsigned)__builtin_amdgcn_s_getreg((3 << 11) | 20) & 0xFu; }
#define XB_SPIN(cond, bar) do { unsigned _sp = 0; while (cond) { __builtin_amdgcn_s_sleep(1); \
    if ((++_sp & 255u) == 0u) { if (xb_ld(&(bar)[XB_TMO])) break; if (_sp > XB_SPIN_CAP) { atomicAdd(&(bar)[XB_TMO], 1u); break; } } } } while (0)
struct XcdBarrier { unsigned* bar; unsigned x; volatile LAS unsigned* st; };
__device__ __forceinline__ XcdBarrier xcd_barrier_post(unsigned* bar, volatile LAS unsigned* st) {
    XcdBarrier b; b.bar = bar; b.x = xb_xcc_id(); b.st = st;
    if (threadIdx.x == 0) (void)xb_add(&bar[XB_XCNT(b.x)], 1u);
    return b;
}
__device__ __forceinline__ void xcd_barrier_complete(unsigned* bar, unsigned x, unsigned& nloc, unsigned& nx) {
    const unsigned G = gridDim.x * gridDim.y * gridDim.z;
    unsigned sum, cnt, mine, sp = 0u;
    for (;;) {
        sum = 0u; cnt = 0u; mine = 0u;
#pragma unroll
        for (unsigned j = 0; j < 16; ++j) { const unsigned c = xb_ld(&bar[XB_XCNT(j)]); sum += c; cnt += (c > 0u) ? 1u : 0u; mine = (j == x) ? c : mine; }
        if (sum == G) break;
        __builtin_amdgcn_s_sleep(1);
        if ((++sp & 255u) == 0u) { if (xb_ld(&bar[XB_TMO])) break; if (sp > XB_SPIN_CAP) { atomicAdd(&bar[XB_TMO], 1u); break; } }
    }
    nloc = mine > 0u ? mine : 1u; nx = cnt > 0u ? cnt : 1u;
}
__device__ __forceinline__ void xcd_barrier_(const XcdBarrier& b) {
    asm volatile("s_waitcnt vmcnt(0)" ::: "memory");
    __syncthreads();
    if (threadIdx.x == 0) {
        unsigned* bar = b.bar;
        __builtin_amdgcn_s_waitcnt(0);
        unsigned nloc = b.st[0], nx = b.st[1];
        if (nloc == 0u) { xcd_barrier_complete(bar, b.x, nloc, nx); b.st[0] = nloc; b.st[1] = nx; }
        const unsigned old = xb_add(&bar[XB_XSUB(b.x)], 1u);
        const unsigned gen = old / nloc;
        if (old + 1u == (gen + 1u) * nloc) {
            __builtin_amdgcn_fence(__ATOMIC_RELEASE, "agent");
            asm volatile("s_waitcnt vmcnt(0)" ::: "memory");
            const unsigned og = xb_add(&bar[XB_TOP], 1u);
            const unsigned tg = og / nx;
            if (og + 1u == (tg + 1u) * nx) xb_add(&bar[XB_TOPGEN], 1u);
            else XB_SPIN(xb_ld(&bar[XB_TOPGEN]) == tg, bar);
            __builtin_amdgcn_fence(__ATOMIC_ACQUIRE, "agent");
            xb_add(&bar[XB_XGEN(b.x)], 1u);
            asm volatile("s_waitcnt vmcnt(0)" ::: "memory");
        } else {
            XB_SPIN(xb_ld(&bar[XB_XGEN(b.x)]) == gen, bar);
            __builtin_amdgcn_fence(__ATOMIC_ACQUIRE, "agent");
            asm volatile("s_waitcnt vmcnt(0)" ::: "memory");
        }
    }
    __syncthreads();
}

__device__ __forceinline__ void xcd_barrier(LAS unsigned char* lds) {
    const Params* kp = launder_p((const Params*)__builtin_amdgcn_kernarg_segment_ptr());
    XcdBarrier b; b.bar = (unsigned*)(kp->ws + OFF_BAR); b.x = xb_xcc_id(); b.st = (volatile LAS unsigned*)(lds + LDS_BCAST + 64);
    xcd_barrier_(b);
}
constexpr int N_PHASES = 52;

__device__ __forceinline__ GemmDesc mkgemm(const void* A, int lda, const void* B, int ldb, int K, int nM, int nN) {
    GemmDesc g{}; g.A = (const char*)A; g.B = (const char*)B; g.lda = lda; g.ldb = ldb; g.K = K; g.nM = nM; g.nN = nN; g.nZ = 1; g.perm = 1; g.epi = E_BF16; return g;
}

__device__ __forceinline__ bool make_gemm(const Params& p, int tr, int l, int k, int i, GemmDesc& g) {
    const int T = tr ? 32768 : 8192, S = tr ? 16384 : 4096, nMT = T / 256;
    char* ws = p.ws;
    float* xout = p.out + (tr ? (size_t)8192 * DM : 0);
    ssq_t* ssq = (ssq_t*)(ws + OFF_SSQ) + (size_t)tr * 11 * TMAX;
    ssq_t* ssq_x0 = ssq + (size_t)(l * 5 + 0) * TMAX; ssq_t* ssq_q = ssq + (size_t)(l * 5 + 1) * TMAX; ssq_t* ssq_kv = ssq + (size_t)(l * 5 + 2) * TMAX;
    ssq_t* ssq_x1 = ssq + (size_t)(l * 5 + 3) * TMAX; ssq_t* ssq_x2 = ssq + (size_t)(l * 5 + 4) * TMAX; ssq_t* ssq_nx = ssq + (size_t)((l + 1) * 5) * TMAX;
    bf16_t* xb = (bf16_t*)(ws + (tr ? OFF_XB : OFF_XB0));
    const char* memn = ws + OFF_MEMN + (size_t)tr * 512 * 2048 * 2;
    if (k == 1) {
        if (i > 0) return false;
        g = mkgemm(xb, DM, ws + OFF_W_IN, DM, DM, nMT, INP / 256); g.epi = E_INPROJ; g.ssq_in = ssq_x0; g.inv_dim = 1.f / DM;
        g.out = (bf16_t*)(ws + OFF_CQ); g.out2 = (bf16_t*)(ws + OFF_KR); g.out3 = (bf16_t*)(ws + OFF_HG); g.ssq_out = ssq_q; g.ssq_out2 = ssq_kv; return true;
    } else if (k == 2) {
        if (i == 0) { g = mkgemm(ws + OFF_CQ, 768, ws + OFF_W_UQ, 512, 512, nMT, 6); g.out = (bf16_t*)(ws + OFF_Q); g.ldo = 1536; g.ssq_in = ssq_q; g.inv_dim = 1.f / 512.f; return true; }
        if (i == 1) { g = mkgemm(ws + OFF_CQ + 512 * 2, 768, ws + OFF_W_UKV, 256, 256, nMT, 8); g.out = (bf16_t*)(ws + OFF_KV); g.ldo = 2048; g.ssq_in = ssq_kv; g.inv_dim = 1.f / 256.f; return true; }
        return false;
    } else if (k == 6) {
        if (i > 0) return false;
        g = mkgemm(ws + OFF_MIX, DM, ws + OFF_W_OUT, DM, DM, nMT, 8); g.epi = E_RESID;
        g.resid = (l == 0) ? p.x_in[tr] : xout; g.xout = xout; g.xb = xb; g.ssq_out = ssq_x1; return true;
    } else if (k == 7) {
        if (i == 0) { g = mkgemm(xb, DM, ws + OFF_W_XQ, DM, DM, nMT, 8); g.out = (bf16_t*)(ws + OFF_XQ); g.ldo = DM; g.ssq_in = ssq_x1; g.inv_dim = 1.f / DM; return true; }
        return false;
    } else if (k == 5) {
        if (i == 0) { g = mkgemm(memn, DM, ws + OFF_W_XK, DM, DM, 2, 8); g.out = (bf16_t*)(ws + OFF_KMEM); g.ldo = DM; return true; }
        if (i == 1) { g = mkgemm(ws + OFF_W_XV, DM, memn, DM, DM, 8, 1); g.nZ = 2; g.bzs = 256 * DM * 2; g.out = (bf16_t*)(ws + OFF_VT); g.ldo = 256; g.ozs = (long)2048 * 256; return true; }
        return false;
    } else if (k == 8) {
        if (i > 0) return false;
        g = mkgemm(ws + OFF_XQ, DM, ws + OFF_KMEM, DM, 512, nMT, 1); g.nZ = 4; g.azs = 512 * 2; g.bzs = 512 * 2; g.bbs = 256 * DM * 2; g.tpb = S / 256;
        g.epi = E_SOFTMAX; g.out = (bf16_t*)(ws + OFF_PBUF); g.ldo = 1024; return true;
    } else if (k == 9) {
        if (i > 0) return false;
        g = mkgemm(ws + OFF_PBUF, 1024, ws + OFF_VT, 256, 256, nMT, 2); g.nZ = 4; g.azs = 256 * 2; g.bzs = 512 * 256 * 2; g.bbs = 2048 * 256 * 2; g.tpb = S / 256;
        g.out = (bf16_t*)(ws + OFF_OBUF); g.ldo = DM; g.ozs = 512; return true;
    } else if (k == 10) {
        if (i > 0) return false;
        g = mkgemm(ws + OFF_OBUF, DM, ws + OFF_W_XO, DM, DM, nMT, 8); g.epi = E_RESID;
        g.resid = xout; g.xout = xout; g.xb = xb; g.ssq_out = ssq_x2; return true;
    } else if (k == 11) {
        if (i > 0) return false;
        g = mkgemm(xb, DM, ws + OFF_W_F1, DM, DM, nMT, 32); g.out = (bf16_t*)(ws + OFF_U); g.ldo = 8192; g.ssq_in = ssq_x2; g.inv_dim = 1.f / DM; g.relu2 = 1; return true;
    } else if (k == 12) {
        if (i > 0) return false;
        g = mkgemm(ws + OFF_U, 8192, ws + OFF_W_F2, 8192, 8192, nMT, 8); g.epi = E_RESID;
        g.resid = xout; g.xout = xout; g.xb = xb; g.ssq_out = ssq_nx; return true;
    }
    return false;
}

__device__ __forceinline__ void run_phase(const Params* kp, int ph, LAS unsigned char* lds) {
    const Params& p = *kp;
    if (ph == 0) { prep_phase(p, 0, 8192, 4096); prep_phase(p, 1, 32768, 16384); return; }
    if (ph == N_PHASES - 1) { final_phase(p, p.out, 8192, 0); final_phase(p, p.out + (size_t)8192 * DM, 32768, 1); return; }
    const int l = (ph - 1) / 25, r = (ph - 1) % 25;
    if (r == 0) { wcvt_phase(lds, p, l); return; }
    const int tr = (r - 1) / 12, k = (r - 1) % 12 + 1;
    const int T = tr ? 32768 : 8192, S = tr ? 16384 : 4096;
    if (k == 3) { rope_phase(p, T, S); return; }
    if (k == 4) { mixer_phase(lds, p, l, T, S, tr); return; }
    if (k == 5) {
        const int c = lbid(), G = gridDim.x;
        if (G >= 64) {
            if (c < 16) gemm_phase<E_BF16>(lds, kp, tr, l, 5, 0, 16, c);
            else if (c < 32) gemm_phase<E_BF16>(lds, kp, tr, l, 5, 1, 16, c - 16);
            else hcomb_phase(p, l, T, G - 32, c - 32, S >= 16384 ? 2 : 1);
        } else { gemm_phase<E_BF16>(lds, kp, tr, l, 5, 0, G, c); gemm_phase<E_BF16>(lds, kp, tr, l, 5, 1, G, c); hcomb_phase(p, l, T, G, c, S >= 16384 ? 2 : 1); }
        return; }
#ifndef MK_NO_GEMM
    { const int c = lbid(), G = gridDim.x;
    if (k == 1) gemm_phase<E_INPROJ>(lds, kp, tr, l, k, 0, G, c);
    else if (k == 6 || k == 10 || k == 12) gemm_phase<E_RESID>(lds, kp, tr, l, k, 0, G, c);
    else if (k == 8) gemm_phase<E_SOFTMAX>(lds, kp, tr, l, k, 0, G, c);
    else for (int i = 0; i < 2; ++i) gemm_phase<E_BF16>(lds, kp, tr, l, k, i, G, c); }
#endif
}

__global__ void __launch_bounds__(512, 2) mk_forward(Params p, int ph_lo, int ph_hi) {
    extern __shared__ __attribute__((aligned(16))) unsigned char shm[];
    LAS unsigned char* lds = (LAS unsigned char*)shm;
    cg::grid_group grid = cg::this_grid();
    volatile LAS unsigned* xst = (volatile LAS unsigned*)(lds + LDS_BCAST + 64);
    if (threadIdx.x == 0) { xst[0] = 0u; xst[1] = 0u; }
    __syncthreads();
    { const Params* kp0 = launder_p((const Params*)__builtin_amdgcn_kernarg_segment_ptr()); (void)xcd_barrier_post((unsigned*)(kp0->ws + OFF_BAR), xst); }
    for (int ph = ph_lo; ph < ph_hi; ++ph) {
        const Params* kp = launder_p((const Params*)__builtin_amdgcn_kernarg_segment_ptr());
#ifdef MK_TIME_KIND
        if (blockIdx.x == 0 && threadIdx.x == 0) ((unsigned long long*)(kp->ws + OFF_TS))[ph] = __builtin_amdgcn_s_memrealtime();
#endif
        run_phase(kp, ph, lds);
        if (ph + 1 < ph_hi) { if (ph_hi > N_PHASES) grid.sync(); else xcd_barrier(lds); }
    }
#ifdef MK_TIME_KIND
    xcd_barrier(lds);
    if (blockIdx.x == 0) {
        const Params* kp = launder_p((const Params*)__builtin_amdgcn_kernarg_segment_ptr());
        unsigned long long* ts = (unsigned long long*)(kp->ws + OFF_TS); float* outp = kp->out;
        if (threadIdx.x == 0) ts[ph_hi] = __builtin_amdgcn_s_memrealtime();
        __syncthreads();
        unsigned tot = 0;
        for (int ph = ph_lo; ph < ph_hi; ++ph) { const int r_ = (ph - 1) % 25; const int kind = (ph == 0) ? 100 : (ph == N_PHASES - 1 ? 101 : (r_ == 0 ? 0 : (r_ - 1) % 12 + 1));
            if (kind == MK_TIME_KIND || MK_TIME_KIND == 200) tot += (unsigned)(ts[ph + 1] - ts[ph]); }
        const int n = (int)(tot / 100u);
        for (int i = threadIdx.x; i < n; i += 512) outp[i] += 0.25f;
        for (int i = threadIdx.x; i < 4 * n; i += 512) outp[(size_t)8192 * DM + i] += 0.25f;
    }
#endif

}

extern "C" void kernel_launch(void* const* d_in, const int* in_sizes, int n_in, void* d_out, int out_size, void* d_ws, size_t ws_size, hipStream_t stream) {
    static int inited = 0; static int grid_blocks = 0;
    if (!inited) {
        hipFuncSetAttribute((const void*)mk_forward, hipFuncAttributeMaxDynamicSharedMemorySize, LDS_BYTES);
        int dev = 0, cus = 0, per_cu = 0;
        hipGetDevice(&dev); hipDeviceGetAttribute(&cus, hipDeviceAttributeMultiprocessorCount, dev);
        hipOccupancyMaxActiveBlocksPerMultiprocessor(&per_cu, mk_forward, 512, LDS_BYTES);
        if (per_cu < 1) per_cu = 1;
        grid_blocks = cus * 1;
        if (ws_size < WS_END) fprintf(stderr, "kernel_launch: workspace too small: %zu < %zu\n", ws_size, (size_t)WS_END);
        inited = 1;
    }
    Params p{};
    const float* const* in = (const float* const*)d_in;
    p.x_in[0] = in[0]; p.x_in[1] = in[1]; p.mem_in[0] = in[2]; p.mem_in[1] = in[3];
    p.mix_norm = in[4]; p.w_in = in[5]; p.q_norm = in[6]; p.w_uq = in[7]; p.kv_norm = in[8]; p.w_ukv = in[9]; p.lb_logits = in[10]; p.out_norm = in[11]; p.w_out = in[12];
    p.xattn_norm = in[13]; p.mem_norm = in[14]; p.w_xq = in[15]; p.w_xk = in[16]; p.w_xv = in[17]; p.w_xo = in[18]; p.ffn_norm = in[19]; p.w_ffn1 = in[20]; p.w_ffn2 = in[21]; p.final_norm = in[22];
    p.out = (float*)d_out; p.ws = (char*)d_ws;
#if MK_ONE_LAUNCH
    hipMemsetAsync((char*)d_ws + OFF_BAR, 0, 16384, stream);
    int lo = 0, hi = N_PHASES;
    void* args[] = {&p, &lo, &hi};
    hipError_t e = hipLaunchCooperativeKernel((const void*)mk_forward, dim3(grid_blocks), dim3(512), args, LDS_BYTES, stream);
    if (e != hipSuccess) fprintf(stderr, "cooperative launch failed: %s\n", hipGetErrorString(e));
#else
    for (int ph = 0; ph < N_PHASES; ++ph) hipLaunchKernelGGL(mk_forward, dim3(grid_blocks), dim3(512), LDS_BYTES, stream, p, ph, ph + 1);
#endif
}
```

```cpp
#include <hip/hip_runtime.h>
#include <hip/hip_cooperative_groups.h>
#include <cstdio>
namespace cg = cooperative_groups;

#define LAS __attribute__((address_space(3)))
typedef unsigned short bf16_t;
typedef short bf16x8 __attribute__((ext_vector_type(8)));
typedef short s16x4 __attribute__((ext_vector_type(4)));
typedef float f32x4 __attribute__((ext_vector_type(4)));
typedef float f32x8 __attribute__((ext_vector_type(8)));
typedef float f32x16 __attribute__((ext_vector_type(16)));
typedef unsigned u32x4 __attribute__((ext_vector_type(4)));
typedef unsigned u32x2 __attribute__((ext_vector_type(2)));

#ifndef MK_QF
#define MK_QF 52
#endif
#ifndef MK_ONE_LAUNCH
#define MK_ONE_LAUNCH 1
#endif

constexpr int DM = 2048, NMEM = 256, DEPTH = 2;
constexpr int INP = 6144;
constexpr int HGW = 5120;
constexpr int TMAX = 32768;
constexpr float EPS = 1e-6f;
constexpr int LDS_BYTES = 144 * 1024;
constexpr int LDS_BCAST = 140 * 1024;
constexpr int LDS_EPI = 128 * 1024;

constexpr size_t al256(size_t x) { return (x + 255) / 256 * 256; }
constexpr size_t E_W_IN = (size_t)INP * 2048, E_W_UQ = 1536 * 512, E_W_UKV = 2048 * 256, E_W_SQ = 2048 * 2048, E_W_F = (size_t)8192 * 2048;
constexpr size_t OFF_W_IN = 0;
constexpr size_t OFF_W_UQ = OFF_W_IN + E_W_IN * 2;
constexpr size_t OFF_W_UKV = OFF_W_UQ + E_W_UQ * 2;
constexpr size_t OFF_W_OUT = OFF_W_UKV + E_W_UKV * 2;
constexpr size_t OFF_W_XQ = OFF_W_OUT + E_W_SQ * 2;
constexpr size_t OFF_W_XK = OFF_W_XQ + E_W_SQ * 2;
constexpr size_t OFF_W_XV = OFF_W_XK + E_W_SQ * 2;
constexpr size_t OFF_W_XO = OFF_W_XV + E_W_SQ * 2;
constexpr size_t OFF_W_F1 = OFF_W_XO + E_W_SQ * 2;
constexpr size_t OFF_W_F2 = OFF_W_F1 + E_W_F * 2;
constexpr size_t OFF_XB = OFF_W_F2 + E_W_F * 2;
constexpr size_t OFF_KR = OFF_XB + (size_t)TMAX * 2048 * 2;
constexpr size_t OFF_KROPE = OFF_KR + (size_t)TMAX * 64 * 2;
constexpr size_t OFF_MIX = OFF_KROPE + (size_t)TMAX * 64 * 2;
constexpr size_t OFF_HG = OFF_MIX + (size_t)TMAX * 2048 * 2;
constexpr size_t OFF_Q = OFF_HG + (size_t)TMAX * HGW * 2;
constexpr size_t OFF_KV = OFF_Q + (size_t)TMAX * 1536 * 2;
constexpr size_t OFF_MEMN = OFF_KV + (size_t)TMAX * 2048 * 2;
constexpr size_t OFF_KMEM = OFF_MEMN + (size_t)2 * 512 * 2048 * 2;
constexpr size_t OFF_VT = OFF_KMEM + (size_t)512 * 2048 * 2;
constexpr size_t OFF_ROPE = OFF_VT + (size_t)512 * 2048 * 2;
constexpr size_t OFF_SSQ = OFF_ROPE + (size_t)16384 * 32 * 4 * 2;
constexpr size_t OFF_CTR = OFF_SSQ + (size_t)22 * TMAX * 8;
constexpr size_t OFF_BAR = OFF_CTR + 256;
constexpr size_t OFF_LB = OFF_BAR + 16384;
constexpr size_t OFF_TS = OFF_LB + 8192;
constexpr size_t OFF_XB0 = OFF_TS + 1024;
constexpr size_t WS_END = OFF_XB0 + (size_t)8192 * 2048 * 2;
constexpr size_t OFF_CQ = OFF_MIX;
constexpr size_t OFF_XQ = OFF_Q;
constexpr size_t OFF_PBUF = OFF_MIX;
constexpr size_t OFF_OBUF = OFF_HG;
constexpr size_t OFF_U = OFF_HG;
static_assert((size_t)TMAX * 8192 * 2 <= OFF_MEMN - OFF_HG, "u must fit");

struct Params {
    const float* x_in[2]; const float* mem_in[2];
    const float *mix_norm, *w_in, *q_norm, *w_uq, *kv_norm, *w_ukv, *lb_logits, *out_norm, *w_out, *xattn_norm, *mem_norm, *w_xq, *w_xk, *w_xv, *w_xo,
        *ffn_norm, *w_ffn1, *w_ffn2, *final_norm;
    float* out; char* ws;
};

__device__ __forceinline__ int ltid() { int t = threadIdx.x; asm volatile("" : "+v"(t)); return t; }
__device__ __forceinline__ int lbid() { int t = blockIdx.x; asm volatile("" : "+s"(t)); return t; }
__device__ __forceinline__ float bf2f(bf16_t b) { return __uint_as_float(((unsigned)b) << 16); }
__device__ __forceinline__ bf16_t f2bf(float f) { unsigned u = __float_as_uint(f); u += 0x7FFFu + ((u >> 16) & 1u); return (bf16_t)(u >> 16); }
__device__ __forceinline__ unsigned cvtpk(float lo, float hi) { unsigned r; asm volatile("v_cvt_pk_bf16_f32 %0, %1, %2" : "=v"(r) : "v"(lo), "v"(hi)); return r; }
__device__ __forceinline__ void wg_barrier() { asm volatile("s_waitcnt vmcnt(0) lgkmcnt(0)" ::: "memory"); __builtin_amdgcn_s_barrier(); asm volatile("" ::: "memory"); }
typedef unsigned long long ssq_t;
__device__ __forceinline__ ssq_t ssq_fix(float v) { return (ssq_t)(v * 16777216.f + 0.5f); }
__device__ __forceinline__ float ssq_val(ssq_t v) { return (float)v * (1.f / 16777216.f); }
__device__ __forceinline__ void atomic_addf(ssq_t* p, float v) { __hip_atomic_fetch_add(p, ssq_fix(v), __ATOMIC_RELAXED, __HIP_MEMORY_SCOPE_AGENT); }

namespace pg8 {
constexpr int BM = 256, BK = 64, HALF = 128, HTB = HALF * BK * 2, NXCD = 8, WGM = 8;
__host__ __device__ __forceinline__ int lds_byte(int r, int c) { const int st = (r >> 4) * 2 + (c >> 5), rr = r & 15, cc = c & 31, ob = rr * 64 + cc * 2; return st * 1024 + (ob ^ (((ob >> 9) & 1) << 5)); }
__host__ __device__ __forceinline__ void stage_rc(int b, int& R, int& C) { const int st = b / 1024, sb = b % 1024, swz = sb ^ (((sb >> 9) & 1) << 5); R = (st >> 1) * 16 + swz / 64; C = (st & 1) * 32 + (swz % 64) / 2; }
__host__ __device__ __forceinline__ int perm32(int rho) { const int n = rho >> 4, i = rho & 15; return 8 * (i >> 2) + 4 * n + (i & 3); }
}
enum { E_BF16 = 0, E_INPROJ = 1, E_RESID = 2, E_SOFTMAX = 3 };
struct GemmDesc {
    const char* A; const char* B; int lda, ldb, K, nM, nN, nZ;
    int azs, bzs, bbs, tpb;
    int epi, perm;
    bf16_t* out; long ozs; int ldo;
    const ssq_t* ssq_in; float inv_dim; int relu2;
    ssq_t* ssq_out; ssq_t* ssq_out2;
    const float* resid; float* xout; bf16_t* xb;
    bf16_t* out2; bf16_t* out3;
};
struct Unit { int pm, pn, z; const char* a; const char* b; };

__device__ __forceinline__ bool make_gemm(const Params& p, int tr, int l, int k, int i, GemmDesc& g);
__device__ __forceinline__ const Params* launder_p(const Params* q) { asm volatile("" : "+s"(q)); return q; }
__device__ __forceinline__ int launder_i(int v) { asm volatile("" : "+s"(v)); return v; }
__device__ __forceinline__ bool next_unit(const Params* kp, int tr, int l, int k, int gi, int i, int G, int c, Unit& u) {
    GemmDesc g; make_gemm(*launder_p(kp), launder_i(tr), launder_i(l), launder_i(k), launder_i(gi), g);
    const int L = i * G + c; const int per = g.nM * g.nN;
    if (L >= per * g.nZ) return false;
    const int z = L / per; int wgid = L - z * per;
    { const int q = per / pg8::NXCD, r = per % pg8::NXCD, xcd = wgid % pg8::NXCD, off = wgid / pg8::NXCD; wgid = (xcd < r ? xcd * (q + 1) : r * (q + 1) + (xcd - r) * q) + off; }
    const int nig = pg8::WGM * g.nN, gid = wgid / nig, fm = gid * pg8::WGM, gsz = (g.nM - fm) < pg8::WGM ? (g.nM - fm) : pg8::WGM;
    u.pm = fm + ((wgid % nig) % gsz); u.pn = (wgid % nig) / gsz; u.z = z;
    const unsigned ao = (unsigned)z * (unsigned)g.azs + (unsigned)u.pm * (unsigned)(512 * g.lda);
    const unsigned bo = (unsigned)z * (unsigned)g.bzs + (unsigned)u.pn * (unsigned)(512 * g.ldb) + (g.tpb ? (unsigned)(u.pm / g.tpb) * (unsigned)g.bbs : 0u);
    u.a = g.A + (size_t)ao; u.b = g.B + (size_t)bo;
    return true;
}

template <int EPI> __device__ __forceinline__ void gemm_epilogue(const Params* kp, int tr, int l, int k, int gi, f32x4 (&acc)[2][2][4][2], const Unit& u, LAS unsigned char* lds) {
    const int tid_e = ltid(), wid_e = tid_e >> 6, lane_e = tid_e & 63, wr = wid_e >> 2, wc = wid_e & 3, fr = lane_e & 15, fq = lane_e >> 4;
    GemmDesc g; make_gemm(*launder_p(kp), launder_i(tr), launder_i(l), launder_i(k), launder_i(gi), g);
    const int row0 = u.pm * 256 + wr * 64 + fr;
    if constexpr (EPI == E_BF16) {
        const int col0 = u.pn * 256 + wc * 32 + 8 * fq;
        float rsv[2][4];
#pragma unroll
        for (int ai = 0; ai < 2; ++ai)
#pragma unroll
            for (int m = 0; m < 4; ++m) rsv[ai][m] = g.ssq_in ? __builtin_amdgcn_rsqf(ssq_val(g.ssq_in[row0 + ai * 128 + m * 16]) * g.inv_dim + EPS) : 1.0f;
#pragma unroll
        for (int ai = 0; ai < 2; ++ai)
#pragma unroll
            for (int m = 0; m < 4; ++m) {
                const int row = row0 + ai * 128 + m * 16;
                const float rs = rsv[ai][m];
                bf16_t* rowp = g.out + (long)u.z * g.ozs + (long)row * g.ldo + col0;
#pragma unroll
                for (int bj = 0; bj < 2; ++bj) {
                    f32x4 v0 = acc[ai][bj][m][0] * rs, v1 = acc[ai][bj][m][1] * rs;
                    if (g.relu2) {
#pragma unroll
                        for (int j = 0; j < 4; ++j) { float a = fmaxf(v0[j], 0.f), b = fmaxf(v1[j], 0.f); v0[j] = a * a; v1[j] = b * b; }
                    }
                    u32x4 w; w.x = cvtpk(v0[0], v0[1]); w.y = cvtpk(v0[2], v0[3]); w.z = cvtpk(v1[0], v1[1]); w.w = cvtpk(v1[2], v1[3]);
                    *(u32x4*)(rowp + bj * 128) = w;
                }
            }
    } else if constexpr (EPI == E_INPROJ) {
        const int lc0 = wc * 32 + 8 * fq;
        const int pn = u.pn;
        const int hseg = (pn >= 4) ? ((pn - 4) >> 2) : 9;
        f32x4 lbv[2][2];
        if (hseg == 1 || hseg == 2) {
            const float* lbt = (const float*)(kp->ws + OFF_LB) + (hseg - 1) * 1024 + ((pn - 4) & 3) * 256 + lc0;
#pragma unroll
            for (int bj = 0; bj < 2; ++bj) { lbv[bj][0] = *(const f32x4*)(lbt + bj * 128); lbv[bj][1] = *(const f32x4*)(lbt + bj * 128 + 4); }
        } else {
#pragma unroll
            for (int bj = 0; bj < 2; ++bj) { lbv[bj][0] = (f32x4){0.f, 0.f, 0.f, 0.f}; lbv[bj][1] = lbv[bj][0]; }
        }
        float rsv[2][4];
#pragma unroll
        for (int ai = 0; ai < 2; ++ai)
#pragma unroll
            for (int m = 0; m < 4; ++m) rsv[ai][m] = __builtin_amdgcn_rsqf(ssq_val(g.ssq_in[row0 + ai * 128 + m * 16]) * g.inv_dim + EPS);
#pragma unroll
        for (int ai = 0; ai < 2; ++ai)
#pragma unroll
            for (int m = 0; m < 4; ++m) {
                const int row = row0 + ai * 128 + m * 16;
                const float rs = rsv[ai][m];
                float ss = 0.f;
#pragma unroll
                for (int bj = 0; bj < 2; ++bj) {
                    f32x4 v0 = acc[ai][bj][m][0] * rs, v1 = acc[ai][bj][m][1] * rs;
                    if (hseg == 0) {
#pragma unroll
                        for (int j = 0; j < 4; ++j) { v0[j] = v0[j] * __builtin_amdgcn_rcpf(1.f + __expf(-v0[j])) * 0.08838834764831845f; v1[j] = v1[j] * __builtin_amdgcn_rcpf(1.f + __expf(-v1[j])) * 0.08838834764831845f; }
                    } else if (hseg == 1 || hseg == 2) {
#pragma unroll
                        for (int j = 0; j < 4; ++j) {
                            const float l0 = lbv[bj][0][j], l1 = lbv[bj][1][j];
                            v0[j] = __logf(l0 + (1.f - l0) * __builtin_amdgcn_rcpf(1.f + __expf(-fmaxf(v0[j], -80.f))));
                            v1[j] = __logf(l1 + (1.f - l1) * __builtin_amdgcn_rcpf(1.f + __expf(-fmaxf(v1[j], -80.f))));
                        }
                    }
                    u32x4 w; w.x = cvtpk(v0[0], v0[1]); w.y = cvtpk(v0[2], v0[3]); w.z = cvtpk(v1[0], v1[1]); w.w = cvtpk(v1[2], v1[3]);
                    const int lc = lc0 + bj * 128;
                    if (pn < 3) {
                        *(u32x4*)(g.out + (long)row * 768 + pn * 256 + lc) = w;
                        ss += (v0[0] * v0[0] + v0[1] * v0[1]) + (v0[2] * v0[2] + v0[3] * v0[3]) + (v1[0] * v1[0] + v1[1] * v1[1]) + (v1[2] * v1[2] + v1[3] * v1[3]);
                    } else if (pn == 3) {
                        if (lc < 64) *(u32x4*)(g.out2 + (long)row * 64 + lc) = w;
                    } else {
                        *(u32x4*)(g.out3 + (long)row * HGW + (pn - 4) * 256 + lc) = w;
                    }
                }
                if (pn < 3) {
                    ss += __shfl_xor(ss, 16); ss += __shfl_xor(ss, 32);
                    if (fq == 0) atomic_addf((pn < 2 ? g.ssq_out : g.ssq_out2) + row, ss);
                }
            }
    } else if constexpr (EPI == E_RESID) {
        const int col0 = u.pn * 256 + wc * 32 + 8 * fq;
#pragma unroll
        for (int ai = 0; ai < 2; ++ai) {
            f32x4 rv[4][2][2];
#pragma unroll
            for (int m = 0; m < 4; ++m)
#pragma unroll
                for (int bj = 0; bj < 2; ++bj)
#pragma unroll
                    for (int n = 0; n < 2; ++n) rv[m][bj][n] = *(const f32x4*)(g.resid + (long)(row0 + ai * 128 + m * 16) * DM + col0 + bj * 128 + n * 4);
#pragma unroll
            for (int m = 0; m < 4; ++m) {
                const int row = row0 + ai * 128 + m * 16;
                float ss = 0.f;
#pragma unroll
                for (int bj = 0; bj < 2; ++bj) {
                    const long o = (long)row * DM + col0 + bj * 128;
                    const f32x4 v0 = rv[m][bj][0] + acc[ai][bj][m][0], v1 = rv[m][bj][1] + acc[ai][bj][m][1];
                    *(f32x4*)(g.xout + o) = v0; *(f32x4*)(g.xout + o + 4) = v1;
                    u32x4 w; w.x = cvtpk(v0[0], v0[1]); w.y = cvtpk(v0[2], v0[3]); w.z = cvtpk(v1[0], v1[1]); w.w = cvtpk(v1[2], v1[3]);
                    *(u32x4*)(g.xb + o) = w;
                    ss += (v0[0] * v0[0] + v0[1] * v0[1]) + (v0[2] * v0[2] + v0[3] * v0[3]) + (v1[0] * v1[0] + v1[1] * v1[1]) + (v1[2] * v1[2] + v1[3] * v1[3]);
                }
                ss += __shfl_xor(ss, 16); ss += __shfl_xor(ss, 32);
                if (fq == 0) atomic_addf(g.ssq_out + row, ss);
            }
        }
    } else {
        LAS float* smax = (LAS float*)(lds + LDS_EPI);
        LAS float* ssum = (LAS float*)(lds + LDS_EPI + 4096);
        const float C = 0.044194173824159216f * 1.4426950408889634f;
#pragma unroll
        for (int ai = 0; ai < 2; ++ai)
#pragma unroll
            for (int m = 0; m < 4; ++m) {
                __builtin_amdgcn_sched_barrier(0);
                float t = -3.0e38f;
#pragma unroll
                for (int bj = 0; bj < 2; ++bj)
#pragma unroll
                    for (int n = 0; n < 2; ++n)
#pragma unroll
                        for (int j = 0; j < 4; ++j) t = fmaxf(t, acc[ai][bj][m][n][j]);
                t = fmaxf(t, __shfl_xor(t, 16)); t = fmaxf(t, __shfl_xor(t, 32));
                if (fq == 0) smax[(ai * 128 + wr * 64 + m * 16 + fr) * 4 + wc] = t;
            }
        asm volatile("s_waitcnt lgkmcnt(0)" ::: "memory"); __builtin_amdgcn_s_barrier(); asm volatile("" ::: "memory");
#pragma unroll
        for (int ai = 0; ai < 2; ++ai)
#pragma unroll
            for (int m = 0; m < 4; ++m) {
                __builtin_amdgcn_sched_barrier(0);
                const int rl = ai * 128 + wr * 64 + m * 16 + fr;
                const f32x4 q = *(LAS f32x4*)(smax + rl * 4);
                const float mm = fmaxf(fmaxf(q[0], q[1]), fmaxf(q[2], q[3])) * C;
                float s = 0.f;
#pragma unroll
                for (int bj = 0; bj < 2; ++bj)
#pragma unroll
                    for (int n = 0; n < 2; ++n)
#pragma unroll
                        for (int j = 0; j < 4; ++j) { const float e = __builtin_amdgcn_exp2f(acc[ai][bj][m][n][j] * C - mm); acc[ai][bj][m][n][j] = e; s += e; }
                s += __shfl_xor(s, 16); s += __shfl_xor(s, 32);
                if (fq == 0) ssum[rl * 4 + wc] = s;
            }
        asm volatile("s_waitcnt lgkmcnt(0)" ::: "memory"); __builtin_amdgcn_s_barrier(); asm volatile("" ::: "memory");
        const int col0 = wc * 32 + 8 * fq;
#pragma unroll
        for (int ai = 0; ai < 2; ++ai)
#pragma unroll
            for (int m = 0; m < 4; ++m) {
                __builtin_amdgcn_sched_barrier(0);
                const int rl = ai * 128 + wr * 64 + m * 16 + fr;
                const f32x4 q = *(LAS f32x4*)(ssum + rl * 4);
                const float inv = 1.0f / ((q[0] + q[1]) + (q[2] + q[3]));
                bf16_t* rowp = g.out + (long)(u.pm * 256 + rl) * g.ldo + u.z * 256 + col0;
#pragma unroll
                for (int bj = 0; bj < 2; ++bj) {
                    const f32x4 v0 = acc[ai][bj][m][0] * inv, v1 = acc[ai][bj][m][1] * inv;
                    u32x4 w; w.x = cvtpk(v0[0], v0[1]); w.y = cvtpk(v0[2], v0[3]); w.z = cvtpk(v1[0], v1[1]); w.w = cvtpk(v1[2], v1[3]);
                    *(u32x4*)(rowp + bj * 128) = w;
                }
            }
    }
}

template <int EPI> __device__ __forceinline__ void gemm_phase(LAS unsigned char* lds, const Params* kp, int tr, int l, int k, int gi, int G, int cblk) {
    using namespace pg8;
    int Kdim, lda_, ldb_, perm_;
    { GemmDesc g0; if (!make_gemm(*kp, tr, l, k, gi, g0)) return; Kdim = g0.K; lda_ = g0.lda; ldb_ = g0.ldb; perm_ = g0.perm; }
    const int tid = ltid(), wid = __builtin_amdgcn_readfirstlane(tid >> 6), lane = tid & 63, wr = wid >> 2, wc = wid & 3, fr = lane & 15, fq = lane >> 4;
    const int K = Kdim, nt = K / BK;
    unsigned voffA[2], voffB[2];
#pragma unroll
    for (int i = 0; i < 2; ++i) { int R, C; stage_rc(tid * 16 + i * 8192, R, C); const int Rb = perm_ ? ((R & ~31) + perm32(R & 31)) : R;
        voffA[i] = (unsigned)(R * lda_ + C) * 2u; voffB[i] = (unsigned)(Rb * ldb_ + C) * 2u; }
    const size_t kstep = (size_t)(BK * 2);
    const size_t hstepA = (size_t)HALF * lda_ * 2, hstepB = (size_t)HALF * ldb_ * 2;
    const unsigned ldsw = (unsigned)wid * 1024u;
    const int aoff = lds_byte(wr * 64 + fr, fq * 8), boff = lds_byte(wc * 32 + fr, fq * 8);
#define PG8_SA(b, h) (((b) * 2 + (h)) * HTB)
#define PG8_SB(b, h) ((4 + (b) * 2 + (h)) * HTB)
#define PG8_STAGE(bufoff, gbase, voff) do { _Pragma("unroll") for (int _i = 0; _i < 2; ++_i) \
        __builtin_amdgcn_global_load_lds((const unsigned*)((const char*)(gbase) + (voff)[_i]), (LAS unsigned*)(lds + (bufoff) + ldsw + _i * 8192), 16, 0, 0); } while (0)
#define PG8_LDA(dst, b, h) do { _Pragma("unroll") for (int m = 0; m < 4; ++m) _Pragma("unroll") for (int k = 0; k < 2; ++k) dst[m][k] = *(const LAS bf16x8*)(lds + PG8_SA(b, h) + aoff + m * 2048 + k * 1024); } while (0)
#define PG8_LDB(dst, b, h) do { _Pragma("unroll") for (int n = 0; n < 2; ++n) _Pragma("unroll") for (int k = 0; k < 2; ++k) dst[n][k] = *(const LAS bf16x8*)(lds + PG8_SB(b, h) + boff + n * 2048 + k * 1024); } while (0)
#define PG8_MMA(ai, bj, At, Bt) do { __builtin_amdgcn_s_setprio(1); _Pragma("unroll") for (int m = 0; m < 4; ++m) _Pragma("unroll") for (int n = 0; n < 2; ++n) _Pragma("unroll") for (int k = 0; k < 2; ++k) \
        acc[ai][bj][m][n] = __builtin_amdgcn_mfma_f32_16x16x32_bf16(Bt[n][k], At[m][k], acc[ai][bj][m][n], 0, 0, 0); __builtin_amdgcn_s_setprio(0); } while (0)
#define PG8_WAIT_V(n) asm volatile("s_waitcnt vmcnt(" #n ")" ::: "memory")
#define PG8_WAIT_L(n) asm volatile("s_waitcnt lgkmcnt(" #n ")" ::: "memory")
#define PG8_BAR __builtin_amdgcn_s_barrier()
#define PG8_SCHED __builtin_amdgcn_sched_barrier(0)
    Unit cur, nxt; int ui = 0;
    if (!next_unit(kp, tr, l, k, gi, 0, G, cblk, cur)) return;
    f32x4 acc[2][2][4][2];
#pragma unroll
    for (int a = 0; a < 2; ++a)
#pragma unroll
        for (int b = 0; b < 2; ++b)
#pragma unroll
            for (int m = 0; m < 4; ++m)
#pragma unroll
                for (int n = 0; n < 2; ++n) acc[a][b][m][n] = (f32x4){0.f, 0.f, 0.f, 0.f};
    bf16x8 At[4][2], B0[2][2], B1[2][2];
    const char* cA = cur.a; const char* cB = cur.b;
    PG8_STAGE(PG8_SB(0, 0), cB, voffB); PG8_STAGE(PG8_SA(0, 0), cA, voffA); PG8_STAGE(PG8_SB(0, 1), cB + hstepB, voffB); PG8_STAGE(PG8_SA(0, 1), cA + hstepA, voffA);
    if (wr == 1) PG8_BAR;
    PG8_WAIT_V(4); PG8_BAR;
    PG8_STAGE(PG8_SB(1, 0), cB + kstep, voffB); PG8_STAGE(PG8_SA(1, 0), cA + kstep, voffA); PG8_STAGE(PG8_SB(1, 1), cB + hstepB + kstep, voffB);
    PG8_WAIT_V(6); PG8_BAR;
    for (;;) {
        const bool has_next = next_unit(kp, tr, l, k, gi, ui + 1, G, cblk, nxt);
        const char* nA = has_next ? nxt.a : cA; const char* nB = has_next ? nxt.b : cB;
        for (int t = 0; t < nt; t += 2) {
            const bool last = (t == nt - 2);
            const char* a1 = cA + (size_t)(t + 1) * kstep;
            const char* a2 = last ? nA : cA + (size_t)(t + 2) * kstep; const char* b2 = last ? nB : cB + (size_t)(t + 2) * kstep;
            const char* a3 = a2 + kstep; const char* b3 = b2 + kstep;
            PG8_LDB(B0, 0, 0); PG8_SCHED; PG8_LDA(At, 0, 0); PG8_STAGE(PG8_SA(1, 1), a1 + hstepA, voffA);
            PG8_WAIT_L(8); PG8_BAR; PG8_WAIT_L(0); PG8_MMA(0, 0, At, B0); PG8_BAR; PG8_SCHED;
            PG8_LDB(B1, 0, 1); PG8_STAGE(PG8_SB(0, 0), b2, voffB);
            PG8_BAR; PG8_WAIT_L(0); PG8_MMA(0, 1, At, B1); PG8_BAR;
            PG8_LDA(At, 0, 1); PG8_STAGE(PG8_SA(0, 0), a2, voffA);
            PG8_BAR; PG8_WAIT_L(0); PG8_MMA(1, 0, At, B0); PG8_BAR; PG8_SCHED;
            PG8_STAGE(PG8_SB(0, 1), b2 + hstepB, voffB);
            PG8_WAIT_V(6); PG8_BAR; PG8_MMA(1, 1, At, B1); PG8_BAR;
            PG8_LDB(B0, 1, 0); PG8_SCHED; PG8_LDA(At, 1, 0); PG8_STAGE(PG8_SA(0, 1), a2 + hstepA, voffA);
            PG8_WAIT_L(8); PG8_BAR; PG8_WAIT_L(0); PG8_MMA(0, 0, At, B0); PG8_BAR; PG8_SCHED;
            PG8_LDB(B1, 1, 1); PG8_STAGE(PG8_SB(1, 0), b3, voffB);
            PG8_BAR; PG8_WAIT_L(0); PG8_MMA(0, 1, At, B1); PG8_BAR;
            PG8_LDA(At, 1, 1); PG8_STAGE(PG8_SA(1, 0), a3, voffA);
            PG8_BAR; PG8_WAIT_L(0); PG8_MMA(1, 0, At, B0); PG8_BAR; PG8_SCHED;
            PG8_STAGE(PG8_SB(1, 1), b3 + hstepB, voffB);
            PG8_WAIT_V(6); PG8_BAR; PG8_MMA(1, 1, At, B1); PG8_BAR;
        }
        gemm_epilogue<EPI>(kp, tr, l, k, gi, acc, cur, lds);
        if (!has_next) break;
#pragma unroll
        for (int a = 0; a < 2; ++a)
#pragma unroll
            for (int b = 0; b < 2; ++b)
#pragma unroll
                for (int m = 0; m < 4; ++m)
#pragma unroll
                    for (int n = 0; n < 2; ++n) acc[a][b][m][n] = (f32x4){0.f, 0.f, 0.f, 0.f};
        cur = nxt; cA = nA; cB = nB; ++ui;
    }
    PG8_WAIT_V(0);
    if (wr == 0) PG8_BAR;
    PG8_BAR;
#undef PG8_SA
#undef PG8_SB
#undef PG8_STAGE
#undef PG8_LDA
#undef PG8_LDB
#undef PG8_MMA
#undef PG8_WAIT_V
#undef PG8_WAIT_L
#undef PG8_BAR
#undef PG8_SCHED
}

namespace att {
constexpr int NW = 8, QBLK = 32, KVBLK = 64;
constexpr float SCALE = 0.07216878364870322f;
constexpr float THR = 8.f;
constexpr int LDQ = 1536, LDK = 2048, LDKR = 64, LDO = 2048;
constexpr int SHM_V = KVBLK * 128 * 2, SHM_K = KVBLK * 128 * 2, SHM_KR = KVBLK * 64 * 2;
#define KSWZ(row, colB) ((row) * 256 + ((colB) ^ (((row) & 7) << 4)))
#define KRSWZ(row, colB) ((row) * 128 + ((colB) ^ (((row) & 7) << 4)))
#define SBAR() __builtin_amdgcn_sched_barrier(0)
__device__ __forceinline__ int crow(int r, int hi) { return (r & 3) + 8 * (r >> 2) + 4 * hi; }
__device__ __forceinline__ void partialSM(f32x16& p0, f32x16& p1, float& m_reg, float& mn, float& alpha) {
    constexpr float C = SCALE * 1.4426950408889634f;
    float pmax = p0[0];
#pragma unroll
    for (int r = 1; r < 16; ++r) pmax = fmaxf(pmax, p0[r]);
#pragma unroll
    for (int r = 0; r < 16; ++r) pmax = fmaxf(pmax, p1[r]);
    { auto rr = __builtin_amdgcn_permlane32_swap(__float_as_uint(pmax), __float_as_uint(pmax), false, false);
      pmax = fmaxf(__uint_as_float(rr[0]), __uint_as_float(rr[1])); }
    if (__builtin_expect(__all(pmax - m_reg <= THR / SCALE), 1)) { mn = m_reg; alpha = 1.f; }
    else { mn = fmaxf(m_reg, pmax); alpha = __builtin_amdgcn_exp2f((m_reg - mn) * C); m_reg = mn; }
    float mnC = -mn * C;
#pragma unroll
    for (int r = 0; r < 16; ++r) p0[r] = fmaf(p0[r], C, mnC);
#pragma unroll
    for (int r = 0; r < 16; ++r) p1[r] = fmaf(p1[r], C, mnC);
#pragma unroll
    for (int r = 0; r < 16; ++r) p0[r] = __builtin_amdgcn_exp2f(p0[r]);
}
__device__ __forceinline__ void finishSM(f32x16& p0, f32x16& p1, float alpha, float& l_reg, bf16x8& pa0, bf16x8& pa1, bf16x8& pa2, bf16x8& pa3) {
#pragma unroll
    for (int r = 0; r < 16; ++r) p1[r] = __builtin_amdgcn_exp2f(p1[r]);
    float ps = 0;
#pragma unroll
    for (int r = 0; r < 16; ++r) ps += p0[r];
#pragma unroll
    for (int r = 0; r < 16; ++r) ps += p1[r];
    { auto rr = __builtin_amdgcn_permlane32_swap(__float_as_uint(ps), __float_as_uint(ps), false, false);
      ps = __uint_as_float(rr[0]) + __uint_as_float(rr[1]); }
    l_reg = l_reg * alpha + ps;
#define PK4(P, BASE, OUT) do { unsigned a0 = cvtpk(P[BASE + 0], P[BASE + 1]), a1 = cvtpk(P[BASE + 2], P[BASE + 3]);   \
    unsigned b0 = cvtpk(P[BASE + 4], P[BASE + 5]), b1 = cvtpk(P[BASE + 6], P[BASE + 7]);                              \
    auto r0 = __builtin_amdgcn_permlane32_swap(a0, b0, false, false); auto r1 = __builtin_amdgcn_permlane32_swap(a1, b1, false, false); \
    u32x4 w = {r0[0], r1[0], r0[1], r1[1]}; OUT = *reinterpret_cast<bf16x8*>(&w); } while (0)
    PK4(p0, 0, pa0); PK4(p0, 8, pa1); PK4(p1, 0, pa2); PK4(p1, 8, pa3);
#undef PK4
}
__device__ __forceinline__ void qkt(f32x16& p0, f32x16& p1, const char* Ks, const char* Krs, const bf16x8* qr, const char* qrl, int r32, int hi) {
    p0 = f32x16{}; p1 = f32x16{};
#pragma unroll
    for (int d0 = 0; d0 < 8; ++d0) { int cb = (d0 * 16 + hi * 8) * 2;
        bf16x8 b0 = *reinterpret_cast<const bf16x8*>(Ks + KSWZ(r32, cb));
        bf16x8 b1 = *reinterpret_cast<const bf16x8*>(Ks + KSWZ(32 + r32, cb));
        p0 = __builtin_amdgcn_mfma_f32_32x32x16_bf16(b0, qr[d0], p0, 0, 0, 0);
        p1 = __builtin_amdgcn_mfma_f32_32x32x16_bf16(b1, qr[d0], p1, 0, 0, 0); }
#pragma unroll
    for (int d0 = 0; d0 < 4; ++d0) { int cb = (d0 * 16 + hi * 8) * 2;
        bf16x8 b0 = *reinterpret_cast<const bf16x8*>(Krs + KRSWZ(r32, cb));
        bf16x8 b1 = *reinterpret_cast<const bf16x8*>(Krs + KRSWZ(32 + r32, cb));
        const bf16x8 qv = *reinterpret_cast<const bf16x8*>(qrl + d0 * 8192);
        p0 = __builtin_amdgcn_mfma_f32_32x32x16_bf16(b0, qv, p0, 0, 0, 0);
        p1 = __builtin_amdgcn_mfma_f32_32x32x16_bf16(b1, qv, p1, 0, 0, 0); }
}
__device__ __forceinline__ int v_st(int k, int c) { const int kk = (k & ~0xC) | ((k & 4) << 1) | ((k & 8) >> 1); return ((kk >> 3) * 4 + (c >> 5)) * 512 + ((kk & 7) * 32 + (c & 31)) * 2; }
__device__ __forceinline__ int v_rd_base(int lane) { return ((lane & 3) << 3) | (((lane >> 2) & 3) << 6) | (((lane >> 4) & 1) << 5) | (((lane >> 5) & 1) << 8); }
constexpr int v_rd_off(int d0, int ks, int half) { return d0 * 512 + ks * 4096 + half * 2048; }
template <int OFF> __device__ __forceinline__ s16x4 tr_read(int vb) {
    s16x4 r; asm volatile("ds_read_b64_tr_b16 %0, %1 offset:%2" : "=&v"(r) : "v"(vb), "i"(OFF) : "memory"); return r;
}
template <int D0> __device__ __forceinline__ void pv_one(f32x16& od, int vb, bf16x8 pa0, bf16x8 pa1, bf16x8 pa2, bf16x8 pa3) {
    const s16x4 l0 = tr_read<v_rd_off(D0, 0, 0)>(vb), h0 = tr_read<v_rd_off(D0, 0, 1)>(vb), l1 = tr_read<v_rd_off(D0, 1, 0)>(vb), h1 = tr_read<v_rd_off(D0, 1, 1)>(vb);
    const s16x4 l2 = tr_read<v_rd_off(D0, 2, 0)>(vb), h2 = tr_read<v_rd_off(D0, 2, 1)>(vb), l3 = tr_read<v_rd_off(D0, 3, 0)>(vb), h3 = tr_read<v_rd_off(D0, 3, 1)>(vb);
    asm volatile("s_waitcnt lgkmcnt(0)" ::: "memory"); SBAR();
#define PK(L, H) (bf16x8){L[0], L[1], L[2], L[3], H[0], H[1], H[2], H[3]}
    od = __builtin_amdgcn_mfma_f32_32x32x16_bf16(pa0, PK(l0, h0), od, 0, 0, 0);
    od = __builtin_amdgcn_mfma_f32_32x32x16_bf16(pa1, PK(l1, h1), od, 0, 0, 0);
    od = __builtin_amdgcn_mfma_f32_32x32x16_bf16(pa2, PK(l2, h2), od, 0, 0, 0);
    od = __builtin_amdgcn_mfma_f32_32x32x16_bf16(pa3, PK(l3, h3), od, 0, 0, 0);
#undef PK
}
__device__ __forceinline__ void pv_d0(f32x16* o, int vb, bf16x8 pa0, bf16x8 pa1, bf16x8 pa2, bf16x8 pa3) {
    pv_one<0>(o[0], vb, pa0, pa1, pa2, pa3); pv_one<1>(o[1], vb, pa0, pa1, pa2, pa3); pv_one<2>(o[2], vb, pa0, pa1, pa2, pa3); pv_one<3>(o[3], vb, pa0, pa1, pa2, pa3);
}

__device__ __forceinline__ void attn_body(const bf16_t* __restrict__ Qb, const bf16_t* __restrict__ Kh, const bf16_t* __restrict__ Kr,
                                          bf16_t* __restrict__ Ob, int ml_off, int seq, char* lds) {
    const int tid = ltid(), wid = tid >> 6, lane = tid & 63, r32 = lane & 31, hi = lane >> 5;
    char* V_lds = lds; char* K_lds = lds + 2 * SHM_V; char* KR_lds = lds + 2 * SHM_V + 2 * SHM_K;
    float* ws = (float*)(lds + 2 * SHM_V + 2 * SHM_K + 2 * SHM_KR) + wid * 64; float* li_l = ws; float* al_l = ws + 32;
    float m_reg = -1e30f, l_reg = 0; f32x16 o[4] = {}; bf16x8 qr[8];
    const bf16_t* Qw = Qb + (long)(wid * QBLK + r32) * LDQ + hi * 8;
#pragma unroll
    for (int d0 = 0; d0 < 8; ++d0) qr[d0] = *reinterpret_cast<const bf16x8*>(Qw + d0 * 16);
    char* qrl = lds + 84 * 1024 + tid * 16;
#pragma unroll
    for (int d0 = 0; d0 < 4; ++d0) *reinterpret_cast<bf16x8*>(qrl + d0 * 8192) = *reinterpret_cast<const bf16x8*>(Qw + (8 + d0) * 16);
    const int sr = tid >> 4, sc = (tid & 15) * 8, vst0 = v_st(sr, sc), vst1 = v_st(32 + sr, sc);
    const int krr = tid >> 3, krc = (tid & 7) * 8;
    const int vb0 = (int)(uintptr_t)V_lds + v_rd_base(lane);
    bf16x8 s_vs0, s_vs1, s_ks0, s_ks1, s_kr;
#define SLOAD(k0) do { s_vs0 = *reinterpret_cast<const bf16x8*>(&Kh[(long)((k0) + sr) * LDK + sc + 128]); s_vs1 = *reinterpret_cast<const bf16x8*>(&Kh[(long)((k0) + 32 + sr) * LDK + sc + 128]); \
    s_ks0 = *reinterpret_cast<const bf16x8*>(&Kh[(long)((k0) + sr) * LDK + sc]); s_ks1 = *reinterpret_cast<const bf16x8*>(&Kh[(long)((k0) + 32 + sr) * LDK + sc]); \
    s_kr = *reinterpret_cast<const bf16x8*>(&Kr[(long)((k0) + krr) * LDKR + krc]); } while (0)
#define SWRITE(b) do { *(bf16x8*)(V_lds + (b) * SHM_V + vst0) = s_vs0; *(bf16x8*)(V_lds + (b) * SHM_V + vst1) = s_vs1; int kc = sc * 2;   \
    *(bf16x8*)(K_lds + (b) * SHM_K + KSWZ(sr, kc)) = s_ks0; *(bf16x8*)(K_lds + (b) * SHM_K + KSWZ(32 + sr, kc)) = s_ks1;                  \
    *(bf16x8*)(KR_lds + (b) * SHM_KR + KRSWZ(krr, krc * 2)) = s_kr; } while (0)
#define SWAIT() asm volatile("s_waitcnt vmcnt(0)" ::: "memory")
#define RESC(a) do { if (__any((a) < 1.f)) { if (hi == 0) al_l[r32] = (a); asm volatile("s_waitcnt lgkmcnt(0)" ::: "memory"); \
    _Pragma("unroll") for (int d = 0; d < 4; ++d) _Pragma("unroll") for (int r = 0; r < 16; ++r) o[d][r] *= al_l[crow(r, hi)]; } } while (0)
    f32x16 pA0, pA1, pB0, pB1; float mnA, mnB, alA, alB; bf16x8 pa0, pa1, pa2, pa3; const int NT = seq / KVBLK;
    SLOAD(0); SWAIT(); SWRITE(0); __syncthreads();
    qkt(pA0, pA1, K_lds, KR_lds, qr, qrl, r32, hi); partialSM(pA0, pA1, m_reg, mnA, alA);
    SLOAD(KVBLK);
    SWAIT(); SWRITE(1); __syncthreads();
    for (int j = 1; j + 1 < NT; j += 2) {
        SBAR(); qkt(pB0, pB1, K_lds + SHM_K, KR_lds + SHM_KR, qr, qrl, r32, hi);
        finishSM(pA0, pA1, alA, l_reg, pa0, pa1, pa2, pa3); SBAR();
        SLOAD((j + 1) * KVBLK); SBAR();
        pv_d0(o, vb0, pa0, pa1, pa2, pa3); partialSM(pB0, pB1, m_reg, mnB, alB);
        __syncthreads(); SWAIT(); SWRITE(0);
        RESC(alB); __syncthreads();
        SBAR(); qkt(pA0, pA1, K_lds, KR_lds, qr, qrl, r32, hi);
        finishSM(pB0, pB1, alB, l_reg, pa0, pa1, pa2, pa3); SBAR();
        SLOAD((j + 2) * KVBLK); SBAR();
        pv_d0(o, vb0 + (int)SHM_V, pa0, pa1, pa2, pa3); partialSM(pA0, pA1, m_reg, mnA, alA);
        __syncthreads(); SWAIT(); SWRITE(1);
        RESC(alA); __syncthreads();
    }
    SBAR(); qkt(pB0, pB1, K_lds + SHM_K, KR_lds + SHM_KR, qr, qrl, r32, hi);
    finishSM(pA0, pA1, alA, l_reg, pa0, pa1, pa2, pa3); SBAR();
    pv_d0(o, vb0, pa0, pa1, pa2, pa3); partialSM(pB0, pB1, m_reg, mnB, alB);
    __syncthreads(); RESC(alB);
    finishSM(pB0, pB1, alB, l_reg, pa0, pa1, pa2, pa3); SBAR();
    pv_d0(o, vb0 + (int)SHM_V, pa0, pa1, pa2, pa3);
    if (hi == 0) li_l[r32] = l_reg; asm volatile("s_waitcnt lgkmcnt(0)" ::: "memory");
    if (ml_off >= 0 && hi == 0) {
        const Params* kpa = (const Params*)__builtin_amdgcn_kernarg_segment_ptr(); asm volatile("" : "+s"(kpa));
        float* d = (float*)(kpa->ws + OFF_XB + 2048) + ml_off + (wid * QBLK + r32) * 1024; d[0] = m_reg; d[1] = l_reg; }
    float rli[16];
#pragma unroll
    for (int r = 0; r < 16; ++r) rli[r] = __builtin_amdgcn_rcpf(li_l[crow(r, hi)]);
    bf16_t* Ow = Ob + (long)(wid * QBLK) * LDO;
#pragma unroll
    for (int r = 0; r < 16; ++r) { int orow = crow(r, hi);
#pragma unroll
        for (int d0 = 0; d0 < 4; ++d0) Ow[(long)orow * LDO + d0 * 32 + r32] = f2bf(o[d0][r] * rli[r]); }
    __syncthreads();
#undef SLOAD
#undef SWRITE
#undef SWAIT
#undef RESC
}
}

namespace hg {
constexpr int LD = 136, LDT = 72;
constexpr int O_RZ = 0, O_RQ = O_RZ + 64 * LD * 2, O_RV = O_RQ + 64 * LD * 2, O_QD = O_RV + 64 * LD * 2, O_KD = O_QD + 64 * LD * 2,
              O_KDT = O_KD + 64 * LD * 2, O_VT = O_KDT + 128 * LDT * 2, O_P = O_VT + 128 * LDT * 2, O_SEG = O_P + 64 * LDT * 2, O_EV = O_SEG + 4 * 128 * 4, O_END = O_EV + 3 * 128 * 4;
static_assert(O_END <= LDS_BCAST, "hgrn LDS");
__device__ __forceinline__ float clampf(float x, float lo, float hi) { return fminf(fmaxf(x, lo), hi); }

__device__ __forceinline__ void hgrn_unit(LAS unsigned char* lds, bf16_t* hgb  , const float* lb_logits, int layer, int S, int unit) {
    const int tid = ltid(), wid = tid >> 6, lane = tid & 63, l15 = lane & 15, quad = lane >> 4;
    const int dir = unit & 1, h = (unit >> 1) & 7, b = unit >> 4;
    const int qcol = h * 128, zcol = (dir ? 2048 : 1024) + h * 128, vcol = 3072 + h * 128;
    const int ch = tid & 127, seg = tid >> 7;
    LAS bf16_t* RZ = (LAS bf16_t*)(lds + O_RZ); LAS bf16_t* RQ = (LAS bf16_t*)(lds + O_RQ); LAS bf16_t* RV = (LAS bf16_t*)(lds + O_RV);
    LAS bf16_t* QD = (LAS bf16_t*)(lds + O_QD); LAS bf16_t* KD = (LAS bf16_t*)(lds + O_KD); LAS bf16_t* KDT = (LAS bf16_t*)(lds + O_KDT);
    LAS bf16_t* VT = (LAS bf16_t*)(lds + O_VT); LAS bf16_t* PP = (LAS bf16_t*)(lds + O_P);
    LAS float* SEG = (LAS float*)(lds + O_SEG); LAS float* EV = (LAS float*)(lds + O_EV);
    const int n = S / 64;
    const int r0 = tid >> 4, c8 = (tid & 15) * 8;
    bf16x8 pz0, pz1, pq0, pq1, pv0, pv1;
#define HG_ROW(c, tau) ((long)b * S + (dir ? (S - 1 - ((c) * 64 + (tau))) : ((c) * 64 + (tau))))
#define HG_LOAD(c) do { const bf16_t* ra = hgb + HG_ROW(c, r0) * HGW; const bf16_t* rb = hgb + HG_ROW(c, r0 + 32) * HGW; \
    pz0 = *(const bf16x8*)(ra + zcol + c8); pz1 = *(const bf16x8*)(rb + zcol + c8); pq0 = *(const bf16x8*)(ra + qcol + c8); pq1 = *(const bf16x8*)(rb + qcol + c8); \
    pv0 = *(const bf16x8*)(ra + vcol + c8); pv1 = *(const bf16x8*)(rb + vcol + c8); } while (0)
    f32x4 Sst[8];
#pragma unroll
    for (int i = 0; i < 8; ++i) Sst[i] = (f32x4){0.f, 0.f, 0.f, 0.f};
    HG_LOAD(0);
    for (int c = 0; c < n; ++c) {
        *(LAS bf16x8*)(RZ + r0 * LD + c8) = pz0; *(LAS bf16x8*)(RZ + (r0 + 32) * LD + c8) = pz1;
        *(LAS bf16x8*)(RQ + r0 * LD + c8) = pq0; *(LAS bf16x8*)(RQ + (r0 + 32) * LD + c8) = pq1;
        *(LAS bf16x8*)(RV + r0 * LD + c8) = pv0; *(LAS bf16x8*)(RV + (r0 + 32) * LD + c8) = pv1;
        asm volatile("s_waitcnt lgkmcnt(0)" ::: "memory"); __builtin_amdgcn_s_barrier(); asm volatile("" ::: "memory");
        if (c + 1 < n) HG_LOAD(c + 1);
        float bl[16], kk[16]; float run = 0.f;
#pragma unroll
        for (int i = 0; i < 16; ++i) {
            const float lf = bf2f(RZ[(seg * 16 + i) * LD + ch]);
            run += lf; bl[i] = run; kk[i] = 1.f - __expf(lf);
        }
        SEG[seg * 128 + ch] = run;
        asm volatile("s_waitcnt lgkmcnt(0)" ::: "memory"); __builtin_amdgcn_s_barrier(); asm volatile("" ::: "memory");
        const float t0 = SEG[ch], t1 = SEG[128 + ch], t2 = SEG[256 + ch], t3 = SEG[384 + ch];
        const float off = (seg > 0 ? t0 : 0.f) + (seg > 1 ? t1 : 0.f) + (seg > 2 ? t2 : 0.f);
        const float bref = t0 + t1, btot = (t0 + t1) + (t2 + t3);
        unsigned kdt[8], vtt[8];
#pragma unroll
        for (int i = 0; i < 16; ++i) {
            const int tau = seg * 16 + i;
            const float bb = bl[i] + off;
            const float eq = __expf(clampf(bb - bref, -80.f, 80.f)), ek = __builtin_amdgcn_rcpf(eq);
            const float sq = bf2f(RQ[tau * LD + ch]);
            QD[tau * LD + ch] = f2bf(sq * eq);
            const bf16_t kb = f2bf(kk[i] * ek);
            KD[tau * LD + ch] = kb;
            const bf16_t vb = RV[tau * LD + ch];
            if (i & 1) { kdt[i >> 1] |= ((unsigned)kb) << 16; vtt[i >> 1] |= ((unsigned)vb) << 16; } else { kdt[i >> 1] = kb; vtt[i >> 1] = vb; }
        }
        *(LAS u32x4*)(KDT + ch * LDT + seg * 16) = (u32x4){kdt[0], kdt[1], kdt[2], kdt[3]}; *(LAS u32x4*)(KDT + ch * LDT + seg * 16 + 8) = (u32x4){kdt[4], kdt[5], kdt[6], kdt[7]};
        *(LAS u32x4*)(VT + ch * LDT + seg * 16) = (u32x4){vtt[0], vtt[1], vtt[2], vtt[3]}; *(LAS u32x4*)(VT + ch * LDT + seg * 16 + 8) = (u32x4){vtt[4], vtt[5], vtt[6], vtt[7]};
        if (seg == 0) { EV[ch] = __expf(clampf(bref, -80.f, 80.f)); EV[128 + ch] = __expf(clampf(btot, -80.f, 80.f)); EV[256 + ch] = __expf(clampf(btot - bref, -80.f, 80.f)); }
        asm volatile("s_waitcnt lgkmcnt(0)" ::: "memory"); __builtin_amdgcn_s_barrier(); asm volatile("" ::: "memory");
#pragma unroll
        for (int tt = 0; tt < 2; ++tt) {
            const int ti = wid * 2 + tt, sblk = ti >> 2, tblk = ti & 3;
            f32x4 a = (f32x4){0.f, 0.f, 0.f, 0.f};
            if (sblk <= tblk) {
#pragma unroll
                for (int ks = 0; ks < 4; ++ks) {
                    const bf16x8 af = *(LAS bf16x8*)(KD + (sblk * 16 + l15) * LD + ks * 32 + quad * 8);
                    const bf16x8 bfr = *(LAS bf16x8*)(QD + (tblk * 16 + l15) * LD + ks * 32 + quad * 8);
                    a = __builtin_amdgcn_mfma_f32_16x16x32_bf16(af, bfr, a, 0, 0, 0);
                }
            }
            const int t = tblk * 16 + l15, s0 = sblk * 16 + quad * 4;
            u32x2 w; w.x = cvtpk(s0 + 0 <= t ? a[0] : 0.f, s0 + 1 <= t ? a[1] : 0.f); w.y = cvtpk(s0 + 2 <= t ? a[2] : 0.f, s0 + 3 <= t ? a[3] : 0.f);
            *(LAS u32x2*)(PP + t * LDT + s0) = w;
        }
        asm volatile("s_waitcnt lgkmcnt(0)" ::: "memory"); __builtin_amdgcn_s_barrier(); asm volatile("" ::: "memory");
        const int dv0 = wid * 16;
        bf16x8 bv[2];
#pragma unroll
        for (int ks = 0; ks < 2; ++ks) bv[ks] = *(LAS bf16x8*)(VT + (dv0 + l15) * LDT + ks * 32 + quad * 8);
        f32x4 o[4];
#pragma unroll
        for (int i = 0; i < 4; ++i) o[i] = (f32x4){0.f, 0.f, 0.f, 0.f};
#pragma unroll
        for (int k4 = 0; k4 < 4; ++k4) {
            const f32x4 er0 = *(LAS f32x4*)(EV + 32 * k4 + 4 * quad), er1 = *(LAS f32x4*)(EV + 32 * k4 + 16 + 4 * quad);
            const f32x4 s0 = Sst[2 * k4] * er0, s1 = Sst[2 * k4 + 1] * er1;
            u32x4 bw; bw.x = cvtpk(s0[0], s0[1]); bw.y = cvtpk(s0[2], s0[3]); bw.z = cvtpk(s1[0], s1[1]); bw.w = cvtpk(s1[2], s1[3]);
            const bf16x8 bfr = *reinterpret_cast<bf16x8*>(&bw);
#pragma unroll
            for (int tb = 0; tb < 4; ++tb) {
                const u32x2 a0 = *(LAS u32x2*)(QD + (tb * 16 + l15) * LD + 32 * k4 + 4 * quad);
                const u32x2 a1 = *(LAS u32x2*)(QD + (tb * 16 + l15) * LD + 32 * k4 + 16 + 4 * quad);
                u32x4 aw; aw.x = a0.x; aw.y = a0.y; aw.z = a1.x; aw.w = a1.y;
                o[tb] = __builtin_amdgcn_mfma_f32_16x16x32_bf16(*reinterpret_cast<bf16x8*>(&aw), bfr, o[tb], 0, 0, 0);
            }
        }
#pragma unroll
        for (int ks = 0; ks < 2; ++ks)
#pragma unroll
            for (int tb = 0; tb < 4; ++tb) {
                const bf16x8 af = *(LAS bf16x8*)(PP + (tb * 16 + l15) * LDT + ks * 32 + quad * 8);
                o[tb] = __builtin_amdgcn_mfma_f32_16x16x32_bf16(af, bv[ks], o[tb], 0, 0, 0);
            }
#pragma unroll
        for (int tb = 0; tb < 4; ++tb)
#pragma unroll
            for (int j = 0; j < 4; ++j) hgb[HG_ROW(c, tb * 16 + quad * 4 + j) * HGW + zcol + dv0 + l15] = f2bf(o[tb][j]);
#pragma unroll
        for (int db = 0; db < 8; ++db) {
            f32x4 tmp = (f32x4){0.f, 0.f, 0.f, 0.f};
#pragma unroll
            for (int ks = 0; ks < 2; ++ks) {
                const bf16x8 af = *(LAS bf16x8*)(KDT + (db * 16 + l15) * LDT + ks * 32 + quad * 8);
                tmp = __builtin_amdgcn_mfma_f32_16x16x32_bf16(af, bv[ks], tmp, 0, 0, 0);
            }
            const f32x4 et = *(LAS f32x4*)(EV + 128 + db * 16 + quad * 4), etr = *(LAS f32x4*)(EV + 256 + db * 16 + quad * 4);
            Sst[db] = Sst[db] * et + tmp * etr;
        }
    }
    wg_barrier();
#undef HG_ROW
#undef HG_LOAD
}
}

struct WDesc { const float* src; const float* gain; bf16_t* dst; int K, N, R, map; };

__device__ __forceinline__ void wcvt_phase(LAS unsigned char* lds, const Params& p, int layer) {
    LAS float* tile = (LAS float*)lds;
    const int tid = ltid();
    char* ws = p.ws;
    if (lbid() == 0) {
        float* lbt = (float*)(ws + OFF_LB);
        for (int i = tid; i < 2048; i += 512) {
            float mx = -3e38f; for (int l = 0; l < DEPTH; ++l) mx = fmaxf(mx, p.lb_logits[l * 2048 + i]);
            float den = 0.f, num = 0.f; for (int l = 0; l < DEPTH; ++l) { const float e = __expf(p.lb_logits[l * 2048 + i] - mx); den += e; if (l >= 1 && l <= layer) num += e; }
            lbt[i] = num / den;
        }
    }
    for (int mi = 0; mi < 10; ++mi) {
        WDesc d;
        switch (mi) {
        case 0: d = {p.w_in + (size_t)layer * 2048 * 5952, p.mix_norm + layer * 2048, (bf16_t*)(ws + OFF_W_IN), 2048, 5952, INP, 1}; break;
        case 1: d = {p.w_uq + (size_t)layer * 512 * 1536, p.q_norm + layer * 512, (bf16_t*)(ws + OFF_W_UQ), 512, 1536, 1536, 0}; break;
        case 2: d = {p.w_ukv + (size_t)layer * 256 * 2048, p.kv_norm + layer * 256, (bf16_t*)(ws + OFF_W_UKV), 256, 2048, 2048, 0}; break;
        case 3: d = {p.w_out + (size_t)layer * 2048 * 2048, nullptr, (bf16_t*)(ws + OFF_W_OUT), 2048, 2048, 2048, 0}; break;
        case 4: d = {p.w_xq + (size_t)layer * 2048 * 2048, p.xattn_norm + layer * 2048, (bf16_t*)(ws + OFF_W_XQ), 2048, 2048, 2048, 0}; break;
        case 5: d = {p.w_xk + (size_t)layer * 2048 * 2048, p.mem_norm + layer * 2048, (bf16_t*)(ws + OFF_W_XK), 2048, 2048, 2048, 0}; break;
        case 6: d = {p.w_xv + (size_t)layer * 2048 * 2048, p.mem_norm + layer * 2048, (bf16_t*)(ws + OFF_W_XV), 2048, 2048, 2048, 0}; break;
        case 7: d = {p.w_xo + (size_t)layer * 2048 * 2048, nullptr, (bf16_t*)(ws + OFF_W_XO), 2048, 2048, 2048, 0}; break;
        case 8: d = {p.w_ffn1 + (size_t)layer * 2048 * 8192, p.ffn_norm + layer * 2048, (bf16_t*)(ws + OFF_W_F1), 2048, 8192, 8192, 0}; break;
        default: d = {p.w_ffn2 + (size_t)layer * 8192 * 2048, nullptr, (bf16_t*)(ws + OFF_W_F2), 8192, 2048, 2048, 0}; break;
        }
        const int nkt = d.K / 64, nrt = d.R / 256, ntile = nkt * nrt;
        for (int t = lbid(); t < ntile; t += gridDim.x) {
            const int kt = t % nkt, rt = t / nkt, k0 = kt * 64, r0 = rt * 256;
            {
                const int c4 = tid & 63, rr = tid >> 6; const int col = r0 + 4 * c4;
                int sc = col; bool zero = false;
                if (d.map) { if (col < 832) sc = col; else if (col < 1024) zero = true; else sc = col - 192; }
#pragma unroll
                for (int ii = 0; ii < 8; ++ii) { const int i = rr + ii * 8;
                    f32x4 v = zero ? (f32x4){0.f, 0.f, 0.f, 0.f} : *(const f32x4*)(d.src + (size_t)(k0 + i) * d.N + sc);
                    if (d.gain) v = v * d.gain[k0 + i];
                    *(LAS f32x4*)(tile + i * 260 + 4 * c4) = v; }
            }
            wg_barrier();
            {
                const int n = tid >> 1, kh = (tid & 1) * 32;
#pragma unroll
                for (int j = 0; j < 4; ++j) {
                    unsigned w[4];
#pragma unroll
                    for (int e = 0; e < 8; e += 2) w[e >> 1] = cvtpk(tile[(kh + j * 8 + e) * 260 + n], tile[(kh + j * 8 + e + 1) * 260 + n]);
                    *(u32x4*)(d.dst + (size_t)(r0 + n) * d.K + k0 + kh + j * 8) = (u32x4){w[0], w[1], w[2], w[3]};
                }
            }
            wg_barrier();
        }
    }
}

__device__ __forceinline__ void prep_phase(const Params& p, int tr, int T, int S) {
    const size_t xb_off = tr ? OFF_XB : OFF_XB0;
    const int tid = ltid(), wid = tid >> 6, lane = tid & 63;
    char* ws = p.ws;
    const long gtid = (long)lbid() * 512 + tid, gstride = (long)gridDim.x * 512;
    { ssq_t* ssq = (ssq_t*)(ws + OFF_SSQ) + (size_t)tr * 11 * TMAX; for (long i = gtid; i < (long)10 * TMAX; i += gstride) ssq[TMAX + i] = 0ull;
      if (gtid < 64) ((unsigned*)(ws + OFF_CTR))[gtid] = 0u; }
    { float* rc = (float*)(ws + OFF_ROPE); float* rs = rc + 16384 * 32;
      for (int i = (int)gtid; i < S * 32; i += (int)gstride) { const int pos = i >> 5, f = i & 31;
          const float inv_freq = exp2f(-(float)f * (13.287712379549449f / 32.f));
          const float ang = (float)pos * inv_freq;
          const double rev = (double)ang * 0.15915494309189535; const float fr = (float)(rev - rint(rev));
          rc[i] = __builtin_amdgcn_cosf(fr); rs[i] = __builtin_amdgcn_sinf(fr); } }
    { const float* x = p.x_in[tr]; bf16_t* xb = (bf16_t*)(ws + xb_off); ssq_t* ssq0 = (ssq_t*)(ws + OFF_SSQ) + (size_t)tr * 11 * TMAX;
      for (int row = lbid() * 8 + wid; row < T; row += gridDim.x * 8) {
          float ss = 0.f;
#pragma unroll
          for (int i = 0; i < 8; ++i) { const int c = i * 256 + lane * 4; const f32x4 v = *(const f32x4*)(x + (size_t)row * DM + c);
              ss += (v[0] * v[0] + v[1] * v[1]) + (v[2] * v[2] + v[3] * v[3]);
              u32x2 w; w.x = cvtpk(v[0], v[1]); w.y = cvtpk(v[2], v[3]); *(u32x2*)(xb + (size_t)row * DM + c) = w; }
#pragma unroll
          for (int o = 32; o > 0; o >>= 1) ss += __shfl_xor(ss, o);
          if (lane == 0) ssq0[row] = ssq_fix(ss);
      } }
    { const float* mem = p.mem_in[tr]; bf16_t* mn = (bf16_t*)(ws + OFF_MEMN) + (size_t)tr * 512 * 2048;
      for (int row = lbid() * 8 + wid; row < 512; row += gridDim.x * 8) {
          f32x4 v[8]; float ss = 0.f;
#pragma unroll
          for (int i = 0; i < 8; ++i) { v[i] = *(const f32x4*)(mem + (size_t)row * DM + i * 256 + lane * 4); ss += (v[i][0] * v[i][0] + v[i][1] * v[i][1]) + (v[i][2] * v[i][2] + v[i][3] * v[i][3]); }
#pragma unroll
          for (int o = 32; o > 0; o >>= 1) ss += __shfl_xor(ss, o);
          const float rs = __builtin_amdgcn_rsqf(ss * (1.f / DM) + EPS);
#pragma unroll
          for (int i = 0; i < 8; ++i) { u32x2 w; w.x = cvtpk(v[i][0] * rs, v[i][1] * rs); w.y = cvtpk(v[i][2] * rs, v[i][3] * rs); *(u32x2*)(mn + (size_t)row * DM + i * 256 + lane * 4) = w; }
      } }
}

__device__ __forceinline__ void rope_phase(const Params& p, int T, int S) {
    char* ws = p.ws;
    bf16_t* q = (bf16_t*)(ws + OFF_Q); const bf16_t* kr = (const bf16_t*)(ws + OFF_KR); bf16_t* kro = (bf16_t*)(ws + OFF_KROPE);
    const float* rc = (const float*)(ws + OFF_ROPE); const float* rs = rc + 16384 * 32;
    const int total = T * 9 * 4;
    for (int i = lbid() * 512 + ltid(); i < total; i += gridDim.x * 512) {
        const int f8 = (i & 3) * 8; const int ru = i >> 2; const int row_i = ru / 9; const int u = ru - row_i * 9; const long row = row_i; const int pos = row_i & (S - 1);
        const f32x8 c = *(const f32x8*)(rc + pos * 32 + f8), s = *(const f32x8*)(rs + pos * 32 + f8);
        const bf16_t* src = (u < 8) ? (q + row * 1536 + u * 192 + 128 + f8) : (kr + row * 64 + f8);
        bf16_t* dst = (u < 8) ? (q + row * 1536 + u * 192 + 128 + f8) : (kro + row * 64 + f8);
        const bf16x8 a1 = *(const bf16x8*)src, a2 = *(const bf16x8*)(src + 32);
        unsigned w1[4], w2[4];
#pragma unroll
        for (int j = 0; j < 8; j += 2) {
            const float x1a = bf2f((bf16_t)a1[j]), x2a = bf2f((bf16_t)a2[j]), x1b = bf2f((bf16_t)a1[j + 1]), x2b = bf2f((bf16_t)a2[j + 1]);
            w1[j >> 1] = cvtpk(x1a * c[j] - x2a * s[j], x1b * c[j + 1] - x2b * s[j + 1]);
            w2[j >> 1] = cvtpk(x2a * c[j] + x1a * s[j], x2b * c[j + 1] + x1b * s[j + 1]);
        }
        *(u32x4*)dst = (u32x4){w1[0], w1[1], w1[2], w1[3]}; *(u32x4*)(dst + 32) = (u32x4){w2[0], w2[1], w2[2], w2[3]};
    }
}

__device__ __forceinline__ void hcomb_phase(const Params& p, int layer, int T, int nblk, int bid, int nsplit) {
    char* ws = p.ws; const bf16_t* hgb = (const bf16_t*)(ws + OFF_HG); bf16_t* mix = (bf16_t*)(ws + OFF_MIX);
    const float* on = p.out_norm + layer * 128;
    const int l16 = ltid() & 15;
    const int total = T * 8 * 16;
    f32x8 onv = *(const f32x8*)(on + l16 * 8);
    constexpr int UN = 4;
    const int stride = nblk * 512;
    for (int i0 = bid * 512 + ltid(); i0 < total; i0 += stride * UN) {
        bf16x8 vf[UN], vb[UN], vg[UN];
#pragma unroll
        for (int u = 0; u < UN; ++u) { const int i = i0 + u * stride; if (i < total) { const int rh = i >> 4; const int h = rh & 7; const long row = rh >> 3;
            const bf16_t* base = hgb + row * HGW + h * 128 + l16 * 8; vf[u] = *(const bf16x8*)(base + 1024); vb[u] = *(const bf16x8*)(base + 2048); vg[u] = *(const bf16x8*)(base + 4096); } }
#pragma unroll
        for (int u = 0; u < UN; ++u) {
            const int i = i0 + u * stride; if (i >= total) break;
            const int rh = i >> 4; const int h = rh & 7; const long row = rh >> 3;
            float o[8]; float ss = 0.f;
#pragma unroll
            for (int j = 0; j < 8; ++j) { o[j] = bf2f((bf16_t)vf[u][j]) + bf2f((bf16_t)vb[u][j]); ss += o[j] * o[j]; }
            ss += __shfl_xor(ss, 1); ss += __shfl_xor(ss, 2); ss += __shfl_xor(ss, 4); ss += __shfl_xor(ss, 8);
            const float rs = __builtin_amdgcn_rsqf(ss * (1.f / 128.f) + EPS);
            unsigned w[4];
#pragma unroll
            for (int j = 0; j < 8; j += 2) {
                const float g0 = bf2f((bf16_t)vg[u][j]), g1 = bf2f((bf16_t)vg[u][j + 1]);
                const float y0 = o[j] * rs * onv[j] * (g0 * __builtin_amdgcn_rcpf(1.f + __expf(-g0))), y1 = o[j + 1] * rs * onv[j + 1] * (g1 * __builtin_amdgcn_rcpf(1.f + __expf(-g1)));
                w[j >> 1] = cvtpk(y0, y1);
            }
            *(u32x4*)(mix + row * 2048 + 1024 + h * 128 + l16 * 8) = (u32x4){w[0], w[1], w[2], w[3]};
            if (nsplit == 2 && (((int)row & 16383) >> 8) >= MK_QF) {
                const f32x4 mlv = *(const f32x4*)((const float*)(ws + OFF_XB + 2048) + row * 1024 + h * 4);
                const float C = att::SCALE * 1.4426950408889634f;
                const float M = fmaxf(mlv[0], mlv[2]);
                const float w1 = mlv[1] * __builtin_amdgcn_exp2f((mlv[0] - M) * C), w2 = mlv[3] * __builtin_amdgcn_exp2f((mlv[2] - M) * C);
                const float inv = 1.f / (w1 + w2), c1 = w1 * inv, c2 = w2 * inv;
                bf16_t* pa = mix + row * 2048 + h * 128 + l16 * 8; const bf16_t* pb = (const bf16_t*)(ws + OFF_XB) + row * 2048 + h * 128 + l16 * 8;
                const bf16x8 va = *(const bf16x8*)pa, vb2 = *(const bf16x8*)pb;
                unsigned wo[4];
#pragma unroll
                for (int j = 0; j < 8; j += 2) wo[j >> 1] = cvtpk(c1 * bf2f((bf16_t)va[j]) + c2 * bf2f((bf16_t)vb2[j]), c1 * bf2f((bf16_t)va[j + 1]) + c2 * bf2f((bf16_t)vb2[j + 1]));
                *(u32x4*)pa = (u32x4){wo[0], wo[1], wo[2], wo[3]};
            }
        }
    }
}

__device__ __forceinline__ void final_phase(const Params& p, float* xout, int T, int tr) {
    const int wid = ltid() >> 6, lane = ltid() & 63;
    const ssq_t* ssq = (const ssq_t*)(p.ws + OFF_SSQ) + (size_t)(tr * 11 + 10) * TMAX;
    for (int row = lbid() * 8 + wid; row < T; row += gridDim.x * 8) {
        const float rs = __builtin_amdgcn_rsqf(ssq_val(ssq[row]) * (1.f / DM) + EPS);
#pragma unroll
        for (int i = 0; i < 8; ++i) { const int c = i * 256 + lane * 4; f32x4 v = *(f32x4*)(xout + (size_t)row * DM + c); const f32x4 g = *(const f32x4*)(p.final_norm + c);
            v = v * rs * g; *(f32x4*)(xout + (size_t)row * DM + c) = v; }
    }
}

__device__ __forceinline__ void mixer_phase(LAS unsigned char* lds, const Params& p, int layer, int T, int S, int tr) {
    char* ws = p.ws;
    unsigned* ctr = (unsigned*)(ws + OFF_CTR) + (tr * 2 + layer) * 16;
    const int nQB = S / 256, QF = (S >= 16384) ? MK_QF : nQB, nQS = nQB - QF;
    const int nH = 2 * 8 * 2, nFull = 16 * QF, nA = nFull + 16 * 2 * nQS;
    LAS unsigned* slot = (LAS unsigned*)(lds + LDS_BCAST);
    for (;;) {
        if (ltid() == 0) *slot = __hip_atomic_fetch_add(ctr, 1u, __ATOMIC_RELAXED, __HIP_MEMORY_SCOPE_AGENT);
        wg_barrier();
        const int idx = (int)__builtin_amdgcn_readfirstlane(*slot);
        wg_barrier();
        if (idx >= nH + nA) break;
        const Params* kq = launder_p((const Params*)__builtin_amdgcn_kernarg_segment_ptr());
        char* wsu = kq->ws;
        bf16_t* hgb = (bf16_t*)(wsu + OFF_HG);
        const bf16_t* q = (const bf16_t*)(wsu + OFF_Q); const bf16_t* kv = (const bf16_t*)(wsu + OFF_KV); const bf16_t* kro = (const bf16_t*)(wsu + OFF_KROPE);
        bf16_t* mix = (bf16_t*)(wsu + OFF_MIX); bf16_t* o2 = (bf16_t*)(wsu + OFF_XB);
#ifndef MK_NO_HG
        if (idx < nH) hg::hgrn_unit(lds, hgb, kq->lb_logits, layer, S, idx);
        else
#endif
        {
#ifndef MK_NO_ATT
            const int a = idx - nH; int qb, half, bh, nsplit;
            if (a < nFull) { qb = a % QF; bh = a / QF; half = 0; nsplit = 1; }
            else { const int a1 = a - nFull; qb = QF + a1 % nQS; const int a2 = a1 / nQS; half = a2 & 1; bh = a2 >> 1; nsplit = 2; }
            const int h = bh & 7, b = bh >> 3;
            const int sseq = S / nsplit;
            const long row0 = (long)b * S + (long)qb * 256, krow0 = (long)b * S + (long)half * sseq;
            bf16_t* ob = (half == 0 ? mix : o2) + row0 * 2048 + h * 128;
            const int ml = (nsplit == 2) ? (int)(row0 * 1024 + h * 4 + half * 2) : -1;
            att::attn_body(q + row0 * 1536 + h * 192, kv + krow0 * 2048 + h * 256, kro + krow0 * 64, ob, ml, sseq, (char*)(unsigned char*)lds);
#endif
        }
    }
}

#define XB_TMO      128
#define XB_XCNT(j)  (256  + 64 * (j))
#define XB_XSUB(j)  (1280 + 64 * (j))
#define XB_XGEN(j)  (2304 + 64 * (j))
#define XB_TOP      3328
#define XB_TOPGEN   3392
#define XCD_BAR_WORDS 3456
#define XB_SPIN_CAP (1u << 22)
__device__ __forceinline__ unsigned xb_ld(unsigned* p)              { return __hip_atomic_load(p, __ATOMIC_RELAXED, __HIP_MEMORY_SCOPE_AGENT); }
__device__ __forceinline__ unsigned xb_add(unsigned* p, unsigned v) { return __hip_atomic_fetch_add(p, v, __ATOMIC_RELAXED, __HIP_MEMORY_SCOPE_AGENT); }
__device__ __forceinline__ unsigned xb_xcc_id() { return (unsigned)__builtin_amdgcn_s_getreg((3 << 11) | 20) & 0xFu; }
#define XB_SPIN(cond, bar) do { unsigned _sp = 0; while (cond) { __builtin_amdgcn_s_sleep(1); \
    if ((++_sp & 255u) == 0u) { if (xb_ld(&(bar)[XB_TMO])) break; if (_sp > XB_SPIN_CAP) { atomicAdd(&(bar)[XB_TMO], 1u); break; } } } } while (0)
struct XcdBarrier { unsigned* bar; unsigned x; volatile LAS unsigned* st; };
__device__ __forceinline__ XcdBarrier xcd_barrier_post(unsigned* bar, volatile LAS unsigned* st) {
    XcdBarrier b; b.bar = bar; b.x = xb_xcc_id(); b.st = st;
    if (threadIdx.x == 0) (void)xb_add(&bar[XB_XCNT(b.x)], 1u);
    return b;
}
__device__ __forceinline__ void xcd_barrier_complete(unsigned* bar, unsigned x, unsigned& nloc, unsigned& nx) {
    const unsigned G = gridDim.x * gridDim.y * gridDim.z;
    unsigned sum, cnt, mine, sp = 0u;
    for (;;) {
        sum = 0u; cnt = 0u; mine = 0u;
#pragma unroll
        for (unsigned j = 0; j < 16; ++j) { const unsigned c = xb_ld(&bar[XB_XCNT(j)]); sum += c; cnt += (c > 0u) ? 1u : 0u; mine = (j == x) ? c : mine; }
        if (sum == G) break;
        __builtin_amdgcn_s_sleep(1);
        if ((++sp & 255u) == 0u) { if (xb_ld(&bar[XB_TMO])) break; if (sp > XB_SPIN_CAP) { atomicAdd(&bar[XB_TMO], 1u); break; } }
    }
    nloc = mine > 0u ? mine : 1u; nx = cnt > 0u ? cnt : 1u;
}
__device__ __forceinline__ void xcd_barrier_(const XcdBarrier& b) {
    asm volatile("s_waitcnt vmcnt(0)" ::: "memory");
    __syncthreads();
    if (threadIdx.x == 0) {
        unsigned* bar = b.bar;
        __builtin_amdgcn_s_waitcnt(0);
        unsigned nloc = b.st[0], nx = b.st[1];
        if (nloc == 0u) { xcd_barrier_complete(bar, b.x, nloc, nx); b.st[0] = nloc; b.st[1] = nx; }
        const unsigned old = xb_add(&bar[XB_XSUB(b.x)], 1u);
        const unsigned gen = old / nloc;
        if (old + 1u == (gen + 1u) * nloc) {
            __builtin_amdgcn_fence(__ATOMIC_RELEASE, "agent");
            asm volatile("s_waitcnt vmcnt(0)" ::: "memory");
            const unsigned og = xb_add(&bar[XB_TOP], 1u);
            const unsigned tg = og / nx;
            if (og + 1u == (tg + 1u) * nx) xb_add(&bar[XB_TOPGEN], 1u);
            else XB_SPIN(xb_ld(&bar[XB_TOPGEN]) == tg, bar);
            __builtin_amdgcn_fence(__ATOMIC_ACQUIRE, "agent");
            xb_add(&bar[XB_XGEN(b.x)], 1u);
            asm volatile("s_waitcnt vmcnt(0)" ::: "memory");
        } else {
            XB_SPIN(xb_ld(&bar[XB_XGEN(b.x)]) == gen, bar);
            __builtin_amdgcn_fence(__ATOMIC_ACQUIRE, "agent");
            asm volatile("s_waitcnt vmcnt(0)" ::: "memory");
        }
    }
    __syncthreads();
}

__device__ __forceinline__ void xcd_barrier(LAS unsigned char* lds) {
    const Params* kp = launder_p((const Params*)__builtin_amdgcn_kernarg_segment_ptr());
    XcdBarrier b; b.bar = (unsigned*)(kp->ws + OFF_BAR); b.x = xb_xcc_id(); b.st = (volatile LAS unsigned*)(lds + LDS_BCAST + 64);
    xcd_barrier_(b);
}
constexpr int N_PHASES = 52;

__device__ __forceinline__ GemmDesc mkgemm(const void* A, int lda, const void* B, int ldb, int K, int nM, int nN) {
    GemmDesc g{}; g.A = (const char*)A; g.B = (const char*)B; g.lda = lda; g.ldb = ldb; g.K = K; g.nM = nM; g.nN = nN; g.nZ = 1; g.perm = 1; g.epi = E_BF16; return g;
}

__device__ __forceinline__ bool make_gemm(const Params& p, int tr, int l, int k, int i, GemmDesc& g) {
    const int T = tr ? 32768 : 8192, S = tr ? 16384 : 4096, nMT = T / 256;
    char* ws = p.ws;
    float* xout = p.out + (tr ? (size_t)8192 * DM : 0);
    ssq_t* ssq = (ssq_t*)(ws + OFF_SSQ) + (size_t)tr * 11 * TMAX;
    ssq_t* ssq_x0 = ssq + (size_t)(l * 5 + 0) * TMAX; ssq_t* ssq_q = ssq + (size_t)(l * 5 + 1) * TMAX; ssq_t* ssq_kv = ssq + (size_t)(l * 5 + 2) * TMAX;
    ssq_t* ssq_x1 = ssq + (size_t)(l * 5 + 3) * TMAX; ssq_t* ssq_x2 = ssq + (size_t)(l * 5 + 4) * TMAX; ssq_t* ssq_nx = ssq + (size_t)((l + 1) * 5) * TMAX;
    bf16_t* xb = (bf16_t*)(ws + (tr ? OFF_XB : OFF_XB0));
    const char* memn = ws + OFF_MEMN + (size_t)tr * 512 * 2048 * 2;
    if (k == 1) {
        if (i > 0) return false;
        g = mkgemm(xb, DM, ws + OFF_W_IN, DM, DM, nMT, INP / 256); g.epi = E_INPROJ; g.ssq_in = ssq_x0; g.inv_dim = 1.f / DM;
        g.out = (bf16_t*)(ws + OFF_CQ); g.out2 = (bf16_t*)(ws + OFF_KR); g.out3 = (bf16_t*)(ws + OFF_HG); g.ssq_out = ssq_q; g.ssq_out2 = ssq_kv; return true;
    } else if (k == 2) {
        if (i == 0) { g = mkgemm(ws + OFF_CQ, 768, ws + OFF_W_UQ, 512, 512, nMT, 6); g.out = (bf16_t*)(ws + OFF_Q); g.ldo = 1536; g.ssq_in = ssq_q; g.inv_dim = 1.f / 512.f; return true; }
        if (i == 1) { g = mkgemm(ws + OFF_CQ + 512 * 2, 768, ws + OFF_W_UKV, 256, 256, nMT, 8); g.out = (bf16_t*)(ws + OFF_KV); g.ldo = 2048; g.ssq_in = ssq_kv; g.inv_dim = 1.f / 256.f; return true; }
        return false;
    } else if (k == 6) {
        if (i > 0) return false;
        g = mkgemm(ws + OFF_MIX, DM, ws + OFF_W_OUT, DM, DM, nMT, 8); g.epi = E_RESID;
        g.resid = (l == 0) ? p.x_in[tr] : xout; g.xout = xout; g.xb = xb; g.ssq_out = ssq_x1; return true;
    } else if (k == 7) {
        if (i == 0) { g = mkgemm(xb, DM, ws + OFF_W_XQ, DM, DM, nMT, 8); g.out = (bf16_t*)(ws + OFF_XQ); g.ldo = DM; g.ssq_in = ssq_x1; g.inv_dim = 1.f / DM; return true; }
        return false;
    } else if (k == 5) {
        if (i == 0) { g = mkgemm(memn, DM, ws + OFF_W_XK, DM, DM, 2, 8); g.out = (bf16_t*)(ws + OFF_KMEM); g.ldo = DM; return true; }
        if (i == 1) { g = mkgemm(ws + OFF_W_XV, DM, memn, DM, DM, 8, 1); g.nZ = 2; g.bzs = 256 * DM * 2; g.out = (bf16_t*)(ws + OFF_VT); g.ldo = 256; g.ozs = (long)2048 * 256; return true; }
        return false;
    } else if (k == 8) {
        if (i > 0) return false;
        g = mkgemm(ws + OFF_XQ, DM, ws + OFF_KMEM, DM, 512, nMT, 1); g.nZ = 4; g.azs = 512 * 2; g.bzs = 512 * 2; g.bbs = 256 * DM * 2; g.tpb = S / 256;
        g.epi = E_SOFTMAX; g.out = (bf16_t*)(ws + OFF_PBUF); g.ldo = 1024; return true;
    } else if (k == 9) {
        if (i > 0) return false;
        g = mkgemm(ws + OFF_PBUF, 1024, ws + OFF_VT, 256, 256, nMT, 2); g.nZ = 4; g.azs = 256 * 2; g.bzs = 512 * 256 * 2; g.bbs = 2048 * 256 * 2; g.tpb = S / 256;
        g.out = (bf16_t*)(ws + OFF_OBUF); g.ldo = DM; g.ozs = 512; return true;
    } else if (k == 10) {
        if (i > 0) return false;
        g = mkgemm(ws + OFF_OBUF, DM, ws + OFF_W_XO, DM, DM, nMT, 8); g.epi = E_RESID;
        g.resid = xout; g.xout = xout; g.xb = xb; g.ssq_out = ssq_x2; return true;
    } else if (k == 11) {
        if (i > 0) return false;
        g = mkgemm(xb, DM, ws + OFF_W_F1, DM, DM, nMT, 32); g.out = (bf16_t*)(ws + OFF_U); g.ldo = 8192; g.ssq_in = ssq_x2; g.inv_dim = 1.f / DM; g.relu2 = 1; return true;
    } else if (k == 12) {
        if (i > 0) return false;
        g = mkgemm(ws + OFF_U, 8192, ws + OFF_W_F2, 8192, 8192, nMT, 8); g.epi = E_RESID;
        g.resid = xout; g.xout = xout; g.xb = xb; g.ssq_out = ssq_nx; return true;
    }
    return false;
}

__device__ __forceinline__ void run_phase(const Params* kp, int ph, LAS unsigned char* lds) {
    const Params& p = *kp;
    if (ph == 0) { prep_phase(p, 0, 8192, 4096); prep_phase(p, 1, 32768, 16384); return; }
    if (ph == N_PHASES - 1) { final_phase(p, p.out, 8192, 0); final_phase(p, p.out + (size_t)8192 * DM, 32768, 1); return; }
    const int l = (ph - 1) / 25, r = (ph - 1) % 25;
    if (r == 0) { wcvt_phase(lds, p, l); return; }
    const int tr = (r - 1) / 12, k = (r - 1) % 12 + 1;
    const int T = tr ? 32768 : 8192, S = tr ? 16384 : 4096;
    if (k == 3) { rope_phase(p, T, S); return; }
    if (k == 4) { mixer_phase(lds, p, l, T, S, tr); return; }
    if (k == 5) {
        const int c = lbid(), G = gridDim.x;
        if (G >= 64) {
            if (c < 16) gemm_phase<E_BF16>(lds, kp, tr, l, 5, 0, 16, c);
            else if (c < 32) gemm_phase<E_BF16>(lds, kp, tr, l, 5, 1, 16, c - 16);
            else hcomb_phase(p, l, T, G - 32, c - 32, S >= 16384 ? 2 : 1);
        } else { gemm_phase<E_BF16>(lds, kp, tr, l, 5, 0, G, c); gemm_phase<E_BF16>(lds, kp, tr, l, 5, 1, G, c); hcomb_phase(p, l, T, G, c, S >= 16384 ? 2 : 1); }
        return; }
#ifndef MK_NO_GEMM
    { const int c = lbid(), G = gridDim.x;
    if (k == 1) gemm_phase<E_INPROJ>(lds, kp, tr, l, k, 0, G, c);
    else if (k == 6 || k == 10 || k == 12) gemm_phase<E_RESID>(lds, kp, tr, l, k, 0, G, c);
    else if (k == 8) gemm_phase<E_SOFTMAX>(lds, kp, tr, l, k, 0, G, c);
    else for (int i = 0; i < 2; ++i) gemm_phase<E_BF16>(lds, kp, tr, l, k, i, G, c); }
#endif
}

__global__ void __launch_bounds__(512, 2) mk_forward(Params p, int ph_lo, int ph_hi) {
    extern __shared__ __attribute__((aligned(16))) unsigned char shm[];
    LAS unsigned char* lds = (LAS unsigned char*)shm;
    cg::grid_group grid = cg::this_grid();
    volatile LAS unsigned* xst = (volatile LAS unsigned*)(lds + LDS_BCAST + 64);
    if (threadIdx.x == 0) { xst[0] = 0u; xst[1] = 0u; }
    __syncthreads();
    { const Params* kp0 = launder_p((const Params*)__builtin_amdgcn_kernarg_segment_ptr()); (void)xcd_barrier_post((unsigned*)(kp0->ws + OFF_BAR), xst); }
    for (int ph = ph_lo; ph < ph_hi; ++ph) {
        const Params* kp = launder_p((const Params*)__builtin_amdgcn_kernarg_segment_ptr());
#ifdef MK_TIME_KIND
        if (blockIdx.x == 0 && threadIdx.x == 0) ((unsigned long long*)(kp->ws + OFF_TS))[ph] = __builtin_amdgcn_s_memrealtime();
#endif
        run_phase(kp, ph, lds);
        if (ph + 1 < ph_hi) { if (ph_hi > N_PHASES) grid.sync(); else xcd_barrier(lds); }
    }
#ifdef MK_TIME_KIND
    xcd_barrier(lds);
    if (blockIdx.x == 0) {
        const Params* kp = launder_p((const Params*)__builtin_amdgcn_kernarg_segment_ptr());
        unsigned long long* ts = (unsigned long long*)(kp->ws + OFF_TS); float* outp = kp->out;
        if (threadIdx.x == 0) ts[ph_hi] = __builtin_amdgcn_s_memrealtime();
        __syncthreads();
        unsigned tot = 0;
        for (int ph = ph_lo; ph < ph_hi; ++ph) { const int r_ = (ph - 1) % 25; const int kind = (ph == 0) ? 100 : (ph == N_PHASES - 1 ? 101 : (r_ == 0 ? 0 : (r_ - 1) % 12 + 1));
            if (kind == MK_TIME_KIND || MK_TIME_KIND == 200) tot += (unsigned)(ts[ph + 1] - ts[ph]); }
        const int n = (int)(tot / 100u);
        for (int i = threadIdx.x; i < n; i += 512) outp[i] += 0.25f;
        for (int i = threadIdx.x; i < 4 * n; i += 512) outp[(size_t)8192 * DM + i] += 0.25f;
    }
#endif

}

extern "C" void kernel_launch(void* const* d_in, const int* in_sizes, int n_in, void* d_out, int out_size, void* d_ws, size_t ws_size, hipStream_t stream) {
    static int inited = 0; static int grid_blocks = 0;
    if (!inited) {
        hipFuncSetAttribute((const void*)mk_forward, hipFuncAttributeMaxDynamicSharedMemorySize, LDS_BYTES);
        int dev = 0, cus = 0, per_cu = 0;
        hipGetDevice(&dev); hipDeviceGetAttribute(&cus, hipDeviceAttributeMultiprocessorCount, dev);
        hipOccupancyMaxActiveBlocksPerMultiprocessor(&per_cu, mk_forward, 512, LDS_BYTES);
        if (per_cu < 1) per_cu = 1;
        grid_blocks = cus * 1;
        if (ws_size < WS_END) fprintf(stderr, "kernel_launch: workspace too small: %zu < %zu\n", ws_size, (size_t)WS_END);
        inited = 1;
    }
    Params p{};
    const float* const* in = (const float* const*)d_in;
    p.x_in[0] = in[0]; p.x_in[1] = in[1]; p.mem_in[0] = in[2]; p.mem_in[1] = in[3];
    p.mix_norm = in[4]; p.w_in = in[5]; p.q_norm = in[6]; p.w_uq = in[7]; p.kv_norm = in[8]; p.w_ukv = in[9]; p.lb_logits = in[10]; p.out_norm = in[11]; p.w_out = in[12];
    p.xattn_norm = in[13]; p.mem_norm = in[14]; p.w_xq = in[15]; p.w_xk = in[16]; p.w_xv = in[17]; p.w_xo = in[18]; p.ffn_norm = in[19]; p.w_ffn1 = in[20]; p.w_ffn2 = in[21]; p.final_norm = in[22];
    p.out = (float*)d_out; p.ws = (char*)d_ws;
#if MK_ONE_LAUNCH
    hipMemsetAsync((char*)d_ws + OFF_BAR, 0, 16384, stream);
    int lo = 0, hi = N_PHASES;
    void* args[] = {&p, &lo, &hi};
    hipError_t e = hipLaunchCooperativeKernel((const void*)mk_forward, dim3(grid_blocks), dim3(512), args, LDS_BYTES, stream);
    if (e != hipSuccess) fprintf(stderr, "cooperative launch failed: %s\n", hipGetErrorString(e));
#else
    for (int ph = 0; ph < N_PHASES; ++ph) hipLaunchKernelGGL(mk_forward, dim3(grid_blocks), dim3(512), LDS_BYTES, stream, p, ph, ph + 1);
#endif
}
```

```cpp
#include <hip/hip_runtime.h>
#include <hip/hip_cooperative_groups.h>
#include <cstdio>
namespace cg = cooperative_groups;

#define LAS __attribute__((address_space(3)))
typedef unsigned short bf16_t;
typedef short bf16x8 __attribute__((ext_vector_type(8)));
typedef short s16x4 __attribute__((ext_vector_type(4)));
typedef float f32x4 __attribute__((ext_vector_type(4)));
typedef float f32x8 __attribute__((ext_vector_type(8)));
typedef float f32x16 __attribute__((ext_vector_type(16)));
typedef unsigned u32x4 __attribute__((ext_vector_type(4)));
typedef unsigned u32x2 __attribute__((ext_vector_type(2)));

#ifndef MK_QF
#define MK_QF 52
#endif
#ifndef MK_ONE_LAUNCH
#define MK_ONE_LAUNCH 1
#endif

constexpr int DM = 2048, NMEM = 256, DEPTH = 2;
constexpr int INP = 6144;
constexpr int HGW = 5120;
constexpr int TMAX = 32768;
constexpr float EPS = 1e-6f;
constexpr int LDS_BYTES = 144 * 1024;
constexpr int LDS_BCAST = 140 * 1024;
constexpr int LDS_EPI = 128 * 1024;

constexpr size_t al256(size_t x) { return (x + 255) / 256 * 256; }
constexpr size_t E_W_IN = (size_t)INP * 2048, E_W_UQ = 1536 * 512, E_W_UKV = 2048 * 256, E_W_SQ = 2048 * 2048, E_W_F = (size_t)8192 * 2048;
constexpr size_t OFF_W_IN = 0;
constexpr size_t OFF_W_UQ = OFF_W_IN + E_W_IN * 2;
constexpr size_t OFF_W_UKV = OFF_W_UQ + E_W_UQ * 2;
constexpr size_t OFF_W_OUT = OFF_W_UKV + E_W_UKV * 2;
constexpr size_t OFF_W_XQ = OFF_W_OUT + E_W_SQ * 2;
constexpr size_t OFF_W_XK = OFF_W_XQ + E_W_SQ * 2;
constexpr size_t OFF_W_XV = OFF_W_XK + E_W_SQ * 2;
constexpr size_t OFF_W_XO = OFF_W_XV + E_W_SQ * 2;
constexpr size_t OFF_W_F1 = OFF_W_XO + E_W_SQ * 2;
constexpr size_t OFF_W_F2 = OFF_W_F1 + E_W_F * 2;
constexpr size_t OFF_XB = OFF_W_F2 + E_W_F * 2;
constexpr size_t OFF_KR = OFF_XB + (size_t)TMAX * 2048 * 2;
constexpr size_t OFF_KROPE = OFF_KR + (size_t)TMAX * 64 * 2;
constexpr size_t OFF_MIX = OFF_KROPE + (size_t)TMAX * 64 * 2;
constexpr size_t OFF_HG = OFF_MIX + (size_t)TMAX * 2048 * 2;
constexpr size_t OFF_Q = OFF_HG + (size_t)TMAX * HGW * 2;
constexpr size_t OFF_KV = OFF_Q + (size_t)TMAX * 1536 * 2;
constexpr size_t OFF_MEMN = OFF_KV + (size_t)TMAX * 2048 * 2;
constexpr size_t OFF_KMEM = OFF_MEMN + (size_t)2 * 512 * 2048 * 2;
constexpr size_t OFF_VT = OFF_KMEM + (size_t)512 * 2048 * 2;
constexpr size_t OFF_ROPE = OFF_VT + (size_t)512 * 2048 * 2;
constexpr size_t OFF_SSQ = OFF_ROPE + (size_t)16384 * 32 * 4 * 2;
constexpr size_t OFF_CTR = OFF_SSQ + (size_t)22 * TMAX * 8;
constexpr size_t OFF_BAR = OFF_CTR + 256;
constexpr size_t OFF_LB = OFF_BAR + 16384;
constexpr size_t OFF_TS = OFF_LB + 8192;
constexpr size_t OFF_XB0 = OFF_TS + 1024;
constexpr size_t WS_END = OFF_XB0 + (size_t)8192 * 2048 * 2;
constexpr size_t OFF_CQ = OFF_MIX;
constexpr size_t OFF_XQ = OFF_Q;
constexpr size_t OFF_PBUF = OFF_MIX;
constexpr size_t OFF_OBUF = OFF_HG;
constexpr size_t OFF_U = OFF_HG;
static_assert((size_t)TMAX * 8192 * 2 <= OFF_MEMN - OFF_HG, "u must fit");

struct Params {
    const float* x_in[2]; const float* mem_in[2];
    const float *mix_norm, *w_in, *q_norm, *w_uq, *kv_norm, *w_ukv, *lb_logits, *out_norm, *w_out, *xattn_norm, *mem_norm, *w_xq, *w_xk, *w_xv, *w_xo,
        *ffn_norm, *w_ffn1, *w_ffn2, *final_norm;
    float* out; char* ws;
};

__device__ __forceinline__ int ltid() { int t = threadIdx.x; asm volatile("" : "+v"(t)); return t; }
__device__ __forceinline__ int lbid() { int t = blockIdx.x; asm volatile("" : "+s"(t)); return t; }
__device__ __forceinline__ float bf2f(bf16_t b) { return __uint_as_float(((unsigned)b) << 16); }
__device__ __forceinline__ bf16_t f2bf(float f) { unsigned u = __float_as_uint(f); u += 0x7FFFu + ((u >> 16) & 1u); return (bf16_t)(u >> 16); }
__device__ __forceinline__ unsigned cvtpk(float lo, float hi) { unsigned r; asm volatile("v_cvt_pk_bf16_f32 %0, %1, %2" : "=v"(r) : "v"(lo), "v"(hi)); return r; }
__device__ __forceinline__ void wg_barrier() { asm volatile("s_waitcnt vmcnt(0) lgkmcnt(0)" ::: "memory"); __builtin_amdgcn_s_barrier(); asm volatile("" ::: "memory"); }
typedef unsigned long long ssq_t;
__device__ __forceinline__ ssq_t ssq_fix(float v) { return (ssq_t)(v * 16777216.f + 0.5f); }
__device__ __forceinline__ float ssq_val(ssq_t v) { return (float)v * (1.f / 16777216.f); }
__device__ __forceinline__ void atomic_addf(ssq_t* p, float v) { __hip_atomic_fetch_add(p, ssq_fix(v), __ATOMIC_RELAXED, __HIP_MEMORY_SCOPE_AGENT); }

namespace pg8 {
constexpr int BM = 256, BK = 64, HALF = 128, HTB = HALF * BK * 2, NXCD = 8, WGM = 8;
__host__ __device__ __forceinline__ int lds_byte(int r, int c) { const int st = (r >> 4) * 2 + (c >> 5), rr = r & 15, cc = c & 31, ob = rr * 64 + cc * 2; return st * 1024 + (ob ^ (((ob >> 9) & 1) << 5)); }
__host__ __device__ __forceinline__ void stage_rc(int b, int& R, int& C) { const int st = b / 1024, sb = b % 1024, swz = sb ^ (((sb >> 9) & 1) << 5); R = (st >> 1) * 16 + swz / 64; C = (st & 1) * 32 + (swz % 64) / 2; }
__host__ __device__ __forceinline__ int perm32(int rho) { const int n = rho >> 4, i = rho & 15; return 8 * (i >> 2) + 4 * n + (i & 3); }
}
enum { E_BF16 = 0, E_INPROJ = 1, E_RESID = 2, E_SOFTMAX = 3 };
struct GemmDesc {
    const char* A; const char* B; int lda, ldb, K, nM, nN, nZ;
    int azs, bzs, bbs, tpb;
    int epi, perm;
    bf16_t* out; long ozs; int ldo;
    const ssq_t* ssq_in; float inv_dim; int relu2;
    ssq_t* ssq_out; ssq_t* ssq_out2;
    const float* resid; float* xout; bf16_t* xb;
    bf16_t* out2; bf16_t* out3;
};
struct Unit { int pm, pn, z; const char* a; const char* b; };

__device__ __forceinline__ bool make_gemm(const Params& p, int tr, int l, int k, int i, GemmDesc& g);
__device__ __forceinline__ const Params* launder_p(const Params* q) { asm volatile("" : "+s"(q)); return q; }
__device__ __forceinline__ int launder_i(int v) { asm volatile("" : "+s"(v)); return v; }
__device__ __forceinline__ bool next_unit(const Params* kp, int tr, int l, int k, int gi, int i, int G, int c, Unit& u) {
    GemmDesc g; make_gemm(*launder_p(kp), launder_i(tr), launder_i(l), launder_i(k), launder_i(gi), g);
    const int L = i * G + c; const int per = g.nM * g.nN;
    if (L >= per * g.nZ) return false;
    const int z = L / per; int wgid = L - z * per;
    { const int q = per / pg8::NXCD, r = per % pg8::NXCD, xcd = wgid % pg8::NXCD, off = wgid / pg8::NXCD; wgid = (xcd < r ? xcd * (q + 1) : r * (q + 1) + (xcd - r) * q) + off; }
    const int nig = pg8::WGM * g.nN, gid = wgid / nig, fm = gid * pg8::WGM, gsz = (g.nM - fm) < pg8::WGM ? (g.nM - fm) : pg8::WGM;
    u.pm = fm + ((wgid % nig) % gsz); u.pn = (wgid % nig) / gsz; u.z = z;
    const unsigned ao = (unsigned)z * (unsigned)g.azs + (unsigned)u.pm * (unsigned)(512 * g.lda);
    const unsigned bo = (unsigned)z * (unsigned)g.bzs + (unsigned)u.pn * (unsigned)(512 * g.ldb) + (g.tpb ? (unsigned)(u.pm / g.tpb) * (unsigned)g.bbs : 0u);
    u.a = g.A + (size_t)ao; u.b = g.B + (size_t)bo;
    return true;
}

template <int EPI> __device__ __forceinline__ void gemm_epilogue(const Params* kp, int tr, int l, int k, int gi, f32x4 (&acc)[2][2][4][2], const Unit& u, LAS unsigned char* lds) {
    const int tid_e = ltid(), wid_e = tid_e >> 6, lane_e = tid_e & 63, wr = wid_e >> 2, wc = wid_e & 3, fr = lane_e & 15, fq = lane_e >> 4;
    GemmDesc g; make_gemm(*launder_p(kp), launder_i(tr), launder_i(l), launder_i(k), launder_i(gi), g);
    const int row0 = u.pm * 256 + wr * 64 + fr;
    if constexpr (EPI == E_BF16) {
        const int col0 = u.pn * 256 + wc * 32 + 8 * fq;
        float rsv[2][4];
#pragma unroll
        for (int ai = 0; ai < 2; ++ai)
#pragma unroll
            for (int m = 0; m < 4; ++m) rsv[ai][m] = g.ssq_in ? __builtin_amdgcn_rsqf(ssq_val(g.ssq_in[row0 + ai * 128 + m * 16]) * g.inv_dim + EPS) : 1.0f;
#pragma unroll
        for (int ai = 0; ai < 2; ++ai)
#pragma unroll
            for (int m = 0; m < 4; ++m) {
                const int row = row0 + ai * 128 + m * 16;
                const float rs = rsv[ai][m];
                bf16_t* rowp = g.out + (long)u.z * g.ozs + (long)row * g.ldo + col0;
#pragma unroll
                for (int bj = 0; bj < 2; ++bj) {
                    f32x4 v0 = acc[ai][bj][m][0] * rs, v1 = acc[ai][bj][m][1] * rs;
                    if (g.relu2) {
#pragma unroll
                        for (int j = 0; j < 4; ++j) { float a = fmaxf(v0[j], 0.f), b = fmaxf(v1[j], 0.f); v0[j] = a * a; v1[j] = b * b; }
                    }
                    u32x4 w; w.x = cvtpk(v0[0], v0[1]); w.y = cvtpk(v0[2], v0[3]); w.z = cvtpk(v1[0], v1[1]); w.w = cvtpk(v1[2], v1[3]);
                    *(u32x4*)(rowp + bj * 128) = w;
                }
            }
    } else if constexpr (EPI == E_INPROJ) {
        const int lc0 = wc * 32 + 8 * fq;
        const int pn = u.pn;
        const int hseg = (pn >= 4) ? ((pn - 4) >> 2) : 9;
        f32x4 lbv[2][2];
        if (hseg == 1 || hseg == 2) {
            const float* lbt = (const float*)(kp->ws + OFF_LB) + (hseg - 1) * 1024 + ((pn - 4) & 3) * 256 + lc0;
#pragma unroll
            for (int bj = 0; bj < 2; ++bj) { lbv[bj][0] = *(const f32x4*)(lbt + bj * 128); lbv[bj][1] = *(const f32x4*)(lbt + bj * 128 + 4); }
        } else {
#pragma unroll
            for (int bj = 0; bj < 2; ++bj) { lbv[bj][0] = (f32x4){0.f, 0.f, 0.f, 0.f}; lbv[bj][1] = lbv[bj][0]; }
        }
        float rsv[2][4];
#pragma unroll
        for (int ai = 0; ai < 2; ++ai)
#pragma unroll
            for (int m = 0; m < 4; ++m) rsv[ai][m] = __builtin_amdgcn_rsqf(ssq_val(g.ssq_in[row0 + ai * 128 + m * 16]) * g.inv_dim + EPS);
#pragma unroll
        for (int ai = 0; ai < 2; ++ai)
#pragma unroll
            for (int m = 0; m < 4; ++m) {
                const int row = row0 + ai * 128 + m * 16;
                const float rs = rsv[ai][m];
                float ss = 0.f;
#pragma unroll
                for (int bj = 0; bj < 2; ++bj) {
                    f32x4 v0 = acc[ai][bj][m][0] * rs, v1 = acc[ai][bj][m][1] * rs;
                    if (hseg == 0) {
#pragma unroll
                        for (int j = 0; j < 4; ++j) { v0[j] = v0[j] * __builtin_amdgcn_rcpf(1.f + __expf(-v0[j])) * 0.08838834764831845f; v1[j] = v1[j] * __builtin_amdgcn_rcpf(1.f + __expf(-v1[j])) * 0.08838834764831845f; }
                    } else if (hseg == 1 || hseg == 2) {
#pragma unroll
                        for (int j = 0; j < 4; ++j) {
                            const float l0 = lbv[bj][0][j], l1 = lbv[bj][1][j];
                            v0[j] = __logf(l0 + (1.f - l0) * __builtin_amdgcn_rcpf(1.f + __expf(-fmaxf(v0[j], -80.f))));
                            v1[j] = __logf(l1 + (1.f - l1) * __builtin_amdgcn_rcpf(1.f + __expf(-fmaxf(v1[j], -80.f))));
                        }
                    }
                    u32x4 w; w.x = cvtpk(v0[0], v0[1]); w.y = cvtpk(v0[2], v0[3]); w.z = cvtpk(v1[0], v1[1]); w.w = cvtpk(v1[2], v1[3]);
                    const int lc = lc0 + bj * 128;
                    if (pn < 3) {
                        *(u32x4*)(g.out + (long)row * 768 + pn * 256 + lc) = w;
                        ss += (v0[0] * v0[0] + v0[1] * v0[1]) + (v0[2] * v0[2] + v0[3] * v0[3]) + (v1[0] * v1[0] + v1[1] * v1[1]) + (v1[2] * v1[2] + v1[3] * v1[3]);
                    } else if (pn == 3) {
                        if (lc < 64) *(u32x4*)(g.out2 + (long)row * 64 + lc) = w;
                    } else {
                        *(u32x4*)(g.out3 + (long)row * HGW + (pn - 4) * 256 + lc) = w;
                    }
                }
                if (pn < 3) {
                    ss += __shfl_xor(ss, 16); ss += __shfl_xor(ss, 32);
                    if (fq == 0) atomic_addf((pn < 2 ? g.ssq_out : g.ssq_out2) + row, ss);
                }
            }
    } else if constexpr (EPI == E_RESID) {
        const int col0 = u.pn * 256 + wc * 32 + 8 * fq;
#pragma unroll
        for (int ai = 0; ai < 2; ++ai) {
            f32x4 rv[4][2][2];
#pragma unroll
            for (int m = 0; m < 4; ++m)
#pragma unroll
                for (int bj = 0; bj < 2; ++bj)
#pragma unroll
                    for (int n = 0; n < 2; ++n) rv[m][bj][n] = *(const f32x4*)(g.resid + (long)(row0 + ai * 128 + m * 16) * DM + col0 + bj * 128 + n * 4);
#pragma unroll
            for (int m = 0; m < 4; ++m) {
                const int row = row0 + ai * 128 + m * 16;
                float ss = 0.f;
#pragma unroll
                for (int bj = 0; bj < 2; ++bj) {
                    const long o = (long)row * DM + col0 + bj * 128;
                    const f32x4 v0 = rv[m][bj][0] + acc[ai][bj][m][0], v1 = rv[m][bj][1] + acc[ai][bj][m][1];
                    *(f32x4*)(g.xout + o) = v0; *(f32x4*)(g.xout + o + 4) = v1;
                    u32x4 w; w.x = cvtpk(v0[0], v0[1]); w.y = cvtpk(v0[2], v0[3]); w.z = cvtpk(v1[0], v1[1]); w.w = cvtpk(v1[2], v1[3]);
                    *(u32x4*)(g.xb + o) = w;
                    ss += (v0[0] * v0[0] + v0[1] * v0[1]) + (v0[2] * v0[2] + v0[3] * v0[3]) + (v1[0] * v1[0] + v1[1] * v1[1]) + (v1[2] * v1[2] + v1[3] * v1[3]);
                }
                ss += __shfl_xor(ss, 16); ss += __shfl_xor(ss, 32);
                if (fq == 0) atomic_addf(g.ssq_out + row, ss);
            }
        }
    } else {
        LAS float* smax = (LAS float*)(lds + LDS_EPI);
        LAS float* ssum = (LAS float*)(lds + LDS_EPI + 4096);
        const float C = 0.044194173824159216f * 1.4426950408889634f;
#pragma unroll
        for (int ai = 0; ai < 2; ++ai)
#pragma unroll
            for (int m = 0; m < 4; ++m) {
                __builtin_amdgcn_sched_barrier(0);
                float t = -3.0e38f;
#pragma unroll
                for (int bj = 0; bj < 2; ++bj)
#pragma unroll
                    for (int n = 0; n < 2; ++n)
#pragma unroll
                        for (int j = 0; j < 4; ++j) t = fmaxf(t, acc[ai][bj][m][n][j]);
                t = fmaxf(t, __shfl_xor(t, 16)); t = fmaxf(t, __shfl_xor(t, 32));
                if (fq == 0) smax[(ai * 128 + wr * 64 + m * 16 + fr) * 4 + wc] = t;
            }
        asm volatile("s_waitcnt lgkmcnt(0)" ::: "memory"); __builtin_amdgcn_s_barrier(); asm volatile("" ::: "memory");
#pragma unroll
        for (int ai = 0; ai < 2; ++ai)
#pragma unroll
            for (int m = 0; m < 4; ++m) {
                __builtin_amdgcn_sched_barrier(0);
                const int rl = ai * 128 + wr * 64 + m * 16 + fr;
                const f32x4 q = *(LAS f32x4*)(smax + rl * 4);
                const float mm = fmaxf(fmaxf(q[0], q[1]), fmaxf(q[2], q[3])) * C;
                float s = 0.f;
#pragma unroll
                for (int bj = 0; bj < 2; ++bj)
#pragma unroll
                    for (int n = 0; n < 2; ++n)
#pragma unroll
                        for (int j = 0; j < 4; ++j) { const float e = __builtin_amdgcn_exp2f(acc[ai][bj][m][n][j] * C - mm); acc[ai][bj][m][n][j] = e; s += e; }
                s += __shfl_xor(s, 16); s += __shfl_xor(s, 32);
                if (fq == 0) ssum[rl * 4 + wc] = s;
            }
        asm volatile("s_waitcnt lgkmcnt(0)" ::: "memory"); __builtin_amdgcn_s_barrier(); asm volatile("" ::: "memory");
        const int col0 = wc * 32 + 8 * fq;
#pragma unroll
        for (int ai = 0; ai < 2; ++ai)
#pragma unroll
            for (int m = 0; m < 4; ++m) {
                __builtin_amdgcn_sched_barrier(0);
                const int rl = ai * 128 + wr * 64 + m * 16 + fr;
                const f32x4 q = *(LAS f32x4*)(ssum + rl * 4);
                const float inv = 1.0f / ((q[0] + q[1]) + (q[2] + q[3]));
                bf16_t* rowp = g.out + (long)(u.pm * 256 + rl) * g.ldo + u.z * 256 + col0;
#pragma unroll
                for (int bj = 0; bj < 2; ++bj) {
                    const f32x4 v0 = acc[ai][bj][m][0] * inv, v1 = acc[ai][bj][m][1] * inv;
                    u32x4 w; w.x = cvtpk(v0[0], v0[1]); w.y = cvtpk(v0[2], v0[3]); w.z = cvtpk(v1[0], v1[1]); w.w = cvtpk(v1[2], v1[3]);
                    *(u32x4*)(rowp + bj * 128) = w;
                }
            }
    }
}

template <int EPI> __device__ __forceinline__ void gemm_phase(LAS unsigned char* lds, const Params* kp, int tr, int l, int k, int gi, int G, int cblk) {
    using namespace pg8;
    int Kdim, lda_, ldb_, perm_;
    { GemmDesc g0; if (!make_gemm(*kp, tr, l, k, gi, g0)) return; Kdim = g0.K; lda_ = g0.lda; ldb_ = g0.ldb; perm_ = g0.perm; }
    const int tid = ltid(), wid = __builtin_amdgcn_readfirstlane(tid >> 6), lane = tid & 63, wr = wid >> 2, wc = wid & 3, fr = lane & 15, fq = lane >> 4;
    const int K = Kdim, nt = K / BK;
    unsigned voffA[2], voffB[2];
#pragma unroll
    for (int i = 0; i < 2; ++i) { int R, C; stage_rc(tid * 16 + i * 8192, R, C); const int Rb = perm_ ? ((R & ~31) + perm32(R & 31)) : R;
        voffA[i] = (unsigned)(R * lda_ + C) * 2u; voffB[i] = (unsigned)(Rb * ldb_ + C) * 2u; }
    const size_t kstep = (size_t)(BK * 2);
    const size_t hstepA = (size_t)HALF * lda_ * 2, hstepB = (size_t)HALF * ldb_ * 2;
    const unsigned ldsw = (unsigned)wid * 1024u;
    const int aoff = lds_byte(wr * 64 + fr, fq * 8), boff = lds_byte(wc * 32 + fr, fq * 8);
#define PG8_SA(b, h) (((b) * 2 + (h)) * HTB)
#define PG8_SB(b, h) ((4 + (b) * 2 + (h)) * HTB)
#define PG8_STAGE(bufoff, gbase, voff) do { _Pragma("unroll") for (int _i = 0; _i < 2; ++_i) \
        __builtin_amdgcn_global_load_lds((const unsigned*)((const char*)(gbase) + (voff)[_i]), (LAS unsigned*)(lds + (bufoff) + ldsw + _i * 8192), 16, 0, 0); } while (0)
#define PG8_LDA(dst, b, h) do { _Pragma("unroll") for (int m = 0; m < 4; ++m) _Pragma("unroll") for (int k = 0; k < 2; ++k) dst[m][k] = *(const LAS bf16x8*)(lds + PG8_SA(b, h) + aoff + m * 2048 + k * 1024); } while (0)
#define PG8_LDB(dst, b, h) do { _Pragma("unroll") for (int n = 0; n < 2; ++n) _Pragma("unroll") for (int k = 0; k < 2; ++k) dst[n][k] = *(const LAS bf16x8*)(lds + PG8_SB(b, h) + boff + n * 2048 + k * 1024); } while (0)
#define PG8_MMA(ai, bj, At, Bt) do { __builtin_amdgcn_s_setprio(1); _Pragma("unroll") for (int m = 0; m < 4; ++m) _Pragma("unroll") for (int n = 0; n < 2; ++n) _Pragma("unroll") for (int k = 0; k < 2; ++k) \
        acc[ai][bj][m][n] = __builtin_amdgcn_mfma_f32_16x16x32_bf16(Bt[n][k], At[m][k], acc[ai][bj][m][n], 0, 0, 0); __builtin_amdgcn_s_setprio(0); } while (0)
#define PG8_WAIT_V(n) asm volatile("s_waitcnt vmcnt(" #n ")" ::: "memory")
#define PG8_WAIT_L(n) asm volatile("s_waitcnt lgkmcnt(" #n ")" ::: "memory")
#define PG8_BAR __builtin_amdgcn_s_barrier()
#define PG8_SCHED __builtin_amdgcn_sched_barrier(0)
    Unit cur, nxt; int ui = 0;
    if (!next_unit(kp, tr, l, k, gi, 0, G, cblk, cur)) return;
    f32x4 acc[2][2][4][2];
#pragma unroll
    for (int a = 0; a < 2; ++a)
#pragma unroll
        for (int b = 0; b < 2; ++b)
#pragma unroll
            for (int m = 0; m < 4; ++m)
#pragma unroll
                for (int n = 0; n < 2; ++n) acc[a][b][m][n] = (f32x4){0.f, 0.f, 0.f, 0.f};
    bf16x8 At[4][2], B0[2][2], B1[2][2];
    const char* cA = cur.a; const char* cB = cur.b;
    PG8_STAGE(PG8_SB(0, 0), cB, voffB); PG8_STAGE(PG8_SA(0, 0), cA, voffA); PG8_STAGE(PG8_SB(0, 1), cB + hstepB, voffB); PG8_STAGE(PG8_SA(0, 1), cA + hstepA, voffA);
    if (wr == 1) PG8_BAR;
    PG8_WAIT_V(4); PG8_BAR;
    PG8_STAGE(PG8_SB(1, 0), cB + kstep, voffB); PG8_STAGE(PG8_SA(1, 0), cA + kstep, voffA); PG8_STAGE(PG8_SB(1, 1), cB + hstepB + kstep, voffB);
    PG8_WAIT_V(6); PG8_BAR;
    for (;;) {
        const bool has_next = next_unit(kp, tr, l, k, gi, ui + 1, G, cblk, nxt);
        const char* nA = has_next ? nxt.a : cA; const char* nB = has_next ? nxt.b : cB;
        for (int t = 0; t < nt; t += 2) {
            const bool last = (t == nt - 2);
            const char* a1 = cA + (size_t)(t + 1) * kstep;
            const char* a2 = last ? nA : cA + (size_t)(t + 2) * kstep; const char* b2 = last ? nB : cB + (size_t)(t + 2) * kstep;
            const char* a3 = a2 + kstep; const char* b3 = b2 + kstep;
            PG8_LDB(B0, 0, 0); PG8_SCHED; PG8_LDA(At, 0, 0); PG8_STAGE(PG8_SA(1, 1), a1 + hstepA, voffA);
            PG8_WAIT_L(8); PG8_BAR; PG8_WAIT_L(0); PG8_MMA(0, 0, At, B0); PG8_BAR; PG8_SCHED;
            PG8_LDB(B1, 0, 1); PG8_STAGE(PG8_SB(0, 0), b2, voffB);
            PG8_BAR; PG8_WAIT_L(0); PG8_MMA(0, 1, At, B1); PG8_BAR;
            PG8_LDA(At, 0, 1); PG8_STAGE(PG8_SA(0, 0), a2, voffA);
            PG8_BAR; PG8_WAIT_L(0); PG8_MMA(1, 0, At, B0); PG8_BAR; PG8_SCHED;
            PG8_STAGE(PG8_SB(0, 1), b2 + hstepB, voffB);
            PG8_WAIT_V(6); PG8_BAR; PG8_MMA(1, 1, At, B1); PG8_BAR;
            PG8_LDB(B0, 1, 0); PG8_SCHED; PG8_LDA(At, 1, 0); PG8_STAGE(PG8_SA(0, 1), a2 + hstepA, voffA);
            PG8_WAIT_L(8); PG8_BAR; PG8_WAIT_L(0); PG8_MMA(0, 0, At, B0); PG8_BAR; PG8_SCHED;
            PG8_LDB(B1, 1, 1); PG8_STAGE(PG8_SB(1, 0), b3, voffB);
            PG8_BAR; PG8_WAIT_L(0); PG8_MMA(0, 1, At, B1); PG8_BAR;
            PG8_LDA(At, 1, 1); PG8_STAGE(PG8_SA(1, 0), a3, voffA);
            PG8_BAR; PG8_WAIT_L(0); PG8_MMA(1, 0, At, B0); PG8_BAR; PG8_SCHED;
            PG8_STAGE(PG8_SB(1, 1), b3 + hstepB, voffB);
            PG8_WAIT_V(6); PG8_BAR; PG8_MMA(1, 1, At, B1); PG8_BAR;
        }
        gemm_epilogue<EPI>(kp, tr, l, k, gi, acc, cur, lds);
        if (!has_next) break;
#pragma unroll
        for (int a = 0; a < 2; ++a)
#pragma unroll
            for (int b = 0; b < 2; ++b)
#pragma unroll
                for (int m = 0; m < 4; ++m)
#pragma unroll
                    for (int n = 0; n < 2; ++n) acc[a][b][m][n] = (f32x4){0.f, 0.f, 0.f, 0.f};
        cur = nxt; cA = nA; cB = nB; ++ui;
    }
    PG8_WAIT_V(0);
    if (wr == 0) PG8_BAR;
    PG8_BAR;
#undef PG8_SA
#undef PG8_SB
#undef PG8_STAGE
#undef PG8_LDA
#undef PG8_LDB
#undef PG8_MMA
#undef PG8_WAIT_V
#undef PG8_WAIT_L
#undef PG8_BAR
#undef PG8_SCHED
}

namespace att {
constexpr int NW = 8, QBLK = 32, KVBLK = 64;
constexpr float SCALE = 0.07216878364870322f;
constexpr float THR = 8.f;
constexpr int LDQ = 1536, LDK = 2048, LDKR = 64, LDO = 2048;
constexpr int SHM_V = KVBLK * 128 * 2, SHM_K = KVBLK * 128 * 2, SHM_KR = KVBLK * 64 * 2;
#define KSWZ(row, colB) ((row) * 256 + ((colB) ^ (((row) & 7) << 4)))
#define KRSWZ(row, colB) ((row) * 128 + ((colB) ^ (((row) & 7) << 4)))
#define SBAR() __builtin_amdgcn_sched_barrier(0)
__device__ __forceinline__ int crow(int r, int hi) { return (r & 3) + 8 * (r >> 2) + 4 * hi; }
__device__ __forceinline__ void partialSM(f32x16& p0, f32x16& p1, float& m_reg, float& mn, float& alpha) {
    constexpr float C = SCALE * 1.4426950408889634f;
    float pmax = p0[0];
#pragma unroll
    for (int r = 1; r < 16; ++r) pmax = fmaxf(pmax, p0[r]);
#pragma unroll
    for (int r = 0; r < 16; ++r) pmax = fmaxf(pmax, p1[r]);
    { auto rr = __builtin_amdgcn_permlane32_swap(__float_as_uint(pmax), __float_as_uint(pmax), false, false);
      pmax = fmaxf(__uint_as_float(rr[0]), __uint_as_float(rr[1])); }
    if (__builtin_expect(__all(pmax - m_reg <= THR / SCALE), 1)) { mn = m_reg; alpha = 1.f; }
    else { mn = fmaxf(m_reg, pmax); alpha = __builtin_amdgcn_exp2f((m_reg - mn) * C); m_reg = mn; }
    float mnC = -mn * C;
#pragma unroll
    for (int r = 0; r < 16; ++r) p0[r] = fmaf(p0[r], C, mnC);
#pragma unroll
    for (int r = 0; r < 16; ++r) p1[r] = fmaf(p1[r], C, mnC);
#pragma unroll
    for (int r = 0; r < 16; ++r) p0[r] = __builtin_amdgcn_exp2f(p0[r]);
}
__device__ __forceinline__ void finishSM(f32x16& p0, f32x16& p1, float alpha, float& l_reg, bf16x8& pa0, bf16x8& pa1, bf16x8& pa2, bf16x8& pa3) {
#pragma unroll
    for (int r = 0; r < 16; ++r) p1[r] = __builtin_amdgcn_exp2f(p1[r]);
    float ps = 0;
#pragma unroll
    for (int r = 0; r < 16; ++r) ps += p0[r];
#pragma unroll
    for (int r = 0; r < 16; ++r) ps += p1[r];
    { auto rr = __builtin_amdgcn_permlane32_swap(__float_as_uint(ps), __float_as_uint(ps), false, false);
      ps = __uint_as_float(rr[0]) + __uint_as_float(rr[1]); }
    l_reg = l_reg * alpha + ps;
#define PK4(P, BASE, OUT) do { unsigned a0 = cvtpk(P[BASE + 0], P[BASE + 1]), a1 = cvtpk(P[BASE + 2], P[BASE + 3]);   \
    unsigned b0 = cvtpk(P[BASE + 4], P[BASE + 5]), b1 = cvtpk(P[BASE + 6], P[BASE + 7]);                              \
    auto r0 = __builtin_amdgcn_permlane32_swap(a0, b0, false, false); auto r1 = __builtin_amdgcn_permlane32_swap(a1, b1, false, false); \
    u32x4 w = {r0[0], r1[0], r0[1], r1[1]}; OUT = *reinterpret_cast<bf16x8*>(&w); } while (0)
    PK4(p0, 0, pa0); PK4(p0, 8, pa1); PK4(p1, 0, pa2); PK4(p1, 8, pa3);
#undef PK4
}
__device__ __forceinline__ void qkt(f32x16& p0, f32x16& p1, const char* Ks, const char* Krs, const bf16x8* qr, const char* qrl, int r32, int hi) {
    p0 = f32x16{}; p1 = f32x16{};
#pragma unroll
    for (int d0 = 0; d0 < 8; ++d0) { int cb = (d0 * 16 + hi * 8) * 2;
        bf16x8 b0 = *reinterpret_cast<const bf16x8*>(Ks + KSWZ(r32, cb));
        bf16x8 b1 = *reinterpret_cast<const bf16x8*>(Ks + KSWZ(32 + r32, cb));
        p0 = __builtin_amdgcn_mfma_f32_32x32x16_bf16(b0, qr[d0], p0, 0, 0, 0);
        p1 = __builtin_amdgcn_mfma_f32_32x32x16_bf16(b1, qr[d0], p1, 0, 0, 0); }
#pragma unroll
    for (int d0 = 0; d0 < 4; ++d0) { int cb = (d0 * 16 + hi * 8) * 2;
        bf16x8 b0 = *reinterpret_cast<const bf16x8*>(Krs + KRSWZ(r32, cb));
        bf16x8 b1 = *reinterpret_cast<const bf16x8*>(Krs + KRSWZ(32 + r32, cb));
        const bf16x8 qv = *reinterpret_cast<const bf16x8*>(qrl + d0 * 8192);
        p0 = __builtin_amdgcn_mfma_f32_32x32x16_bf16(b0, qv, p0, 0, 0, 0);
        p1 = __builtin_amdgcn_mfma_f32_32x32x16_bf16(b1, qv, p1, 0, 0, 0); }
}
__device__ __forceinline__ int v_st(int k, int c) { const int kk = (k & ~0xC) | ((k & 4) << 1) | ((k & 8) >> 1); return ((kk >> 3) * 4 + (c >> 5)) * 512 + ((kk & 7) * 32 + (c & 31)) * 2; }
__device__ __forceinline__ int v_rd_base(int lane) { return ((lane & 3) << 3) | (((lane >> 2) & 3) << 6) | (((lane >> 4) & 1) << 5) | (((lane >> 5) & 1) << 8); }
constexpr int v_rd_off(int d0, int ks, int half) { return d0 * 512 + ks * 4096 + half * 2048; }
template <int OFF> __device__ __forceinline__ s16x4 tr_read(int vb) {
    s16x4 r; asm volatile("ds_read_b64_tr_b16 %0, %1 offset:%2" : "=&v"(r) : "v"(vb), "i"(OFF) : "memory"); return r;
}
template <int D0> __device__ __forceinline__ void pv_one(f32x16& od, int vb, bf16x8 pa0, bf16x8 pa1, bf16x8 pa2, bf16x8 pa3) {
    const s16x4 l0 = tr_read<v_rd_off(D0, 0, 0)>(vb), h0 = tr_read<v_rd_off(D0, 0, 1)>(vb), l1 = tr_read<v_rd_off(D0, 1, 0)>(vb), h1 = tr_read<v_rd_off(D0, 1, 1)>(vb);
    const s16x4 l2 = tr_read<v_rd_off(D0, 2, 0)>(vb), h2 = tr_read<v_rd_off(D0, 2, 1)>(vb), l3 = tr_read<v_rd_off(D0, 3, 0)>(vb), h3 = tr_read<v_rd_off(D0, 3, 1)>(vb);
    asm volatile("s_waitcnt lgkmcnt(0)" ::: "memory"); SBAR();
#define PK(L, H) (bf16x8){L[0], L[1], L[2], L[3], H[0], H[1], H[2], H[3]}
    od = __builtin_amdgcn_mfma_f32_32x32x16_bf16(pa0, PK(l0, h0), od, 0, 0, 0);
    od = __builtin_amdgcn_mfma_f32_32x32x16_bf16(pa1, PK(l1, h1), od, 0, 0, 0);
    od = __builtin_amdgcn_mfma_f32_32x32x16_bf16(pa2, PK(l2, h2), od, 0, 0, 0);
    od = __builtin_amdgcn_mfma_f32_32x32x16_bf16(pa3, PK(l3, h3), od, 0, 0, 0);
#undef PK
}
__device__ __forceinline__ void pv_d0(f32x16* o, int vb, bf16x8 pa0, bf16x8 pa1, bf16x8 pa2, bf16x8 pa3) {
    pv_one<0>(o[0], vb, pa0, pa1, pa2, pa3); pv_one<1>(o[1], vb, pa0, pa1, pa2, pa3); pv_one<2>(o[2], vb, pa0, pa1, pa2, pa3); pv_one<3>(o[3], vb, pa0, pa1, pa2, pa3);
}

__device__ __forceinline__ void attn_body(const bf16_t* __restrict__ Qb, const bf16_t* __restrict__ Kh, const bf16_t* __restrict__ Kr,
                                          bf16_t* __restrict__ Ob, int ml_off, int seq, char* lds) {
    const int tid = ltid(), wid = tid >> 6, lane = tid & 63, r32 = lane & 31, hi = lane >> 5;
    char* V_lds = lds; char* K_lds = lds + 2 * SHM_V; char* KR_lds = lds + 2 * SHM_V + 2 * SHM_K;
    float* ws = (float*)(lds + 2 * SHM_V + 2 * SHM_K + 2 * SHM_KR) + wid * 64; float* li_l = ws; float* al_l = ws + 32;
    float m_reg = -1e30f, l_reg = 0; f32x16 o[4] = {}; bf16x8 qr[8];
    const bf16_t* Qw = Qb + (long)(wid * QBLK + r32) * LDQ + hi * 8;
#pragma unroll
    for (int d0 = 0; d0 < 8; ++d0) qr[d0] = *reinterpret_cast<const bf16x8*>(Qw + d0 * 16);
    char* qrl = lds + 84 * 1024 + tid * 16;
#pragma unroll
    for (int d0 = 0; d0 < 4; ++d0) *reinterpret_cast<bf16x8*>(qrl + d0 * 8192) = *reinterpret_cast<const bf16x8*>(Qw + (8 + d0) * 16);
    const int sr = tid >> 4, sc = (tid & 15) * 8, vst0 = v_st(sr, sc), vst1 = v_st(32 + sr, sc);
    const int krr = tid >> 3, krc = (tid & 7) * 8;
    const int vb0 = (int)(uintptr_t)V_lds + v_rd_base(lane);
    bf16x8 s_vs0, s_vs1, s_ks0, s_ks1, s_kr;
#define SLOAD(k0) do { s_vs0 = *reinterpret_cast<const bf16x8*>(&Kh[(long)((k0) + sr) * LDK + sc + 128]); s_vs1 = *reinterpret_cast<const bf16x8*>(&Kh[(long)((k0) + 32 + sr) * LDK + sc + 128]); \
    s_ks0 = *reinterpret_cast<const bf16x8*>(&Kh[(long)((k0) + sr) * LDK + sc]); s_ks1 = *reinterpret_cast<const bf16x8*>(&Kh[(long)((k0) + 32 + sr) * LDK + sc]); \
    s_kr = *reinterpret_cast<const bf16x8*>(&Kr[(long)((k0) + krr) * LDKR + krc]); } while (0)
#define SWRITE(b) do { *(bf16x8*)(V_lds + (b) * SHM_V + vst0) = s_vs0; *(bf16x8*)(V_lds + (b) * SHM_V + vst1) = s_vs1; int kc = sc * 2;   \
    *(bf16x8*)(K_lds + (b) * SHM_K + KSWZ(sr, kc)) = s_ks0; *(bf16x8*)(K_lds + (b) * SHM_K + KSWZ(32 + sr, kc)) = s_ks1;                  \
    *(bf16x8*)(KR_lds + (b) * SHM_KR + KRSWZ(krr, krc * 2)) = s_kr; } while (0)
#define SWAIT() asm volatile("s_waitcnt vmcnt(0)" ::: "memory")
#define RESC(a) do { if (__any((a) < 1.f)) { if (hi == 0) al_l[r32] = (a); asm volatile("s_waitcnt lgkmcnt(0)" ::: "memory"); \
    _Pragma("unroll") for (int d = 0; d < 4; ++d) _Pragma("unroll") for (int r = 0; r < 16; ++r) o[d][r] *= al_l[crow(r, hi)]; } } while (0)
    f32x16 pA0, pA1, pB0, pB1; float mnA, mnB, alA, alB; bf16x8 pa0, pa1, pa2, pa3; const int NT = seq / KVBLK;
    SLOAD(0); SWAIT(); SWRITE(0); __syncthreads();
    qkt(pA0, pA1, K_lds, KR_lds, qr, qrl, r32, hi); partialSM(pA0, pA1, m_reg, mnA, alA);
    SLOAD(KVBLK);
    SWAIT(); SWRITE(1); __syncthreads();
    for (int j = 1; j + 1 < NT; j += 2) {
        SBAR(); qkt(pB0, pB1, K_lds + SHM_K, KR_lds + SHM_KR, qr, qrl, r32, hi);
        finishSM(pA0, pA1, alA, l_reg, pa0, pa1, pa2, pa3); SBAR();
        SLOAD((j + 1) * KVBLK); SBAR();
        pv_d0(o, vb0, pa0, pa1, pa2, pa3); partialSM(pB0, pB1, m_reg, mnB, alB);
        __syncthreads(); SWAIT(); SWRITE(0);
        RESC(alB); __syncthreads();
        SBAR(); qkt(pA0, pA1, K_lds, KR_lds, qr, qrl, r32, hi);
        finishSM(pB0, pB1, alB, l_reg, pa0, pa1, pa2, pa3); SBAR();
        SLOAD((j + 2) * KVBLK); SBAR();
        pv_d0(o, vb0 + (int)SHM_V, pa0, pa1, pa2, pa3); partialSM(pA0, pA1, m_reg, mnA, alA);
        __syncthreads(); SWAIT(); SWRITE(1);
        RESC(alA); __syncthreads();
    }
    SBAR(); qkt(pB0, pB1, K_lds + SHM_K, KR_lds + SHM_KR, qr, qrl, r32, hi);
    finishSM(pA0, pA1, alA, l_reg, pa0, pa1, pa2, pa3); SBAR();
    pv_d0(o, vb0, pa0, pa1, pa2, pa3); partialSM(pB0, pB1, m_reg, mnB, alB);
    __syncthreads(); RESC(alB);
    finishSM(pB0, pB1, alB, l_reg, pa0, pa1, pa2, pa3); SBAR();
    pv_d0(o, vb0 + (int)SHM_V, pa0, pa1, pa2, pa3);
    if (hi == 0) li_l[r32] = l_reg; asm volatile("s_waitcnt lgkmcnt(0)" ::: "memory");
    if (ml_off >= 0 && hi == 0) {
        const Params* kpa = (const Params*)__builtin_amdgcn_kernarg_segment_ptr(); asm volatile("" : "+s"(kpa));
        float* d = (float*)(kpa->ws + OFF_XB + 2048) + ml_off + (wid * QBLK + r32) * 1024; d[0] = m_reg; d[1] = l_reg; }
    float rli[16];
#pragma unroll
    for (int r = 0; r < 16; ++r) rli[r] = __builtin_amdgcn_rcpf(li_l[crow(r, hi)]);
    bf16_t* Ow = Ob + (long)(wid * QBLK) * LDO;
#pragma unroll
    for (int r = 0; r < 16; ++r) { int orow = crow(r, hi);
#pragma unroll
        for (int d0 = 0; d0 < 4; ++d0) Ow[(long)orow * LDO + d0 * 32 + r32] = f2bf(o[d0][r] * rli[r]); }
    __syncthreads();
#undef SLOAD
#undef SWRITE
#undef SWAIT
#undef RESC
}
}

namespace hg {
constexpr int LD = 136, LDT = 72;
constexpr int O_RZ = 0, O_RQ = O_RZ + 64 * LD * 2, O_RV = O_RQ + 64 * LD * 2, O_QD = O_RV + 64 * LD * 2, O_KD = O_QD + 64 * LD * 2,
              O_KDT = O_KD + 64 * LD * 2, O_VT = O_KDT + 128 * LDT * 2, O_P = O_VT + 128 * LDT * 2, O_SEG = O_P + 64 * LDT * 2, O_EV = O_SEG + 4 * 128 * 4, O_END = O_EV + 3 * 128 * 4;
static_assert(O_END <= LDS_BCAST, "hgrn LDS");
__device__ __forceinline__ float clampf(float x, float lo, float hi) { return fminf(fmaxf(x, lo), hi); }

__device__ __forceinline__ void hgrn_unit(LAS unsigned char* lds, bf16_t* hgb  , const float* lb_logits, int layer, int S, int unit) {
    const int tid = ltid(), wid = tid >> 6, lane = tid & 63, l15 = lane & 15, quad = lane >> 4;
    const int dir = unit & 1, h = (unit >> 1) & 7, b = unit >> 4;
    const int qcol = h * 128, zcol = (dir ? 2048 : 1024) + h * 128, vcol = 3072 + h * 128;
    const int ch = tid & 127, seg = tid >> 7;
    LAS bf16_t* RZ = (LAS bf16_t*)(lds + O_RZ); LAS bf16_t* RQ = (LAS bf16_t*)(lds + O_RQ); LAS bf16_t* RV = (LAS bf16_t*)(lds + O_RV);
    LAS bf16_t* QD = (LAS bf16_t*)(lds + O_QD); LAS bf16_t* KD = (LAS bf16_t*)(lds + O_KD); LAS bf16_t* KDT = (LAS bf16_t*)(lds + O_KDT);
    LAS bf16_t* VT = (LAS bf16_t*)(lds + O_VT); LAS bf16_t* PP = (LAS bf16_t*)(lds + O_P);
    LAS float* SEG = (LAS float*)(lds + O_SEG); LAS float* EV = (LAS float*)(lds + O_EV);
    const int n = S / 64;
    const int r0 = tid >> 4, c8 = (tid & 15) * 8;
    bf16x8 pz0, pz1, pq0, pq1, pv0, pv1;
#define HG_ROW(c, tau) ((long)b * S + (dir ? (S - 1 - ((c) * 64 + (tau))) : ((c) * 64 + (tau))))
#define HG_LOAD(c) do { const bf16_t* ra = hgb + HG_ROW(c, r0) * HGW; const bf16_t* rb = hgb + HG_ROW(c, r0 + 32) * HGW; \
    pz0 = *(const bf16x8*)(ra + zcol + c8); pz1 = *(const bf16x8*)(rb + zcol + c8); pq0 = *(const bf16x8*)(ra + qcol + c8); pq1 = *(const bf16x8*)(rb + qcol + c8); \
    pv0 = *(const bf16x8*)(ra + vcol + c8); pv1 = *(const bf16x8*)(rb + vcol + c8); } while (0)
    f32x4 Sst[8];
#pragma unroll
    for (int i = 0; i < 8; ++i) Sst[i] = (f32x4){0.f, 0.f, 0.f, 0.f};
    HG_LOAD(0);
    for (int c = 0; c < n; ++c) {
        *(LAS bf16x8*)(RZ + r0 * LD + c8) = pz0; *(LAS bf16x8*)(RZ + (r0 + 32) * LD + c8) = pz1;
        *(LAS bf16x8*)(RQ + r0 * LD + c8) = pq0; *(LAS bf16x8*)(RQ + (r0 + 32) * LD + c8) = pq1;
        *(LAS bf16x8*)(RV + r0 * LD + c8) = pv0; *(LAS bf16x8*)(RV + (r0 + 32) * LD + c8) = pv1;
        asm volatile("s_waitcnt lgkmcnt(0)" ::: "memory"); __builtin_amdgcn_s_barrier(); asm volatile("" ::: "memory");
        if (c + 1 < n) HG_LOAD(c + 1);
        float bl[16], kk[16]; float run = 0.f;
#pragma unroll
        for (int i = 0; i < 16; ++i) {
            const float lf = bf2f(RZ[(seg * 16 + i) * LD + ch]);
            run += lf; bl[i] = run; kk[i] = 1.f - __expf(lf);
        }
        SEG[seg * 128 + ch] = run;
        asm volatile("s_waitcnt lgkmcnt(0)" ::: "memory"); __builtin_amdgcn_s_barrier(); asm volatile("" ::: "memory");
        const float t0 = SEG[ch], t1 = SEG[128 + ch], t2 = SEG[256 + ch], t3 = SEG[384 + ch];
        const float off = (seg > 0 ? t0 : 0.f) + (seg > 1 ? t1 : 0.f) + (seg > 2 ? t2 : 0.f);
        const float bref = t0 + t1, btot = (t0 + t1) + (t2 + t3);
        unsigned kdt[8], vtt[8];
#pragma unroll
        for (int i = 0; i < 16; ++i) {
            const int tau = seg * 16 + i;
            const float bb = bl[i] + off;
            const float eq = __expf(clampf(bb - bref, -80.f, 80.f)), ek = __builtin_amdgcn_rcpf(eq);
            const float sq = bf2f(RQ[tau * LD + ch]);
            QD[tau * LD + ch] = f2bf(sq * eq);
            const bf16_t kb = f2bf(kk[i] * ek);
            KD[tau * LD + ch] = kb;
            const bf16_t vb = RV[tau * LD + ch];
            if (i & 1) { kdt[i >> 1] |= ((unsigned)kb) << 16; vtt[i >> 1] |= ((unsigned)vb) << 16; } else { kdt[i >> 1] = kb; vtt[i >> 1] = vb; }
        }
        *(LAS u32x4*)(KDT + ch * LDT + seg * 16) = (u32x4){kdt[0], kdt[1], kdt[2], kdt[3]}; *(LAS u32x4*)(KDT + ch * LDT + seg * 16 + 8) = (u32x4){kdt[4], kdt[5], kdt[6], kdt[7]};
        *(LAS u32x4*)(VT + ch * LDT + seg * 16) = (u32x4){vtt[0], vtt[1], vtt[2], vtt[3]}; *(LAS u32x4*)(VT + ch * LDT + seg * 16 + 8) = (u32x4){vtt[4], vtt[5], vtt[6], vtt[7]};
        if (seg == 0) { EV[ch] = __expf(clampf(bref, -80.f, 80.f)); EV[128 + ch] = __expf(clampf(btot, -80.f, 80.f)); EV[256 + ch] = __expf(clampf(btot - bref, -80.f, 80.f)); }
        asm volatile("s_waitcnt lgkmcnt(0)" ::: "memory"); __builtin_amdgcn_s_barrier(); asm volatile("" ::: "memory");
#pragma unroll
        for (int tt = 0; tt < 2; ++tt) {
            const int ti = wid * 2 + tt, sblk = ti >> 2, tblk = ti & 3;
            f32x4 a = (f32x4){0.f, 0.f, 0.f, 0.f};
            if (sblk <= tblk) {
#pragma unroll
                for (int ks = 0; ks < 4; ++ks) {
                    const bf16x8 af = *(LAS bf16x8*)(KD + (sblk * 16 + l15) * LD + ks * 32 + quad * 8);
                    const bf16x8 bfr = *(LAS bf16x8*)(QD + (tblk * 16 + l15) * LD + ks * 32 + quad * 8);
                    a = __builtin_amdgcn_mfma_f32_16x16x32_bf16(af, bfr, a, 0, 0, 0);
                }
            }
            const int t = tblk * 16 + l15, s0 = sblk * 16 + quad * 4;
            u32x2 w; w.x = cvtpk(s0 + 0 <= t ? a[0] : 0.f, s0 + 1 <= t ? a[1] : 0.f); w.y = cvtpk(s0 + 2 <= t ? a[2] : 0.f, s0 + 3 <= t ? a[3] : 0.f);
            *(LAS u32x2*)(PP + t * LDT + s0) = w;
        }
        asm volatile("s_waitcnt lgkmcnt(0)" ::: "memory"); __builtin_amdgcn_s_barrier(); asm volatile("" ::: "memory");
        const int dv0 = wid * 16;
        bf16x8 bv[2];
#pragma unroll
        for (int ks = 0; ks < 2; ++ks) bv[ks] = *(LAS bf16x8*)(VT + (dv0 + l15) * LDT + ks * 32 + quad * 8);
        f32x4 o[4];
#pragma unroll
        for (int i = 0; i < 4; ++i) o[i] = (f32x4){0.f, 0.f, 0.f, 0.f};
#pragma unroll
        for (int k4 = 0; k4 < 4; ++k4) {
            const f32x4 er0 = *(LAS f32x4*)(EV + 32 * k4 + 4 * quad), er1 = *(LAS f32x4*)(EV + 32 * k4 + 16 + 4 * quad);
            const f32x4 s0 = Sst[2 * k4] * er0, s1 = Sst[2 * k4 + 1] * er1;
            u32x4 bw; bw.x = cvtpk(s0[0], s0[1]); bw.y = cvtpk(s0[2], s0[3]); bw.z = cvtpk(s1[0], s1[1]); bw.w = cvtpk(s1[2], s1[3]);
            const bf16x8 bfr = *reinterpret_cast<bf16x8*>(&bw);
#pragma unroll
            for (int tb = 0; tb < 4; ++tb) {
                const u32x2 a0 = *(LAS u32x2*)(QD + (tb * 16 + l15) * LD + 32 * k4 + 4 * quad);
                const u32x2 a1 = *(LAS u32x2*)(QD + (tb * 16 + l15) * LD + 32 * k4 + 16 + 4 * quad);
                u32x4 aw; aw.x = a0.x; aw.y = a0.y; aw.z = a1.x; aw.w = a1.y;
                o[tb] = __builtin_amdgcn_mfma_f32_16x16x32_bf16(*reinterpret_cast<bf16x8*>(&aw), bfr, o[tb], 0, 0, 0);
            }
        }
#pragma unroll
        for (int ks = 0; ks < 2; ++ks)
#pragma unroll
            for (int tb = 0; tb < 4; ++tb) {
                const bf16x8 af = *(LAS bf16x8*)(PP + (tb * 16 + l15) * LDT + ks * 32 + quad * 8);
                o[tb] = __builtin_amdgcn_mfma_f32_16x16x32_bf16(af, bv[ks], o[tb], 0, 0, 0);
            }
#pragma unroll
        for (int tb = 0; tb < 4; ++tb)
#pragma unroll
            for (int j = 0; j < 4; ++j) hgb[HG_ROW(c, tb * 16 + quad * 4 + j) * HGW + zcol + dv0 + l15] = f2bf(o[tb][j]);
#pragma unroll
        for (int db = 0; db < 8; ++db) {
            f32x4 tmp = (f32x4){0.f, 0.f, 0.f, 0.f};
#pragma unroll
            for (int ks = 0; ks < 2; ++ks) {
                const bf16x8 af = *(LAS bf16x8*)(KDT + (db * 16 + l15) * LDT + ks * 32 + quad * 8);
                tmp = __builtin_amdgcn_mfma_f32_16x16x32_bf16(af, bv[ks], tmp, 0, 0, 0);
            }
            const f32x4 et = *(LAS f32x4*)(EV + 128 + db * 16 + quad * 4), etr = *(LAS f32x4*)(EV + 256 + db * 16 + quad * 4);
            Sst[db] = Sst[db] * et + tmp * etr;
        }
    }
    wg_barrier();
#undef HG_ROW
#undef HG_LOAD
}
}

struct WDesc { const float* src; const float* gain; bf16_t* dst; int K, N, R, map; };

__device__ __forceinline__ void wcvt_phase(LAS unsigned char* lds, const Params& p, int layer) {
    LAS float* tile = (LAS float*)lds;
    const int tid = ltid();
    char* ws = p.ws;
    if (lbid() == 0) {
        float* lbt = (float*)(ws + OFF_LB);
        for (int i = tid; i < 2048; i += 512) {
            float mx = -3e38f; for (int l = 0; l < DEPTH; ++l) mx = fmaxf(mx, p.lb_logits[l * 2048 + i]);
            float den = 0.f, num = 0.f; for (int l = 0; l < DEPTH; ++l) { const float e = __expf(p.lb_logits[l * 2048 + i] - mx); den += e; if (l >= 1 && l <= layer) num += e; }
            lbt[i] = num / den;
        }
    }
    for (int mi = 0; mi < 10; ++mi) {
        WDesc d;
        switch (mi) {
        case 0: d = {p.w_in + (size_t)layer * 2048 * 5952, p.mix_norm + layer * 2048, (bf16_t*)(ws + OFF_W_IN), 2048, 5952, INP, 1}; break;
        case 1: d = {p.w_uq + (size_t)layer * 512 * 1536, p.q_norm + layer * 512, (bf16_t*)(ws + OFF_W_UQ), 512, 1536, 1536, 0}; break;
        case 2: d = {p.w_ukv + (size_t)layer * 256 * 2048, p.kv_norm + layer * 256, (bf16_t*)(ws + OFF_W_UKV), 256, 2048, 2048, 0}; break;
        case 3: d = {p.w_out + (size_t)layer * 2048 * 2048, nullptr, (bf16_t*)(ws + OFF_W_OUT), 2048, 2048, 2048, 0}; break;
        case 4: d = {p.w_xq + (size_t)layer * 2048 * 2048, p.xattn_norm + layer * 2048, (bf16_t*)(ws + OFF_W_XQ), 2048, 2048, 2048, 0}; break;
        case 5: d = {p.w_xk + (size_t)layer * 2048 * 2048, p.mem_norm + layer * 2048, (bf16_t*)(ws + OFF_W_XK), 2048, 2048, 2048, 0}; break;
        case 6: d = {p.w_xv + (size_t)layer * 2048 * 2048, p.mem_norm + layer * 2048, (bf16_t*)(ws + OFF_W_XV), 2048, 2048, 2048, 0}; break;
        case 7: d = {p.w_xo + (size_t)layer * 2048 * 2048, nullptr, (bf16_t*)(ws + OFF_W_XO), 2048, 2048, 2048, 0}; break;
        case 8: d = {p.w_ffn1 + (size_t)layer * 2048 * 8192, p.ffn_norm + layer * 2048, (bf16_t*)(ws + OFF_W_F1), 2048, 8192, 8192, 0}; break;
        default: d = {p.w_ffn2 + (size_t)layer * 8192 * 2048, nullptr, (bf16_t*)(ws + OFF_W_F2), 8192, 2048, 2048, 0}; break;
        }
        const int nkt = d.K / 64, nrt = d.R / 256, ntile = nkt * nrt;
        for (int t = lbid(); t < ntile; t += gridDim.x) {
            const int kt = t % nkt, rt = t / nkt, k0 = kt * 64, r0 = rt * 256;
            {
                const int c4 = tid & 63, rr = tid >> 6; const int col = r0 + 4 * c4;
                int sc = col; bool zero = false;
                if (d.map) { if (col < 832) sc = col; else if (col < 1024) zero = true; else sc = col - 192; }
#pragma unroll
                for (int ii = 0; ii < 8; ++ii) { const int i = rr + ii * 8;
                    f32x4 v = zero ? (f32x4){0.f, 0.f, 0.f, 0.f} : *(const f32x4*)(d.src + (size_t)(k0 + i) * d.N + sc);
                    if (d.gain) v = v * d.gain[k0 + i];
                    *(LAS f32x4*)(tile + i * 260 + 4 * c4) = v; }
            }
            wg_barrier();
            {
                const int n = tid >> 1, kh = (tid & 1) * 32;
#pragma unroll
                for (int j = 0; j < 4; ++j) {
                    unsigned w[4];
#pragma unroll
                    for (int e = 0; e < 8; e += 2) w[e >> 1] = cvtpk(tile[(kh + j * 8 + e) * 260 + n], tile[(kh + j * 8 + e + 1) * 260 + n]);
                    *(u32x4*)(d.dst + (size_t)(r0 + n) * d.K + k0 + kh + j * 8) = (u32x4){w[0], w[1], w[2], w[3]};
                }
            }
            wg_barrier();
        }
    }
}

__device__ __forceinline__ void prep_phase(const Params& p, int tr, int T, int S) {
    const size_t xb_off = tr ? OFF_XB : OFF_XB0;
    const int tid = ltid(), wid = tid >> 6, lane = tid & 63;
    char* ws = p.ws;
    const long gtid = (long)lbid() * 512 + tid, gstride = (long)gridDim.x * 512;
    { ssq_t* ssq = (ssq_t*)(ws + OFF_SSQ) + (size_t)tr * 11 * TMAX; for (long i = gtid; i < (long)10 * TMAX; i += gstride) ssq[TMAX + i] = 0ull;
      if (gtid < 64) ((unsigned*)(ws + OFF_CTR))[gtid] = 0u; }
    { float* rc = (float*)(ws + OFF_ROPE); float* rs = rc + 16384 * 32;
      for (int i = (int)gtid; i < S * 32; i += (int)gstride) { const int pos = i >> 5, f = i & 31;
          const float inv_freq = exp2f(-(float)f * (13.287712379549449f / 32.f));
          const float ang = (float)pos * inv_freq;
          const double rev = (double)ang * 0.15915494309189535; const float fr = (float)(rev - rint(rev));
          rc[i] = __builtin_amdgcn_cosf(fr); rs[i] = __builtin_amdgcn_sinf(fr); } }
    { const float* x = p.x_in[tr]; bf16_t* xb = (bf16_t*)(ws + xb_off); ssq_t* ssq0 = (ssq_t*)(ws + OFF_SSQ) + (size_t)tr * 11 * TMAX;
      for (int row = lbid() * 8 + wid; row < T; row += gridDim.x * 8) {
          float ss = 0.f;
#pragma unroll
          for (int i = 0; i < 8; ++i) { const int c = i * 256 + lane * 4; const f32x4 v = *(const f32x4*)(x + (size_t)row * DM + c);
              ss += (v[0] * v[0] + v[1] * v[1]) + (v[2] * v[2] + v[3] * v[3]);
              u32x2 w; w.x = cvtpk(v[0], v[1]); w.y = cvtpk(v[2], v[3]); *(u32x2*)(xb + (size_t)row * DM + c) = w; }
#pragma unroll
          for (int o = 32; o > 0; o >>= 1) ss += __shfl_xor(ss, o);
          if (lane == 0) ssq0[row] = ssq_fix(ss);
      } }
    { const float* mem = p.mem_in[tr]; bf16_t* mn = (bf16_t*)(ws + OFF_MEMN) + (size_t)tr * 512 * 2048;
      for (int row = lbid() * 8 + wid; row < 512; row += gridDim.x * 8) {
          f32x4 v[8]; float ss = 0.f;
#pragma unroll
          for (int i = 0; i < 8; ++i) { v[i] = *(const f32x4*)(mem + (size_t)row * DM + i * 256 + lane * 4); ss += (v[i][0] * v[i][0] + v[i][1] * v[i][1]) + (v[i][2] * v[i][2] + v[i][3] * v[i][3]); }
#pragma unroll
          for (int o = 32; o > 0; o >>= 1) ss += __shfl_xor(ss, o);
          const float rs = __builtin_amdgcn_rsqf(ss * (1.f / DM) + EPS);
#pragma unroll
          for (int i = 0; i < 8; ++i) { u32x2 w; w.x = cvtpk(v[i][0] * rs, v[i][1] * rs); w.y = cvtpk(v[i][2] * rs, v[i][3] * rs); *(u32x2*)(mn + (size_t)row * DM + i * 256 + lane * 4) = w; }
      } }
}

__device__ __forceinline__ void rope_phase(const Params& p, int T, int S) {
    char* ws = p.ws;
    bf16_t* q = (bf16_t*)(ws + OFF_Q); const bf16_t* kr = (const bf16_t*)(ws + OFF_KR); bf16_t* kro = (bf16_t*)(ws + OFF_KROPE);
    const float* rc = (const float*)(ws + OFF_ROPE); const float* rs = rc + 16384 * 32;
    const int total = T * 9 * 4;
    constexpr int UN = 3;
    const int stride = gridDim.x * 512;
    for (int i0 = lbid() * 512 + ltid(); i0 < total; i0 += stride * UN) {
        f32x8 c[UN], s[UN]; bf16x8 a1[UN], a2[UN];
#pragma unroll
        for (int u = 0; u < UN; ++u) { const int i = i0 + u * stride; if (i < total) {
            const int f8 = (i & 3) * 8; const int ru = i >> 2; const int row_i = ru / 9; const int un = ru - row_i * 9; const long row = row_i; const int pos = row_i & (S - 1);
            c[u] = *(const f32x8*)(rc + pos * 32 + f8); s[u] = *(const f32x8*)(rs + pos * 32 + f8);
            const bf16_t* src = (un < 8) ? (q + row * 1536 + un * 192 + 128 + f8) : (kr + row * 64 + f8);
            a1[u] = *(const bf16x8*)src; a2[u] = *(const bf16x8*)(src + 32); } }
#pragma unroll
        for (int u = 0; u < UN; ++u) { const int i = i0 + u * stride; if (i >= total) break;
            const int f8 = (i & 3) * 8; const int ru = i >> 2; const int row_i = ru / 9; const int un = ru - row_i * 9; const long row = row_i;
            bf16_t* dst = (un < 8) ? (q + row * 1536 + un * 192 + 128 + f8) : (kro + row * 64 + f8);
            unsigned w1[4], w2[4];
#pragma unroll
            for (int j = 0; j < 8; j += 2) {
                const float x1a = bf2f((bf16_t)a1[u][j]), x2a = bf2f((bf16_t)a2[u][j]), x1b = bf2f((bf16_t)a1[u][j + 1]), x2b = bf2f((bf16_t)a2[u][j + 1]);
                w1[j >> 1] = cvtpk(x1a * c[u][j] - x2a * s[u][j], x1b * c[u][j + 1] - x2b * s[u][j + 1]);
                w2[j >> 1] = cvtpk(x2a * c[u][j] + x1a * s[u][j], x2b * c[u][j + 1] + x1b * s[u][j + 1]);
            }
            *(u32x4*)dst = (u32x4){w1[0], w1[1], w1[2], w1[3]}; *(u32x4*)(dst + 32) = (u32x4){w2[0], w2[1], w2[2], w2[3]};
        }
    }
}

__device__ __forceinline__ void hcomb_phase(const Params& p, int layer, int T, int nblk, int bid, int nsplit) {
    char* ws = p.ws; const bf16_t* hgb = (const bf16_t*)(ws + OFF_HG); bf16_t* mix = (bf16_t*)(ws + OFF_MIX);
    const float* on = p.out_norm + layer * 128;
    const int l16 = ltid() & 15;
    const int total = T * 8 * 16;
    f32x8 onv = *(const f32x8*)(on + l16 * 8);
    constexpr int UN = 4;
    const int stride = nblk * 512;
    for (int i0 = bid * 512 + ltid(); i0 < total; i0 += stride * UN) {
        bf16x8 vf[UN], vb[UN], vg[UN];
#pragma unroll
        for (int u = 0; u < UN; ++u) { const int i = i0 + u * stride; if (i < total) { const int rh = i >> 4; const int h = rh & 7; const long row = rh >> 3;
            const bf16_t* base = hgb + row * HGW + h * 128 + l16 * 8; vf[u] = *(const bf16x8*)(base + 1024); vb[u] = *(const bf16x8*)(base + 2048); vg[u] = *(const bf16x8*)(base + 4096); } }
#pragma unroll
        for (int u = 0; u < UN; ++u) {
            const int i = i0 + u * stride; if (i >= total) break;
            const int rh = i >> 4; const int h = rh & 7; const long row = rh >> 3;
            float o[8]; float ss = 0.f;
#pragma unroll
            for (int j = 0; j < 8; ++j) { o[j] = bf2f((bf16_t)vf[u][j]) + bf2f((bf16_t)vb[u][j]); ss += o[j] * o[j]; }
            ss += __shfl_xor(ss, 1); ss += __shfl_xor(ss, 2); ss += __shfl_xor(ss, 4); ss += __shfl_xor(ss, 8);
            const float rs = __builtin_amdgcn_rsqf(ss * (1.f / 128.f) + EPS);
            unsigned w[4];
#pragma unroll
            for (int j = 0; j < 8; j += 2) {
                const float g0 = bf2f((bf16_t)vg[u][j]), g1 = bf2f((bf16_t)vg[u][j + 1]);
                const float y0 = o[j] * rs * onv[j] * (g0 * __builtin_amdgcn_rcpf(1.f + __expf(-g0))), y1 = o[j + 1] * rs * onv[j + 1] * (g1 * __builtin_amdgcn_rcpf(1.f + __expf(-g1)));
                w[j >> 1] = cvtpk(y0, y1);
            }
            *(u32x4*)(mix + row * 2048 + 1024 + h * 128 + l16 * 8) = (u32x4){w[0], w[1], w[2], w[3]};
            if (nsplit == 2 && (((int)row & 16383) >> 8) >= MK_QF) {
                const f32x4 mlv = *(const f32x4*)((const float*)(ws + OFF_XB + 2048) + row * 1024 + h * 4);
                const float C = att::SCALE * 1.4426950408889634f;
                const float M = fmaxf(mlv[0], mlv[2]);
                const float w1 = mlv[1] * __builtin_amdgcn_exp2f((mlv[0] - M) * C), w2 = mlv[3] * __builtin_amdgcn_exp2f((mlv[2] - M) * C);
                const float inv = 1.f / (w1 + w2), c1 = w1 * inv, c2 = w2 * inv;
                bf16_t* pa = mix + row * 2048 + h * 128 + l16 * 8; const bf16_t* pb = (const bf16_t*)(ws + OFF_XB) + row * 2048 + h * 128 + l16 * 8;
                const bf16x8 va = *(const bf16x8*)pa, vb2 = *(const bf16x8*)pb;
                unsigned wo[4];
#pragma unroll
                for (int j = 0; j < 8; j += 2) wo[j >> 1] = cvtpk(c1 * bf2f((bf16_t)va[j]) + c2 * bf2f((bf16_t)vb2[j]), c1 * bf2f((bf16_t)va[j + 1]) + c2 * bf2f((bf16_t)vb2[j + 1]));
                *(u32x4*)pa = (u32x4){wo[0], wo[1], wo[2], wo[3]};
            }
        }
    }
}

__device__ __forceinline__ void final_phase(const Params& p, float* xout, int T, int tr) {
    const int wid = ltid() >> 6, lane = ltid() & 63;
    const ssq_t* ssq = (const ssq_t*)(p.ws + OFF_SSQ) + (size_t)(tr * 11 + 10) * TMAX;
    for (int row = lbid() * 8 + wid; row < T; row += gridDim.x * 8) {
        const float rs = __builtin_amdgcn_rsqf(ssq_val(ssq[row]) * (1.f / DM) + EPS);
#pragma unroll
        for (int i = 0; i < 8; ++i) { const int c = i * 256 + lane * 4; f32x4 v = *(f32x4*)(xout + (size_t)row * DM + c); const f32x4 g = *(const f32x4*)(p.final_norm + c);
            v = v * rs * g; *(f32x4*)(xout + (size_t)row * DM + c) = v; }
    }
}

__device__ __forceinline__ void mixer_phase(LAS unsigned char* lds, const Params& p, int layer, int T, int S, int tr) {
    char* ws = p.ws;
    unsigned* ctr = (unsigned*)(ws + OFF_CTR) + (tr * 2 + layer) * 16;
    const int nQB = S / 256, QF = (S >= 16384) ? MK_QF : nQB, nQS = nQB - QF;
    const int nH = 2 * 8 * 2, nFull = 16 * QF, nA = nFull + 16 * 2 * nQS;
    LAS unsigned* slot = (LAS unsigned*)(lds + LDS_BCAST);
    for (;;) {
        if (ltid() == 0) *slot = __hip_atomic_fetch_add(ctr, 1u, __ATOMIC_RELAXED, __HIP_MEMORY_SCOPE_AGENT);
        wg_barrier();
        const int idx = (int)__builtin_amdgcn_readfirstlane(*slot);
        wg_barrier();
        if (idx >= nH + nA) break;
        const Params* kq = launder_p((const Params*)__builtin_amdgcn_kernarg_segment_ptr());
        char* wsu = kq->ws;
        bf16_t* hgb = (bf16_t*)(wsu + OFF_HG);
        const bf16_t* q = (const bf16_t*)(wsu + OFF_Q); const bf16_t* kv = (const bf16_t*)(wsu + OFF_KV); const bf16_t* kro = (const bf16_t*)(wsu + OFF_KROPE);
        bf16_t* mix = (bf16_t*)(wsu + OFF_MIX); bf16_t* o2 = (bf16_t*)(wsu + OFF_XB);
#ifndef MK_NO_HG
        if (idx < nH) hg::hgrn_unit(lds, hgb, kq->lb_logits, layer, S, idx);
        else
#endif
        {
#ifndef MK_NO_ATT
            const int a = idx - nH; int qb, half, bh, nsplit;
            if (a < nFull) { qb = a % QF; bh = a / QF; half = 0; nsplit = 1; }
            else { const int a1 = a - nFull; qb = QF + a1 % nQS; const int a2 = a1 / nQS; half = a2 & 1; bh = a2 >> 1; nsplit = 2; }
            const int h = bh & 7, b = bh >> 3;
            const int sseq = S / nsplit;
            const long row0 = (long)b * S + (long)qb * 256, krow0 = (long)b * S + (long)half * sseq;
            bf16_t* ob = (half == 0 ? mix : o2) + row0 * 2048 + h * 128;
            const int ml = (nsplit == 2) ? (int)(row0 * 1024 + h * 4 + half * 2) : -1;
            att::attn_body(q + row0 * 1536 + h * 192, kv + krow0 * 2048 + h * 256, kro + krow0 * 64, ob, ml, sseq, (char*)(unsigned char*)lds);
#endif
        }
    }
}

#define XB_TMO      128
#define XB_XCNT(j)  (256  + 64 * (j))
#define XB_XSUB(j)  (1280 + 64 * (j))
#define XB_XGEN(j)  (2304 + 64 * (j))
#define XB_TOP      3328
#define XB_TOPGEN   3392
#define XCD_BAR_WORDS 3456
#define XB_SPIN_CAP (1u << 22)
__device__ __forceinline__ unsigned xb_ld(unsigned* p)              { return __hip_atomic_load(p, __ATOMIC_RELAXED, __HIP_MEMORY_SCOPE_AGENT); }
__device__ __forceinline__ unsigned xb_add(unsigned* p, unsigned v) { return __hip_atomic_fetch_add(p, v, __ATOMIC_RELAXED, __HIP_MEMORY_SCOPE_AGENT); }
__device__ __forceinline__ unsigned xb_xcc_id() { return (unsigned)__builtin_amdgcn_s_getreg((3 << 11) | 20) & 0xFu; }
#define XB_SPIN(cond, bar) do { unsigned _sp = 0; while (cond) { __builtin_amdgcn_s_sleep(1); \
    if ((++_sp & 255u) == 0u) { if (xb_ld(&(bar)[XB_TMO])) break; if (_sp > XB_SPIN_CAP) { atomicAdd(&(bar)[XB_TMO], 1u); break; } } } } while (0)
struct XcdBarrier { unsigned* bar; unsigned x; volatile LAS unsigned* st; };
__device__ __forceinline__ XcdBarrier xcd_barrier_post(unsigned* bar, volatile LAS unsigned* st) {
    XcdBarrier b; b.bar = bar; b.x = xb_xcc_id(); b.st = st;
    if (threadIdx.x == 0) (void)xb_add(&bar[XB_XCNT(b.x)], 1u);
    return b;
}
__device__ __forceinline__ void xcd_barrier_complete(unsigned* bar, unsigned x, unsigned& nloc, unsigned& nx) {
    const unsigned G = gridDim.x * gridDim.y * gridDim.z;
    unsigned sum, cnt, mine, sp = 0u;
    for (;;) {
        sum = 0u; cnt = 0u; mine = 0u;
#pragma unroll
        for (unsigned j = 0; j < 16; ++j) { const unsigned c = xb_ld(&bar[XB_XCNT(j)]); sum += c; cnt += (c > 0u) ? 1u : 0u; mine = (j == x) ? c : mine; }
        if (sum == G) break;
        __builtin_amdgcn_s_sleep(1);
        if ((++sp & 255u) == 0u) { if (xb_ld(&bar[XB_TMO])) break; if (sp > XB_SPIN_CAP) { atomicAdd(&bar[XB_TMO], 1u); break; } }
    }
    nloc = mine > 0u ? mine : 1u; nx = cnt > 0u ? cnt : 1u;
}
__device__ __forceinline__ void xcd_barrier_(const XcdBarrier& b) {
    asm volatile("s_waitcnt vmcnt(0)" ::: "memory");
    __syncthreads();
    if (threadIdx.x == 0) {
        unsigned* bar = b.bar;
        __builtin_amdgcn_s_waitcnt(0);
        unsigned nloc = b.st[0], nx = b.st[1];
        if (nloc == 0u) { xcd_barrier_complete(bar, b.x, nloc, nx); b.st[0] = nloc; b.st[1] = nx; }
        const unsigned old = xb_add(&bar[XB_XSUB(b.x)], 1u);
        const unsigned gen = old / nloc;
        if (old + 1u == (gen + 1u) * nloc) {
            __builtin_amdgcn_fence(__ATOMIC_RELEASE, "agent");
            asm volatile("s_waitcnt vmcnt(0)" ::: "memory");
            const unsigned og = xb_add(&bar[XB_TOP], 1u);
            const unsigned tg = og / nx;
            if (og + 1u == (tg + 1u) * nx) xb_add(&bar[XB_TOPGEN], 1u);
            else XB_SPIN(xb_ld(&bar[XB_TOPGEN]) == tg, bar);
            __builtin_amdgcn_fence(__ATOMIC_ACQUIRE, "agent");
            xb_add(&bar[XB_XGEN(b.x)], 1u);
            asm volatile("s_waitcnt vmcnt(0)" ::: "memory");
        } else {
            XB_SPIN(xb_ld(&bar[XB_XGEN(b.x)]) == gen, bar);
            __builtin_amdgcn_fence(__ATOMIC_ACQUIRE, "agent");
            asm volatile("s_waitcnt vmcnt(0)" ::: "memory");
        }
    }
    __syncthreads();
}

__device__ __forceinline__ void xcd_barrier(LAS unsigned char* lds) {
    const Params* kp = launder_p((const Params*)__builtin_amdgcn_kernarg_segment_ptr());
    XcdBarrier b; b.bar = (unsigned*)(kp->ws + OFF_BAR); b.x = xb_xcc_id(); b.st = (volatile LAS unsigned*)(lds + LDS_BCAST + 64);
    xcd_barrier_(b);
}
constexpr int N_PHASES = 52;

__device__ __forceinline__ GemmDesc mkgemm(const void* A, int lda, const void* B, int ldb, int K, int nM, int nN) {
    GemmDesc g{}; g.A = (const char*)A; g.B = (const char*)B; g.lda = lda; g.ldb = ldb; g.K = K; g.nM = nM; g.nN = nN; g.nZ = 1; g.perm = 1; g.epi = E_BF16; return g;
}

__device__ __forceinline__ bool make_gemm(const Params& p, int tr, int l, int k, int i, GemmDesc& g) {
    const int T = tr ? 32768 : 8192, S = tr ? 16384 : 4096, nMT = T / 256;
    char* ws = p.ws;
    float* xout = p.out + (tr ? (size_t)8192 * DM : 0);
    ssq_t* ssq = (ssq_t*)(ws + OFF_SSQ) + (size_t)tr * 11 * TMAX;
    ssq_t* ssq_x0 = ssq + (size_t)(l * 5 + 0) * TMAX; ssq_t* ssq_q = ssq + (size_t)(l * 5 + 1) * TMAX; ssq_t* ssq_kv = ssq + (size_t)(l * 5 + 2) * TMAX;
    ssq_t* ssq_x1 = ssq + (size_t)(l * 5 + 3) * TMAX; ssq_t* ssq_x2 = ssq + (size_t)(l * 5 + 4) * TMAX; ssq_t* ssq_nx = ssq + (size_t)((l + 1) * 5) * TMAX;
    bf16_t* xb = (bf16_t*)(ws + (tr ? OFF_XB : OFF_XB0));
    const char* memn = ws + OFF_MEMN + (size_t)tr * 512 * 2048 * 2;
    if (k == 1) {
        if (i > 0) return false;
        g = mkgemm(xb, DM, ws + OFF_W_IN, DM, DM, nMT, INP / 256); g.epi = E_INPROJ; g.ssq_in = ssq_x0; g.inv_dim = 1.f / DM;
        g.out = (bf16_t*)(ws + OFF_CQ); g.out2 = (bf16_t*)(ws + OFF_KR); g.out3 = (bf16_t*)(ws + OFF_HG); g.ssq_out = ssq_q; g.ssq_out2 = ssq_kv; return true;
    } else if (k == 2) {
        if (i == 0) { g = mkgemm(ws + OFF_CQ, 768, ws + OFF_W_UQ, 512, 512, nMT, 6); g.out = (bf16_t*)(ws + OFF_Q); g.ldo = 1536; g.ssq_in = ssq_q; g.inv_dim = 1.f / 512.f; return true; }
        if (i == 1) { g = mkgemm(ws + OFF_CQ + 512 * 2, 768, ws + OFF_W_UKV, 256, 256, nMT, 8); g.out = (bf16_t*)(ws + OFF_KV); g.ldo = 2048; g.ssq_in = ssq_kv; g.inv_dim = 1.f / 256.f; return true; }
        return false;
    } else if (k == 6) {
        if (i > 0) return false;
        g = mkgemm(ws + OFF_MIX, DM, ws + OFF_W_OUT, DM, DM, nMT, 8); g.epi = E_RESID;
        g.resid = (l == 0) ? p.x_in[tr] : xout; g.xout = xout; g.xb = xb; g.ssq_out = ssq_x1; return true;
    } else if (k == 7) {
        if (i == 0) { g = mkgemm(xb, DM, ws + OFF_W_XQ, DM, DM, nMT, 8); g.out = (bf16_t*)(ws + OFF_XQ); g.ldo = DM; g.ssq_in = ssq_x1; g.inv_dim = 1.f / DM; return true; }
        return false;
    } else if (k == 5) {
        if (i == 0) { g = mkgemm(memn, DM, ws + OFF_W_XK, DM, DM, 2, 8); g.out = (bf16_t*)(ws + OFF_KMEM); g.ldo = DM; return true; }
        if (i == 1) { g = mkgemm(ws + OFF_W_XV, DM, memn, DM, DM, 8, 1); g.nZ = 2; g.bzs = 256 * DM * 2; g.out = (bf16_t*)(ws + OFF_VT); g.ldo = 256; g.ozs = (long)2048 * 256; return true; }
        return false;
    } else if (k == 8) {
        if (i > 0) return false;
        g = mkgemm(ws + OFF_XQ, DM, ws + OFF_KMEM, DM, 512, nMT, 1); g.nZ = 4; g.azs = 512 * 2; g.bzs = 512 * 2; g.bbs = 256 * DM * 2; g.tpb = S / 256;
        g.epi = E_SOFTMAX; g.out = (bf16_t*)(ws + OFF_PBUF); g.ldo = 1024; return true;
    } else if (k == 9) {
        if (i > 0) return false;
        g = mkgemm(ws + OFF_PBUF, 1024, ws + OFF_VT, 256, 256, nMT, 2); g.nZ = 4; g.azs = 256 * 2; g.bzs = 512 * 256 * 2; g.bbs = 2048 * 256 * 2; g.tpb = S / 256;
        g.out = (bf16_t*)(ws + OFF_OBUF); g.ldo = DM; g.ozs = 512; return true;
    } else if (k == 10) {
        if (i > 0) return false;
        g = mkgemm(ws + OFF_OBUF, DM, ws + OFF_W_XO, DM, DM, nMT, 8); g.epi = E_RESID;
        g.resid = xout; g.xout = xout; g.xb = xb; g.ssq_out = ssq_x2; return true;
    } else if (k == 11) {
        if (i > 0) return false;
        g = mkgemm(xb, DM, ws + OFF_W_F1, DM, DM, nMT, 32); g.out = (bf16_t*)(ws + OFF_U); g.ldo = 8192; g.ssq_in = ssq_x2; g.inv_dim = 1.f / DM; g.relu2 = 1; return true;
    } else if (k == 12) {
        if (i > 0) return false;
        g = mkgemm(ws + OFF_U, 8192, ws + OFF_W_F2, 8192, 8192, nMT, 8); g.epi = E_RESID;
        g.resid = xout; g.xout = xout; g.xb = xb; g.ssq_out = ssq_nx; return true;
    }
    return false;
}

__device__ __forceinline__ void run_phase(const Params* kp, int ph, LAS unsigned char* lds) {
    const Params& p = *kp;
    if (ph == 0) { prep_phase(p, 0, 8192, 4096); prep_phase(p, 1, 32768, 16384); return; }
    if (ph == N_PHASES - 1) { final_phase(p, p.out, 8192, 0); final_phase(p, p.out + (size_t)8192 * DM, 32768, 1); return; }
    const int l = (ph - 1) / 25, r = (ph - 1) % 25;
    if (r == 0) { wcvt_phase(lds, p, l); return; }
    const int tr = (r - 1) / 12, k = (r - 1) % 12 + 1;
    const int T = tr ? 32768 : 8192, S = tr ? 16384 : 4096;
    if (k == 3) { rope_phase(p, T, S); return; }
    if (k == 4) { mixer_phase(lds, p, l, T, S, tr); return; }
    if (k == 5) {
        const int c = lbid(), G = gridDim.x;
        if (G >= 64) {
            if (c < 16) gemm_phase<E_BF16>(lds, kp, tr, l, 5, 0, 16, c);
            else if (c < 32) gemm_phase<E_BF16>(lds, kp, tr, l, 5, 1, 16, c - 16);
            else hcomb_phase(p, l, T, G - 32, c - 32, S >= 16384 ? 2 : 1);
        } else { gemm_phase<E_BF16>(lds, kp, tr, l, 5, 0, G, c); gemm_phase<E_BF16>(lds, kp, tr, l, 5, 1, G, c); hcomb_phase(p, l, T, G, c, S >= 16384 ? 2 : 1); }
        return; }
#ifndef MK_NO_GEMM
    { const int c = lbid(), G = gridDim.x;
    if (k == 1) gemm_phase<E_INPROJ>(lds, kp, tr, l, k, 0, G, c);
    else if (k == 6 || k == 10 || k == 12) gemm_phase<E_RESID>(lds, kp, tr, l, k, 0, G, c);
    else if (k == 8) gemm_phase<E_SOFTMAX>(lds, kp, tr, l, k, 0, G, c);
    else for (int i = 0; i < 2; ++i) gemm_phase<E_BF16>(lds, kp, tr, l, k, i, G, c); }
#endif
}

__global__ void __launch_bounds__(512, 2) mk_forward(Params p, int ph_lo, int ph_hi) {
    extern __shared__ __attribute__((aligned(16))) unsigned char shm[];
    LAS unsigned char* lds = (LAS unsigned char*)shm;
    cg::grid_group grid = cg::this_grid();
    volatile LAS unsigned* xst = (volatile LAS unsigned*)(lds + LDS_BCAST + 64);
    if (threadIdx.x == 0) { xst[0] = 0u; xst[1] = 0u; }
    __syncthreads();
    { const Params* kp0 = launder_p((const Params*)__builtin_amdgcn_kernarg_segment_ptr()); (void)xcd_barrier_post((unsigned*)(kp0->ws + OFF_BAR), xst); }
    for (int ph = ph_lo; ph < ph_hi; ++ph) {
        const Params* kp = launder_p((const Params*)__builtin_amdgcn_kernarg_segment_ptr());
#ifdef MK_TIME_KIND
        if (blockIdx.x == 0 && threadIdx.x == 0) ((unsigned long long*)(kp->ws + OFF_TS))[ph] = __builtin_amdgcn_s_memrealtime();
#endif
        run_phase(kp, ph, lds);
        if (ph + 1 < ph_hi) { if (ph_hi > N_PHASES) grid.sync(); else xcd_barrier(lds); }
    }
#ifdef MK_TIME_KIND
    xcd_barrier(lds);
    if (blockIdx.x == 0) {
        const Params* kp = launder_p((const Params*)__builtin_amdgcn_kernarg_segment_ptr());
        unsigned long long* ts = (unsigned long long*)(kp->ws + OFF_TS); float* outp = kp->out;
        if (threadIdx.x == 0) ts[ph_hi] = __builtin_amdgcn_s_memrealtime();
        __syncthreads();
        unsigned tot = 0;
        for (int ph = ph_lo; ph < ph_hi; ++ph) { const int r_ = (ph - 1) % 25; const int kind = (ph == 0) ? 100 : (ph == N_PHASES - 1 ? 101 : (r_ == 0 ? 0 : (r_ - 1) % 12 + 1));
            if (kind == MK_TIME_KIND || MK_TIME_KIND == 200) tot += (unsigned)(ts[ph + 1] - ts[ph]); }
        const int n = (int)(tot / 100u);
        for (int i = threadIdx.x; i < n; i += 512) outp[i] += 0.25f;
        for (int i = threadIdx.x; i < 4 * n; i += 512) outp[(size_t)8192 * DM + i] += 0.25f;
    }
#endif

}

extern "C" void kernel_launch(void* const* d_in, const int* in_sizes, int n_in, void* d_out, int out_size, void* d_ws, size_t ws_size, hipStream_t stream) {
    static int inited = 0; static int grid_blocks = 0;
    if (!inited) {
        hipFuncSetAttribute((const void*)mk_forward, hipFuncAttributeMaxDynamicSharedMemorySize, LDS_BYTES);
        int dev = 0, cus = 0, per_cu = 0;
        hipGetDevice(&dev); hipDeviceGetAttribute(&cus, hipDeviceAttributeMultiprocessorCount, dev);
        hipOccupancyMaxActiveBlocksPerMultiprocessor(&per_cu, mk_forward, 512, LDS_BYTES);
        if (per_cu < 1) per_cu = 1;
        grid_blocks = cus * 1;
        if (ws_size < WS_END) fprintf(stderr, "kernel_launch: workspace too small: %zu < %zu\n", ws_size, (size_t)WS_END);
        inited = 1;
    }
    Params p{};
    const float* const* in = (const float* const*)d_in;
    p.x_in[0] = in[0]; p.x_in[1] = in[1]; p.mem_in[0] = in[2]; p.mem_in[1] = in[3];
    p.mix_norm = in[4]; p.w_in = in[5]; p.q_norm = in[6]; p.w_uq = in[7]; p.kv_norm = in[8]; p.w_ukv = in[9]; p.lb_logits = in[10]; p.out_norm = in[11]; p.w_out = in[12];
    p.xattn_norm = in[13]; p.mem_norm = in[14]; p.w_xq = in[15]; p.w_xk = in[16]; p.w_xv = in[17]; p.w_xo = in[18]; p.ffn_norm = in[19]; p.w_ffn1 = in[20]; p.w_ffn2 = in[21]; p.final_norm = in[22];
    p.out = (float*)d_out; p.ws = (char*)d_ws;
#if MK_ONE_LAUNCH
    hipMemsetAsync((char*)d_ws + OFF_BAR, 0, 16384, stream);
    int lo = 0, hi = N_PHASES;
    void* args[] = {&p, &lo, &hi};
    hipError_t e = hipLaunchCooperativeKernel((const void*)mk_forward, dim3(grid_blocks), dim3(512), args, LDS_BYTES, stream);
    if (e != hipSuccess) fprintf(stderr, "cooperative launch failed: %s\n", hipGetErrorString(e));
#else
    for (int ph = 0; ph < N_PHASES; ++ph) hipLaunchKernelGGL(mk_forward, dim3(grid_blocks), dim3(512), LDS_BYTES, stream, p, ph, ph + 1);
#endif
}
```

```cpp
#include <hip/hip_runtime.h>
#include <hip/hip_cooperative_groups.h>
#include <cstdio>
namespace cg = cooperative_groups;

#define LAS __attribute__((address_space(3)))
typedef unsigned short bf16_t;
typedef short bf16x8 __attribute__((ext_vector_type(8)));
typedef short s16x4 __attribute__((ext_vector_type(4)));
typedef float f32x4 __attribute__((ext_vector_type(4)));
typedef float f32x8 __attribute__((ext_vector_type(8)));
typedef float f32x16 __attribute__((ext_vector_type(16)));
typedef unsigned u32x4 __attribute__((ext_vector_type(4)));
typedef unsigned u32x2 __attribute__((ext_vector_type(2)));

#ifndef MK_QF
#define MK_QF 52
#endif
#ifndef MK_ONE_LAUNCH
#define MK_ONE_LAUNCH 1
#endif

constexpr int DM = 2048, NMEM = 256, DEPTH = 2;
constexpr int INP = 6144;
constexpr int HGW = 5120;
constexpr int TMAX = 32768;
constexpr float EPS = 1e-6f;
constexpr int LDS_BYTES = 144 * 1024;
constexpr int LDS_BCAST = 140 * 1024;
constexpr int LDS_EPI = 128 * 1024;

constexpr size_t al256(size_t x) { return (x + 255) / 256 * 256; }
constexpr size_t E_W_IN = (size_t)INP * 2048, E_W_UQ = 1536 * 512, E_W_UKV = 2048 * 256, E_W_SQ = 2048 * 2048, E_W_F = (size_t)8192 * 2048;
constexpr size_t OFF_W_IN = 0;
constexpr size_t OFF_W_UQ = OFF_W_IN + E_W_IN * 2;
constexpr size_t OFF_W_UKV = OFF_W_UQ + E_W_UQ * 2;
constexpr size_t OFF_W_OUT = OFF_W_UKV + E_W_UKV * 2;
constexpr size_t OFF_W_XQ = OFF_W_OUT + E_W_SQ * 2;
constexpr size_t OFF_W_XK = OFF_W_XQ + E_W_SQ * 2;
constexpr size_t OFF_W_XV = OFF_W_XK + E_W_SQ * 2;
constexpr size_t OFF_W_XO = OFF_W_XV + E_W_SQ * 2;
constexpr size_t OFF_W_F1 = OFF_W_XO + E_W_SQ * 2;
constexpr size_t OFF_W_F2 = OFF_W_F1 + E_W_F * 2;
constexpr size_t OFF_XB = OFF_W_F2 + E_W_F * 2;
constexpr size_t OFF_KR = OFF_XB + (size_t)TMAX * 2048 * 2;
constexpr size_t OFF_KROPE = OFF_KR + (size_t)TMAX * 64 * 2;
constexpr size_t OFF_MIX = OFF_KROPE + (size_t)TMAX * 64 * 2;
constexpr size_t OFF_HG = OFF_MIX + (size_t)TMAX * 2048 * 2;
constexpr size_t OFF_Q = OFF_HG + (size_t)TMAX * HGW * 2;
constexpr size_t OFF_KV = OFF_Q + (size_t)TMAX * 1536 * 2;
constexpr size_t OFF_MEMN = OFF_KV + (size_t)TMAX * 2048 * 2;
constexpr size_t OFF_KMEM = OFF_MEMN + (size_t)2 * 512 * 2048 * 2;
constexpr size_t OFF_VT = OFF_KMEM + (size_t)512 * 2048 * 2;
constexpr size_t OFF_ROPE = OFF_VT + (size_t)512 * 2048 * 2;
constexpr size_t OFF_SSQ = OFF_ROPE + (size_t)16384 * 32 * 4 * 2;
constexpr size_t OFF_CTR = OFF_SSQ + (size_t)22 * TMAX * 8;
constexpr size_t OFF_BAR = OFF_CTR + 256;
constexpr size_t OFF_LB = OFF_BAR + 16384;
constexpr size_t OFF_TS = OFF_LB + 8192;
constexpr size_t OFF_XB0 = OFF_TS + 1024;
constexpr size_t WS_END = OFF_XB0 + (size_t)8192 * 2048 * 2;
constexpr size_t OFF_CQ = OFF_MIX;
constexpr size_t OFF_XQ = OFF_Q;
constexpr size_t OFF_PBUF = OFF_MIX;
constexpr size_t OFF_OBUF = OFF_HG;
constexpr size_t OFF_U = OFF_HG;
static_assert((size_t)TMAX * 8192 * 2 <= OFF_MEMN - OFF_HG, "u must fit");

struct Params {
    const float* x_in[2]; const float* mem_in[2];
    const float *mix_norm, *w_in, *q_norm, *w_uq, *kv_norm, *w_ukv, *lb_logits, *out_norm, *w_out, *xattn_norm, *mem_norm, *w_xq, *w_xk, *w_xv, *w_xo,
        *ffn_norm, *w_ffn1, *w_ffn2, *final_norm;
    float* out; char* ws;
};

__device__ __forceinline__ int ltid() { int t = threadIdx.x; asm volatile("" : "+v"(t)); return t; }
__device__ __forceinline__ int lbid() { int t = blockIdx.x; asm volatile("" : "+s"(t)); return t; }
__device__ __forceinline__ float bf2f(bf16_t b) { return __uint_as_float(((unsigned)b) << 16); }
__device__ __forceinline__ bf16_t f2bf(float f) { unsigned u = __float_as_uint(f); u += 0x7FFFu + ((u >> 16) & 1u); return (bf16_t)(u >> 16); }
__device__ __forceinline__ unsigned cvtpk(float lo, float hi) { unsigned r; asm volatile("v_cvt_pk_bf16_f32 %0, %1, %2" : "=v"(r) : "v"(lo), "v"(hi)); return r; }
__device__ __forceinline__ void wg_barrier() { asm volatile("s_waitcnt vmcnt(0) lgkmcnt(0)" ::: "memory"); __builtin_amdgcn_s_barrier(); asm volatile("" ::: "memory"); }
typedef unsigned long long ssq_t;
__device__ __forceinline__ ssq_t ssq_fix(float v) { return (ssq_t)(v * 16777216.f + 0.5f); }
__device__ __forceinline__ float ssq_val(ssq_t v) { return (float)v * (1.f / 16777216.f); }
__device__ __forceinline__ void atomic_addf(ssq_t* p, float v) { __hip_atomic_fetch_add(p, ssq_fix(v), __ATOMIC_RELAXED, __HIP_MEMORY_SCOPE_AGENT); }

namespace pg8 {
constexpr int BM = 256, BK = 64, HALF = 128, HTB = HALF * BK * 2, NXCD = 8, WGM = 8;
__host__ __device__ __forceinline__ int lds_byte(int r, int c) { const int st = (r >> 4) * 2 + (c >> 5), rr = r & 15, cc = c & 31, ob = rr * 64 + cc * 2; return st * 1024 + (ob ^ (((ob >> 9) & 1) << 5)); }
__host__ __device__ __forceinline__ void stage_rc(int b, int& R, int& C) { const int st = b / 1024, sb = b % 1024, swz = sb ^ (((sb >> 9) & 1) << 5); R = (st >> 1) * 16 + swz / 64; C = (st & 1) * 32 + (swz % 64) / 2; }
__host__ __device__ __forceinline__ int perm32(int rho) { const int n = rho >> 4, i = rho & 15; return 8 * (i >> 2) + 4 * n + (i & 3); }
}
enum { E_BF16 = 0, E_INPROJ = 1, E_RESID = 2, E_SOFTMAX = 3 };
struct GemmDesc {
    const char* A; const char* B; int lda, ldb, K, nM, nN, nZ;
    int azs, bzs, bbs, tpb;
    int epi, perm;
    bf16_t* out; long ozs; int ldo;
    const ssq_t* ssq_in; float inv_dim; int relu2;
    ssq_t* ssq_out; ssq_t* ssq_out2;
    const float* resid; float* xout; bf16_t* xb;
    bf16_t* out2; bf16_t* out3;
};
struct Unit { int pm, pn, z; const char* a; const char* b; };

__device__ __forceinline__ bool make_gemm(const Params& p, int tr, int l, int k, int i, GemmDesc& g);
__device__ __forceinline__ const Params* launder_p(const Params* q) { asm volatile("" : "+s"(q)); return q; }
__device__ __forceinline__ int launder_i(int v) { asm volatile("" : "+s"(v)); return v; }
__device__ __forceinline__ bool next_unit(const Params* kp, int tr, int l, int k, int gi, int i, int G, int c, Unit& u) {
    GemmDesc g; make_gemm(*launder_p(kp), launder_i(tr), launder_i(l), launder_i(k), launder_i(gi), g);
    const int L = i * G + c; const int per = g.nM * g.nN;
    if (L >= per * g.nZ) return false;
    const int z = L / per; int wgid = L - z * per;
    { const int q = per / pg8::NXCD, r = per % pg8::NXCD, xcd = wgid % pg8::NXCD, off = wgid / pg8::NXCD; wgid = (xcd < r ? xcd * (q + 1) : r * (q + 1) + (xcd - r) * q) + off; }
    const int nig = pg8::WGM * g.nN, gid = wgid / nig, fm = gid * pg8::WGM, gsz = (g.nM - fm) < pg8::WGM ? (g.nM - fm) : pg8::WGM;
    u.pm = fm + ((wgid % nig) % gsz); u.pn = (wgid % nig) / gsz; u.z = z;
    const unsigned ao = (unsigned)z * (unsigned)g.azs + (unsigned)u.pm * (unsigned)(512 * g.lda);
    const unsigned bo = (unsigned)z * (unsigned)g.bzs + (unsigned)u.pn * (unsigned)(512 * g.ldb) + (g.tpb ? (unsigned)(u.pm / g.tpb) * (unsigned)g.bbs : 0u);
    u.a = g.A + (size_t)ao; u.b = g.B + (size_t)bo;
    return true;
}

template <int EPI> __device__ __forceinline__ void gemm_epilogue(const Params* kp, int tr, int l, int k, int gi, f32x4 (&acc)[2][2][4][2], const Unit& u, LAS unsigned char* lds) {
    const int tid_e = ltid(), wid_e = tid_e >> 6, lane_e = tid_e & 63, wr = wid_e >> 2, wc = wid_e & 3, fr = lane_e & 15, fq = lane_e >> 4;
    GemmDesc g; make_gemm(*launder_p(kp), launder_i(tr), launder_i(l), launder_i(k), launder_i(gi), g);
    const int row0 = u.pm * 256 + wr * 64 + fr;
    if constexpr (EPI == E_BF16) {
        const int col0 = u.pn * 256 + wc * 32 + 8 * fq;
        float rsv[2][4];
#pragma unroll
        for (int ai = 0; ai < 2; ++ai)
#pragma unroll
            for (int m = 0; m < 4; ++m) rsv[ai][m] = g.ssq_in ? __builtin_amdgcn_rsqf(ssq_val(g.ssq_in[row0 + ai * 128 + m * 16]) * g.inv_dim + EPS) : 1.0f;
#pragma unroll
        for (int ai = 0; ai < 2; ++ai)
#pragma unroll
            for (int m = 0; m < 4; ++m) {
                const int row = row0 + ai * 128 + m * 16;
                const float rs = rsv[ai][m];
                bf16_t* rowp = g.out + (long)u.z * g.ozs + (long)row * g.ldo + col0;
#pragma unroll
                for (int bj = 0; bj < 2; ++bj) {
                    f32x4 v0 = acc[ai][bj][m][0] * rs, v1 = acc[ai][bj][m][1] * rs;
                    if (g.relu2) {
#pragma unroll
                        for (int j = 0; j < 4; ++j) { float a = fmaxf(v0[j], 0.f), b = fmaxf(v1[j], 0.f); v0[j] = a * a; v1[j] = b * b; }
                    }
                    u32x4 w; w.x = cvtpk(v0[0], v0[1]); w.y = cvtpk(v0[2], v0[3]); w.z = cvtpk(v1[0], v1[1]); w.w = cvtpk(v1[2], v1[3]);
                    *(u32x4*)(rowp + bj * 128) = w;
                }
            }
    } else if constexpr (EPI == E_INPROJ) {
        const int lc0 = wc * 32 + 8 * fq;
        const int pn = u.pn;
        const int hseg = (pn >= 4) ? ((pn - 4) >> 2) : 9;
        f32x4 lbv[2][2];
        if (hseg == 1 || hseg == 2) {
            const float* lbt = (const float*)(kp->ws + OFF_LB) + (hseg - 1) * 1024 + ((pn - 4) & 3) * 256 + lc0;
#pragma unroll
            for (int bj = 0; bj < 2; ++bj) { lbv[bj][0] = *(const f32x4*)(lbt + bj * 128); lbv[bj][1] = *(const f32x4*)(lbt + bj * 128 + 4); }
        } else {
#pragma unroll
            for (int bj = 0; bj < 2; ++bj) { lbv[bj][0] = (f32x4){0.f, 0.f, 0.f, 0.f}; lbv[bj][1] = lbv[bj][0]; }
        }
        float rsv[2][4];
#pragma unroll
        for (int ai = 0; ai < 2; ++ai)
#pragma unroll
            for (int m = 0; m < 4; ++m) rsv[ai][m] = __builtin_amdgcn_rsqf(ssq_val(g.ssq_in[row0 + ai * 128 + m * 16]) * g.inv_dim + EPS);
#pragma unroll
        for (int ai = 0; ai < 2; ++ai)
#pragma unroll
            for (int m = 0; m < 4; ++m) {
                const int row = row0 + ai * 128 + m * 16;
                const float rs = rsv[ai][m];
                float ss = 0.f;
#pragma unroll
                for (int bj = 0; bj < 2; ++bj) {
                    f32x4 v0 = acc[ai][bj][m][0] * rs, v1 = acc[ai][bj][m][1] * rs;
                    if (hseg == 0) {
#pragma unroll
                        for (int j = 0; j < 4; ++j) { v0[j] = v0[j] * __builtin_amdgcn_rcpf(1.f + __expf(-v0[j])) * 0.08838834764831845f; v1[j] = v1[j] * __builtin_amdgcn_rcpf(1.f + __expf(-v1[j])) * 0.08838834764831845f; }
                    } else if (hseg == 1 || hseg == 2) {
#pragma unroll
                        for (int j = 0; j < 4; ++j) {
                            const float l0 = lbv[bj][0][j], l1 = lbv[bj][1][j];
                            v0[j] = __logf(l0 + (1.f - l0) * __builtin_amdgcn_rcpf(1.f + __expf(-fmaxf(v0[j], -80.f))));
                            v1[j] = __logf(l1 + (1.f - l1) * __builtin_amdgcn_rcpf(1.f + __expf(-fmaxf(v1[j], -80.f))));
                        }
                    }
                    u32x4 w; w.x = cvtpk(v0[0], v0[1]); w.y = cvtpk(v0[2], v0[3]); w.z = cvtpk(v1[0], v1[1]); w.w = cvtpk(v1[2], v1[3]);
                    const int lc = lc0 + bj * 128;
                    if (pn < 3) {
                        *(u32x4*)(g.out + (long)row * 768 + pn * 256 + lc) = w;
                        ss += (v0[0] * v0[0] + v0[1] * v0[1]) + (v0[2] * v0[2] + v0[3] * v0[3]) + (v1[0] * v1[0] + v1[1] * v1[1]) + (v1[2] * v1[2] + v1[3] * v1[3]);
                    } else if (pn == 3) {
                        if (lc < 64) *(u32x4*)(g.out2 + (long)row * 64 + lc) = w;
                    } else {
                        *(u32x4*)(g.out3 + (long)row * HGW + (pn - 4) * 256 + lc) = w;
                    }
                }
                if (pn < 3) {
                    ss += __shfl_xor(ss, 16); ss += __shfl_xor(ss, 32);
                    if (fq == 0) atomic_addf((pn < 2 ? g.ssq_out : g.ssq_out2) + row, ss);
                }
            }
    } else if constexpr (EPI == E_RESID) {
        const int col0 = u.pn * 256 + wc * 32 + 8 * fq;
#pragma unroll
        for (int ai = 0; ai < 2; ++ai) {
            f32x4 rv[4][2][2];
#pragma unroll
            for (int m = 0; m < 4; ++m)
#pragma unroll
                for (int bj = 0; bj < 2; ++bj)
#pragma unroll
                    for (int n = 0; n < 2; ++n) rv[m][bj][n] = *(const f32x4*)(g.resid + (long)(row0 + ai * 128 + m * 16) * DM + col0 + bj * 128 + n * 4);
#pragma unroll
            for (int m = 0; m < 4; ++m) {
                const int row = row0 + ai * 128 + m * 16;
                float ss = 0.f;
#pragma unroll
                for (int bj = 0; bj < 2; ++bj) {
                    const long o = (long)row * DM + col0 + bj * 128;
                    const f32x4 v0 = rv[m][bj][0] + acc[ai][bj][m][0], v1 = rv[m][bj][1] + acc[ai][bj][m][1];
                    *(f32x4*)(g.xout + o) = v0; *(f32x4*)(g.xout + o + 4) = v1;
                    u32x4 w; w.x = cvtpk(v0[0], v0[1]); w.y = cvtpk(v0[2], v0[3]); w.z = cvtpk(v1[0], v1[1]); w.w = cvtpk(v1[2], v1[3]);
                    *(u32x4*)(g.xb + o) = w;
                    ss += (v0[0] * v0[0] + v0[1] * v0[1]) + (v0[2] * v0[2] + v0[3] * v0[3]) + (v1[0] * v1[0] + v1[1] * v1[1]) + (v1[2] * v1[2] + v1[3] * v1[3]);
                }
                ss += __shfl_xor(ss, 16); ss += __shfl_xor(ss, 32);
                if (fq == 0) atomic_addf(g.ssq_out + row, ss);
            }
        }
    } else {
        LAS float* smax = (LAS float*)(lds + LDS_EPI);
        LAS float* ssum = (LAS float*)(lds + LDS_EPI + 4096);
        const float C = 0.044194173824159216f * 1.4426950408889634f;
#pragma unroll
        for (int ai = 0; ai < 2; ++ai)
#pragma unroll
            for (int m = 0; m < 4; ++m) {
                __builtin_amdgcn_sched_barrier(0);
                float t = -3.0e38f;
#pragma unroll
                for (int bj = 0; bj < 2; ++bj)
#pragma unroll
                    for (int n = 0; n < 2; ++n)
#pragma unroll
                        for (int j = 0; j < 4; ++j) t = fmaxf(t, acc[ai][bj][m][n][j]);
                t = fmaxf(t, __shfl_xor(t, 16)); t = fmaxf(t, __shfl_xor(t, 32));
                if (fq == 0) smax[(ai * 128 + wr * 64 + m * 16 + fr) * 4 + wc] = t;
            }
        asm volatile("s_waitcnt lgkmcnt(0)" ::: "memory"); __builtin_amdgcn_s_barrier(); asm volatile("" ::: "memory");
#pragma unroll
        for (int ai = 0; ai < 2; ++ai)
#pragma unroll
            for (int m = 0; m < 4; ++m) {
                __builtin_amdgcn_sched_barrier(0);
                const int rl = ai * 128 + wr * 64 + m * 16 + fr;
                const f32x4 q = *(LAS f32x4*)(smax + rl * 4);
                const float mm = fmaxf(fmaxf(q[0], q[1]), fmaxf(q[2], q[3])) * C;
                float s = 0.f;
#pragma unroll
                for (int bj = 0; bj < 2; ++bj)
#pragma unroll
                    for (int n = 0; n < 2; ++n)
#pragma unroll
                        for (int j = 0; j < 4; ++j) { const float e = __builtin_amdgcn_exp2f(acc[ai][bj][m][n][j] * C - mm); acc[ai][bj][m][n][j] = e; s += e; }
                s += __shfl_xor(s, 16); s += __shfl_xor(s, 32);
                if (fq == 0) ssum[rl * 4 + wc] = s;
            }
        asm volatile("s_waitcnt lgkmcnt(0)" ::: "memory"); __builtin_amdgcn_s_barrier(); asm volatile("" ::: "memory");
        const int col0 = wc * 32 + 8 * fq;
#pragma unroll
        for (int ai = 0; ai < 2; ++ai)
#pragma unroll
            for (int m = 0; m < 4; ++m) {
                __builtin_amdgcn_sched_barrier(0);
                const int rl = ai * 128 + wr * 64 + m * 16 + fr;
                const f32x4 q = *(LAS f32x4*)(ssum + rl * 4);
                const float inv = 1.0f / ((q[0] + q[1]) + (q[2] + q[3]));
                bf16_t* rowp = g.out + (long)(u.pm * 256 + rl) * g.ldo + u.z * 256 + col0;
#pragma unroll
                for (int bj = 0; bj < 2; ++bj) {
                    const f32x4 v0 = acc[ai][bj][m][0] * inv, v1 = acc[ai][bj][m][1] * inv;
                    u32x4 w; w.x = cvtpk(v0[0], v0[1]); w.y = cvtpk(v0[2], v0[3]); w.z = cvtpk(v1[0], v1[1]); w.w = cvtpk(v1[2], v1[3]);
                    *(u32x4*)(rowp + bj * 128) = w;
                }
            }
    }
}

template <int EPI> __device__ __forceinline__ void gemm_phase(LAS unsigned char* lds, const Params* kp, int tr, int l, int k, int gi, int G, int cblk) {
    using namespace pg8;
    int Kdim, lda_, ldb_, perm_;
    { GemmDesc g0; if (!make_gemm(*kp, tr, l, k, gi, g0)) return; Kdim = g0.K; lda_ = g0.lda; ldb_ = g0.ldb; perm_ = g0.perm; }
    const int tid = ltid(), wid = __builtin_amdgcn_readfirstlane(tid >> 6), lane = tid & 63, wr = wid >> 2, wc = wid & 3, fr = lane & 15, fq = lane >> 4;
    const int K = Kdim, nt = K / BK;
    unsigned voffA[2], voffB[2];
#pragma unroll
    for (int i = 0; i < 2; ++i) { int R, C; stage_rc(tid * 16 + i * 8192, R, C); const int Rb = perm_ ? ((R & ~31) + perm32(R & 31)) : R;
        voffA[i] = (unsigned)(R * lda_ + C) * 2u; voffB[i] = (unsigned)(Rb * ldb_ + C) * 2u; }
    const size_t kstep = (size_t)(BK * 2);
    const size_t hstepA = (size_t)HALF * lda_ * 2, hstepB = (size_t)HALF * ldb_ * 2;
    const unsigned ldsw = (unsigned)wid * 1024u;
    const int aoff = lds_byte(wr * 64 + fr, fq * 8), boff = lds_byte(wc * 32 + fr, fq * 8);
#define PG8_SA(b, h) (((b) * 2 + (h)) * HTB)
#define PG8_SB(b, h) ((4 + (b) * 2 + (h)) * HTB)
#define PG8_STAGE(bufoff, gbase, voff) do { _Pragma("unroll") for (int _i = 0; _i < 2; ++_i) \
        __builtin_amdgcn_global_load_lds((const unsigned*)((const char*)(gbase) + (voff)[_i]), (LAS unsigned*)(lds + (bufoff) + ldsw + _i * 8192), 16, 0, 0); } while (0)
#define PG8_LDA(dst, b, h) do { _Pragma("unroll") for (int m = 0; m < 4; ++m) _Pragma("unroll") for (int k = 0; k < 2; ++k) dst[m][k] = *(const LAS bf16x8*)(lds + PG8_SA(b, h) + aoff + m * 2048 + k * 1024); } while (0)
#define PG8_LDB(dst, b, h) do { _Pragma("unroll") for (int n = 0; n < 2; ++n) _Pragma("unroll") for (int k = 0; k < 2; ++k) dst[n][k] = *(const LAS bf16x8*)(lds + PG8_SB(b, h) + boff + n * 2048 + k * 1024); } while (0)
#define PG8_MMA(ai, bj, At, Bt) do { __builtin_amdgcn_s_setprio(1); _Pragma("unroll") for (int m = 0; m < 4; ++m) _Pragma("unroll") for (int n = 0; n < 2; ++n) _Pragma("unroll") for (int k = 0; k < 2; ++k) \
        acc[ai][bj][m][n] = __builtin_amdgcn_mfma_f32_16x16x32_bf16(Bt[n][k], At[m][k], acc[ai][bj][m][n], 0, 0, 0); __builtin_amdgcn_s_setprio(0); } while (0)
#define PG8_WAIT_V(n) asm volatile("s_waitcnt vmcnt(" #n ")" ::: "memory")
#define PG8_WAIT_L(n) asm volatile("s_waitcnt lgkmcnt(" #n ")" ::: "memory")
#define PG8_BAR __builtin_amdgcn_s_barrier()
#define PG8_SCHED __builtin_amdgcn_sched_barrier(0)
    Unit cur, nxt; int ui = 0;
    if (!next_unit(kp, tr, l, k, gi, 0, G, cblk, cur)) return;
    f32x4 acc[2][2][4][2];
#pragma unroll
    for (int a = 0; a < 2; ++a)
#pragma unroll
        for (int b = 0; b < 2; ++b)
#pragma unroll
            for (int m = 0; m < 4; ++m)
#pragma unroll
                for (int n = 0; n < 2; ++n) acc[a][b][m][n] = (f32x4){0.f, 0.f, 0.f, 0.f};
    bf16x8 At[4][2], B0[2][2], B1[2][2];
    const char* cA = cur.a; const char* cB = cur.b;
    PG8_STAGE(PG8_SB(0, 0), cB, voffB); PG8_STAGE(PG8_SA(0, 0), cA, voffA); PG8_STAGE(PG8_SB(0, 1), cB + hstepB, voffB); PG8_STAGE(PG8_SA(0, 1), cA + hstepA, voffA);
    if (wr == 1) PG8_BAR;
    PG8_WAIT_V(4); PG8_BAR;
    PG8_STAGE(PG8_SB(1, 0), cB + kstep, voffB); PG8_STAGE(PG8_SA(1, 0), cA + kstep, voffA); PG8_STAGE(PG8_SB(1, 1), cB + hstepB + kstep, voffB);
    PG8_WAIT_V(6); PG8_BAR;
    for (;;) {
        const bool has_next = next_unit(kp, tr, l, k, gi, ui + 1, G, cblk, nxt);
        const char* nA = has_next ? nxt.a : cA; const char* nB = has_next ? nxt.b : cB;
        for (int t = 0; t < nt; t += 2) {
            const bool last = (t == nt - 2);
            const char* a1 = cA + (size_t)(t + 1) * kstep;
            const char* a2 = last ? nA : cA + (size_t)(t + 2) * kstep; const char* b2 = last ? nB : cB + (size_t)(t + 2) * kstep;
            const char* a3 = a2 + kstep; const char* b3 = b2 + kstep;
            PG8_LDB(B0, 0, 0); PG8_SCHED; PG8_LDA(At, 0, 0); PG8_STAGE(PG8_SA(1, 1), a1 + hstepA, voffA);
            PG8_WAIT_L(8); PG8_BAR; PG8_WAIT_L(0); PG8_MMA(0, 0, At, B0); PG8_BAR; PG8_SCHED;
            PG8_LDB(B1, 0, 1); PG8_STAGE(PG8_SB(0, 0), b2, voffB);
            PG8_BAR; PG8_WAIT_L(0); PG8_MMA(0, 1, At, B1); PG8_BAR;
            PG8_LDA(At, 0, 1); PG8_STAGE(PG8_SA(0, 0), a2, voffA);
            PG8_BAR; PG8_WAIT_L(0); PG8_MMA(1, 0, At, B0); PG8_BAR; PG8_SCHED;
            PG8_STAGE(PG8_SB(0, 1), b2 + hstepB, voffB);
            PG8_WAIT_V(6); PG8_BAR; PG8_MMA(1, 1, At, B1); PG8_BAR;
            PG8_LDB(B0, 1, 0); PG8_SCHED; PG8_LDA(At, 1, 0); PG8_STAGE(PG8_SA(0, 1), a2 + hstepA, voffA);
            PG8_WAIT_L(8); PG8_BAR; PG8_WAIT_L(0); PG8_MMA(0, 0, At, B0); PG8_BAR; PG8_SCHED;
            PG8_LDB(B1, 1, 1); PG8_STAGE(PG8_SB(1, 0), b3, voffB);
            PG8_BAR; PG8_WAIT_L(0); PG8_MMA(0, 1, At, B1); PG8_BAR;
            PG8_LDA(At, 1, 1); PG8_STAGE(PG8_SA(1, 0), a3, voffA);
            PG8_BAR; PG8_WAIT_L(0); PG8_MMA(1, 0, At, B0); PG8_BAR; PG8_SCHED;
            PG8_STAGE(PG8_SB(1, 1), b3 + hstepB, voffB);
            PG8_WAIT_V(6); PG8_BAR; PG8_MMA(1, 1, At, B1); PG8_BAR;
        }
        gemm_epilogue<EPI>(kp, tr, l, k, gi, acc, cur, lds);
        if (!has_next) break;
#pragma unroll
        for (int a = 0; a < 2; ++a)
#pragma unroll
            for (int b = 0; b < 2; ++b)
#pragma unroll
                for (int m = 0; m < 4; ++m)
#pragma unroll
                    for (int n = 0; n < 2; ++n) acc[a][b][m][n] = (f32x4){0.f, 0.f, 0.f, 0.f};
        cur = nxt; cA = nA; cB = nB; ++ui;
    }
    PG8_WAIT_V(0);
    if (wr == 0) PG8_BAR;
    PG8_BAR;
#undef PG8_SA
#undef PG8_SB
#undef PG8_STAGE
#undef PG8_LDA
#undef PG8_LDB
#undef PG8_MMA
#undef PG8_WAIT_V
#undef PG8_WAIT_L
#undef PG8_BAR
#undef PG8_SCHED
}

namespace att {
constexpr int NW = 8, QBLK = 32, KVBLK = 64;
constexpr float SCALE = 0.07216878364870322f;
constexpr float THR = 8.f;
constexpr int LDQ = 1536, LDK = 2048, LDKR = 64, LDO = 2048;
constexpr int SHM_V = KVBLK * 128 * 2, SHM_K = KVBLK * 128 * 2, SHM_KR = KVBLK * 64 * 2;
#define KSWZ(row, colB) ((row) * 256 + ((colB) ^ (((row) & 7) << 4)))
#define KRSWZ(row, colB) ((row) * 128 + ((colB) ^ (((row) & 7) << 4)))
#define SBAR() __builtin_amdgcn_sched_barrier(0)
__device__ __forceinline__ int crow(int r, int hi) { return (r & 3) + 8 * (r >> 2) + 4 * hi; }
__device__ __forceinline__ void partialSM(f32x16& p0, f32x16& p1, float& m_reg, float& mn, float& alpha) {
    constexpr float C = SCALE * 1.4426950408889634f;
    float pmax = p0[0];
#pragma unroll
    for (int r = 1; r < 16; ++r) pmax = fmaxf(pmax, p0[r]);
#pragma unroll
    for (int r = 0; r < 16; ++r) pmax = fmaxf(pmax, p1[r]);
    { auto rr = __builtin_amdgcn_permlane32_swap(__float_as_uint(pmax), __float_as_uint(pmax), false, false);
      pmax = fmaxf(__uint_as_float(rr[0]), __uint_as_float(rr[1])); }
    if (__builtin_expect(__all(pmax - m_reg <= THR / SCALE), 1)) { mn = m_reg; alpha = 1.f; }
    else { mn = fmaxf(m_reg, pmax); alpha = __builtin_amdgcn_exp2f((m_reg - mn) * C); m_reg = mn; }
    float mnC = -mn * C;
#pragma unroll
    for (int r = 0; r < 16; ++r) p0[r] = fmaf(p0[r], C, mnC);
#pragma unroll
    for (int r = 0; r < 16; ++r) p1[r] = fmaf(p1[r], C, mnC);
#pragma unroll
    for (int r = 0; r < 16; ++r) p0[r] = __builtin_amdgcn_exp2f(p0[r]);
}
__device__ __forceinline__ void finishSM(f32x16& p0, f32x16& p1, float alpha, float& l_reg, bf16x8& pa0, bf16x8& pa1, bf16x8& pa2, bf16x8& pa3) {
#pragma unroll
    for (int r = 0; r < 16; ++r) p1[r] = __builtin_amdgcn_exp2f(p1[r]);
    float ps = 0;
#pragma unroll
    for (int r = 0; r < 16; ++r) ps += p0[r];
#pragma unroll
    for (int r = 0; r < 16; ++r) ps += p1[r];
    { auto rr = __builtin_amdgcn_permlane32_swap(__float_as_uint(ps), __float_as_uint(ps), false, false);
      ps = __uint_as_float(rr[0]) + __uint_as_float(rr[1]); }
    l_reg = l_reg * alpha + ps;
#define PK4(P, BASE, OUT) do { unsigned a0 = cvtpk(P[BASE + 0], P[BASE + 1]), a1 = cvtpk(P[BASE + 2], P[BASE + 3]);   \
    unsigned b0 = cvtpk(P[BASE + 4], P[BASE + 5]), b1 = cvtpk(P[BASE + 6], P[BASE + 7]);                              \
    auto r0 = __builtin_amdgcn_permlane32_swap(a0, b0, false, false); auto r1 = __builtin_amdgcn_permlane32_swap(a1, b1, false, false); \
    u32x4 w = {r0[0], r1[0], r0[1], r1[1]}; OUT = *reinterpret_cast<bf16x8*>(&w); } while (0)
    PK4(p0, 0, pa0); PK4(p0, 8, pa1); PK4(p1, 0, pa2); PK4(p1, 8, pa3);
#undef PK4
}
__device__ __forceinline__ void qkt(f32x16& p0, f32x16& p1, const char* Ks, const char* Krs, const bf16x8* qr, const char* qrl, int r32, int hi) {
    p0 = f32x16{}; p1 = f32x16{};
#pragma unroll
    for (int d0 = 0; d0 < 8; ++d0) { int cb = (d0 * 16 + hi * 8) * 2;
        bf16x8 b0 = *reinterpret_cast<const bf16x8*>(Ks + KSWZ(r32, cb));
        bf16x8 b1 = *reinterpret_cast<const bf16x8*>(Ks + KSWZ(32 + r32, cb));
        p0 = __builtin_amdgcn_mfma_f32_32x32x16_bf16(b0, qr[d0], p0, 0, 0, 0);
        p1 = __builtin_amdgcn_mfma_f32_32x32x16_bf16(b1, qr[d0], p1, 0, 0, 0); }
#pragma unroll
    for (int d0 = 0; d0 < 4; ++d0) { int cb = (d0 * 16 + hi * 8) * 2;
        bf16x8 b0 = *reinterpret_cast<const bf16x8*>(Krs + KRSWZ(r32, cb));
        bf16x8 b1 = *reinterpret_cast<const bf16x8*>(Krs + KRSWZ(32 + r32, cb));
        const bf16x8 qv = *reinterpret_cast<const bf16x8*>(qrl + d0 * 8192);
        p0 = __builtin_amdgcn_mfma_f32_32x32x16_bf16(b0, qv, p0, 0, 0, 0);
        p1 = __builtin_amdgcn_mfma_f32_32x32x16_bf16(b1, qv, p1, 0, 0, 0); }
}
__device__ __forceinline__ int v_st(int k, int c) { const int kk = (k & ~0xC) | ((k & 4) << 1) | ((k & 8) >> 1); return ((kk >> 3) * 4 + (c >> 5)) * 512 + ((kk & 7) * 32 + (c & 31)) * 2; }
__device__ __forceinline__ int v_rd_base(int lane) { return ((lane & 3) << 3) | (((lane >> 2) & 3) << 6) | (((lane >> 4) & 1) << 5) | (((lane >> 5) & 1) << 8); }
constexpr int v_rd_off(int d0, int ks, int half) { return d0 * 512 + ks * 4096 + half * 2048; }
template <int OFF> __device__ __forceinline__ s16x4 tr_read(int vb) {
    s16x4 r; asm volatile("ds_read_b64_tr_b16 %0, %1 offset:%2" : "=&v"(r) : "v"(vb), "i"(OFF) : "memory"); return r;
}
template <int D0> __device__ __forceinline__ void pv_one(f32x16& od, int vb, bf16x8 pa0, bf16x8 pa1, bf16x8 pa2, bf16x8 pa3) {
    const s16x4 l0 = tr_read<v_rd_off(D0, 0, 0)>(vb), h0 = tr_read<v_rd_off(D0, 0, 1)>(vb), l1 = tr_read<v_rd_off(D0, 1, 0)>(vb), h1 = tr_read<v_rd_off(D0, 1, 1)>(vb);
    const s16x4 l2 = tr_read<v_rd_off(D0, 2, 0)>(vb), h2 = tr_read<v_rd_off(D0, 2, 1)>(vb), l3 = tr_read<v_rd_off(D0, 3, 0)>(vb), h3 = tr_read<v_rd_off(D0, 3, 1)>(vb);
    asm volatile("s_waitcnt lgkmcnt(0)" ::: "memory"); SBAR();
#define PK(L, H) (bf16x8){L[0], L[1], L[2], L[3], H[0], H[1], H[2], H[3]}
    od = __builtin_amdgcn_mfma_f32_32x32x16_bf16(pa0, PK(l0, h0), od, 0, 0, 0);
    od = __builtin_amdgcn_mfma_f32_32x32x16_bf16(pa1, PK(l1, h1), od, 0, 0, 0);
    od = __builtin_amdgcn_mfma_f32_32x32x16_bf16(pa2, PK(l2, h2), od, 0, 0, 0);
    od = __builtin_amdgcn_mfma_f32_32x32x16_bf16(pa3, PK(l3, h3), od, 0, 0, 0);
#undef PK
}
__device__ __forceinline__ void pv_d0(f32x16* o, int vb, bf16x8 pa0, bf16x8 pa1, bf16x8 pa2, bf16x8 pa3) {
    pv_one<0>(o[0], vb, pa0, pa1, pa2, pa3); pv_one<1>(o[1], vb, pa0, pa1, pa2, pa3); pv_one<2>(o[2], vb, pa0, pa1, pa2, pa3); pv_one<3>(o[3], vb, pa0, pa1, pa2, pa3);
}

__device__ __forceinline__ void attn_body(const bf16_t* __restrict__ Qb, const bf16_t* __restrict__ Kh, const bf16_t* __restrict__ Kr,
                                          bf16_t* __restrict__ Ob, int ml_off, int seq, char* lds) {
    const int tid = ltid(), wid = tid >> 6, lane = tid & 63, r32 = lane & 31, hi = lane >> 5;
    char* V_lds = lds; char* K_lds = lds + 2 * SHM_V; char* KR_lds = lds + 2 * SHM_V + 2 * SHM_K;
    float* ws = (float*)(lds + 2 * SHM_V + 2 * SHM_K + 2 * SHM_KR) + wid * 64; float* li_l = ws; float* al_l = ws + 32;
    float m_reg = -1e30f, l_reg = 0; f32x16 o[4] = {}; bf16x8 qr[8];
    const bf16_t* Qw = Qb + (long)(wid * QBLK + r32) * LDQ + hi * 8;
#pragma unroll
    for (int d0 = 0; d0 < 8; ++d0) qr[d0] = *reinterpret_cast<const bf16x8*>(Qw + d0 * 16);
    char* qrl = lds + 84 * 1024 + tid * 16;
#pragma unroll
    for (int d0 = 0; d0 < 4; ++d0) *reinterpret_cast<bf16x8*>(qrl + d0 * 8192) = *reinterpret_cast<const bf16x8*>(Qw + (8 + d0) * 16);
    const int sr = tid >> 4, sc = (tid & 15) * 8, vst0 = v_st(sr, sc), vst1 = v_st(32 + sr, sc);
    const int krr = tid >> 3, krc = (tid & 7) * 8;
    const int vb0 = (int)(uintptr_t)V_lds + v_rd_base(lane);
    bf16x8 s_vs0, s_vs1, s_ks0, s_ks1, s_kr;
#define SLOAD(k0) do { s_vs0 = *reinterpret_cast<const bf16x8*>(&Kh[(long)((k0) + sr) * LDK + sc + 128]); s_vs1 = *reinterpret_cast<const bf16x8*>(&Kh[(long)((k0) + 32 + sr) * LDK + sc + 128]); \
    s_ks0 = *reinterpret_cast<const bf16x8*>(&Kh[(long)((k0) + sr) * LDK + sc]); s_ks1 = *reinterpret_cast<const bf16x8*>(&Kh[(long)((k0) + 32 + sr) * LDK + sc]); \
    s_kr = *reinterpret_cast<const bf16x8*>(&Kr[(long)((k0) + krr) * LDKR + krc]); } while (0)
#define SWRITE(b) do { *(bf16x8*)(V_lds + (b) * SHM_V + vst0) = s_vs0; *(bf16x8*)(V_lds + (b) * SHM_V + vst1) = s_vs1; int kc = sc * 2;   \
    *(bf16x8*)(K_lds + (b) * SHM_K + KSWZ(sr, kc)) = s_ks0; *(bf16x8*)(K_lds + (b) * SHM_K + KSWZ(32 + sr, kc)) = s_ks1;                  \
    *(bf16x8*)(KR_lds + (b) * SHM_KR + KRSWZ(krr, krc * 2)) = s_kr; } while (0)
#define SWAIT() asm volatile("s_waitcnt vmcnt(0)" ::: "memory")
#define RESC(a) do { if (__any((a) < 1.f)) { if (hi == 0) al_l[r32] = (a); asm volatile("s_waitcnt lgkmcnt(0)" ::: "memory"); \
    _Pragma("unroll") for (int d = 0; d < 4; ++d) _Pragma("unroll") for (int r = 0; r < 16; ++r) o[d][r] *= al_l[crow(r, hi)]; } } while (0)
    f32x16 pA0, pA1, pB0, pB1; float mnA, mnB, alA, alB; bf16x8 pa0, pa1, pa2, pa3; const int NT = seq / KVBLK;
    SLOAD(0); SWAIT(); SWRITE(0); __syncthreads();
    qkt(pA0, pA1, K_lds, KR_lds, qr, qrl, r32, hi); partialSM(pA0, pA1, m_reg, mnA, alA);
    SLOAD(KVBLK);
    SWAIT(); SWRITE(1); __syncthreads();
    for (int j = 1; j + 1 < NT; j += 2) {
        SBAR(); qkt(pB0, pB1, K_lds + SHM_K, KR_lds + SHM_KR, qr, qrl, r32, hi);
        finishSM(pA0, pA1, alA, l_reg, pa0, pa1, pa2, pa3); SBAR();
        SLOAD((j + 1) * KVBLK); SBAR();
        pv_d0(o, vb0, pa0, pa1, pa2, pa3); partialSM(pB0, pB1, m_reg, mnB, alB);
        __syncthreads(); SWAIT(); SWRITE(0);
        RESC(alB); __syncthreads();
        SBAR(); qkt(pA0, pA1, K_lds, KR_lds, qr, qrl, r32, hi);
        finishSM(pB0, pB1, alB, l_reg, pa0, pa1, pa2, pa3); SBAR();
        SLOAD((j + 2) * KVBLK); SBAR();
        pv_d0(o, vb0 + (int)SHM_V, pa0, pa1, pa2, pa3); partialSM(pA0, pA1, m_reg, mnA, alA);
        __syncthreads(); SWAIT(); SWRITE(1);
        RESC(alA); __syncthreads();
    }
    SBAR(); qkt(pB0, pB1, K_lds + SHM_K, KR_lds + SHM_KR, qr, qrl, r32, hi);
    finishSM(pA0, pA1, alA, l_reg, pa0, pa1, pa2, pa3); SBAR();
    pv_d0(o, vb0, pa0, pa1, pa2, pa3); partialSM(pB0, pB1, m_reg, mnB, alB);
    __syncthreads(); RESC(alB);
    finishSM(pB0, pB1, alB, l_reg, pa0, pa1, pa2, pa3); SBAR();
    pv_d0(o, vb0 + (int)SHM_V, pa0, pa1, pa2, pa3);
    if (hi == 0) li_l[r32] = l_reg; asm volatile("s_waitcnt lgkmcnt(0)" ::: "memory");
    if (ml_off >= 0 && hi == 0) {
        const Params* kpa = (const Params*)__builtin_amdgcn_kernarg_segment_ptr(); asm volatile("" : "+s"(kpa));
        float* d = (float*)(kpa->ws + OFF_XB + 2048) + ml_off + (wid * QBLK + r32) * 1024; d[0] = m_reg; d[1] = l_reg; }
    float rli[16];
#pragma unroll
    for (int r = 0; r < 16; ++r) rli[r] = __builtin_amdgcn_rcpf(li_l[crow(r, hi)]);
    bf16_t* Ow = Ob + (long)(wid * QBLK) * LDO;
#pragma unroll
    for (int r = 0; r < 16; ++r) { int orow = crow(r, hi);
#pragma unroll
        for (int d0 = 0; d0 < 4; ++d0) Ow[(long)orow * LDO + d0 * 32 + r32] = f2bf(o[d0][r] * rli[r]); }
    __syncthreads();
#undef SLOAD
#undef SWRITE
#undef SWAIT
#undef RESC
}
}

namespace hg {
constexpr int LD = 136, LDT = 72;
constexpr int O_RZ = 0, O_RQ = O_RZ + 64 * LD * 2, O_RV = O_RQ + 64 * LD * 2, O_QD = O_RV + 64 * LD * 2, O_KD = O_QD + 64 * LD * 2,
              O_KDT = O_KD + 64 * LD * 2, O_VT = O_KDT + 128 * LDT * 2, O_P = O_VT + 128 * LDT * 2, O_SEG = O_P + 64 * LDT * 2, O_EV = O_SEG + 4 * 128 * 4, O_END = O_EV + 3 * 128 * 4;
static_assert(O_END <= LDS_BCAST, "hgrn LDS");
__device__ __forceinline__ float clampf(float x, float lo, float hi) { return fminf(fmaxf(x, lo), hi); }

__device__ __forceinline__ void hgrn_unit(LAS unsigned char* lds, bf16_t* hgb  , const float* lb_logits, int layer, int S, int unit) {
    const int tid = ltid(), wid = tid >> 6, lane = tid & 63, l15 = lane & 15, quad = lane >> 4;
    const int dir = unit & 1, h = (unit >> 1) & 7, b = unit >> 4;
    const int qcol = h * 128, zcol = (dir ? 2048 : 1024) + h * 128, vcol = 3072 + h * 128;
    const int ch = tid & 127, seg = tid >> 7;
    LAS bf16_t* RZ = (LAS bf16_t*)(lds + O_RZ); LAS bf16_t* RQ = (LAS bf16_t*)(lds + O_RQ); LAS bf16_t* RV = (LAS bf16_t*)(lds + O_RV);
    LAS bf16_t* QD = (LAS bf16_t*)(lds + O_QD); LAS bf16_t* KD = (LAS bf16_t*)(lds + O_KD); LAS bf16_t* KDT = (LAS bf16_t*)(lds + O_KDT);
    LAS bf16_t* VT = (LAS bf16_t*)(lds + O_VT); LAS bf16_t* PP = (LAS bf16_t*)(lds + O_P);
    LAS float* SEG = (LAS float*)(lds + O_SEG); LAS float* EV = (LAS float*)(lds + O_EV);
    const int n = S / 64;
    const int r0 = tid >> 4, c8 = (tid & 15) * 8;
    bf16x8 pz0, pz1, pq0, pq1, pv0, pv1;
#define HG_ROW(c, tau) ((long)b * S + (dir ? (S - 1 - ((c) * 64 + (tau))) : ((c) * 64 + (tau))))
#define HG_LOAD(c) do { const bf16_t* ra = hgb + HG_ROW(c, r0) * HGW; const bf16_t* rb = hgb + HG_ROW(c, r0 + 32) * HGW; \
    pz0 = *(const bf16x8*)(ra + zcol + c8); pz1 = *(const bf16x8*)(rb + zcol + c8); pq0 = *(const bf16x8*)(ra + qcol + c8); pq1 = *(const bf16x8*)(rb + qcol + c8); \
    pv0 = *(const bf16x8*)(ra + vcol + c8); pv1 = *(const bf16x8*)(rb + vcol + c8); } while (0)
    f32x4 Sst[8];
#pragma unroll
    for (int i = 0; i < 8; ++i) Sst[i] = (f32x4){0.f, 0.f, 0.f, 0.f};
    HG_LOAD(0);
    for (int c = 0; c < n; ++c) {
        *(LAS bf16x8*)(RZ + r0 * LD + c8) = pz0; *(LAS bf16x8*)(RZ + (r0 + 32) * LD + c8) = pz1;
        *(LAS bf16x8*)(RQ + r0 * LD + c8) = pq0; *(LAS bf16x8*)(RQ + (r0 + 32) * LD + c8) = pq1;
        *(LAS bf16x8*)(RV + r0 * LD + c8) = pv0; *(LAS bf16x8*)(RV + (r0 + 32) * LD + c8) = pv1;
        asm volatile("s_waitcnt lgkmcnt(0)" ::: "memory"); __builtin_amdgcn_s_barrier(); asm volatile("" ::: "memory");
        if (c + 1 < n) HG_LOAD(c + 1);
        float bl[16], kk[16]; float run = 0.f;
#pragma unroll
        for (int i = 0; i < 16; ++i) {
            const float lf = bf2f(RZ[(seg * 16 + i) * LD + ch]);
            run += lf; bl[i] = run; kk[i] = 1.f - __expf(lf);
        }
        SEG[seg * 128 + ch] = run;
        asm volatile("s_waitcnt lgkmcnt(0)" ::: "memory"); __builtin_amdgcn_s_barrier(); asm volatile("" ::: "memory");
        const float t0 = SEG[ch], t1 = SEG[128 + ch], t2 = SEG[256 + ch], t3 = SEG[384 + ch];
        const float off = (seg > 0 ? t0 : 0.f) + (seg > 1 ? t1 : 0.f) + (seg > 2 ? t2 : 0.f);
        const float bref = t0 + t1, btot = (t0 + t1) + (t2 + t3);
        unsigned kdt[8], vtt[8];
#pragma unroll
        for (int i = 0; i < 16; ++i) {
            const int tau = seg * 16 + i;
            const float bb = bl[i] + off;
            const float eq = __expf(clampf(bb - bref, -80.f, 80.f)), ek = __builtin_amdgcn_rcpf(eq);
            const float sq = bf2f(RQ[tau * LD + ch]);
            QD[tau * LD + ch] = f2bf(sq * eq);
            const bf16_t kb = f2bf(kk[i] * ek);
            KD[tau * LD + ch] = kb;
            const bf16_t vb = RV[tau * LD + ch];
            if (i & 1) { kdt[i >> 1] |= ((unsigned)kb) << 16; vtt[i >> 1] |= ((unsigned)vb) << 16; } else { kdt[i >> 1] = kb; vtt[i >> 1] = vb; }
        }
        *(LAS u32x4*)(KDT + ch * LDT + seg * 16) = (u32x4){kdt[0], kdt[1], kdt[2], kdt[3]}; *(LAS u32x4*)(KDT + ch * LDT + seg * 16 + 8) = (u32x4){kdt[4], kdt[5], kdt[6], kdt[7]};
        *(LAS u32x4*)(VT + ch * LDT + seg * 16) = (u32x4){vtt[0], vtt[1], vtt[2], vtt[3]}; *(LAS u32x4*)(VT + ch * LDT + seg * 16 + 8) = (u32x4){vtt[4], vtt[5], vtt[6], vtt[7]};
        if (seg == 0) { EV[ch] = __expf(clampf(bref, -80.f, 80.f)); EV[128 + ch] = __expf(clampf(btot, -80.f, 80.f)); EV[256 + ch] = __expf(clampf(btot - bref, -80.f, 80.f)); }
        asm volatile("s_waitcnt lgkmcnt(0)" ::: "memory"); __builtin_amdgcn_s_barrier(); asm volatile("" ::: "memory");
#pragma unroll
        for (int tt = 0; tt < 2; ++tt) {
            const int ti = wid * 2 + tt, sblk = ti >> 2, tblk = ti & 3;
            f32x4 a = (f32x4){0.f, 0.f, 0.f, 0.f};
            if (sblk <= tblk) {
#pragma unroll
                for (int ks = 0; ks < 4; ++ks) {
                    const bf16x8 af = *(LAS bf16x8*)(KD + (sblk * 16 + l15) * LD + ks * 32 + quad * 8);
                    const bf16x8 bfr = *(LAS bf16x8*)(QD + (tblk * 16 + l15) * LD + ks * 32 + quad * 8);
                    a = __builtin_amdgcn_mfma_f32_16x16x32_bf16(af, bfr, a, 0, 0, 0);
                }
            }
            const int t = tblk * 16 + l15, s0 = sblk * 16 + quad * 4;
            u32x2 w; w.x = cvtpk(s0 + 0 <= t ? a[0] : 0.f, s0 + 1 <= t ? a[1] : 0.f); w.y = cvtpk(s0 + 2 <= t ? a[2] : 0.f, s0 + 3 <= t ? a[3] : 0.f);
            *(LAS u32x2*)(PP + t * LDT + s0) = w;
        }
        asm volatile("s_waitcnt lgkmcnt(0)" ::: "memory"); __builtin_amdgcn_s_barrier(); asm volatile("" ::: "memory");
        const int dv0 = wid * 16;
        bf16x8 bv[2];
#pragma unroll
        for (int ks = 0; ks < 2; ++ks) bv[ks] = *(LAS bf16x8*)(VT + (dv0 + l15) * LDT + ks * 32 + quad * 8);
        f32x4 o[4];
#pragma unroll
        for (int i = 0; i < 4; ++i) o[i] = (f32x4){0.f, 0.f, 0.f, 0.f};
#pragma unroll
        for (int k4 = 0; k4 < 4; ++k4) {
            const f32x4 er0 = *(LAS f32x4*)(EV + 32 * k4 + 4 * quad), er1 = *(LAS f32x4*)(EV + 32 * k4 + 16 + 4 * quad);
            const f32x4 s0 = Sst[2 * k4] * er0, s1 = Sst[2 * k4 + 1] * er1;
            u32x4 bw; bw.x = cvtpk(s0[0], s0[1]); bw.y = cvtpk(s0[2], s0[3]); bw.z = cvtpk(s1[0], s1[1]); bw.w = cvtpk(s1[2], s1[3]);
            const bf16x8 bfr = *reinterpret_cast<bf16x8*>(&bw);
#pragma unroll
            for (int tb = 0; tb < 4; ++tb) {
                const u32x2 a0 = *(LAS u32x2*)(QD + (tb * 16 + l15) * LD + 32 * k4 + 4 * quad);
                const u32x2 a1 = *(LAS u32x2*)(QD + (tb * 16 + l15) * LD + 32 * k4 + 16 + 4 * quad);
                u32x4 aw; aw.x = a0.x; aw.y = a0.y; aw.z = a1.x; aw.w = a1.y;
                o[tb] = __builtin_amdgcn_mfma_f32_16x16x32_bf16(*reinterpret_cast<bf16x8*>(&aw), bfr, o[tb], 0, 0, 0);
            }
        }
#pragma unroll
        for (int ks = 0; ks < 2; ++ks)
#pragma unroll
            for (int tb = 0; tb < 4; ++tb) {
                const bf16x8 af = *(LAS bf16x8*)(PP + (tb * 16 + l15) * LDT + ks * 32 + quad * 8);
                o[tb] = __builtin_amdgcn_mfma_f32_16x16x32_bf16(af, bv[ks], o[tb], 0, 0, 0);
            }
#pragma unroll
        for (int tb = 0; tb < 4; ++tb)
#pragma unroll
            for (int j = 0; j < 4; ++j) hgb[HG_ROW(c, tb * 16 + quad * 4 + j) * HGW + zcol + dv0 + l15] = f2bf(o[tb][j]);
#pragma unroll
        for (int db = 0; db < 8; ++db) {
            f32x4 tmp = (f32x4){0.f, 0.f, 0.f, 0.f};
#pragma unroll
            for (int ks = 0; ks < 2; ++ks) {
                const bf16x8 af = *(LAS bf16x8*)(KDT + (db * 16 + l15) * LDT + ks * 32 + quad * 8);
                tmp = __builtin_amdgcn_mfma_f32_16x16x32_bf16(af, bv[ks], tmp, 0, 0, 0);
            }
            const f32x4 et = *(LAS f32x4*)(EV + 128 + db * 16 + quad * 4), etr = *(LAS f32x4*)(EV + 256 + db * 16 + quad * 4);
            Sst[db] = Sst[db] * et + tmp * etr;
        }
    }
    wg_barrier();
#undef HG_ROW
#undef HG_LOAD
}
}

struct WDesc { const float* src; const float* gain; bf16_t* dst; int K, N, R, map; };

__device__ __forceinline__ void wcvt_phase(LAS unsigned char* lds, const Params& p, int layer) {
    LAS float* tile = (LAS float*)lds;
    const int tid = ltid();
    char* ws = p.ws;
    if (lbid() == 0) {
        float* lbt = (float*)(ws + OFF_LB);
        for (int i = tid; i < 2048; i += 512) {
            float mx = -3e38f; for (int l = 0; l < DEPTH; ++l) mx = fmaxf(mx, p.lb_logits[l * 2048 + i]);
            float den = 0.f, num = 0.f; for (int l = 0; l < DEPTH; ++l) { const float e = __expf(p.lb_logits[l * 2048 + i] - mx); den += e; if (l >= 1 && l <= layer) num += e; }
            lbt[i] = num / den;
        }
    }
    for (int mi = 0; mi < 10; ++mi) {
        WDesc d;
        switch (mi) {
        case 0: d = {p.w_in + (size_t)layer * 2048 * 5952, p.mix_norm + layer * 2048, (bf16_t*)(ws + OFF_W_IN), 2048, 5952, INP, 1}; break;
        case 1: d = {p.w_uq + (size_t)layer * 512 * 1536, p.q_norm + layer * 512, (bf16_t*)(ws + OFF_W_UQ), 512, 1536, 1536, 0}; break;
        case 2: d = {p.w_ukv + (size_t)layer * 256 * 2048, p.kv_norm + layer * 256, (bf16_t*)(ws + OFF_W_UKV), 256, 2048, 2048, 0}; break;
        case 3: d = {p.w_out + (size_t)layer * 2048 * 2048, nullptr, (bf16_t*)(ws + OFF_W_OUT), 2048, 2048, 2048, 0}; break;
        case 4: d = {p.w_xq + (size_t)layer * 2048 * 2048, p.xattn_norm + layer * 2048, (bf16_t*)(ws + OFF_W_XQ), 2048, 2048, 2048, 0}; break;
        case 5: d = {p.w_xk + (size_t)layer * 2048 * 2048, p.mem_norm + layer * 2048, (bf16_t*)(ws + OFF_W_XK), 2048, 2048, 2048, 0}; break;
        case 6: d = {p.w_xv + (size_t)layer * 2048 * 2048, p.mem_norm + layer * 2048, (bf16_t*)(ws + OFF_W_XV), 2048, 2048, 2048, 0}; break;
        case 7: d = {p.w_xo + (size_t)layer * 2048 * 2048, nullptr, (bf16_t*)(ws + OFF_W_XO), 2048, 2048, 2048, 0}; break;
        case 8: d = {p.w_ffn1 + (size_t)layer * 2048 * 8192, p.ffn_norm + layer * 2048, (bf16_t*)(ws + OFF_W_F1), 2048, 8192, 8192, 0}; break;
        default: d = {p.w_ffn2 + (size_t)layer * 8192 * 2048, nullptr, (bf16_t*)(ws + OFF_W_F2), 8192, 2048, 2048, 0}; break;
        }
        const int nkt = d.K / 64, nrt = d.R / 256, ntile = nkt * nrt;
        for (int t = lbid(); t < ntile; t += gridDim.x) {
            const int kt = t % nkt, rt = t / nkt, k0 = kt * 64, r0 = rt * 256;
            {
                const int c4 = tid & 63, rr = tid >> 6; const int col = r0 + 4 * c4;
                int sc = col; bool zero = false;
                if (d.map) { if (col < 832) sc = col; else if (col < 1024) zero = true; else sc = col - 192; }
#pragma unroll
                for (int ii = 0; ii < 8; ++ii) { const int i = rr + ii * 8;
                    f32x4 v = zero ? (f32x4){0.f, 0.f, 0.f, 0.f} : *(const f32x4*)(d.src + (size_t)(k0 + i) * d.N + sc);
                    if (d.gain) v = v * d.gain[k0 + i];
                    *(LAS f32x4*)(tile + i * 260 + 4 * c4) = v; }
            }
            wg_barrier();
            {
                const int n = tid >> 1, kh = (tid & 1) * 32;
#pragma unroll
                for (int j = 0; j < 4; ++j) {
                    unsigned w[4];
#pragma unroll
                    for (int e = 0; e < 8; e += 2) w[e >> 1] = cvtpk(tile[(kh + j * 8 + e) * 260 + n], tile[(kh + j * 8 + e + 1) * 260 + n]);
                    *(u32x4*)(d.dst + (size_t)(r0 + n) * d.K + k0 + kh + j * 8) = (u32x4){w[0], w[1], w[2], w[3]};
                }
            }
            wg_barrier();
        }
    }
}

__device__ __forceinline__ void prep_phase(const Params& p, int tr, int T, int S) {
    const size_t xb_off = tr ? OFF_XB : OFF_XB0;
    const int tid = ltid(), wid = tid >> 6, lane = tid & 63;
    char* ws = p.ws;
    const long gtid = (long)lbid() * 512 + tid, gstride = (long)gridDim.x * 512;
    { ssq_t* ssq = (ssq_t*)(ws + OFF_SSQ) + (size_t)tr * 11 * TMAX; for (long i = gtid; i < (long)10 * TMAX; i += gstride) ssq[TMAX + i] = 0ull;
      if (gtid < 64) ((unsigned*)(ws + OFF_CTR))[gtid] = 0u; }
    { float* rc = (float*)(ws + OFF_ROPE); float* rs = rc + 16384 * 32;
      for (int i = (int)gtid; i < S * 32; i += (int)gstride) { const int pos = i >> 5, f = i & 31;
          const float inv_freq = exp2f(-(float)f * (13.287712379549449f / 32.f));
          const float ang = (float)pos * inv_freq;
          const double rev = (double)ang * 0.15915494309189535; const float fr = (float)(rev - rint(rev));
          rc[i] = __builtin_amdgcn_cosf(fr); rs[i] = __builtin_amdgcn_sinf(fr); } }
    { const float* x = p.x_in[tr]; bf16_t* xb = (bf16_t*)(ws + xb_off); ssq_t* ssq0 = (ssq_t*)(ws + OFF_SSQ) + (size_t)tr * 11 * TMAX;
      for (int row = lbid() * 8 + wid; row < T; row += gridDim.x * 8) {
          float ss = 0.f;
#pragma unroll
          for (int i = 0; i < 8; ++i) { const int c = i * 256 + lane * 4; const f32x4 v = *(const f32x4*)(x + (size_t)row * DM + c);
              ss += (v[0] * v[0] + v[1] * v[1]) + (v[2] * v[2] + v[3] * v[3]);
              u32x2 w; w.x = cvtpk(v[0], v[1]); w.y = cvtpk(v[2], v[3]); *(u32x2*)(xb + (size_t)row * DM + c) = w; }
#pragma unroll
          for (int o = 32; o > 0; o >>= 1) ss += __shfl_xor(ss, o);
          if (lane == 0) ssq0[row] = ssq_fix(ss);
      } }
    { const float* mem = p.mem_in[tr]; bf16_t* mn = (bf16_t*)(ws + OFF_MEMN) + (size_t)tr * 512 * 2048;
      for (int row = lbid() * 8 + wid; row < 512; row += gridDim.x * 8) {
          f32x4 v[8]; float ss = 0.f;
#pragma unroll
          for (int i = 0; i < 8; ++i) { v[i] = *(const f32x4*)(mem + (size_t)row * DM + i * 256 + lane * 4); ss += (v[i][0] * v[i][0] + v[i][1] * v[i][1]) + (v[i][2] * v[i][2] + v[i][3] * v[i][3]); }
#pragma unroll
          for (int o = 32; o > 0; o >>= 1) ss += __shfl_xor(ss, o);
          const float rs = __builtin_amdgcn_rsqf(ss * (1.f / DM) + EPS);
#pragma unroll
          for (int i = 0; i < 8; ++i) { u32x2 w; w.x = cvtpk(v[i][0] * rs, v[i][1] * rs); w.y = cvtpk(v[i][2] * rs, v[i][3] * rs); *(u32x2*)(mn + (size_t)row * DM + i * 256 + lane * 4) = w; }
      } }
}

__device__ __forceinline__ void rope_phase(const Params& p, int T, int S) {
    char* ws = p.ws;
    bf16_t* q = (bf16_t*)(ws + OFF_Q); const bf16_t* kr = (const bf16_t*)(ws + OFF_KR); bf16_t* kro = (bf16_t*)(ws + OFF_KROPE);
    const float* rc = (const float*)(ws + OFF_ROPE); const float* rs = rc + 16384 * 32;
    const int total = T * 9 * 4;
    constexpr int UN = 3;
    const int stride = gridDim.x * 512;
    for (int i0 = lbid() * 512 + ltid(); i0 < total; i0 += stride * UN) {
        f32x8 c[UN], s[UN]; bf16x8 a1[UN], a2[UN];
#pragma unroll
        for (int u = 0; u < UN; ++u) { const int i = i0 + u * stride; if (i < total) {
            const int f8 = (i & 3) * 8; const int ru = i >> 2; const int row_i = ru / 9; const int un = ru - row_i * 9; const long row = row_i; const int pos = row_i & (S - 1);
            c[u] = *(const f32x8*)(rc + pos * 32 + f8); s[u] = *(const f32x8*)(rs + pos * 32 + f8);
            const bf16_t* src = (un < 8) ? (q + row * 1536 + un * 192 + 128 + f8) : (kr + row * 64 + f8);
            a1[u] = *(const bf16x8*)src; a2[u] = *(const bf16x8*)(src + 32); } }
#pragma unroll
        for (int u = 0; u < UN; ++u) { const int i = i0 + u * stride; if (i >= total) break;
            const int f8 = (i & 3) * 8; const int ru = i >> 2; const int row_i = ru / 9; const int un = ru - row_i * 9; const long row = row_i;
            bf16_t* dst = (un < 8) ? (q + row * 1536 + un * 192 + 128 + f8) : (kro + row * 64 + f8);
            unsigned w1[4], w2[4];
#pragma unroll
            for (int j = 0; j < 8; j += 2) {
                const float x1a = bf2f((bf16_t)a1[u][j]), x2a = bf2f((bf16_t)a2[u][j]), x1b = bf2f((bf16_t)a1[u][j + 1]), x2b = bf2f((bf16_t)a2[u][j + 1]);
                w1[j >> 1] = cvtpk(x1a * c[u][j] - x2a * s[u][j], x1b * c[u][j + 1] - x2b * s[u][j + 1]);
                w2[j >> 1] = cvtpk(x2a * c[u][j] + x1a * s[u][j], x2b * c[u][j + 1] + x1b * s[u][j + 1]);
            }
            *(u32x4*)dst = (u32x4){w1[0], w1[1], w1[2], w1[3]}; *(u32x4*)(dst + 32) = (u32x4){w2[0], w2[1], w2[2], w2[3]};
        }
    }
}

__device__ __forceinline__ void hcomb_phase(const Params& p, int layer, int T, int nblk, int bid, int nsplit) {
    char* ws = p.ws; const bf16_t* hgb = (const bf16_t*)(ws + OFF_HG); bf16_t* mix = (bf16_t*)(ws + OFF_MIX);
    const float* on = p.out_norm + layer * 128;
    const int l16 = ltid() & 15;
    const int total = T * 8 * 16;
    f32x8 onv = *(const f32x8*)(on + l16 * 8);
    constexpr int UN = 4;
    const int stride = nblk * 512;
    for (int i0 = bid * 512 + ltid(); i0 < total; i0 += stride * UN) {
        bf16x8 vf[UN], vb[UN], vg[UN];
#pragma unroll
        for (int u = 0; u < UN; ++u) { const int i = i0 + u * stride; if (i < total) { const int rh = i >> 4; const int h = rh & 7; const long row = rh >> 3;
            const bf16_t* base = hgb + row * HGW + h * 128 + l16 * 8; vf[u] = *(const bf16x8*)(base + 1024); vb[u] = *(const bf16x8*)(base + 2048); vg[u] = *(const bf16x8*)(base + 4096); } }
#pragma unroll
        for (int u = 0; u < UN; ++u) {
            const int i = i0 + u * stride; if (i >= total) break;
            const int rh = i >> 4; const int h = rh & 7; const long row = rh >> 3;
            float o[8]; float ss = 0.f;
#pragma unroll
            for (int j = 0; j < 8; ++j) { o[j] = bf2f((bf16_t)vf[u][j]) + bf2f((bf16_t)vb[u][j]); ss += o[j] * o[j]; }
            ss += __shfl_xor(ss, 1); ss += __shfl_xor(ss, 2); ss += __shfl_xor(ss, 4); ss += __shfl_xor(ss, 8);
            const float rs = __builtin_amdgcn_rsqf(ss * (1.f / 128.f) + EPS);
            unsigned w[4];
#pragma unroll
            for (int j = 0; j < 8; j += 2) {
                const float g0 = bf2f((bf16_t)vg[u][j]), g1 = bf2f((bf16_t)vg[u][j + 1]);
                const float y0 = o[j] * rs * onv[j] * (g0 * __builtin_amdgcn_rcpf(1.f + __expf(-g0))), y1 = o[j + 1] * rs * onv[j + 1] * (g1 * __builtin_amdgcn_rcpf(1.f + __expf(-g1)));
                w[j >> 1] = cvtpk(y0, y1);
            }
            *(u32x4*)(mix + row * 2048 + 1024 + h * 128 + l16 * 8) = (u32x4){w[0], w[1], w[2], w[3]};
            if (nsplit == 2 && (((int)row & 16383) >> 8) >= MK_QF) {
                const f32x4 mlv = *(const f32x4*)((const float*)(ws + OFF_XB + 2048) + row * 1024 + h * 4);
                const float C = att::SCALE * 1.4426950408889634f;
                const float M = fmaxf(mlv[0], mlv[2]);
                const float w1 = mlv[1] * __builtin_amdgcn_exp2f((mlv[0] - M) * C), w2 = mlv[3] * __builtin_amdgcn_exp2f((mlv[2] - M) * C);
                const float inv = 1.f / (w1 + w2), c1 = w1 * inv, c2 = w2 * inv;
                bf16_t* pa = mix + row * 2048 + h * 128 + l16 * 8; const bf16_t* pb = (const bf16_t*)(ws + OFF_XB) + row * 2048 + h * 128 + l16 * 8;
                const bf16x8 va = *(const bf16x8*)pa, vb2 = *(const bf16x8*)pb;
                unsigned wo[4];
#pragma unroll
                for (int j = 0; j < 8; j += 2) wo[j >> 1] = cvtpk(c1 * bf2f((bf16_t)va[j]) + c2 * bf2f((bf16_t)vb2[j]), c1 * bf2f((bf16_t)va[j + 1]) + c2 * bf2f((bf16_t)vb2[j + 1]));
                *(u32x4*)pa = (u32x4){wo[0], wo[1], wo[2], wo[3]};
            }
        }
    }
}

__device__ __forceinline__ void final_phase(const Params& p, float* xout, int T, int tr) {
    const int wid = ltid() >> 6, lane = ltid() & 63;
    const ssq_t* ssq = (const ssq_t*)(p.ws + OFF_SSQ) + (size_t)(tr * 11 + 10) * TMAX;
    for (int row = lbid() * 8 + wid; row < T; row += gridDim.x * 8) {
        const float rs = __builtin_amdgcn_rsqf(ssq_val(ssq[row]) * (1.f / DM) + EPS);
#pragma unroll
        for (int i = 0; i < 8; ++i) { const int c = i * 256 + lane * 4; f32x4 v = *(f32x4*)(xout + (size_t)row * DM + c); const f32x4 g = *(const f32x4*)(p.final_norm + c);
            v = v * rs * g; *(f32x4*)(xout + (size_t)row * DM + c) = v; }
    }
}

__device__ __forceinline__ void mixer_phase(LAS unsigned char* lds, const Params& p, int layer, int T, int S, int tr) {
    char* ws = p.ws;
    unsigned* ctr = (unsigned*)(ws + OFF_CTR) + (tr * 2 + layer) * 16;
    const int nQB = S / 256, QF = (S >= 16384) ? MK_QF : nQB, nQS = nQB - QF;
    const int nG = 32, nH = 2 * 8 * 2, nFull = 16 * QF, nA = nFull + 16 * 2 * nQS;
    LAS unsigned* slot = (LAS unsigned*)(lds + LDS_BCAST);
    for (;;) {
        if (ltid() == 0) *slot = __hip_atomic_fetch_add(ctr, 1u, __ATOMIC_RELAXED, __HIP_MEMORY_SCOPE_AGENT);
        wg_barrier();
        const int idx = (int)__builtin_amdgcn_readfirstlane(*slot);
        wg_barrier();
        if (idx >= nG + nH + nA) break;
        const Params* kq = launder_p((const Params*)__builtin_amdgcn_kernarg_segment_ptr());
        if (idx < nG) {
            gemm_phase<E_BF16>(lds, kq, tr, layer, 5, idx >> 4, 16, idx & 15);
            continue;
        }
        char* wsu = kq->ws;
        bf16_t* hgb = (bf16_t*)(wsu + OFF_HG);
        const bf16_t* q = (const bf16_t*)(wsu + OFF_Q); const bf16_t* kv = (const bf16_t*)(wsu + OFF_KV); const bf16_t* kro = (const bf16_t*)(wsu + OFF_KROPE);
        bf16_t* mix = (bf16_t*)(wsu + OFF_MIX); bf16_t* o2 = (bf16_t*)(wsu + OFF_XB);
#ifndef MK_NO_HG
        if (idx < nG + nH) hg::hgrn_unit(lds, hgb, kq->lb_logits, layer, S, idx - nG);
        else
#endif
        {
#ifndef MK_NO_ATT
            const int a = idx - nG - nH; int qb, half, bh, nsplit;
            if (a < nFull) { qb = a % QF; bh = a / QF; half = 0; nsplit = 1; }
            else { const int a1 = a - nFull; qb = QF + a1 % nQS; const int a2 = a1 / nQS; half = a2 & 1; bh = a2 >> 1; nsplit = 2; }
            const int h = bh & 7, b = bh >> 3;
            const int sseq = S / nsplit;
            const long row0 = (long)b * S + (long)qb * 256, krow0 = (long)b * S + (long)half * sseq;
            bf16_t* ob = (half == 0 ? mix : o2) + row0 * 2048 + h * 128;
            const int ml = (nsplit == 2) ? (int)(row0 * 1024 + h * 4 + half * 2) : -1;
            att::attn_body(q + row0 * 1536 + h * 192, kv + krow0 * 2048 + h * 256, kro + krow0 * 64, ob, ml, sseq, (char*)(unsigned char*)lds);
#endif
        }
    }
}

#define XB_TMO      128
#define XB_XCNT(j)  (256  + 64 * (j))
#define XB_XSUB(j)  (1280 + 64 * (j))
#define XB_XGEN(j)  (2304 + 64 * (j))
#define XB_TOP      3328
#define XB_TOPGEN   3392
#define XCD_BAR_WORDS 3456
#define XB_SPIN_CAP (1u << 22)
__device__ __forceinline__ unsigned xb_ld(unsigned* p)              { return __hip_atomic_load(p, __ATOMIC_RELAXED, __HIP_MEMORY_SCOPE_AGENT); }
__device__ __forceinline__ unsigned xb_add(unsigned* p, unsigned v) { return __hip_atomic_fetch_add(p, v, __ATOMIC_RELAXED, __HIP_MEMORY_SCOPE_AGENT); }
__device__ __forceinline__ unsigned xb_xcc_id() { return (unsigned)__builtin_amdgcn_s_getreg((3 << 11) | 20) & 0xFu; }
#define XB_SPIN(cond, bar) do { unsigned _sp = 0; while (cond) { __builtin_amdgcn_s_sleep(1); \
    if ((++_sp & 255u) == 0u) { if (xb_ld(&(bar)[XB_TMO])) break; if (_sp > XB_SPIN_CAP) { atomicAdd(&(bar)[XB_TMO], 1u); break; } } } } while (0)
struct XcdBarrier { unsigned* bar; unsigned x; volatile LAS unsigned* st; };
__device__ __forceinline__ XcdBarrier xcd_barrier_post(unsigned* bar, volatile LAS unsigned* st) {
    XcdBarrier b; b.bar = bar; b.x = xb_xcc_id(); b.st = st;
    if (threadIdx.x == 0) (void)xb_add(&bar[XB_XCNT(b.x)], 1u);
    return b;
}
__device__ __forceinline__ void xcd_barrier_complete(unsigned* bar, unsigned x, unsigned& nloc, unsigned& nx) {
    const unsigned G = gridDim.x * gridDim.y * gridDim.z;
    unsigned sum, cnt, mine, sp = 0u;
    for (;;) {
        sum = 0u; cnt = 0u; mine = 0u;
#pragma unroll
        for (unsigned j = 0; j < 16; ++j) { const unsigned c = xb_ld(&bar[XB_XCNT(j)]); sum += c; cnt += (c > 0u) ? 1u : 0u; mine = (j == x) ? c : mine; }
        if (sum == G) break;
        __builtin_amdgcn_s_sleep(1);
        if ((++sp & 255u) == 0u) { if (xb_ld(&bar[XB_TMO])) break; if (sp > XB_SPIN_CAP) { atomicAdd(&bar[XB_TMO], 1u); break; } }
    }
    nloc = mine > 0u ? mine : 1u; nx = cnt > 0u ? cnt : 1u;
}
__device__ __forceinline__ void xcd_barrier_(const XcdBarrier& b) {
    asm volatile("s_waitcnt vmcnt(0)" ::: "memory");
    __syncthreads();
    if (threadIdx.x == 0) {
        unsigned* bar = b.bar;
        __builtin_amdgcn_s_waitcnt(0);
        unsigned nloc = b.st[0], nx = b.st[1];
        if (nloc == 0u) { xcd_barrier_complete(bar, b.x, nloc, nx); b.st[0] = nloc; b.st[1] = nx; }
        const unsigned old = xb_add(&bar[XB_XSUB(b.x)], 1u);
        const unsigned gen = old / nloc;
        if (old + 1u == (gen + 1u) * nloc) {
            __builtin_amdgcn_fence(__ATOMIC_RELEASE, "agent");
            asm volatile("s_waitcnt vmcnt(0)" ::: "memory");
            const unsigned og = xb_add(&bar[XB_TOP], 1u);
            const unsigned tg = og / nx;
            if (og + 1u == (tg + 1u) * nx) xb_add(&bar[XB_TOPGEN], 1u);
            else XB_SPIN(xb_ld(&bar[XB_TOPGEN]) == tg, bar);
            __builtin_amdgcn_fence(__ATOMIC_ACQUIRE, "agent");
            xb_add(&bar[XB_XGEN(b.x)], 1u);
            asm volatile("s_waitcnt vmcnt(0)" ::: "memory");
        } else {
            XB_SPIN(xb_ld(&bar[XB_XGEN(b.x)]) == gen, bar);
            __builtin_amdgcn_fence(__ATOMIC_ACQUIRE, "agent");
            asm volatile("s_waitcnt vmcnt(0)" ::: "memory");
        }
    }
    __syncthreads();
}

__device__ __forceinline__ void xcd_barrier(LAS unsigned char* lds) {
    const Params* kp = launder_p((const Params*)__builtin_amdgcn_kernarg_segment_ptr());
    XcdBarrier b; b.bar = (unsigned*)(kp->ws + OFF_BAR); b.x = xb_xcc_id(); b.st = (volatile LAS unsigned*)(lds + LDS_BCAST + 64);
    xcd_barrier_(b);
}
constexpr int N_PHASES = 52;

__device__ __forceinline__ GemmDesc mkgemm(const void* A, int lda, const void* B, int ldb, int K, int nM, int nN) {
    GemmDesc g{}; g.A = (const char*)A; g.B = (const char*)B; g.lda = lda; g.ldb = ldb; g.K = K; g.nM = nM; g.nN = nN; g.nZ = 1; g.perm = 1; g.epi = E_BF16; return g;
}

__device__ __forceinline__ bool make_gemm(const Params& p, int tr, int l, int k, int i, GemmDesc& g) {
    const int T = tr ? 32768 : 8192, S = tr ? 16384 : 4096, nMT = T / 256;
    char* ws = p.ws;
    float* xout = p.out + (tr ? (size_t)8192 * DM : 0);
    ssq_t* ssq = (ssq_t*)(ws + OFF_SSQ) + (size_t)tr * 11 * TMAX;
    ssq_t* ssq_x0 = ssq + (size_t)(l * 5 + 0) * TMAX; ssq_t* ssq_q = ssq + (size_t)(l * 5 + 1) * TMAX; ssq_t* ssq_kv = ssq + (size_t)(l * 5 + 2) * TMAX;
    ssq_t* ssq_x1 = ssq + (size_t)(l * 5 + 3) * TMAX; ssq_t* ssq_x2 = ssq + (size_t)(l * 5 + 4) * TMAX; ssq_t* ssq_nx = ssq + (size_t)((l + 1) * 5) * TMAX;
    bf16_t* xb = (bf16_t*)(ws + (tr ? OFF_XB : OFF_XB0));
    const char* memn = ws + OFF_MEMN + (size_t)tr * 512 * 2048 * 2;
    if (k == 1) {
        if (i > 0) return false;
        g = mkgemm(xb, DM, ws + OFF_W_IN, DM, DM, nMT, INP / 256); g.epi = E_INPROJ; g.ssq_in = ssq_x0; g.inv_dim = 1.f / DM;
        g.out = (bf16_t*)(ws + OFF_CQ); g.out2 = (bf16_t*)(ws + OFF_KR); g.out3 = (bf16_t*)(ws + OFF_HG); g.ssq_out = ssq_q; g.ssq_out2 = ssq_kv; return true;
    } else if (k == 2) {
        if (i == 0) { g = mkgemm(ws + OFF_CQ, 768, ws + OFF_W_UQ, 512, 512, nMT, 6); g.out = (bf16_t*)(ws + OFF_Q); g.ldo = 1536; g.ssq_in = ssq_q; g.inv_dim = 1.f / 512.f; return true; }
        if (i == 1) { g = mkgemm(ws + OFF_CQ + 512 * 2, 768, ws + OFF_W_UKV, 256, 256, nMT, 8); g.out = (bf16_t*)(ws + OFF_KV); g.ldo = 2048; g.ssq_in = ssq_kv; g.inv_dim = 1.f / 256.f; return true; }
        return false;
    } else if (k == 6) {
        if (i > 0) return false;
        g = mkgemm(ws + OFF_MIX, DM, ws + OFF_W_OUT, DM, DM, nMT, 8); g.epi = E_RESID;
        g.resid = (l == 0) ? p.x_in[tr] : xout; g.xout = xout; g.xb = xb; g.ssq_out = ssq_x1; return true;
    } else if (k == 7) {
        if (i == 0) { g = mkgemm(xb, DM, ws + OFF_W_XQ, DM, DM, nMT, 8); g.out = (bf16_t*)(ws + OFF_XQ); g.ldo = DM; g.ssq_in = ssq_x1; g.inv_dim = 1.f / DM; return true; }
        return false;
    } else if (k == 5) {
        if (i == 0) { g = mkgemm(memn, DM, ws + OFF_W_XK, DM, DM, 2, 8); g.out = (bf16_t*)(ws + OFF_KMEM); g.ldo = DM; return true; }
        if (i == 1) { g = mkgemm(ws + OFF_W_XV, DM, memn, DM, DM, 8, 1); g.nZ = 2; g.bzs = 256 * DM * 2; g.out = (bf16_t*)(ws + OFF_VT); g.ldo = 256; g.ozs = (long)2048 * 256; return true; }
        return false;
    } else if (k == 8) {
        if (i > 0) return false;
        g = mkgemm(ws + OFF_XQ, DM, ws + OFF_KMEM, DM, 512, nMT, 1); g.nZ = 4; g.azs = 512 * 2; g.bzs = 512 * 2; g.bbs = 256 * DM * 2; g.tpb = S / 256;
        g.epi = E_SOFTMAX; g.out = (bf16_t*)(ws + OFF_PBUF); g.ldo = 1024; return true;
    } else if (k == 9) {
        if (i > 0) return false;
        g = mkgemm(ws + OFF_PBUF, 1024, ws + OFF_VT, 256, 256, nMT, 2); g.nZ = 4; g.azs = 256 * 2; g.bzs = 512 * 256 * 2; g.bbs = 2048 * 256 * 2; g.tpb = S / 256;
        g.out = (bf16_t*)(ws + OFF_OBUF); g.ldo = DM; g.ozs = 512; return true;
    } else if (k == 10) {
        if (i > 0) return false;
        g = mkgemm(ws + OFF_OBUF, DM, ws + OFF_W_XO, DM, DM, nMT, 8); g.epi = E_RESID;
        g.resid = xout; g.xout = xout; g.xb = xb; g.ssq_out = ssq_x2; return true;
    } else if (k == 11) {
        if (i > 0) return false;
        g = mkgemm(xb, DM, ws + OFF_W_F1, DM, DM, nMT, 32); g.out = (bf16_t*)(ws + OFF_U); g.ldo = 8192; g.ssq_in = ssq_x2; g.inv_dim = 1.f / DM; g.relu2 = 1; return true;
    } else if (k == 12) {
        if (i > 0) return false;
        g = mkgemm(ws + OFF_U, 8192, ws + OFF_W_F2, 8192, 8192, nMT, 8); g.epi = E_RESID;
        g.resid = xout; g.xout = xout; g.xb = xb; g.ssq_out = ssq_nx; return true;
    }
    return false;
}

__device__ __forceinline__ void run_phase(const Params* kp, int ph, LAS unsigned char* lds) {
    const Params& p = *kp;
    if (ph == 0) { prep_phase(p, 0, 8192, 4096); prep_phase(p, 1, 32768, 16384); return; }
    if (ph == N_PHASES - 1) { final_phase(p, p.out, 8192, 0); final_phase(p, p.out + (size_t)8192 * DM, 32768, 1); return; }
    const int l = (ph - 1) / 25, r = (ph - 1) % 25;
    if (r == 0) { wcvt_phase(lds, p, l); return; }
    const int tr = (r - 1) / 12, k = (r - 1) % 12 + 1;
    const int T = tr ? 32768 : 8192, S = tr ? 16384 : 4096;
    if (k == 3) { rope_phase(p, T, S); return; }
    if (k == 4) { mixer_phase(lds, p, l, T, S, tr); return; }
    if (k == 5) { hcomb_phase(p, l, T, gridDim.x, lbid(), S >= 16384 ? 2 : 1); return; }
#ifndef MK_NO_GEMM
    { const int c = lbid(), G = gridDim.x;
    if (k == 1) gemm_phase<E_INPROJ>(lds, kp, tr, l, k, 0, G, c);
    else if (k == 6 || k == 10 || k == 12) gemm_phase<E_RESID>(lds, kp, tr, l, k, 0, G, c);
    else if (k == 8) gemm_phase<E_SOFTMAX>(lds, kp, tr, l, k, 0, G, c);
    else for (int i = 0; i < 2; ++i) gemm_phase<E_BF16>(lds, kp, tr, l, k, i, G, c); }
#endif
}

__global__ void __launch_bounds__(512, 2) mk_forward(Params p, int ph_lo, int ph_hi) {
    extern __shared__ __attribute__((aligned(16))) unsigned char shm[];
    LAS unsigned char* lds = (LAS unsigned char*)shm;
    cg::grid_group grid = cg::this_grid();
    volatile LAS unsigned* xst = (volatile LAS unsigned*)(lds + LDS_BCAST + 64);
    if (threadIdx.x == 0) { xst[0] = 0u; xst[1] = 0u; }
    __syncthreads();
    { const Params* kp0 = launder_p((const Params*)__builtin_amdgcn_kernarg_segment_ptr()); (void)xcd_barrier_post((unsigned*)(kp0->ws + OFF_BAR), xst); }
    for (int ph = ph_lo; ph < ph_hi; ++ph) {
        const Params* kp = launder_p((const Params*)__builtin_amdgcn_kernarg_segment_ptr());
#ifdef MK_TIME_KIND
        if (blockIdx.x == 0 && threadIdx.x == 0) ((unsigned long long*)(kp->ws + OFF_TS))[ph] = __builtin_amdgcn_s_memrealtime();
#endif
        run_phase(kp, ph, lds);
        if (ph + 1 < ph_hi) { if (ph_hi > N_PHASES) grid.sync(); else xcd_barrier(lds); }
    }
#ifdef MK_TIME_KIND
    xcd_barrier(lds);
    if (blockIdx.x == 0) {
        const Params* kp = launder_p((const Params*)__builtin_amdgcn_kernarg_segment_ptr());
        unsigned long long* ts = (unsigned long long*)(kp->ws + OFF_TS); float* outp = kp->out;
        if (threadIdx.x == 0) ts[ph_hi] = __builtin_amdgcn_s_memrealtime();
        __syncthreads();
        unsigned tot = 0;
        for (int ph = ph_lo; ph < ph_hi; ++ph) { const int r_ = (ph - 1) % 25; const int kind = (ph == 0) ? 100 : (ph == N_PHASES - 1 ? 101 : (r_ == 0 ? 0 : (r_ - 1) % 12 + 1));
            if (kind == MK_TIME_KIND || MK_TIME_KIND == 200) tot += (unsigned)(ts[ph + 1] - ts[ph]); }
        const int n = (int)(tot / 100u);
        for (int i = threadIdx.x; i < n; i += 512) outp[i] += 0.25f;
        for (int i = threadIdx.x; i < 4 * n; i += 512) outp[(size_t)8192 * DM + i] += 0.25f;
    }
#endif

}

extern "C" void kernel_launch(void* const* d_in, const int* in_sizes, int n_in, void* d_out, int out_size, void* d_ws, size_t ws_size, hipStream_t stream) {
    static int inited = 0; static int grid_blocks = 0;
    if (!inited) {
        hipFuncSetAttribute((const void*)mk_forward, hipFuncAttributeMaxDynamicSharedMemorySize, LDS_BYTES);
        int dev = 0, cus = 0, per_cu = 0;
        hipGetDevice(&dev); hipDeviceGetAttribute(&cus, hipDeviceAttributeMultiprocessorCount, dev);
        hipOccupancyMaxActiveBlocksPerMultiprocessor(&per_cu, mk_forward, 512, LDS_BYTES);
        if (per_cu < 1) per_cu = 1;
        grid_blocks = cus * 1;
        if (ws_size < WS_END) fprintf(stderr, "kernel_launch: workspace too small: %zu < %zu\n", ws_size, (size_t)WS_END);
        inited = 1;
    }
    Params p{};
    const float* const* in = (const float* const*)d_in;
    p.x_in[0] = in[0]; p.x_in[1] = in[1]; p.mem_in[0] = in[2]; p.mem_in[1] = in[3];
    p.mix_norm = in[4]; p.w_in = in[5]; p.q_norm = in[6]; p.w_uq = in[7]; p.kv_norm = in[8]; p.w_ukv = in[9]; p.lb_logits = in[10]; p.out_norm = in[11]; p.w_out = in[12];
    p.xattn_norm = in[13]; p.mem_norm = in[14]; p.w_xq = in[15]; p.w_xk = in[16]; p.w_xv = in[17]; p.w_xo = in[18]; p.ffn_norm = in[19]; p.w_ffn1 = in[20]; p.w_ffn2 = in[21]; p.final_norm = in[22];
    p.out = (float*)d_out; p.ws = (char*)d_ws;
#if MK_ONE_LAUNCH
    hipMemsetAsync((char*)d_ws + OFF_BAR, 0, 16384, stream);
    int lo = 0, hi = N_PHASES;
    void* args[] = {&p, &lo, &hi};
    hipError_t e = hipLaunchCooperativeKernel((const void*)mk_forward, dim3(grid_blocks), dim3(512), args, LDS_BYTES, stream);
    if (e != hipSuccess) fprintf(stderr, "cooperative launch failed: %s\n", hipGetErrorString(e));
#else
    for (int ph = 0; ph < N_PHASES; ++ph) hipLaunchKernelGGL(mk_forward, dim3(grid_blocks), dim3(512), LDS_BYTES, stream, p, ph, ph + 1);
#endif
}
```

```cpp
#include <hip/hip_runtime.h>
#include <hip/hip_cooperative_groups.h>
#include <cstdio>
namespace cg = cooperative_groups;

#define LAS __attribute__((address_space(3)))
typedef unsigned short bf16_t;
typedef short bf16x8 __attribute__((ext_vector_type(8)));
typedef short s16x4 __attribute__((ext_vector_type(4)));
typedef float f32x4 __attribute__((ext_vector_type(4)));
typedef float f32x8 __attribute__((ext_vector_type(8)));
typedef float f32x16 __attribute__((ext_vector_type(16)));
typedef unsigned u32x4 __attribute__((ext_vector_type(4)));
typedef unsigned u32x2 __attribute__((ext_vector_type(2)));

#ifndef MK_QF
#define MK_QF 52
#endif
#ifndef MK_ONE_LAUNCH
#define MK_ONE_LAUNCH 1
#endif

constexpr int DM = 2048, NMEM = 256, DEPTH = 2;
constexpr int INP = 6144;
constexpr int HGW = 5120;
constexpr int TMAX = 32768;
constexpr float EPS = 1e-6f;
constexpr int LDS_BYTES = 144 * 1024;
constexpr int LDS_BCAST = 140 * 1024;
constexpr int LDS_EPI = 128 * 1024;

constexpr size_t al256(size_t x) { return (x + 255) / 256 * 256; }
constexpr size_t E_W_IN = (size_t)INP * 2048, E_W_UQ = 1536 * 512, E_W_UKV = 2048 * 256, E_W_SQ = 2048 * 2048, E_W_F = (size_t)8192 * 2048;
constexpr size_t OFF_W_IN = 0;
constexpr size_t OFF_W_UQ = OFF_W_IN + E_W_IN * 2;
constexpr size_t OFF_W_UKV = OFF_W_UQ + E_W_UQ * 2;
constexpr size_t OFF_W_OUT = OFF_W_UKV + E_W_UKV * 2;
constexpr size_t OFF_W_XQ = OFF_W_OUT + E_W_SQ * 2;
constexpr size_t OFF_W_XK = OFF_W_XQ + E_W_SQ * 2;
constexpr size_t OFF_W_XV = OFF_W_XK + E_W_SQ * 2;
constexpr size_t OFF_W_XO = OFF_W_XV + E_W_SQ * 2;
constexpr size_t OFF_W_F1 = OFF_W_XO + E_W_SQ * 2;
constexpr size_t OFF_W_F2 = OFF_W_F1 + E_W_F * 2;
constexpr size_t OFF_XB = OFF_W_F2 + E_W_F * 2;
constexpr size_t OFF_KR = OFF_XB + (size_t)TMAX * 2048 * 2;
constexpr size_t OFF_KROPE = OFF_KR + (size_t)TMAX * 64 * 2;
constexpr size_t OFF_MIX = OFF_KROPE + (size_t)TMAX * 64 * 2;
constexpr size_t OFF_HG = OFF_MIX + (size_t)TMAX * 2048 * 2;
constexpr size_t OFF_Q = OFF_HG + (size_t)TMAX * HGW * 2;
constexpr size_t OFF_KV = OFF_Q + (size_t)TMAX * 1536 * 2;
constexpr size_t OFF_MEMN = OFF_KV + (size_t)TMAX * 2048 * 2;
constexpr size_t OFF_KMEM = OFF_MEMN + (size_t)2 * 512 * 2048 * 2;
constexpr size_t OFF_VT = OFF_KMEM + (size_t)512 * 2048 * 2;
constexpr size_t OFF_ROPE = OFF_VT + (size_t)512 * 2048 * 2;
constexpr size_t OFF_SSQ = OFF_ROPE + (size_t)16384 * 32 * 4 * 2;
constexpr size_t OFF_CTR = OFF_SSQ + (size_t)22 * TMAX * 8;
constexpr size_t OFF_BAR = OFF_CTR + 256;
constexpr size_t OFF_LB = OFF_BAR + 16384;
constexpr size_t OFF_TS = OFF_LB + 8192;
constexpr size_t OFF_XB0 = OFF_TS + 1024;
constexpr size_t WS_END = OFF_XB0 + (size_t)8192 * 2048 * 2;
constexpr size_t OFF_CQ = OFF_MIX;
constexpr size_t OFF_XQ = OFF_Q;
constexpr size_t OFF_PBUF = OFF_MIX;
constexpr size_t OFF_OBUF = OFF_HG;
constexpr size_t OFF_U = OFF_HG;
static_assert((size_t)TMAX * 8192 * 2 <= OFF_MEMN - OFF_HG, "u must fit");

struct Params {
    const float* x_in[2]; const float* mem_in[2];
    const float *mix_norm, *w_in, *q_norm, *w_uq, *kv_norm, *w_ukv, *lb_logits, *out_norm, *w_out, *xattn_norm, *mem_norm, *w_xq, *w_xk, *w_xv, *w_xo,
        *ffn_norm, *w_ffn1, *w_ffn2, *final_norm;
    float* out; char* ws;
};

__device__ __forceinline__ int ltid() { int t = threadIdx.x; asm volatile("" : "+v"(t)); return t; }
__device__ __forceinline__ int lbid() { int t = blockIdx.x; asm volatile("" : "+s"(t)); return t; }
__device__ __forceinline__ float bf2f(bf16_t b) { return __uint_as_float(((unsigned)b) << 16); }
__device__ __forceinline__ bf16_t f2bf(float f) { unsigned u = __float_as_uint(f); u += 0x7FFFu + ((u >> 16) & 1u); return (bf16_t)(u >> 16); }
__device__ __forceinline__ unsigned cvtpk(float lo, float hi) { unsigned r; asm volatile("v_cvt_pk_bf16_f32 %0, %1, %2" : "=v"(r) : "v"(lo), "v"(hi)); return r; }
__device__ __forceinline__ void wg_barrier() { asm volatile("s_waitcnt vmcnt(0) lgkmcnt(0)" ::: "memory"); __builtin_amdgcn_s_barrier(); asm volatile("" ::: "memory"); }
typedef unsigned long long ssq_t;
__device__ __forceinline__ ssq_t ssq_fix(float v) { return (ssq_t)(v * 16777216.f + 0.5f); }
__device__ __forceinline__ float ssq_val(ssq_t v) { return (float)v * (1.f / 16777216.f); }
__device__ __forceinline__ void atomic_addf(ssq_t* p, float v) { __hip_atomic_fetch_add(p, ssq_fix(v), __ATOMIC_RELAXED, __HIP_MEMORY_SCOPE_AGENT); }

namespace pg8 {
constexpr int BM = 256, BK = 64, HALF = 128, HTB = HALF * BK * 2, NXCD = 8, WGM = 8;
__host__ __device__ __forceinline__ int lds_byte(int r, int c) { const int st = (r >> 4) * 2 + (c >> 5), rr = r & 15, cc = c & 31, ob = rr * 64 + cc * 2; return st * 1024 + (ob ^ (((ob >> 9) & 1) << 5)); }
__host__ __device__ __forceinline__ void stage_rc(int b, int& R, int& C) { const int st = b / 1024, sb = b % 1024, swz = sb ^ (((sb >> 9) & 1) << 5); R = (st >> 1) * 16 + swz / 64; C = (st & 1) * 32 + (swz % 64) / 2; }
__host__ __device__ __forceinline__ int perm32(int rho) { const int n = rho >> 4, i = rho & 15; return 8 * (i >> 2) + 4 * n + (i & 3); }
}
enum { E_BF16 = 0, E_INPROJ = 1, E_RESID = 2, E_SOFTMAX = 3 };
struct GemmDesc {
    const char* A; const char* B; int lda, ldb, K, nM, nN, nZ;
    int azs, bzs, bbs, tpb;
    int epi, perm;
    bf16_t* out; long ozs; int ldo;
    const ssq_t* ssq_in; float inv_dim; int relu2;
    ssq_t* ssq_out; ssq_t* ssq_out2;
    const float* resid; float* xout; bf16_t* xb;
    bf16_t* out2; bf16_t* out3;
};
struct Unit { int pm, pn, z; const char* a; const char* b; };

__device__ __forceinline__ bool make_gemm(const Params& p, int tr, int l, int k, int i, GemmDesc& g);
__device__ __forceinline__ const Params* launder_p(const Params* q) { asm volatile("" : "+s"(q)); return q; }
__device__ __forceinline__ int launder_i(int v) { asm volatile("" : "+s"(v)); return v; }
__device__ __forceinline__ bool next_unit(const Params* kp, int tr, int l, int k, int gi, int i, int G, int c, Unit& u) {
    GemmDesc g; make_gemm(*launder_p(kp), launder_i(tr), launder_i(l), launder_i(k), launder_i(gi), g);
    const int L = i * G + c; const int per = g.nM * g.nN;
    if (L >= per * g.nZ) return false;
    const int z = L / per; int wgid = L - z * per;
    { const int q = per / pg8::NXCD, r = per % pg8::NXCD, xcd = wgid % pg8::NXCD, off = wgid / pg8::NXCD; wgid = (xcd < r ? xcd * (q + 1) : r * (q + 1) + (xcd - r) * q) + off; }
    const int nig = pg8::WGM * g.nN, gid = wgid / nig, fm = gid * pg8::WGM, gsz = (g.nM - fm) < pg8::WGM ? (g.nM - fm) : pg8::WGM;
    u.pm = fm + ((wgid % nig) % gsz); u.pn = (wgid % nig) / gsz; u.z = z;
    const unsigned ao = (unsigned)z * (unsigned)g.azs + (unsigned)u.pm * (unsigned)(512 * g.lda);
    const unsigned bo = (unsigned)z * (unsigned)g.bzs + (unsigned)u.pn * (unsigned)(512 * g.ldb) + (g.tpb ? (unsigned)(u.pm / g.tpb) * (unsigned)g.bbs : 0u);
    u.a = g.A + (size_t)ao; u.b = g.B + (size_t)bo;
    return true;
}

template <int EPI> __device__ __forceinline__ void gemm_epilogue(const Params* kp, int tr, int l, int k, int gi, f32x4 (&acc)[2][2][4][2], const Unit& u, LAS unsigned char* lds) {
    const int tid_e = ltid(), wid_e = tid_e >> 6, lane_e = tid_e & 63, wr = wid_e >> 2, wc = wid_e & 3, fr = lane_e & 15, fq = lane_e >> 4;
    GemmDesc g; make_gemm(*launder_p(kp), launder_i(tr), launder_i(l), launder_i(k), launder_i(gi), g);
    const int row0 = u.pm * 256 + wr * 64 + fr;
    if constexpr (EPI == E_BF16) {
        const int col0 = u.pn * 256 + wc * 32 + 8 * fq;
        float rsv[2][4];
#pragma unroll
        for (int ai = 0; ai < 2; ++ai)
#pragma unroll
            for (int m = 0; m < 4; ++m) rsv[ai][m] = g.ssq_in ? __builtin_amdgcn_rsqf(ssq_val(g.ssq_in[row0 + ai * 128 + m * 16]) * g.inv_dim + EPS) : 1.0f;
#pragma unroll
        for (int ai = 0; ai < 2; ++ai)
#pragma unroll
            for (int m = 0; m < 4; ++m) {
                const int row = row0 + ai * 128 + m * 16;
                const float rs = rsv[ai][m];
                bf16_t* rowp = g.out + (long)u.z * g.ozs + (long)row * g.ldo + col0;
#pragma unroll
                for (int bj = 0; bj < 2; ++bj) {
                    f32x4 v0 = acc[ai][bj][m][0] * rs, v1 = acc[ai][bj][m][1] * rs;
                    if (g.relu2) {
#pragma unroll
                        for (int j = 0; j < 4; ++j) { float a = fmaxf(v0[j], 0.f), b = fmaxf(v1[j], 0.f); v0[j] = a * a; v1[j] = b * b; }
                    }
                    u32x4 w; w.x = cvtpk(v0[0], v0[1]); w.y = cvtpk(v0[2], v0[3]); w.z = cvtpk(v1[0], v1[1]); w.w = cvtpk(v1[2], v1[3]);
                    *(u32x4*)(rowp + bj * 128) = w;
                }
            }
    } else if constexpr (EPI == E_INPROJ) {
        const int lc0 = wc * 32 + 8 * fq;
        const int pn = u.pn;
        const int hseg = (pn >= 4) ? ((pn - 4) >> 2) : 9;
        f32x4 lbv[2][2];
        if (hseg == 1 || hseg == 2) {
            const float* lbt = (const float*)(kp->ws + OFF_LB) + (hseg - 1) * 1024 + ((pn - 4) & 3) * 256 + lc0;
#pragma unroll
            for (int bj = 0; bj < 2; ++bj) { lbv[bj][0] = *(const f32x4*)(lbt + bj * 128); lbv[bj][1] = *(const f32x4*)(lbt + bj * 128 + 4); }
        } else {
#pragma unroll
            for (int bj = 0; bj < 2; ++bj) { lbv[bj][0] = (f32x4){0.f, 0.f, 0.f, 0.f}; lbv[bj][1] = lbv[bj][0]; }
        }
        float rsv[2][4];
#pragma unroll
        for (int ai = 0; ai < 2; ++ai)
#pragma unroll
            for (int m = 0; m < 4; ++m) rsv[ai][m] = __builtin_amdgcn_rsqf(ssq_val(g.ssq_in[row0 + ai * 128 + m * 16]) * g.inv_dim + EPS);
#pragma unroll
        for (int ai = 0; ai < 2; ++ai)
#pragma unroll
            for (int m = 0; m < 4; ++m) {
                const int row = row0 + ai * 128 + m * 16;
                const float rs = rsv[ai][m];
                float ss = 0.f;
#pragma unroll
                for (int bj = 0; bj < 2; ++bj) {
                    f32x4 v0 = acc[ai][bj][m][0] * rs, v1 = acc[ai][bj][m][1] * rs;
                    if (hseg == 0) {
#pragma unroll
                        for (int j = 0; j < 4; ++j) { v0[j] = v0[j] * __builtin_amdgcn_rcpf(1.f + __expf(-v0[j])) * 0.08838834764831845f; v1[j] = v1[j] * __builtin_amdgcn_rcpf(1.f + __expf(-v1[j])) * 0.08838834764831845f; }
                    } else if (hseg == 1 || hseg == 2) {
#pragma unroll
                        for (int j = 0; j < 4; ++j) {
                            const float l0 = lbv[bj][0][j], l1 = lbv[bj][1][j];
                            v0[j] = __logf(l0 + (1.f - l0) * __builtin_amdgcn_rcpf(1.f + __expf(-fmaxf(v0[j], -80.f))));
                            v1[j] = __logf(l1 + (1.f - l1) * __builtin_amdgcn_rcpf(1.f + __expf(-fmaxf(v1[j], -80.f))));
                        }
                    }
                    u32x4 w; w.x = cvtpk(v0[0], v0[1]); w.y = cvtpk(v0[2], v0[3]); w.z = cvtpk(v1[0], v1[1]); w.w = cvtpk(v1[2], v1[3]);
                    const int lc = lc0 + bj * 128;
                    if (pn < 3) {
                        *(u32x4*)(g.out + (long)row * 768 + pn * 256 + lc) = w;
                        ss += (v0[0] * v0[0] + v0[1] * v0[1]) + (v0[2] * v0[2] + v0[3] * v0[3]) + (v1[0] * v1[0] + v1[1] * v1[1]) + (v1[2] * v1[2] + v1[3] * v1[3]);
                    } else if (pn == 3) {
                        if (lc < 64) *(u32x4*)(g.out2 + (long)row * 64 + lc) = w;
                    } else {
                        *(u32x4*)(g.out3 + (long)row * HGW + (pn - 4) * 256 + lc) = w;
                    }
                }
                if (pn < 3) {
                    ss += __shfl_xor(ss, 16); ss += __shfl_xor(ss, 32);
                    if (fq == 0) atomic_addf((pn < 2 ? g.ssq_out : g.ssq_out2) + row, ss);
                }
            }
    } else if constexpr (EPI == E_RESID) {
        const int col0 = u.pn * 256 + wc * 32 + 8 * fq;
#pragma unroll
        for (int ai = 0; ai < 2; ++ai) {
            f32x4 rv[4][2][2];
#pragma unroll
            for (int m = 0; m < 4; ++m)
#pragma unroll
                for (int bj = 0; bj < 2; ++bj)
#pragma unroll
                    for (int n = 0; n < 2; ++n) rv[m][bj][n] = *(const f32x4*)(g.resid + (long)(row0 + ai * 128 + m * 16) * DM + col0 + bj * 128 + n * 4);
#pragma unroll
            for (int m = 0; m < 4; ++m) {
                const int row = row0 + ai * 128 + m * 16;
                float ss = 0.f;
#pragma unroll
                for (int bj = 0; bj < 2; ++bj) {
                    const long o = (long)row * DM + col0 + bj * 128;
                    const f32x4 v0 = rv[m][bj][0] + acc[ai][bj][m][0], v1 = rv[m][bj][1] + acc[ai][bj][m][1];
                    *(f32x4*)(g.xout + o) = v0; *(f32x4*)(g.xout + o + 4) = v1;
                    u32x4 w; w.x = cvtpk(v0[0], v0[1]); w.y = cvtpk(v0[2], v0[3]); w.z = cvtpk(v1[0], v1[1]); w.w = cvtpk(v1[2], v1[3]);
                    *(u32x4*)(g.xb + o) = w;
                    ss += (v0[0] * v0[0] + v0[1] * v0[1]) + (v0[2] * v0[2] + v0[3] * v0[3]) + (v1[0] * v1[0] + v1[1] * v1[1]) + (v1[2] * v1[2] + v1[3] * v1[3]);
                }
                ss += __shfl_xor(ss, 16); ss += __shfl_xor(ss, 32);
                if (fq == 0) atomic_addf(g.ssq_out + row, ss);
            }
        }
    } else {
        LAS float* smax = (LAS float*)(lds + LDS_EPI);
        LAS float* ssum = (LAS float*)(lds + LDS_EPI + 4096);
        const float C = 0.044194173824159216f * 1.4426950408889634f;
#pragma unroll
        for (int ai = 0; ai < 2; ++ai)
#pragma unroll
            for (int m = 0; m < 4; ++m) {
                __builtin_amdgcn_sched_barrier(0);
                float t = -3.0e38f;
#pragma unroll
                for (int bj = 0; bj < 2; ++bj)
#pragma unroll
                    for (int n = 0; n < 2; ++n)
#pragma unroll
                        for (int j = 0; j < 4; ++j) t = fmaxf(t, acc[ai][bj][m][n][j]);
                t = fmaxf(t, __shfl_xor(t, 16)); t = fmaxf(t, __shfl_xor(t, 32));
                if (fq == 0) smax[(ai * 128 + wr * 64 + m * 16 + fr) * 4 + wc] = t;
            }
        asm volatile("s_waitcnt lgkmcnt(0)" ::: "memory"); __builtin_amdgcn_s_barrier(); asm volatile("" ::: "memory");
#pragma unroll
        for (int ai = 0; ai < 2; ++ai)
#pragma unroll
            for (int m = 0; m < 4; ++m) {
                __builtin_amdgcn_sched_barrier(0);
                const int rl = ai * 128 + wr * 64 + m * 16 + fr;
                const f32x4 q = *(LAS f32x4*)(smax + rl * 4);
                const float mm = fmaxf(fmaxf(q[0], q[1]), fmaxf(q[2], q[3])) * C;
                float s = 0.f;
#pragma unroll
                for (int bj = 0; bj < 2; ++bj)
#pragma unroll
                    for (int n = 0; n < 2; ++n)
#pragma unroll
                        for (int j = 0; j < 4; ++j) { const float e = __builtin_amdgcn_exp2f(acc[ai][bj][m][n][j] * C - mm); acc[ai][bj][m][n][j] = e; s += e; }
                s += __shfl_xor(s, 16); s += __shfl_xor(s, 32);
                if (fq == 0) ssum[rl * 4 + wc] = s;
            }
        asm volatile("s_waitcnt lgkmcnt(0)" ::: "memory"); __builtin_amdgcn_s_barrier(); asm volatile("" ::: "memory");
        const int col0 = wc * 32 + 8 * fq;
#pragma unroll
        for (int ai = 0; ai < 2; ++ai)
#pragma unroll
            for (int m = 0; m < 4; ++m) {
                __builtin_amdgcn_sched_barrier(0);
                const int rl = ai * 128 + wr * 64 + m * 16 + fr;
                const f32x4 q = *(LAS f32x4*)(ssum + rl * 4);
                const float inv = 1.0f / ((q[0] + q[1]) + (q[2] + q[3]));
                bf16_t* rowp = g.out + (long)(u.pm * 256 + rl) * g.ldo + u.z * 256 + col0;
#pragma unroll
                for (int bj = 0; bj < 2; ++bj) {
                    const f32x4 v0 = acc[ai][bj][m][0] * inv, v1 = acc[ai][bj][m][1] * inv;
                    u32x4 w; w.x = cvtpk(v0[0], v0[1]); w.y = cvtpk(v0[2], v0[3]); w.z = cvtpk(v1[0], v1[1]); w.w = cvtpk(v1[2], v1[3]);
                    *(u32x4*)(rowp + bj * 128) = w;
                }
            }
    }
}

template <int EPI> __device__ __forceinline__ void gemm_phase(LAS unsigned char* lds, const Params* kp, int tr, int l, int k, int gi, int G, int cblk) {
    using namespace pg8;
    int Kdim, lda_, ldb_, perm_;
    { GemmDesc g0; if (!make_gemm(*kp, tr, l, k, gi, g0)) return; Kdim = g0.K; lda_ = g0.lda; ldb_ = g0.ldb; perm_ = g0.perm; }
    const int tid = ltid(), wid = __builtin_amdgcn_readfirstlane(tid >> 6), lane = tid & 63, wr = wid >> 2, wc = wid & 3, fr = lane & 15, fq = lane >> 4;
    const int K = Kdim, nt = K / BK;
    unsigned voffA[2], voffB[2];
#pragma unroll
    for (int i = 0; i < 2; ++i) { int R, C; stage_rc(tid * 16 + i * 8192, R, C); const int Rb = perm_ ? ((R & ~31) + perm32(R & 31)) : R;
        voffA[i] = (unsigned)(R * lda_ + C) * 2u; voffB[i] = (unsigned)(Rb * ldb_ + C) * 2u; }
    const size_t kstep = (size_t)(BK * 2);
    const size_t hstepA = (size_t)HALF * lda_ * 2, hstepB = (size_t)HALF * ldb_ * 2;
    const unsigned ldsw = (unsigned)wid * 1024u;
    const int aoff = lds_byte(wr * 64 + fr, fq * 8), boff = lds_byte(wc * 32 + fr, fq * 8);
#define PG8_SA(b, h) (((b) * 2 + (h)) * HTB)
#define PG8_SB(b, h) ((4 + (b) * 2 + (h)) * HTB)
#define PG8_STAGE(bufoff, gbase, voff) do { _Pragma("unroll") for (int _i = 0; _i < 2; ++_i) \
        __builtin_amdgcn_global_load_lds((const unsigned*)((const char*)(gbase) + (voff)[_i]), (LAS unsigned*)(lds + (bufoff) + ldsw + _i * 8192), 16, 0, 0); } while (0)
#define PG8_LDA(dst, b, h) do { _Pragma("unroll") for (int m = 0; m < 4; ++m) _Pragma("unroll") for (int k = 0; k < 2; ++k) dst[m][k] = *(const LAS bf16x8*)(lds + PG8_SA(b, h) + aoff + m * 2048 + k * 1024); } while (0)
#define PG8_LDB(dst, b, h) do { _Pragma("unroll") for (int n = 0; n < 2; ++n) _Pragma("unroll") for (int k = 0; k < 2; ++k) dst[n][k] = *(const LAS bf16x8*)(lds + PG8_SB(b, h) + boff + n * 2048 + k * 1024); } while (0)
#define PG8_MMA(ai, bj, At, Bt) do { __builtin_amdgcn_s_setprio(1); _Pragma("unroll") for (int m = 0; m < 4; ++m) _Pragma("unroll") for (int n = 0; n < 2; ++n) _Pragma("unroll") for (int k = 0; k < 2; ++k) \
        acc[ai][bj][m][n] = __builtin_amdgcn_mfma_f32_16x16x32_bf16(Bt[n][k], At[m][k], acc[ai][bj][m][n], 0, 0, 0); __builtin_amdgcn_s_setprio(0); } while (0)
#define PG8_WAIT_V(n) asm volatile("s_waitcnt vmcnt(" #n ")" ::: "memory")
#define PG8_WAIT_L(n) asm volatile("s_waitcnt lgkmcnt(" #n ")" ::: "memory")
#define PG8_BAR __builtin_amdgcn_s_barrier()
#define PG8_SCHED __builtin_amdgcn_sched_barrier(0)
    Unit cur, nxt; int ui = 0;
    if (!next_unit(kp, tr, l, k, gi, 0, G, cblk, cur)) return;
    f32x4 acc[2][2][4][2];
#pragma unroll
    for (int a = 0; a < 2; ++a)
#pragma unroll
        for (int b = 0; b < 2; ++b)
#pragma unroll
            for (int m = 0; m < 4; ++m)
#pragma unroll
                for (int n = 0; n < 2; ++n) acc[a][b][m][n] = (f32x4){0.f, 0.f, 0.f, 0.f};
    bf16x8 At[4][2], B0[2][2], B1[2][2];
    const char* cA = cur.a; const char* cB = cur.b;
    PG8_STAGE(PG8_SB(0, 0), cB, voffB); PG8_STAGE(PG8_SA(0, 0), cA, voffA); PG8_STAGE(PG8_SB(0, 1), cB + hstepB, voffB); PG8_STAGE(PG8_SA(0, 1), cA + hstepA, voffA);
    if (wr == 1) PG8_BAR;
    PG8_WAIT_V(4); PG8_BAR;
    PG8_STAGE(PG8_SB(1, 0), cB + kstep, voffB); PG8_STAGE(PG8_SA(1, 0), cA + kstep, voffA); PG8_STAGE(PG8_SB(1, 1), cB + hstepB + kstep, voffB);
    PG8_WAIT_V(6); PG8_BAR;
    for (;;) {
        const bool has_next = next_unit(kp, tr, l, k, gi, ui + 1, G, cblk, nxt);
        const char* nA = has_next ? nxt.a : cA; const char* nB = has_next ? nxt.b : cB;
        for (int t = 0; t < nt; t += 2) {
            const bool last = (t == nt - 2);
            const char* a1 = cA + (size_t)(t + 1) * kstep;
            const char* a2 = last ? nA : cA + (size_t)(t + 2) * kstep; const char* b2 = last ? nB : cB + (size_t)(t + 2) * kstep;
            const char* a3 = a2 + kstep; const char* b3 = b2 + kstep;
            PG8_LDB(B0, 0, 0); PG8_SCHED; PG8_LDA(At, 0, 0); PG8_STAGE(PG8_SA(1, 1), a1 + hstepA, voffA);
            PG8_WAIT_L(8); PG8_BAR; PG8_WAIT_L(0); PG8_MMA(0, 0, At, B0); PG8_BAR; PG8_SCHED;
            PG8_LDB(B1, 0, 1); PG8_STAGE(PG8_SB(0, 0), b2, voffB);
            PG8_BAR; PG8_WAIT_L(0); PG8_MMA(0, 1, At, B1); PG8_BAR;
            PG8_LDA(At, 0, 1); PG8_STAGE(PG8_SA(0, 0), a2, voffA);
            PG8_BAR; PG8_WAIT_L(0); PG8_MMA(1, 0, At, B0); PG8_BAR; PG8_SCHED;
            PG8_STAGE(PG8_SB(0, 1), b2 + hstepB, voffB);
            PG8_WAIT_V(6); PG8_BAR; PG8_MMA(1, 1, At, B1); PG8_BAR;
            PG8_LDB(B0, 1, 0); PG8_SCHED; PG8_LDA(At, 1, 0); PG8_STAGE(PG8_SA(0, 1), a2 + hstepA, voffA);
            PG8_WAIT_L(8); PG8_BAR; PG8_WAIT_L(0); PG8_MMA(0, 0, At, B0); PG8_BAR; PG8_SCHED;
            PG8_LDB(B1, 1, 1); PG8_STAGE(PG8_SB(1, 0), b3, voffB);
            PG8_BAR; PG8_WAIT_L(0); PG8_MMA(0, 1, At, B1); PG8_BAR;
            PG8_LDA(At, 1, 1); PG8_STAGE(PG8_SA(1, 0), a3, voffA);
            PG8_BAR; PG8_WAIT_L(0); PG8_MMA(1, 0, At, B0); PG8_BAR; PG8_SCHED;
            PG8_STAGE(PG8_SB(1, 1), b3 + hstepB, voffB);
            PG8_WAIT_V(6); PG8_BAR; PG8_MMA(1, 1, At, B1); PG8_BAR;
        }
        gemm_epilogue<EPI>(kp, tr, l, k, gi, acc, cur, lds);
        if (!has_next) break;
#pragma unroll
        for (int a = 0; a < 2; ++a)
#pragma unroll
            for (int b = 0; b < 2; ++b)
#pragma unroll
                for (int m = 0; m < 4; ++m)
#pragma unroll
                    for (int n = 0; n < 2; ++n) acc[a][b][m][n] = (f32x4){0.f, 0.f, 0.f, 0.f};
        cur = nxt; cA = nA; cB = nB; ++ui;
    }
    PG8_WAIT_V(0);
    if (wr == 0) PG8_BAR;
    PG8_BAR;
#undef PG8_SA
#undef PG8_SB
#undef PG8_STAGE
#undef PG8_LDA
#undef PG8_LDB
#undef PG8_MMA
#undef PG8_WAIT_V
#undef PG8_WAIT_L
#undef PG8_BAR
#undef PG8_SCHED
}

namespace att {
constexpr int NW = 8, QBLK = 32, KVBLK = 64;
constexpr float SCALE = 0.07216878364870322f;
constexpr float THR = 8.f;
constexpr int LDQ = 1536, LDK = 2048, LDKR = 64, LDO = 2048;
constexpr int SHM_V = KVBLK * 128 * 2, SHM_K = KVBLK * 128 * 2, SHM_KR = KVBLK * 64 * 2;
#define KSWZ(row, colB) ((row) * 256 + ((colB) ^ (((row) & 7) << 4)))
#define KRSWZ(row, colB) ((row) * 128 + ((colB) ^ (((row) & 7) << 4)))
#define SBAR() __builtin_amdgcn_sched_barrier(0)
__device__ __forceinline__ int crow(int r, int hi) { return (r & 3) + 8 * (r >> 2) + 4 * hi; }
__device__ __forceinline__ void partialSM(f32x16& p0, f32x16& p1, float& m_reg, float& mn, float& alpha) {
    constexpr float C = SCALE * 1.4426950408889634f;
    float pmax = p0[0];
#pragma unroll
    for (int r = 1; r < 16; ++r) pmax = fmaxf(pmax, p0[r]);
#pragma unroll
    for (int r = 0; r < 16; ++r) pmax = fmaxf(pmax, p1[r]);
    { auto rr = __builtin_amdgcn_permlane32_swap(__float_as_uint(pmax), __float_as_uint(pmax), false, false);
      pmax = fmaxf(__uint_as_float(rr[0]), __uint_as_float(rr[1])); }
    if (__builtin_expect(__all(pmax - m_reg <= THR / SCALE), 1)) { mn = m_reg; alpha = 1.f; }
    else { mn = fmaxf(m_reg, pmax); alpha = __builtin_amdgcn_exp2f((m_reg - mn) * C); m_reg = mn; }
    float mnC = -mn * C;
#pragma unroll
    for (int r = 0; r < 16; ++r) p0[r] = fmaf(p0[r], C, mnC);
#pragma unroll
    for (int r = 0; r < 16; ++r) p1[r] = fmaf(p1[r], C, mnC);
#pragma unroll
    for (int r = 0; r < 16; ++r) p0[r] = __builtin_amdgcn_exp2f(p0[r]);
}
__device__ __forceinline__ void finishSM(f32x16& p0, f32x16& p1, float alpha, float& l_reg, bf16x8& pa0, bf16x8& pa1, bf16x8& pa2, bf16x8& pa3) {
#pragma unroll
    for (int r = 0; r < 16; ++r) p1[r] = __builtin_amdgcn_exp2f(p1[r]);
    float ps = 0;
#pragma unroll
    for (int r = 0; r < 16; ++r) ps += p0[r];
#pragma unroll
    for (int r = 0; r < 16; ++r) ps += p1[r];
    { auto rr = __builtin_amdgcn_permlane32_swap(__float_as_uint(ps), __float_as_uint(ps), false, false);
      ps = __uint_as_float(rr[0]) + __uint_as_float(rr[1]); }
    l_reg = l_reg * alpha + ps;
#define PK4(P, BASE, OUT) do { unsigned a0 = cvtpk(P[BASE + 0], P[BASE + 1]), a1 = cvtpk(P[BASE + 2], P[BASE + 3]);   \
    unsigned b0 = cvtpk(P[BASE + 4], P[BASE + 5]), b1 = cvtpk(P[BASE + 6], P[BASE + 7]);                              \
    auto r0 = __builtin_amdgcn_permlane32_swap(a0, b0, false, false); auto r1 = __builtin_amdgcn_permlane32_swap(a1, b1, false, false); \
    u32x4 w = {r0[0], r1[0], r0[1], r1[1]}; OUT = *reinterpret_cast<bf16x8*>(&w); } while (0)
    PK4(p0, 0, pa0); PK4(p0, 8, pa1); PK4(p1, 0, pa2); PK4(p1, 8, pa3);
#undef PK4
}
__device__ __forceinline__ void qkt(f32x16& p0, f32x16& p1, const char* Ks, const char* Krs, const bf16x8* qr, const char* qrl, int r32, int hi) {
    p0 = f32x16{}; p1 = f32x16{};
#pragma unroll
    for (int d0 = 0; d0 < 8; ++d0) { int cb = (d0 * 16 + hi * 8) * 2;
        bf16x8 b0 = *reinterpret_cast<const bf16x8*>(Ks + KSWZ(r32, cb));
        bf16x8 b1 = *reinterpret_cast<const bf16x8*>(Ks + KSWZ(32 + r32, cb));
        p0 = __builtin_amdgcn_mfma_f32_32x32x16_bf16(b0, qr[d0], p0, 0, 0, 0);
        p1 = __builtin_amdgcn_mfma_f32_32x32x16_bf16(b1, qr[d0], p1, 0, 0, 0); }
#pragma unroll
    for (int d0 = 0; d0 < 4; ++d0) { int cb = (d0 * 16 + hi * 8) * 2;
        bf16x8 b0 = *reinterpret_cast<const bf16x8*>(Krs + KRSWZ(r32, cb));
        bf16x8 b1 = *reinterpret_cast<const bf16x8*>(Krs + KRSWZ(32 + r32, cb));
        const bf16x8 qv = *reinterpret_cast<const bf16x8*>(qrl + d0 * 8192);
        p0 = __builtin_amdgcn_mfma_f32_32x32x16_bf16(b0, qv, p0, 0, 0, 0);
        p1 = __builtin_amdgcn_mfma_f32_32x32x16_bf16(b1, qv, p1, 0, 0, 0); }
}
__device__ __forceinline__ int v_st(int k, int c) { const int kk = (k & ~0xC) | ((k & 4) << 1) | ((k & 8) >> 1); return ((kk >> 3) * 4 + (c >> 5)) * 512 + ((kk & 7) * 32 + (c & 31)) * 2; }
__device__ __forceinline__ int v_rd_base(int lane) { return ((lane & 3) << 3) | (((lane >> 2) & 3) << 6) | (((lane >> 4) & 1) << 5) | (((lane >> 5) & 1) << 8); }
constexpr int v_rd_off(int d0, int ks, int half) { return d0 * 512 + ks * 4096 + half * 2048; }
template <int OFF> __device__ __forceinline__ s16x4 tr_read(int vb) {
    s16x4 r; asm volatile("ds_read_b64_tr_b16 %0, %1 offset:%2" : "=&v"(r) : "v"(vb), "i"(OFF) : "memory"); return r;
}
template <int D0> __device__ __forceinline__ void pv_one(f32x16& od, int vb, bf16x8 pa0, bf16x8 pa1, bf16x8 pa2, bf16x8 pa3) {
    const s16x4 l0 = tr_read<v_rd_off(D0, 0, 0)>(vb), h0 = tr_read<v_rd_off(D0, 0, 1)>(vb), l1 = tr_read<v_rd_off(D0, 1, 0)>(vb), h1 = tr_read<v_rd_off(D0, 1, 1)>(vb);
    const s16x4 l2 = tr_read<v_rd_off(D0, 2, 0)>(vb), h2 = tr_read<v_rd_off(D0, 2, 1)>(vb), l3 = tr_read<v_rd_off(D0, 3, 0)>(vb), h3 = tr_read<v_rd_off(D0, 3, 1)>(vb);
    asm volatile("s_waitcnt lgkmcnt(0)" ::: "memory"); SBAR();
#define PK(L, H) (bf16x8){L[0], L[1], L[2], L[3], H[0], H[1], H[2], H[3]}
    od = __builtin_amdgcn_mfma_f32_32x32x16_bf16(pa0, PK(l0, h0), od, 0, 0, 0);
    od = __builtin_amdgcn_mfma_f32_32x32x16_bf16(pa1, PK(l1, h1), od, 0, 0, 0);
    od = __builtin_amdgcn_mfma_f32_32x32x16_bf16(pa2, PK(l2, h2), od, 0, 0, 0);
    od = __builtin_amdgcn_mfma_f32_32x32x16_bf16(pa3, PK(l3, h3), od, 0, 0, 0);
#undef PK
}
__device__ __forceinline__ void pv_d0(f32x16* o, int vb, bf16x8 pa0, bf16x8 pa1, bf16x8 pa2, bf16x8 pa3) {
    pv_one<0>(o[0], vb, pa0, pa1, pa2, pa3); pv_one<1>(o[1], vb, pa0, pa1, pa2, pa3); pv_one<2>(o[2], vb, pa0, pa1, pa2, pa3); pv_one<3>(o[3], vb, pa0, pa1, pa2, pa3);
}

__device__ __forceinline__ void attn_body(const bf16_t* __restrict__ Qb, const bf16_t* __restrict__ Kh, const bf16_t* __restrict__ Kr,
                                          bf16_t* __restrict__ Ob, int ml_off, int seq, char* lds) {
    const int tid = ltid(), wid = tid >> 6, lane = tid & 63, r32 = lane & 31, hi = lane >> 5;
    char* V_lds = lds; char* K_lds = lds + 2 * SHM_V; char* KR_lds = lds + 2 * SHM_V + 2 * SHM_K;
    float* ws = (float*)(lds + 2 * SHM_V + 2 * SHM_K + 2 * SHM_KR) + wid * 64; float* li_l = ws; float* al_l = ws + 32;
    float m_reg = -1e30f, l_reg = 0; f32x16 o[4] = {}; bf16x8 qr[8];
    const bf16_t* Qw = Qb + (long)(wid * QBLK + r32) * LDQ + hi * 8;
#pragma unroll
    for (int d0 = 0; d0 < 8; ++d0) qr[d0] = *reinterpret_cast<const bf16x8*>(Qw + d0 * 16);
    char* qrl = lds + 84 * 1024 + tid * 16;
#pragma unroll
    for (int d0 = 0; d0 < 4; ++d0) *reinterpret_cast<bf16x8*>(qrl + d0 * 8192) = *reinterpret_cast<const bf16x8*>(Qw + (8 + d0) * 16);
    const int sr = tid >> 4, sc = (tid & 15) * 8, vst0 = v_st(sr, sc), vst1 = v_st(32 + sr, sc);
    const int krr = tid >> 3, krc = (tid & 7) * 8;
    const int vb0 = (int)(uintptr_t)V_lds + v_rd_base(lane);
    bf16x8 s_vs0, s_vs1, s_ks0, s_ks1, s_kr;
#define SLOAD(k0) do { s_vs0 = *reinterpret_cast<const bf16x8*>(&Kh[(long)((k0) + sr) * LDK + sc + 128]); s_vs1 = *reinterpret_cast<const bf16x8*>(&Kh[(long)((k0) + 32 + sr) * LDK + sc + 128]); \
    s_ks0 = *reinterpret_cast<const bf16x8*>(&Kh[(long)((k0) + sr) * LDK + sc]); s_ks1 = *reinterpret_cast<const bf16x8*>(&Kh[(long)((k0) + 32 + sr) * LDK + sc]); \
    s_kr = *reinterpret_cast<const bf16x8*>(&Kr[(long)((k0) + krr) * LDKR + krc]); } while (0)
#define SWRITE(b) do { *(bf16x8*)(V_lds + (b) * SHM_V + vst0) = s_vs0; *(bf16x8*)(V_lds + (b) * SHM_V + vst1) = s_vs1; int kc = sc * 2;   \
    *(bf16x8*)(K_lds + (b) * SHM_K + KSWZ(sr, kc)) = s_ks0; *(bf16x8*)(K_lds + (b) * SHM_K + KSWZ(32 + sr, kc)) = s_ks1;                  \
    *(bf16x8*)(KR_lds + (b) * SHM_KR + KRSWZ(krr, krc * 2)) = s_kr; } while (0)
#define SWAIT() asm volatile("s_waitcnt vmcnt(0)" ::: "memory")
#define RESC(a) do { if (__any((a) < 1.f)) { if (hi == 0) al_l[r32] = (a); asm volatile("s_waitcnt lgkmcnt(0)" ::: "memory"); \
    _Pragma("unroll") for (int d = 0; d < 4; ++d) _Pragma("unroll") for (int r = 0; r < 16; ++r) o[d][r] *= al_l[crow(r, hi)]; } } while (0)
    f32x16 pA0, pA1, pB0, pB1; float mnA, mnB, alA, alB; bf16x8 pa0, pa1, pa2, pa3; const int NT = seq / KVBLK;
    SLOAD(0); SWAIT(); SWRITE(0); __syncthreads();
    qkt(pA0, pA1, K_lds, KR_lds, qr, qrl, r32, hi); partialSM(pA0, pA1, m_reg, mnA, alA);
    SLOAD(KVBLK);
    SWAIT(); SWRITE(1); __syncthreads();
    for (int j = 1; j + 1 < NT; j += 2) {
        SBAR(); qkt(pB0, pB1, K_lds + SHM_K, KR_lds + SHM_KR, qr, qrl, r32, hi);
        finishSM(pA0, pA1, alA, l_reg, pa0, pa1, pa2, pa3); SBAR();
        SLOAD((j + 1) * KVBLK); SBAR();
        pv_d0(o, vb0, pa0, pa1, pa2, pa3); partialSM(pB0, pB1, m_reg, mnB, alB);
        __syncthreads(); SWAIT(); SWRITE(0);
        RESC(alB); __syncthreads();
        SBAR(); qkt(pA0, pA1, K_lds, KR_lds, qr, qrl, r32, hi);
        finishSM(pB0, pB1, alB, l_reg, pa0, pa1, pa2, pa3); SBAR();
        SLOAD((j + 2) * KVBLK); SBAR();
        pv_d0(o, vb0 + (int)SHM_V, pa0, pa1, pa2, pa3); partialSM(pA0, pA1, m_reg, mnA, alA);
        __syncthreads(); SWAIT(); SWRITE(1);
        RESC(alA); __syncthreads();
    }
    SBAR(); qkt(pB0, pB1, K_lds + SHM_K, KR_lds + SHM_KR, qr, qrl, r32, hi);
    finishSM(pA0, pA1, alA, l_reg, pa0, pa1, pa2, pa3); SBAR();
    pv_d0(o, vb0, pa0, pa1, pa2, pa3); partialSM(pB0, pB1, m_reg, mnB, alB);
    __syncthreads(); RESC(alB);
    finishSM(pB0, pB1, alB, l_reg, pa0, pa1, pa2, pa3); SBAR();
    pv_d0(o, vb0 + (int)SHM_V, pa0, pa1, pa2, pa3);
    if (hi == 0) li_l[r32] = l_reg; asm volatile("s_waitcnt lgkmcnt(0)" ::: "memory");
    if (ml_off >= 0 && hi == 0) {
        const Params* kpa = (const Params*)__builtin_amdgcn_kernarg_segment_ptr(); asm volatile("" : "+s"(kpa));
        float* d = (float*)(kpa->ws + OFF_XB + 2048) + ml_off + (wid * QBLK + r32) * 1024; d[0] = m_reg; d[1] = l_reg; }
    float rli[16];
#pragma unroll
    for (int r = 0; r < 16; ++r) rli[r] = __builtin_amdgcn_rcpf(li_l[crow(r, hi)]);
    bf16_t* Ow = Ob + (long)(wid * QBLK) * LDO;
#pragma unroll
    for (int r = 0; r < 16; ++r) { int orow = crow(r, hi);
#pragma unroll
        for (int d0 = 0; d0 < 4; ++d0) Ow[(long)orow * LDO + d0 * 32 + r32] = f2bf(o[d0][r] * rli[r]); }
    __syncthreads();
#undef SLOAD
#undef SWRITE
#undef SWAIT
#undef RESC
}
}

namespace hg {
constexpr int LD = 136, LDT = 72;
constexpr int O_RZ = 0, O_RQ = O_RZ + 64 * LD * 2, O_RV = O_RQ + 64 * LD * 2, O_QD = O_RV + 64 * LD * 2, O_KD = O_QD + 64 * LD * 2,
              O_KDT = O_KD + 64 * LD * 2, O_VT = O_KDT + 128 * LDT * 2, O_P = O_VT + 128 * LDT * 2, O_SEG = O_P + 64 * LDT * 2, O_EV = O_SEG + 4 * 128 * 4, O_END = O_EV + 3 * 128 * 4;
static_assert(O_END <= LDS_BCAST, "hgrn LDS");
__device__ __forceinline__ float clampf(float x, float lo, float hi) { return fminf(fmaxf(x, lo), hi); }

__device__ __forceinline__ void hgrn_unit(LAS unsigned char* lds, bf16_t* hgb  , const float* lb_logits, int layer, int S, int unit) {
    const int tid = ltid(), wid = tid >> 6, lane = tid & 63, l15 = lane & 15, quad = lane >> 4;
    const int dir = unit & 1, h = (unit >> 1) & 7, b = unit >> 4;
    const int qcol = h * 128, zcol = (dir ? 2048 : 1024) + h * 128, vcol = 3072 + h * 128;
    const int ch = tid & 127, seg = tid >> 7;
    LAS bf16_t* RZ = (LAS bf16_t*)(lds + O_RZ); LAS bf16_t* RQ = (LAS bf16_t*)(lds + O_RQ); LAS bf16_t* RV = (LAS bf16_t*)(lds + O_RV);
    LAS bf16_t* QD = (LAS bf16_t*)(lds + O_QD); LAS bf16_t* KD = (LAS bf16_t*)(lds + O_KD); LAS bf16_t* KDT = (LAS bf16_t*)(lds + O_KDT);
    LAS bf16_t* VT = (LAS bf16_t*)(lds + O_VT); LAS bf16_t* PP = (LAS bf16_t*)(lds + O_P);
    LAS float* SEG = (LAS float*)(lds + O_SEG); LAS float* EV = (LAS float*)(lds + O_EV);
    const int n = S / 64;
    const int r0 = tid >> 4, c8 = (tid & 15) * 8;
    bf16x8 pz0, pz1, pq0, pq1, pv0, pv1;
#define HG_ROW(c, tau) ((long)b * S + (dir ? (S - 1 - ((c) * 64 + (tau))) : ((c) * 64 + (tau))))
#define HG_LOAD(c) do { const bf16_t* ra = hgb + HG_ROW(c, r0) * HGW; const bf16_t* rb = hgb + HG_ROW(c, r0 + 32) * HGW; \
    pz0 = *(const bf16x8*)(ra + zcol + c8); pz1 = *(const bf16x8*)(rb + zcol + c8); pq0 = *(const bf16x8*)(ra + qcol + c8); pq1 = *(const bf16x8*)(rb + qcol + c8); \
    pv0 = *(const bf16x8*)(ra + vcol + c8); pv1 = *(const bf16x8*)(rb + vcol + c8); } while (0)
    f32x4 Sst[8];
#pragma unroll
    for (int i = 0; i < 8; ++i) Sst[i] = (f32x4){0.f, 0.f, 0.f, 0.f};
    HG_LOAD(0);
    for (int c = 0; c < n; ++c) {
        *(LAS bf16x8*)(RZ + r0 * LD + c8) = pz0; *(LAS bf16x8*)(RZ + (r0 + 32) * LD + c8) = pz1;
        *(LAS bf16x8*)(RQ + r0 * LD + c8) = pq0; *(LAS bf16x8*)(RQ + (r0 + 32) * LD + c8) = pq1;
        *(LAS bf16x8*)(RV + r0 * LD + c8) = pv0; *(LAS bf16x8*)(RV + (r0 + 32) * LD + c8) = pv1;
        asm volatile("s_waitcnt lgkmcnt(0)" ::: "memory"); __builtin_amdgcn_s_barrier(); asm volatile("" ::: "memory");
        if (c + 1 < n) HG_LOAD(c + 1);
        float bl[16], kk[16]; float run = 0.f;
#pragma unroll
        for (int i = 0; i < 16; ++i) {
            const float lf = bf2f(RZ[(seg * 16 + i) * LD + ch]);
            run += lf; bl[i] = run; kk[i] = 1.f - __expf(lf);
        }
        SEG[seg * 128 + ch] = run;
        asm volatile("s_waitcnt lgkmcnt(0)" ::: "memory"); __builtin_amdgcn_s_barrier(); asm volatile("" ::: "memory");
        const float t0 = SEG[ch], t1 = SEG[128 + ch], t2 = SEG[256 + ch], t3 = SEG[384 + ch];
        const float off = (seg > 0 ? t0 : 0.f) + (seg > 1 ? t1 : 0.f) + (seg > 2 ? t2 : 0.f);
        const float bref = t0 + t1, btot = (t0 + t1) + (t2 + t3);
        unsigned kdt[8], vtt[8];
#pragma unroll
        for (int i = 0; i < 16; ++i) {
            const int tau = seg * 16 + i;
            const float bb = bl[i] + off;
            const float eq = __expf(clampf(bb - bref, -80.f, 80.f)), ek = __builtin_amdgcn_rcpf(eq);
            const float sq = bf2f(RQ[tau * LD + ch]);
            QD[tau * LD + ch] = f2bf(sq * eq);
            const bf16_t kb = f2bf(kk[i] * ek);
            KD[tau * LD + ch] = kb;
            const bf16_t vb = RV[tau * LD + ch];
            if (i & 1) { kdt[i >> 1] |= ((unsigned)kb) << 16; vtt[i >> 1] |= ((unsigned)vb) << 16; } else { kdt[i >> 1] = kb; vtt[i >> 1] = vb; }
        }
        *(LAS u32x4*)(KDT + ch * LDT + seg * 16) = (u32x4){kdt[0], kdt[1], kdt[2], kdt[3]}; *(LAS u32x4*)(KDT + ch * LDT + seg * 16 + 8) = (u32x4){kdt[4], kdt[5], kdt[6], kdt[7]};
        *(LAS u32x4*)(VT + ch * LDT + seg * 16) = (u32x4){vtt[0], vtt[1], vtt[2], vtt[3]}; *(LAS u32x4*)(VT + ch * LDT + seg * 16 + 8) = (u32x4){vtt[4], vtt[5], vtt[6], vtt[7]};
        if (seg == 0) { EV[ch] = __expf(clampf(bref, -80.f, 80.f)); EV[128 + ch] = __expf(clampf(btot, -80.f, 80.f)); EV[256 + ch] = __expf(clampf(btot - bref, -80.f, 80.f)); }
        asm volatile("s_waitcnt lgkmcnt(0)" ::: "memory"); __builtin_amdgcn_s_barrier(); asm volatile("" ::: "memory");
#pragma unroll
        for (int tt = 0; tt < 2; ++tt) {
            const int ti = wid * 2 + tt, sblk = ti >> 2, tblk = ti & 3;
            f32x4 a = (f32x4){0.f, 0.f, 0.f, 0.f};
            if (sblk <= tblk) {
#pragma unroll
                for (int ks = 0; ks < 4; ++ks) {
                    const bf16x8 af = *(LAS bf16x8*)(KD + (sblk * 16 + l15) * LD + ks * 32 + quad * 8);
                    const bf16x8 bfr = *(LAS bf16x8*)(QD + (tblk * 16 + l15) * LD + ks * 32 + quad * 8);
                    a = __builtin_amdgcn_mfma_f32_16x16x32_bf16(af, bfr, a, 0, 0, 0);
                }
            }
            const int t = tblk * 16 + l15, s0 = sblk * 16 + quad * 4;
            u32x2 w; w.x = cvtpk(s0 + 0 <= t ? a[0] : 0.f, s0 + 1 <= t ? a[1] : 0.f); w.y = cvtpk(s0 + 2 <= t ? a[2] : 0.f, s0 + 3 <= t ? a[3] : 0.f);
            *(LAS u32x2*)(PP + t * LDT + s0) = w;
        }
        asm volatile("s_waitcnt lgkmcnt(0)" ::: "memory"); __builtin_amdgcn_s_barrier(); asm volatile("" ::: "memory");
        const int dv0 = wid * 16;
        bf16x8 bv[2];
#pragma unroll
        for (int ks = 0; ks < 2; ++ks) bv[ks] = *(LAS bf16x8*)(VT + (dv0 + l15) * LDT + ks * 32 + quad * 8);
        f32x4 o[4];
#pragma unroll
        for (int i = 0; i < 4; ++i) o[i] = (f32x4){0.f, 0.f, 0.f, 0.f};
#pragma unroll
        for (int k4 = 0; k4 < 4; ++k4) {
            const f32x4 er0 = *(LAS f32x4*)(EV + 32 * k4 + 4 * quad), er1 = *(LAS f32x4*)(EV + 32 * k4 + 16 + 4 * quad);
            const f32x4 s0 = Sst[2 * k4] * er0, s1 = Sst[2 * k4 + 1] * er1;
            u32x4 bw; bw.x = cvtpk(s0[0], s0[1]); bw.y = cvtpk(s0[2], s0[3]); bw.z = cvtpk(s1[0], s1[1]); bw.w = cvtpk(s1[2], s1[3]);
            const bf16x8 bfr = *reinterpret_cast<bf16x8*>(&bw);
#pragma unroll
            for (int tb = 0; tb < 4; ++tb) {
                const u32x2 a0 = *(LAS u32x2*)(QD + (tb * 16 + l15) * LD + 32 * k4 + 4 * quad);
                const u32x2 a1 = *(LAS u32x2*)(QD + (tb * 16 + l15) * LD + 32 * k4 + 16 + 4 * quad);
                u32x4 aw; aw.x = a0.x; aw.y = a0.y; aw.z = a1.x; aw.w = a1.y;
                o[tb] = __builtin_amdgcn_mfma_f32_16x16x32_bf16(*reinterpret_cast<bf16x8*>(&aw), bfr, o[tb], 0, 0, 0);
            }
        }
#pragma unroll
        for (int ks = 0; ks < 2; ++ks)
#pragma unroll
            for (int tb = 0; tb < 4; ++tb) {
                const bf16x8 af = *(LAS bf16x8*)(PP + (tb * 16 + l15) * LDT + ks * 32 + quad * 8);
                o[tb] = __builtin_amdgcn_mfma_f32_16x16x32_bf16(af, bv[ks], o[tb], 0, 0, 0);
            }
#pragma unroll
        for (int tb = 0; tb < 4; ++tb)
#pragma unroll
            for (int j = 0; j < 4; ++j) hgb[HG_ROW(c, tb * 16 + quad * 4 + j) * HGW + zcol + dv0 + l15] = f2bf(o[tb][j]);
#pragma unroll
        for (int db = 0; db < 8; ++db) {
            f32x4 tmp = (f32x4){0.f, 0.f, 0.f, 0.f};
#pragma unroll
            for (int ks = 0; ks < 2; ++ks) {
                const bf16x8 af = *(LAS bf16x8*)(KDT + (db * 16 + l15) * LDT + ks * 32 + quad * 8);
                tmp = __builtin_amdgcn_mfma_f32_16x16x32_bf16(af, bv[ks], tmp, 0, 0, 0);
            }
            const f32x4 et = *(LAS f32x4*)(EV + 128 + db * 16 + quad * 4), etr = *(LAS f32x4*)(EV + 256 + db * 16 + quad * 4);
            Sst[db] = Sst[db] * et + tmp * etr;
        }
    }
    wg_barrier();
#undef HG_ROW
#undef HG_LOAD
}
}

struct WDesc { const float* src; const float* gain; bf16_t* dst; int K, N, R, map; };

__device__ __forceinline__ void wcvt_phase(LAS unsigned char* lds, const Params& p, int layer) {
    LAS float* tile = (LAS float*)lds;
    const int tid = ltid();
    char* ws = p.ws;
    if (lbid() == 0) {
        float* lbt = (float*)(ws + OFF_LB);
        for (int i = tid; i < 2048; i += 512) {
            float mx = -3e38f; for (int l = 0; l < DEPTH; ++l) mx = fmaxf(mx, p.lb_logits[l * 2048 + i]);
            float den = 0.f, num = 0.f; for (int l = 0; l < DEPTH; ++l) { const float e = __expf(p.lb_logits[l * 2048 + i] - mx); den += e; if (l >= 1 && l <= layer) num += e; }
            lbt[i] = num / den;
        }
    }
    for (int mi = 0; mi < 10; ++mi) {
        WDesc d;
        switch (mi) {
        case 0: d = {p.w_in + (size_t)layer * 2048 * 5952, p.mix_norm + layer * 2048, (bf16_t*)(ws + OFF_W_IN), 2048, 5952, INP, 1}; break;
        case 1: d = {p.w_uq + (size_t)layer * 512 * 1536, p.q_norm + layer * 512, (bf16_t*)(ws + OFF_W_UQ), 512, 1536, 1536, 0}; break;
        case 2: d = {p.w_ukv + (size_t)layer * 256 * 2048, p.kv_norm + layer * 256, (bf16_t*)(ws + OFF_W_UKV), 256, 2048, 2048, 0}; break;
        case 3: d = {p.w_out + (size_t)layer * 2048 * 2048, nullptr, (bf16_t*)(ws + OFF_W_OUT), 2048, 2048, 2048, 0}; break;
        case 4: d = {p.w_xq + (size_t)layer * 2048 * 2048, p.xattn_norm + layer * 2048, (bf16_t*)(ws + OFF_W_XQ), 2048, 2048, 2048, 0}; break;
        case 5: d = {p.w_xk + (size_t)layer * 2048 * 2048, p.mem_norm + layer * 2048, (bf16_t*)(ws + OFF_W_XK), 2048, 2048, 2048, 0}; break;
        case 6: d = {p.w_xv + (size_t)layer * 2048 * 2048, p.mem_norm + layer * 2048, (bf16_t*)(ws + OFF_W_XV), 2048, 2048, 2048, 0}; break;
        case 7: d = {p.w_xo + (size_t)layer * 2048 * 2048, nullptr, (bf16_t*)(ws + OFF_W_XO), 2048, 2048, 2048, 0}; break;
        case 8: d = {p.w_ffn1 + (size_t)layer * 2048 * 8192, p.ffn_norm + layer * 2048, (bf16_t*)(ws + OFF_W_F1), 2048, 8192, 8192, 0}; break;
        default: d = {p.w_ffn2 + (size_t)layer * 8192 * 2048, nullptr, (bf16_t*)(ws + OFF_W_F2), 8192, 2048, 2048, 0}; break;
        }
        const int nkt = d.K / 64, nrt = d.R / 256, ntile = nkt * nrt;
        for (int t = lbid(); t < ntile; t += gridDim.x) {
            const int kt = t % nkt, rt = t / nkt, k0 = kt * 64, r0 = rt * 256;
            {
                const int c4 = tid & 63, rr = tid >> 6; const int col = r0 + 4 * c4;
                int sc = col; bool zero = false;
                if (d.map) { if (col < 832) sc = col; else if (col < 1024) zero = true; else sc = col - 192; }
#pragma unroll
                for (int ii = 0; ii < 8; ++ii) { const int i = rr + ii * 8;
                    f32x4 v = zero ? (f32x4){0.f, 0.f, 0.f, 0.f} : *(const f32x4*)(d.src + (size_t)(k0 + i) * d.N + sc);
                    if (d.gain) v = v * d.gain[k0 + i];
                    *(LAS f32x4*)(tile + i * 260 + 4 * c4) = v; }
            }
            wg_barrier();
            {
                const int n = tid >> 1, kh = (tid & 1) * 32;
#pragma unroll
                for (int j = 0; j < 4; ++j) {
                    unsigned w[4];
#pragma unroll
                    for (int e = 0; e < 8; e += 2) w[e >> 1] = cvtpk(tile[(kh + j * 8 + e) * 260 + n], tile[(kh + j * 8 + e + 1) * 260 + n]);
                    *(u32x4*)(d.dst + (size_t)(r0 + n) * d.K + k0 + kh + j * 8) = (u32x4){w[0], w[1], w[2], w[3]};
                }
            }
            wg_barrier();
        }
    }
}

__device__ __forceinline__ void prep_phase(const Params& p, int tr, int T, int S) {
    const size_t xb_off = tr ? OFF_XB : OFF_XB0;
    const int tid = ltid(), wid = tid >> 6, lane = tid & 63;
    char* ws = p.ws;
    const long gtid = (long)lbid() * 512 + tid, gstride = (long)gridDim.x * 512;
    { ssq_t* ssq = (ssq_t*)(ws + OFF_SSQ) + (size_t)tr * 11 * TMAX; for (long i = gtid; i < (long)10 * TMAX; i += gstride) ssq[TMAX + i] = 0ull;
      if (gtid < 64) ((unsigned*)(ws + OFF_CTR))[gtid] = 0u; }
    { float* rc = (float*)(ws + OFF_ROPE); float* rs = rc + 16384 * 32;
      for (int i = (int)gtid; i < S * 32; i += (int)gstride) { const int pos = i >> 5, f = i & 31;
          const float inv_freq = exp2f(-(float)f * (13.287712379549449f / 32.f));
          const float ang = (float)pos * inv_freq;
          const double rev = (double)ang * 0.15915494309189535; const float fr = (float)(rev - rint(rev));
          rc[i] = __builtin_amdgcn_cosf(fr); rs[i] = __builtin_amdgcn_sinf(fr); } }
    { const float* x = p.x_in[tr]; bf16_t* xb = (bf16_t*)(ws + xb_off); ssq_t* ssq0 = (ssq_t*)(ws + OFF_SSQ) + (size_t)tr * 11 * TMAX;
      const int rstep = gridDim.x * 8; int row = lbid() * 8 + wid;
      f32x4 cur[8], nxt[8];
      if (row < T) {
#pragma unroll
          for (int i = 0; i < 8; ++i) cur[i] = *(const f32x4*)(x + (size_t)row * DM + i * 256 + lane * 4);
      }
      for (; row < T; row += rstep) {
          const int nrow = row + rstep;
          if (nrow < T) {
#pragma unroll
              for (int i = 0; i < 8; ++i) nxt[i] = *(const f32x4*)(x + (size_t)nrow * DM + i * 256 + lane * 4);
          }
          __builtin_amdgcn_sched_barrier(0);
          float ss = 0.f;
#pragma unroll
          for (int i = 0; i < 8; ++i) { const f32x4 v = cur[i];
              ss += (v[0] * v[0] + v[1] * v[1]) + (v[2] * v[2] + v[3] * v[3]);
              u32x2 w; w.x = cvtpk(v[0], v[1]); w.y = cvtpk(v[2], v[3]); *(u32x2*)(xb + (size_t)row * DM + i * 256 + lane * 4) = w; }
#pragma unroll
          for (int o = 32; o > 0; o >>= 1) ss += __shfl_xor(ss, o);
          if (lane == 0) ssq0[row] = ssq_fix(ss);
#pragma unroll
          for (int i = 0; i < 8; ++i) cur[i] = nxt[i];
      } }
    { const float* mem = p.mem_in[tr]; bf16_t* mn = (bf16_t*)(ws + OFF_MEMN) + (size_t)tr * 512 * 2048;
      for (int row = lbid() * 8 + wid; row < 512; row += gridDim.x * 8) {
          f32x4 v[8]; float ss = 0.f;
#pragma unroll
          for (int i = 0; i < 8; ++i) { v[i] = *(const f32x4*)(mem + (size_t)row * DM + i * 256 + lane * 4); ss += (v[i][0] * v[i][0] + v[i][1] * v[i][1]) + (v[i][2] * v[i][2] + v[i][3] * v[i][3]); }
#pragma unroll
          for (int o = 32; o > 0; o >>= 1) ss += __shfl_xor(ss, o);
          const float rs = __builtin_amdgcn_rsqf(ss * (1.f / DM) + EPS);
#pragma unroll
          for (int i = 0; i < 8; ++i) { u32x2 w; w.x = cvtpk(v[i][0] * rs, v[i][1] * rs); w.y = cvtpk(v[i][2] * rs, v[i][3] * rs); *(u32x2*)(mn + (size_t)row * DM + i * 256 + lane * 4) = w; }
      } }
}

__device__ __forceinline__ void rope_phase(const Params& p, int T, int S) {
    char* ws = p.ws;
    bf16_t* q = (bf16_t*)(ws + OFF_Q); const bf16_t* kr = (const bf16_t*)(ws + OFF_KR); bf16_t* kro = (bf16_t*)(ws + OFF_KROPE);
    const float* rc = (const float*)(ws + OFF_ROPE); const float* rs = rc + 16384 * 32;
    const int total = T * 9 * 4;
    constexpr int UN = 3;
    const int stride = gridDim.x * 512;
    for (int i0 = lbid() * 512 + ltid(); i0 < total; i0 += stride * UN) {
        f32x8 c[UN], s[UN]; bf16x8 a1[UN], a2[UN];
#pragma unroll
        for (int u = 0; u < UN; ++u) { const int i = i0 + u * stride; if (i < total) {
            const int f8 = (i & 3) * 8; const int ru = i >> 2; const int row_i = ru / 9; const int un = ru - row_i * 9; const long row = row_i; const int pos = row_i & (S - 1);
            c[u] = *(const f32x8*)(rc + pos * 32 + f8); s[u] = *(const f32x8*)(rs + pos * 32 + f8);
            const bf16_t* src = (un < 8) ? (q + row * 1536 + un * 192 + 128 + f8) : (kr + row * 64 + f8);
            a1[u] = *(const bf16x8*)src; a2[u] = *(const bf16x8*)(src + 32); } }
#pragma unroll
        for (int u = 0; u < UN; ++u) { const int i = i0 + u * stride; if (i >= total) break;
            const int f8 = (i & 3) * 8; const int ru = i >> 2; const int row_i = ru / 9; const int un = ru - row_i * 9; const long row = row_i;
            bf16_t* dst = (un < 8) ? (q + row * 1536 + un * 192 + 128 + f8) : (kro + row * 64 + f8);
            unsigned w1[4], w2[4];
#pragma unroll
            for (int j = 0; j < 8; j += 2) {
                const float x1a = bf2f((bf16_t)a1[u][j]), x2a = bf2f((bf16_t)a2[u][j]), x1b = bf2f((bf16_t)a1[u][j + 1]), x2b = bf2f((bf16_t)a2[u][j + 1]);
                w1[j >> 1] = cvtpk(x1a * c[u][j] - x2a * s[u][j], x1b * c[u][j + 1] - x2b * s[u][j + 1]);
                w2[j >> 1] = cvtpk(x2a * c[u][j] + x1a * s[u][j], x2b * c[u][j + 1] + x1b * s[u][j + 1]);
            }
            *(u32x4*)dst = (u32x4){w1[0], w1[1], w1[2], w1[3]}; *(u32x4*)(dst + 32) = (u32x4){w2[0], w2[1], w2[2], w2[3]};
        }
    }
}

__device__ __forceinline__ void hcomb_phase(const Params& p, int layer, int T, int nblk, int bid, int nsplit) {
    char* ws = p.ws; const bf16_t* hgb = (const bf16_t*)(ws + OFF_HG); bf16_t* mix = (bf16_t*)(ws + OFF_MIX);
    const float* on = p.out_norm + layer * 128;
    const int l16 = ltid() & 15;
    const int total = T * 8 * 16;
    f32x8 onv = *(const f32x8*)(on + l16 * 8);
    constexpr int UN = 4;
    const int stride = nblk * 512;
    bf16x8 vf[UN], vb[UN], vg[UN], nf[UN], nb[UN], ng[UN];
#define HC_LOAD(F, B, G, base_i) do { _Pragma("unroll") for (int u = 0; u < UN; ++u) { const int i = (base_i) + u * stride; if (i < total) { const int rh = i >> 4; const int h = rh & 7; const long row = rh >> 3; \
        const bf16_t* base = hgb + row * HGW + h * 128 + l16 * 8; F[u] = *(const bf16x8*)(base + 1024); B[u] = *(const bf16x8*)(base + 2048); G[u] = *(const bf16x8*)(base + 4096); } } } while (0)
    { const int first = bid * 512 + ltid(); HC_LOAD(vf, vb, vg, first); }
    for (int i0 = bid * 512 + ltid(); i0 < total; i0 += stride * UN) {
        HC_LOAD(nf, nb, ng, i0 + stride * UN);
        __builtin_amdgcn_sched_barrier(0);
#pragma unroll
        for (int u = 0; u < UN; ++u) {
            const int i = i0 + u * stride; if (i >= total) break;
            const int rh = i >> 4; const int h = rh & 7; const long row = rh >> 3;
            float o[8]; float ss = 0.f;
#pragma unroll
            for (int j = 0; j < 8; ++j) { o[j] = bf2f((bf16_t)vf[u][j]) + bf2f((bf16_t)vb[u][j]); ss += o[j] * o[j]; }
            ss += __shfl_xor(ss, 1); ss += __shfl_xor(ss, 2); ss += __shfl_xor(ss, 4); ss += __shfl_xor(ss, 8);
            const float rs = __builtin_amdgcn_rsqf(ss * (1.f / 128.f) + EPS);
            unsigned w[4];
#pragma unroll
            for (int j = 0; j < 8; j += 2) {
                const float g0 = bf2f((bf16_t)vg[u][j]), g1 = bf2f((bf16_t)vg[u][j + 1]);
                const float y0 = o[j] * rs * onv[j] * (g0 * __builtin_amdgcn_rcpf(1.f + __expf(-g0))), y1 = o[j + 1] * rs * onv[j + 1] * (g1 * __builtin_amdgcn_rcpf(1.f + __expf(-g1)));
                w[j >> 1] = cvtpk(y0, y1);
            }
            *(u32x4*)(mix + row * 2048 + 1024 + h * 128 + l16 * 8) = (u32x4){w[0], w[1], w[2], w[3]};
            if (nsplit == 2 && (((int)row & 16383) >> 8) >= MK_QF) {
                const f32x4 mlv = *(const f32x4*)((const float*)(ws + OFF_XB + 2048) + row * 1024 + h * 4);
                const float C = att::SCALE * 1.4426950408889634f;
                const float M = fmaxf(mlv[0], mlv[2]);
                const float w1 = mlv[1] * __builtin_amdgcn_exp2f((mlv[0] - M) * C), w2 = mlv[3] * __builtin_amdgcn_exp2f((mlv[2] - M) * C);
                const float inv = 1.f / (w1 + w2), c1 = w1 * inv, c2 = w2 * inv;
                bf16_t* pa = mix + row * 2048 + h * 128 + l16 * 8; const bf16_t* pb = (const bf16_t*)(ws + OFF_XB) + row * 2048 + h * 128 + l16 * 8;
                const bf16x8 va = *(const bf16x8*)pa, vb2 = *(const bf16x8*)pb;
                unsigned wo[4];
#pragma unroll
                for (int j = 0; j < 8; j += 2) wo[j >> 1] = cvtpk(c1 * bf2f((bf16_t)va[j]) + c2 * bf2f((bf16_t)vb2[j]), c1 * bf2f((bf16_t)va[j + 1]) + c2 * bf2f((bf16_t)vb2[j + 1]));
                *(u32x4*)pa = (u32x4){wo[0], wo[1], wo[2], wo[3]};
            }
        }
#pragma unroll
        for (int u = 0; u < UN; ++u) { vf[u] = nf[u]; vb[u] = nb[u]; vg[u] = ng[u]; }
    }
#undef HC_LOAD
}

__device__ __forceinline__ void final_phase(const Params& p, float* xout, int T, int tr) {
    const int wid = ltid() >> 6, lane = ltid() & 63;
    const ssq_t* ssq = (const ssq_t*)(p.ws + OFF_SSQ) + (size_t)(tr * 11 + 10) * TMAX;
    f32x4 gv[8];
#pragma unroll
    for (int i = 0; i < 8; ++i) gv[i] = *(const f32x4*)(p.final_norm + i * 256 + lane * 4);
    const int rstep = gridDim.x * 8;
    int row = lbid() * 8 + wid;
    f32x4 cur[8], nxt[8]; float rs_c = 0.f, rs_n = 0.f;
    if (row < T) {
#pragma unroll
        for (int i = 0; i < 8; ++i) cur[i] = *(const f32x4*)(xout + (size_t)row * DM + i * 256 + lane * 4);
        rs_c = __builtin_amdgcn_rsqf(ssq_val(ssq[row]) * (1.f / DM) + EPS);
    }
    for (; row < T; row += rstep) {
        const int nrow = row + rstep;
        if (nrow < T) {
#pragma unroll
            for (int i = 0; i < 8; ++i) nxt[i] = *(const f32x4*)(xout + (size_t)nrow * DM + i * 256 + lane * 4);
            rs_n = __builtin_amdgcn_rsqf(ssq_val(ssq[nrow]) * (1.f / DM) + EPS);
        }
        __builtin_amdgcn_sched_barrier(0);
#pragma unroll
        for (int i = 0; i < 8; ++i) *(f32x4*)(xout + (size_t)row * DM + i * 256 + lane * 4) = cur[i] * rs_c * gv[i];
#pragma unroll
        for (int i = 0; i < 8; ++i) cur[i] = nxt[i];
        rs_c = rs_n;
    }
}

__device__ __forceinline__ void mixer_phase(LAS unsigned char* lds, const Params& p, int layer, int T, int S, int tr) {
    char* ws = p.ws;
    unsigned* ctr = (unsigned*)(ws + OFF_CTR) + (tr * 2 + layer) * 16;
    const int nQB = S / 256, QF = (S >= 16384) ? MK_QF : nQB, nQS = nQB - QF;
    const int nG = 32, nH = 2 * 8 * 2, nFull = 16 * QF, nA = nFull + 16 * 2 * nQS;
    LAS unsigned* slot = (LAS unsigned*)(lds + LDS_BCAST);
    for (;;) {
        if (ltid() == 0) *slot = __hip_atomic_fetch_add(ctr, 1u, __ATOMIC_RELAXED, __HIP_MEMORY_SCOPE_AGENT);
        wg_barrier();
        const int idx = (int)__builtin_amdgcn_readfirstlane(*slot);
        wg_barrier();
        if (idx >= nG + nH + nA) break;
        const Params* kq = launder_p((const Params*)__builtin_amdgcn_kernarg_segment_ptr());
        if (idx < nG) {
            gemm_phase<E_BF16>(lds, kq, tr, layer, 5, idx >> 4, 16, idx & 15);
            continue;
        }
        char* wsu = kq->ws;
        bf16_t* hgb = (bf16_t*)(wsu + OFF_HG);
        const bf16_t* q = (const bf16_t*)(wsu + OFF_Q); const bf16_t* kv = (const bf16_t*)(wsu + OFF_KV); const bf16_t* kro = (const bf16_t*)(wsu + OFF_KROPE);
        bf16_t* mix = (bf16_t*)(wsu + OFF_MIX); bf16_t* o2 = (bf16_t*)(wsu + OFF_XB);
#ifndef MK_NO_HG
        if (idx < nG + nH) hg::hgrn_unit(lds, hgb, kq->lb_logits, layer, S, idx - nG);
        else
#endif
        {
#ifndef MK_NO_ATT
            const int a = idx - nG - nH; int qb, half, bh, nsplit;
            if (a < nFull) { qb = a % QF; bh = a / QF; half = 0; nsplit = 1; }
            else { const int a1 = a - nFull; qb = QF + a1 % nQS; const int a2 = a1 / nQS; half = a2 & 1; bh = a2 >> 1; nsplit = 2; }
            const int h = bh & 7, b = bh >> 3;
            const int sseq = S / nsplit;
            const long row0 = (long)b * S + (long)qb * 256, krow0 = (long)b * S + (long)half * sseq;
            bf16_t* ob = (half == 0 ? mix : o2) + row0 * 2048 + h * 128;
            const int ml = (nsplit == 2) ? (int)(row0 * 1024 + h * 4 + half * 2) : -1;
            att::attn_body(q + row0 * 1536 + h * 192, kv + krow0 * 2048 + h * 256, kro + krow0 * 64, ob, ml, sseq, (char*)(unsigned char*)lds);
#endif
        }
    }
}

#define XB_TMO      128
#define XB_XCNT(j)  (256  + 64 * (j))
#define XB_XSUB(j)  (1280 + 64 * (j))
#define XB_XGEN(j)  (2304 + 64 * (j))
#define XB_TOP      3328
#define XB_TOPGEN   3392
#define XCD_BAR_WORDS 3456
#define XB_SPIN_CAP (1u << 22)
__device__ __forceinline__ unsigned xb_ld(unsigned* p)              { return __hip_atomic_load(p, __ATOMIC_RELAXED, __HIP_MEMORY_SCOPE_AGENT); }
__device__ __forceinline__ unsigned xb_add(unsigned* p, unsigned v) { return __hip_atomic_fetch_add(p, v, __ATOMIC_RELAXED, __HIP_MEMORY_SCOPE_AGENT); }
__device__ __forceinline__ unsigned xb_xcc_id() { return (unsigned)__builtin_amdgcn_s_getreg((3 << 11) | 20) & 0xFu; }
#define XB_SPIN(cond, bar) do { unsigned _sp = 0; while (cond) { __builtin_amdgcn_s_sleep(1); \
    if ((++_sp & 255u) == 0u) { if (xb_ld(&(bar)[XB_TMO])) break; if (_sp > XB_SPIN_CAP) { atomicAdd(&(bar)[XB_TMO], 1u); break; } } } } while (0)
struct XcdBarrier { unsigned* bar; unsigned x; volatile LAS unsigned* st; };
__device__ __forceinline__ XcdBarrier xcd_barrier_post(unsigned* bar, volatile LAS unsigned* st) {
    XcdBarrier b; b.bar = bar; b.x = xb_xcc_id(); b.st = st;
    if (threadIdx.x == 0) (void)xb_add(&bar[XB_XCNT(b.x)], 1u);
    return b;
}
__device__ __forceinline__ void xcd_barrier_complete(unsigned* bar, unsigned x, unsigned& nloc, unsigned& nx) {
    const unsigned G = gridDim.x * gridDim.y * gridDim.z;
    unsigned sum, cnt, mine, sp = 0u;
    for (;;) {
        sum = 0u; cnt = 0u; mine = 0u;
#pragma unroll
        for (unsigned j = 0; j < 16; ++j) { const unsigned c = xb_ld(&bar[XB_XCNT(j)]); sum += c; cnt += (c > 0u) ? 1u : 0u; mine = (j == x) ? c : mine; }
        if (sum == G) break;
        __builtin_amdgcn_s_sleep(1);
        if ((++sp & 255u) == 0u) { if (xb_ld(&bar[XB_TMO])) break; if (sp > XB_SPIN_CAP) { atomicAdd(&bar[XB_TMO], 1u); break; } }
    }
    nloc = mine > 0u ? mine : 1u; nx = cnt > 0u ? cnt : 1u;
}
__device__ __forceinline__ void xcd_barrier_(const XcdBarrier& b) {
    asm volatile("s_waitcnt vmcnt(0)" ::: "memory");
    __syncthreads();
    if (threadIdx.x == 0) {
        unsigned* bar = b.bar;
        __builtin_amdgcn_s_waitcnt(0);
        unsigned nloc = b.st[0], nx = b.st[1];
        if (nloc == 0u) { xcd_barrier_complete(bar, b.x, nloc, nx); b.st[0] = nloc; b.st[1] = nx; }
        const unsigned old = xb_add(&bar[XB_XSUB(b.x)], 1u);
        const unsigned gen = old / nloc;
        if (old + 1u == (gen + 1u) * nloc) {
            __builtin_amdgcn_fence(__ATOMIC_RELEASE, "agent");
            asm volatile("s_waitcnt vmcnt(0)" ::: "memory");
            const unsigned og = xb_add(&bar[XB_TOP], 1u);
            const unsigned tg = og / nx;
            if (og + 1u == (tg + 1u) * nx) xb_add(&bar[XB_TOPGEN], 1u);
            else XB_SPIN(xb_ld(&bar[XB_TOPGEN]) == tg, bar);
            __builtin_amdgcn_fence(__ATOMIC_ACQUIRE, "agent");
            xb_add(&bar[XB_XGEN(b.x)], 1u);
            asm volatile("s_waitcnt vmcnt(0)" ::: "memory");
        } else {
            XB_SPIN(xb_ld(&bar[XB_XGEN(b.x)]) == gen, bar);
            __builtin_amdgcn_fence(__ATOMIC_ACQUIRE, "agent");
            asm volatile("s_waitcnt vmcnt(0)" ::: "memory");
        }
    }
    __syncthreads();
}

__device__ __forceinline__ void xcd_barrier(LAS unsigned char* lds) {
    const Params* kp = launder_p((const Params*)__builtin_amdgcn_kernarg_segment_ptr());
    XcdBarrier b; b.bar = (unsigned*)(kp->ws + OFF_BAR); b.x = xb_xcc_id(); b.st = (volatile LAS unsigned*)(lds + LDS_BCAST + 64);
    xcd_barrier_(b);
}
constexpr int N_PHASES = 52;

__device__ __forceinline__ GemmDesc mkgemm(const void* A, int lda, const void* B, int ldb, int K, int nM, int nN) {
    GemmDesc g{}; g.A = (const char*)A; g.B = (const char*)B; g.lda = lda; g.ldb = ldb; g.K = K; g.nM = nM; g.nN = nN; g.nZ = 1; g.perm = 1; g.epi = E_BF16; return g;
}

__device__ __forceinline__ bool make_gemm(const Params& p, int tr, int l, int k, int i, GemmDesc& g) {
    const int T = tr ? 32768 : 8192, S = tr ? 16384 : 4096, nMT = T / 256;
    char* ws = p.ws;
    float* xout = p.out + (tr ? (size_t)8192 * DM : 0);
    ssq_t* ssq = (ssq_t*)(ws + OFF_SSQ) + (size_t)tr * 11 * TMAX;
    ssq_t* ssq_x0 = ssq + (size_t)(l * 5 + 0) * TMAX; ssq_t* ssq_q = ssq + (size_t)(l * 5 + 1) * TMAX; ssq_t* ssq_kv = ssq + (size_t)(l * 5 + 2) * TMAX;
    ssq_t* ssq_x1 = ssq + (size_t)(l * 5 + 3) * TMAX; ssq_t* ssq_x2 = ssq + (size_t)(l * 5 + 4) * TMAX; ssq_t* ssq_nx = ssq + (size_t)((l + 1) * 5) * TMAX;
    bf16_t* xb = (bf16_t*)(ws + (tr ? OFF_XB : OFF_XB0));
    const char* memn = ws + OFF_MEMN + (size_t)tr * 512 * 2048 * 2;
    if (k == 1) {
        if (i > 0) return false;
        g = mkgemm(xb, DM, ws + OFF_W_IN, DM, DM, nMT, INP / 256); g.epi = E_INPROJ; g.ssq_in = ssq_x0; g.inv_dim = 1.f / DM;
        g.out = (bf16_t*)(ws + OFF_CQ); g.out2 = (bf16_t*)(ws + OFF_KR); g.out3 = (bf16_t*)(ws + OFF_HG); g.ssq_out = ssq_q; g.ssq_out2 = ssq_kv; return true;
    } else if (k == 2) {
        if (i == 0) { g = mkgemm(ws + OFF_CQ, 768, ws + OFF_W_UQ, 512, 512, nMT, 6); g.out = (bf16_t*)(ws + OFF_Q); g.ldo = 1536; g.ssq_in = ssq_q; g.inv_dim = 1.f / 512.f; return true; }
        if (i == 1) { g = mkgemm(ws + OFF_CQ + 512 * 2, 768, ws + OFF_W_UKV, 256, 256, nMT, 8); g.out = (bf16_t*)(ws + OFF_KV); g.ldo = 2048; g.ssq_in = ssq_kv; g.inv_dim = 1.f / 256.f; return true; }
        return false;
    } else if (k == 6) {
        if (i > 0) return false;
        g = mkgemm(ws + OFF_MIX, DM, ws + OFF_W_OUT, DM, DM, nMT, 8); g.epi = E_RESID;
        g.resid = (l == 0) ? p.x_in[tr] : xout; g.xout = xout; g.xb = xb; g.ssq_out = ssq_x1; return true;
    } else if (k == 7) {
        if (i == 0) { g = mkgemm(xb, DM, ws + OFF_W_XQ, DM, DM, nMT, 8); g.out = (bf16_t*)(ws + OFF_XQ); g.ldo = DM; g.ssq_in = ssq_x1; g.inv_dim = 1.f / DM; return true; }
        return false;
    } else if (k == 5) {
        if (i == 0) { g = mkgemm(memn, DM, ws + OFF_W_XK, DM, DM, 2, 8); g.out = (bf16_t*)(ws + OFF_KMEM); g.ldo = DM; return true; }
        if (i == 1) { g = mkgemm(ws + OFF_W_XV, DM, memn, DM, DM, 8, 1); g.nZ = 2; g.bzs = 256 * DM * 2; g.out = (bf16_t*)(ws + OFF_VT); g.ldo = 256; g.ozs = (long)2048 * 256; return true; }
        return false;
    } else if (k == 8) {
        if (i > 0) return false;
        g = mkgemm(ws + OFF_XQ, DM, ws + OFF_KMEM, DM, 512, nMT, 1); g.nZ = 4; g.azs = 512 * 2; g.bzs = 512 * 2; g.bbs = 256 * DM * 2; g.tpb = S / 256;
        g.epi = E_SOFTMAX; g.out = (bf16_t*)(ws + OFF_PBUF); g.ldo = 1024; return true;
    } else if (k == 9) {
        if (i > 0) return false;
        g = mkgemm(ws + OFF_PBUF, 1024, ws + OFF_VT, 256, 256, nMT, 2); g.nZ = 4; g.azs = 256 * 2; g.bzs = 512 * 256 * 2; g.bbs = 2048 * 256 * 2; g.tpb = S / 256;
        g.out = (bf16_t*)(ws + OFF_OBUF); g.ldo = DM; g.ozs = 512; return true;
    } else if (k == 10) {
        if (i > 0) return false;
        g = mkgemm(ws + OFF_OBUF, DM, ws + OFF_W_XO, DM, DM, nMT, 8); g.epi = E_RESID;
        g.resid = xout; g.xout = xout; g.xb = xb; g.ssq_out = ssq_x2; return true;
    } else if (k == 11) {
        if (i > 0) return false;
        g = mkgemm(xb, DM, ws + OFF_W_F1, DM, DM, nMT, 32); g.out = (bf16_t*)(ws + OFF_U); g.ldo = 8192; g.ssq_in = ssq_x2; g.inv_dim = 1.f / DM; g.relu2 = 1; return true;
    } else if (k == 12) {
        if (i > 0) return false;
        g = mkgemm(ws + OFF_U, 8192, ws + OFF_W_F2, 8192, 8192, nMT, 8); g.epi = E_RESID;
        g.resid = xout; g.xout = xout; g.xb = xb; g.ssq_out = ssq_nx; return true;
    }
    return false;
}

__device__ __forceinline__ void run_phase(const Params* kp, int ph, LAS unsigned char* lds) {
    const Params& p = *kp;
    if (ph == 0) { prep_phase(p, 0, 8192, 4096); prep_phase(p, 1, 32768, 16384); return; }
    if (ph == N_PHASES - 1) { final_phase(p, p.out, 8192, 0); final_phase(p, p.out + (size_t)8192 * DM, 32768, 1); return; }
    const int l = (ph - 1) / 25, r = (ph - 1) % 25;
    if (r == 0) { wcvt_phase(lds, p, l); return; }
    const int tr = (r - 1) / 12, k = (r - 1) % 12 + 1;
    const int T = tr ? 32768 : 8192, S = tr ? 16384 : 4096;
    if (k == 3) { rope_phase(p, T, S); return; }
    if (k == 4) { mixer_phase(lds, p, l, T, S, tr); return; }
    if (k == 5) { hcomb_phase(p, l, T, gridDim.x, lbid(), S >= 16384 ? 2 : 1); return; }
#ifndef MK_NO_GEMM
    { const int c = lbid(), G = gridDim.x;
    if (k == 1) gemm_phase<E_INPROJ>(lds, kp, tr, l, k, 0, G, c);
    else if (k == 6 || k == 10 || k == 12) gemm_phase<E_RESID>(lds, kp, tr, l, k, 0, G, c);
    else if (k == 8) gemm_phase<E_SOFTMAX>(lds, kp, tr, l, k, 0, G, c);
    else for (int i = 0; i < 2; ++i) gemm_phase<E_BF16>(lds, kp, tr, l, k, i, G, c); }
#endif
}

__global__ void __launch_bounds__(512, 2) mk_forward(Params p, int ph_lo, int ph_hi) {
    extern __shared__ __attribute__((aligned(16))) unsigned char shm[];
    LAS unsigned char* lds = (LAS unsigned char*)shm;
    cg::grid_group grid = cg::this_grid();
    volatile LAS unsigned* xst = (volatile LAS unsigned*)(lds + LDS_BCAST + 64);
    if (threadIdx.x == 0) { xst[0] = 0u; xst[1] = 0u; }
    __syncthreads();
    { const Params* kp0 = launder_p((const Params*)__builtin_amdgcn_kernarg_segment_ptr()); (void)xcd_barrier_post((unsigned*)(kp0->ws + OFF_BAR), xst); }
    for (int ph = ph_lo; ph < ph_hi; ++ph) {
        const Params* kp = launder_p((const Params*)__builtin_amdgcn_kernarg_segment_ptr());
#ifdef MK_TIME_KIND
        if (blockIdx.x == 0 && threadIdx.x == 0) ((unsigned long long*)(kp->ws + OFF_TS))[ph] = __builtin_amdgcn_s_memrealtime();
#endif
        run_phase(kp, ph, lds);
        if (ph + 1 < ph_hi) { if (ph_hi > N_PHASES) grid.sync(); else xcd_barrier(lds); }
    }
#ifdef MK_TIME_KIND
    xcd_barrier(lds);
    if (blockIdx.x == 0) {
        const Params* kp = launder_p((const Params*)__builtin_amdgcn_kernarg_segment_ptr());
        unsigned long long* ts = (unsigned long long*)(kp->ws + OFF_TS); float* outp = kp->out;
        if (threadIdx.x == 0) ts[ph_hi] = __builtin_amdgcn_s_memrealtime();
        __syncthreads();
        unsigned tot = 0;
        for (int ph = ph_lo; ph < ph_hi; ++ph) { const int r_ = (ph - 1) % 25; const int kind = (ph == 0) ? 100 : (ph == N_PHASES - 1 ? 101 : (r_ == 0 ? 0 : (r_ - 1) % 12 + 1));
            if (kind == MK_TIME_KIND || MK_TIME_KIND == 200) tot += (unsigned)(ts[ph + 1] - ts[ph]); }
        const int n = (int)(tot / 100u);
        for (int i = threadIdx.x; i < n; i += 512) outp[i] += 0.25f;
        for (int i = threadIdx.x; i < 4 * n; i += 512) outp[(size_t)8192 * DM + i] += 0.25f;
    }
#endif

}

extern "C" void kernel_launch(void* const* d_in, const int* in_sizes, int n_in, void* d_out, int out_size, void* d_ws, size_t ws_size, hipStream_t stream) {
    static int inited = 0; static int grid_blocks = 0;
    if (!inited) {
        hipFuncSetAttribute((const void*)mk_forward, hipFuncAttributeMaxDynamicSharedMemorySize, LDS_BYTES);
        int dev = 0, cus = 0, per_cu = 0;
        hipGetDevice(&dev); hipDeviceGetAttribute(&cus, hipDeviceAttributeMultiprocessorCount, dev);
        hipOccupancyMaxActiveBlocksPerMultiprocessor(&per_cu, mk_forward, 512, LDS_BYTES);
        if (per_cu < 1) per_cu = 1;
        grid_blocks = cus * 1;
        if (ws_size < WS_END) fprintf(stderr, "kernel_launch: workspace too small: %zu < %zu\n", ws_size, (size_t)WS_END);
        inited = 1;
    }
    Params p{};
    const float* const* in = (const float* const*)d_in;
    p.x_in[0] = in[0]; p.x_in[1] = in[1]; p.mem_in[0] = in[2]; p.mem_in[1] = in[3];
    p.mix_norm = in[4]; p.w_in = in[5]; p.q_norm = in[6]; p.w_uq = in[7]; p.kv_norm = in[8]; p.w_ukv = in[9]; p.lb_logits = in[10]; p.out_norm = in[11]; p.w_out = in[12];
    p.xattn_norm = in[13]; p.mem_norm = in[14]; p.w_xq = in[15]; p.w_xk = in[16]; p.w_xv = in[17]; p.w_xo = in[18]; p.ffn_norm = in[19]; p.w_ffn1 = in[20]; p.w_ffn2 = in[21]; p.final_norm = in[22];
    p.out = (float*)d_out; p.ws = (char*)d_ws;
#if MK_ONE_LAUNCH
    hipMemsetAsync((char*)d_ws + OFF_BAR, 0, 16384, stream);
    int lo = 0, hi = N_PHASES;
    void* args[] = {&p, &lo, &hi};
    hipError_t e = hipLaunchCooperativeKernel((const void*)mk_forward, dim3(grid_blocks), dim3(512), args, LDS_BYTES, stream);
    if (e != hipSuccess) fprintf(stderr, "cooperative launch failed: %s\n", hipGetErrorString(e));
#else
    for (int ph = 0; ph < N_PHASES; ++ph) hipLaunchKernelGGL(mk_forward, dim3(grid_blocks), dim3(512), LDS_BYTES, stream, p, ph, ph + 1);
#endif
}
```
